# Optimizing an MI355X kernel written in HIP

```python
import math
import jax
import jax.numpy as jnp
from jax import lax
import numpy as np

D_MODEL = 2048
BATCH = 4
SEQ = 2048
DEPTH = 2

GRID_W = 64
CTX_LEN = 256
EPS = 1e-6
SHORT_K = 3
HY_D = 1024
HY_EMB = 33
HY_HID = 64
HY_FAST_DECAY = 0.3
HY_SLOW_DECAY = 1.5
HY_DECAY_TARGET = 1e-2
ML_H = 8
ML_DH = 128
ML_D = ML_H * ML_DH
ML_CHUNK = 128
AB_IN = 3 * HY_D + 4 * ML_D + 4 * ML_H
SSD_H = 16
SSD_P = 64
SSD_D = SSD_H * SSD_P
SSD_G = 2
SSD_N = 128
SSD_CHUNK = 128
SSD_XBC = SSD_D + 2 * SSD_G * SSD_N
S5_W = 512
S5_GS = 16
S5_G = S5_W // S5_GS
S5_P = 64
CD_IN = SSD_D + SSD_XBC + 2 * SSD_H + S5_W
FFN_F = 5632
N_EXPERTS = 8
TOP_K = 2
EXPERT_F = 5632

kernel_name = 'hybrid_hyena_mlstm_ssd_s5_moe_prefix_dit'


def _cuts(*widths):
    out, acc = [], 0
    for w in widths:
        acc += w
        out.append(acc)
    return out


def rmsnorm(x, w=None):
    xf = x.astype(jnp.float32)
    y = xf * lax.rsqrt(jnp.mean(xf * xf, axis=-1, keepdims=True) + EPS)
    if w is not None:
        y = y * w.astype(jnp.float32)
    return y.astype(x.dtype)


def modulate(x, shift, scale):
    return rmsnorm(x) * (1 + scale) + shift


def short_conv(u, w, b, rows):
    bsz, L, ch = u.shape
    pad = SHORT_K // 2
    seg = u[:, None] if rows is None else u.reshape(bsz, rows, L // rows, ch)
    n = seg.shape[2]
    sp = jnp.pad(seg, ((0, 0), (0, 0), (pad, pad), (0, 0)))
    y = b + sp[:, :, 0:n] * w[0]
    for j in range(1, SHORT_K):
        y = y + sp[:, :, j:j + n] * w[j]
    return y.reshape(bsz, L, ch)


def swiglu(h, w_gu, w_down):
    g, u = jnp.split(h @ w_gu, 2, axis=-1)
    return (jax.nn.silu(g) * u) @ w_down


def moe_swiglu(h, w_router, w_gu, w_down):
    bsz, L, d = h.shape
    t = h.reshape(bsz * L, d)
    logits = (t @ w_router).astype(jnp.float32)
    top_val, top_idx = lax.top_k(logits, TOP_K)
    probs = jax.nn.softmax(top_val, axis=-1)
    comb = jnp.sum(jax.nn.one_hot(top_idx, N_EXPERTS, dtype=jnp.float32) * probs[..., None], axis=1)
    out = jnp.zeros_like(t)
    for e in range(N_EXPERTS):
        out = out + comb[:, e:e + 1].astype(t.dtype) * swiglu(t, w_gu[e], w_down[e])
    return out.reshape(bsz, L, d)


def flip_seq(tree):
    return jax.tree_util.tree_map(lambda a: jnp.flip(a, axis=1), tree)


def prefix_bidir(scan_fn, ctx_f, lat_f, par_f, ctx_b, lat_b, par_b, state0):
    yc_f, s_f = scan_fn(ctx_f, par_f, state0)
    yl_f, _ = scan_fn(lat_f, par_f, s_f)
    yc_b, s_b = scan_fn(flip_seq(ctx_b), par_b, state0)
    yl_b, _ = scan_fn(flip_seq(lat_b), par_b, s_b)
    merge = lambda a, b: a + jnp.flip(b, axis=1)
    return (jax.tree_util.tree_map(merge, yc_f, yc_b), jax.tree_util.tree_map(merge, yl_f, yl_b))


def hyena_filter(L, w1, b1, w2, b2, w3, freq):
    w1, b1, w2, b2, w3, freq = (a.astype(jnp.float32) for a in (w1, b1, w2, b2, w3, freq))
    pos = jnp.arange(L, dtype=jnp.float32)
    t = pos / max(L - 1, 1)
    n_bands = (HY_EMB - 1) // 2
    bands = jnp.linspace(1e-4, n_bands - 1, n_bands, dtype=jnp.float32)
    ang = (2 * math.pi / L) * pos[:, None] * bands[None, :]
    feats = jnp.concatenate([t[:, None], jnp.cos(ang), -jnp.sin(ang)], axis=-1)
    h = jnp.sin(freq[0] * (feats @ w1 + b1))
    h = jnp.sin(freq[1] * (h @ w2 + b2))
    h = (h @ w3).reshape(L, 2, HY_D)
    deltas = jnp.abs(jnp.linspace(math.log(HY_DECAY_TARGET) / HY_SLOW_DECAY, math.log(HY_DECAY_TARGET) / HY_FAST_DECAY, HY_D, dtype=jnp.float32))
    h = h * jnp.exp(-t[:, None, None] * deltas)
    h_f, h_b = h[:, 0], h[:, 1]
    l1 = jnp.sum(jnp.abs(h_f), axis=0) + jnp.sum(jnp.abs(h_b[1:]), axis=0)
    return h_f / l1, h_b / l1


def bidir_long_conv(u, h_f, h_b, bias):
    L, ch = h_f.shape
    k = jnp.concatenate([h_f, jnp.zeros((1, ch), h_f.dtype), h_b[:0:-1]], axis=0)
    y = jnp.fft.irfft(jnp.fft.rfft(u, n=2 * L, axis=1) * jnp.fft.rfft(k, axis=0)[None], n=2 * L, axis=1)[:, :L]
    return y + bias * u


def hyena_mixer(proj, conv_w, conv_b, filt, bias, rows):
    u = short_conv(proj, conv_w, conv_b, rows).astype(jnp.float32)
    x0, x1, v = jnp.split(u, 3, axis=-1)
    h_f, h_b = hyena_filter(proj.shape[1], *filt)
    y = x0 * bidir_long_conv(x1 * v, h_f, h_b, bias.astype(jnp.float32))
    return y.astype(proj.dtype)


def mlstm_chunk_scan(seq, gate_bias, state0):
    q, k, v, i_pre, f_pre = seq
    bsz, L, H, dh = q.shape
    nc = L // ML_CHUNK
    gate_bias = gate_bias.astype(jnp.float32)

    def chunks(a):
        return jnp.moveaxis(a.reshape(bsz, nc, ML_CHUNK, H, *a.shape[3:]), 3, 1)

    ig = chunks(i_pre + gate_bias[0])
    lf = chunks(jax.nn.log_sigmoid(f_pre + gate_bias[1]))
    q, k, v = chunks(q) * ML_DH ** -0.5, chunks(k), chunks(v)
    bcum = jnp.cumsum(lf, axis=-1)
    g = bcum[..., -1]
    a = g[..., None] - bcum + ig
    m_loc = jnp.max(a, axis=-1)
    w_loc = jnp.exp(a - m_loc[..., None])
    c_loc = jnp.einsum('bhcs,bhcsk,bhcsv->bhckv', w_loc, k, v)
    n_loc = jnp.einsum('bhcs,bhcsk->bhck', w_loc, k)

    def step(carry, inp):
        c_prev, n_prev, m_prev = carry
        cl, nl, ml, gc = inp
        m_new = jnp.maximum(gc + m_prev, ml)
        s_prev = jnp.exp(gc + m_prev - m_new)
        s_loc = jnp.exp(ml - m_new)
        new = (s_prev[..., None, None] * c_prev + s_loc[..., None, None] * cl,
               s_prev[..., None] * n_prev + s_loc[..., None] * nl, m_new)
        return new, carry

    xs = (jnp.moveaxis(c_loc, 2, 0), jnp.moveaxis(n_loc, 2, 0), jnp.moveaxis(m_loc, 2, 0), jnp.moveaxis(g, 2, 0))
    state_T, (c_in, n_in, m_in) = lax.scan(step, state0, xs)
    c_in, n_in, m_in = jnp.moveaxis(c_in, 0, 2), jnp.moveaxis(n_in, 0, 2), jnp.moveaxis(m_in, 0, 2)
    lower = jnp.tril(jnp.ones((ML_CHUNK, ML_CHUNK), dtype=bool))
    dmat = jnp.where(lower, bcum[..., :, None] - bcum[..., None, :] + ig[..., None, :], -jnp.inf)
    m_inter = bcum + m_in[..., None]
    m_t = jnp.maximum(jnp.max(dmat, axis=-1), m_inter)
    s = jnp.einsum('bhctk,bhcsk->bhcts', q, k) * jnp.exp(dmat - m_t[..., None])
    w_inter = jnp.exp(m_inter - m_t)
    num = jnp.einsum('bhcts,bhcsv->bhctv', s, v) + w_inter[..., None] * jnp.einsum('bhctk,bhckv->bhctv', q, c_in)
    den = jnp.sum(s, axis=-1) + w_inter * jnp.einsum('bhctk,bhck->bhct', q, n_in)
    h = num / jnp.maximum(jnp.abs(den), jnp.exp(-m_t))[..., None]
    return jnp.moveaxis(h, 1, 3).reshape(bsz, L, H, dh), state_T


def head_norm(h, w):
    mu = jnp.mean(h, axis=-1, keepdims=True)
    var = jnp.mean(jnp.square(h - mu), axis=-1, keepdims=True)
    y = ((h - mu) * lax.rsqrt(var + EPS)).reshape(h.shape[0], h.shape[1], -1)
    return y * w.astype(jnp.float32)


def mlstm_inputs(qk_cols, v_cols, gate_cols, conv_w, conv_b, rows):
    bsz, L, _ = v_cols.shape
    qk = jax.nn.silu(short_conv(qk_cols, conv_w, conv_b, rows).astype(jnp.float32)).reshape(bsz, L, 2, ML_H, ML_DH)
    v = v_cols.astype(jnp.float32).reshape(bsz, L, ML_H, ML_DH)
    g = gate_cols.astype(jnp.float32).reshape(bsz, L, 4, ML_H)
    q, k = qk[:, :, 0], qk[:, :, 1]
    return (q, k, v, g[:, :, 0], g[:, :, 1]), (q, k, v, g[:, :, 2], g[:, :, 3])


def mixer_ab(hc, hl, rows, need_ctx, w_in, hy_conv_w, hy_conv_b, hy_filt, hy_bias,
             ml_conv_w, ml_conv_b, ml_gate_b, ml_norm_w, w_out):
    cuts = _cuts(3 * HY_D, 2 * ML_D, ML_D, ML_D)
    pc = jnp.split(hc @ w_in, cuts, axis=-1)
    pl = jnp.split(hl @ w_in, cuts, axis=-1)
    seq_cf, seq_cb = mlstm_inputs(pc[1], pc[2], pc[4], ml_conv_w, ml_conv_b, None)
    seq_lf, seq_lb = mlstm_inputs(pl[1], pl[2], pl[4], ml_conv_w, ml_conv_b, rows)
    bsz = hl.shape[0]
    state0 = (jnp.zeros((bsz, ML_H, ML_DH, ML_DH), jnp.float32), jnp.zeros((bsz, ML_H, ML_DH), jnp.float32),
              jnp.zeros((bsz, ML_H), jnp.float32))
    mc, ml = prefix_bidir(mlstm_chunk_scan, seq_cf, seq_lf, ml_gate_b[:2], seq_cb, seq_lb, ml_gate_b[2:], state0)

    def finish(p, m, r):
        yh = hyena_mixer(p[0], hy_conv_w, hy_conv_b, hy_filt, hy_bias, r)
        ym = head_norm(m, ml_norm_w) * jax.nn.sigmoid(p[3].astype(jnp.float32))
        return jnp.concatenate([yh, ym.astype(yh.dtype)], axis=-1) @ w_out

    yl = finish(pl, ml, rows)
    yc = finish(pc, mc, None) if need_ctx else None
    return yc, yl


def ssd_chunk_scan(seq, par, h0):
    xs, bm, cm, dt_raw = seq
    a_log, dt_bias = par
    bsz, L, H, P = xs.shape
    q_len = SSD_CHUNK
    nc = L // q_len
    r = H // SSD_G
    dt = jax.nn.softplus(dt_raw + dt_bias.astype(jnp.float32))
    la = dt * (-jnp.exp(a_log.astype(jnp.float32)))
    xc = xs.reshape(bsz, nc, q_len, SSD_G, r, P)
    dtc = dt.reshape(bsz, nc, q_len, SSD_G, r)
    acum = jnp.cumsum(la.reshape(bsz, nc, q_len, SSD_G, r), axis=2)
    bc = bm.reshape(bsz, nc, q_len, SSD_G, SSD_N)
    cc = cm.reshape(bsz, nc, q_len, SSD_G, SSD_N)
    lower = jnp.tril(jnp.ones((q_len, q_len), dtype=bool))[:, :, None, None]
    seg = acum[:, :, :, None] - acum[:, :, None, :]
    decay = jnp.exp(jnp.where(lower, seg, -jnp.inf))
    cb = jnp.einsum('bctgn,bcsgn->bctsg', cc, bc)
    y_diag = jnp.einsum('bctsgr,bcsgrp->bctgrp', cb[..., None] * decay * dtc[:, :, None], xc)
    w_end = jnp.exp(acum[:, :, -1:] - acum) * dtc
    states = jnp.einsum('bcsgn,bcsgr,bcsgrp->bcgrpn', bc, w_end, xc)
    chunk_decay = jnp.exp(acum[:, :, -1])

    def step(h, inp):
        st, dc = inp
        return dc[..., None, None] * h + st, h

    h_T, h_in = lax.scan(step, h0.reshape(bsz, SSD_G, r, P, SSD_N),
                         (jnp.moveaxis(states, 1, 0), jnp.moveaxis(chunk_decay, 1, 0)))
    h_in = jnp.moveaxis(h_in, 0, 1)
    y_off = jnp.einsum('bctgn,bcgrpn->bctgrp', cc, h_in) * jnp.exp(acum)[..., None]
    y = (y_diag + y_off).reshape(bsz, L, H, P)
    return y, h_T.reshape(bsz, H, P, SSD_N)


def cplx_affine_combine(e1, e2):
    a1r, a1i, b1r, b1i = e1
    a2r, a2i, b2r, b2i = e2
    return (a2r * a1r - a2i * a1i, a2r * a1i + a2i * a1r,
            a2r * b1r - a2i * b1i + b2r, a2r * b1i + a2i * b1r + b2i)


def s5_scan(seq, par, s0):
    (u,) = seq
    lam_re, lam_im, log_dt, b_re, b_im = (p.astype(jnp.float32) for p in par)
    dt = jnp.exp(log_dt)[:, None]
    mag = jnp.exp(lam_re * dt)
    lb_re, lb_im = mag * jnp.cos(lam_im * dt), mag * jnp.sin(lam_im * dt)
    den = lam_re * lam_re + lam_im * lam_im
    f_re = ((lb_re - 1) * lam_re + lb_im * lam_im) / den
    f_im = (lb_im * lam_re - (lb_re - 1) * lam_im) / den
    bb_re = f_re[..., None] * b_re - f_im[..., None] * b_im
    bb_im = f_re[..., None] * b_im + f_im[..., None] * b_re
    bu_re = jnp.einsum('gpi,blgi->blgp', bb_re, u)
    bu_im = jnp.einsum('gpi,blgi->blgp', bb_im, u)
    s_re, s_im = s0
    bu_re = bu_re.at[:, 0].add(lb_re * s_re - lb_im * s_im)
    bu_im = bu_im.at[:, 0].add(lb_re * s_im + lb_im * s_re)
    a_re = jnp.broadcast_to(lb_re, bu_re.shape)
    a_im = jnp.broadcast_to(lb_im, bu_im.shape)
    _, _, x_re, x_im = lax.associative_scan(cplx_affine_combine, (a_re, a_im, bu_re, bu_im), axis=1)
    return (x_re, x_im), (x_re[:, -1], x_im[:, -1])


def mixer_cd(hc, hl, rows, need_ctx, w_in, ssd_conv_w, ssd_conv_b, ssd_A_log, ssd_dt_bias, ssd_D, ssd_norm_w,
             s5_lam_re, s5_lam_im, s5_log_dt, s5_B_re, s5_B_im, s5_C_re, s5_C_im, s5_D, s5_glu_w, w_out):
    cuts = _cuts(SSD_D, SSD_XBC, 2 * SSD_H)
    pc = jnp.split(hc @ w_in, cuts, axis=-1)
    pl = jnp.split(hl @ w_in, cuts, axis=-1)

    def ssd_inputs(p, r):
        xbc = jax.nn.silu(short_conv(p[1], ssd_conv_w, ssd_conv_b, r).astype(jnp.float32))
        bsz, L, _ = xbc.shape
        xs, bm, cm = jnp.split(xbc, _cuts(SSD_D, SSD_G * SSD_N), axis=-1)
        xs = xs.reshape(bsz, L, SSD_H, SSD_P)
        bm = bm.reshape(bsz, L, SSD_G, SSD_N)
        cm = cm.reshape(bsz, L, SSD_G, SSD_N)
        dt = p[2].astype(jnp.float32).reshape(bsz, L, 2, SSD_H)
        return xs, (xs, bm, cm, dt[:, :, 0]), (xs, bm, cm, dt[:, :, 1])

    xs_c, sc_f, sc_b = ssd_inputs(pc, None)
    xs_l, sl_f, sl_b = ssd_inputs(pl, rows)
    bsz = hl.shape[0]
    h0 = jnp.zeros((bsz, SSD_H, SSD_P, SSD_N), jnp.float32)
    yc_ssd, yl_ssd = prefix_bidir(ssd_chunk_scan, sc_f, sl_f, (ssd_A_log[0], ssd_dt_bias[0]),
                                  sc_b, sl_b, (ssd_A_log[1], ssd_dt_bias[1]), h0)

    def s5_in(p):
        b_, L, _ = p[3].shape
        return (p[3].astype(jnp.float32).reshape(b_, L, S5_G, S5_GS),)

    uc, ul = s5_in(pc), s5_in(pl)
    s5_par = lambda d: (s5_lam_re[d], s5_lam_im[d], s5_log_dt[d], s5_B_re, s5_B_im)
    s0 = (jnp.zeros((bsz, S5_G, S5_P), jnp.float32), jnp.zeros((bsz, S5_G, S5_P), jnp.float32))
    stc, stl = prefix_bidir(s5_scan, uc, ul, s5_par(0), uc, ul, s5_par(1), s0)

    def finish(p, y_ssd, xs, st, u):
        b_, L = y_ssd.shape[0], y_ssd.shape[1]
        y = (y_ssd + ssd_D.astype(jnp.float32)[:, None] * xs).reshape(b_, L, SSD_D)
        y = rmsnorm(y * jax.nn.silu(p[0].astype(jnp.float32)), ssd_norm_w)
        x_re, x_im = st
        s = (jnp.einsum('gip,blgp->blgi', s5_C_re.astype(jnp.float32), x_re)
             - jnp.einsum('gip,blgp->blgi', s5_C_im.astype(jnp.float32), x_im))
        s = s.reshape(b_, L, S5_W) + s5_D.astype(jnp.float32) * u[0].reshape(b_, L, S5_W)
        s = jax.nn.gelu(s, approximate=False)
        val, gate = jnp.split(s @ s5_glu_w.astype(jnp.float32), 2, axis=-1)
        ys5 = val * jax.nn.sigmoid(gate)
        return jnp.concatenate([y, ys5], axis=-1).astype(hl.dtype) @ w_out

    yl = finish(pl, yl_ssd, xs_l, stl, ul)
    yc = finish(pc, yc_ssd, xs_c, stc, uc) if need_ctx else None
    return yc, yl


def setup_inputs(seed: int = 0) -> dict:
    key = jax.random.key(seed)
    keys = list(jax.random.split(key, 48))
    n_even = (DEPTH + 1) // 2
    n_odd = DEPTH // 2
    f32 = jnp.float32

    def nrm(shape, scale):
        return scale * jax.random.normal(keys.pop(), shape, f32)

    def unif(shape, lo, hi):
        return jax.random.uniform(keys.pop(), shape, f32, lo, hi)

    D = D_MODEL
    i_bias = nrm((n_even, 2, ML_H), 0.1)
    f_bias = jnp.linspace(3.0, 6.0, ML_H, dtype=f32) + nrm((n_even, 2, ML_H), 0.1)
    dt0 = jnp.exp(unif((n_odd, 2, SSD_H), math.log(1e-3), math.log(1e-1)))
    return {
        'x': nrm((BATCH, SEQ, D), 1.0),
        'c': nrm((BATCH, D), 1.0),
        'ctx': nrm((BATCH, CTX_LEN, D), 1.0),
        'c_ctx': nrm((D,), 1.0),
        'ada_w': nrm((DEPTH, D, 6 * D), D ** -0.5),
        'ada_b': nrm((DEPTH, 6 * D), 0.02),
        'ab_w_in': nrm((n_even, D, AB_IN), D ** -0.5),
        'hy_conv_w': nrm((n_even, SHORT_K, 3 * HY_D), SHORT_K ** -0.5),
        'hy_conv_b': nrm((n_even, 3 * HY_D), 0.02),
        'hy_filt_w1': nrm((n_even, HY_EMB, HY_HID), HY_EMB ** -0.5),
        'hy_filt_b1': nrm((n_even, HY_HID), 0.02),
        'hy_filt_w2': nrm((n_even, HY_HID, HY_HID), HY_HID ** -0.5),
        'hy_filt_b2': nrm((n_even, HY_HID), 0.02),
        'hy_filt_w3': nrm((n_even, HY_HID, 2 * HY_D), HY_HID ** -0.5),
        'hy_filt_freq': 1.0 + nrm((n_even, 2, HY_HID), 0.1),
        'hy_bias': nrm((n_even, HY_D), 0.5),
        'ml_conv_w': nrm((n_even, SHORT_K, 2 * ML_D), SHORT_K ** -0.5),
        'ml_conv_b': nrm((n_even, 2 * ML_D), 0.02),
        'ml_gate_b': jnp.stack([i_bias[:, 0], f_bias[:, 0], i_bias[:, 1], f_bias[:, 1]], axis=1),
        'ml_norm_w': 1.0 + nrm((n_even, ML_D), 0.1),
        'ab_w_out': nrm((n_even, HY_D + ML_D, D), (HY_D + ML_D) ** -0.5),
        'ffn_w_gu': nrm((n_even, D, 2 * FFN_F), D ** -0.5),
        'ffn_w_down': nrm((n_even, FFN_F, D), FFN_F ** -0.5),
        'cd_w_in': nrm((n_odd, D, CD_IN), D ** -0.5),
        'ssd_conv_w': nrm((n_odd, SHORT_K, SSD_XBC), SHORT_K ** -0.5),
        'ssd_conv_b': nrm((n_odd, SSD_XBC), 0.02),
        'ssd_A_log': jnp.log(unif((n_odd, 2, SSD_H), 1.0, 16.0)),
        'ssd_dt_bias': dt0 + jnp.log(-jnp.expm1(-dt0)),
        'ssd_D': 1.0 + nrm((n_odd, SSD_H), 0.1),
        'ssd_norm_w': 1.0 + nrm((n_odd, SSD_D), 0.1),
        's5_lam_re': -0.5 + nrm((n_odd, 2, S5_G, S5_P), 0.01),
        's5_lam_im': math.pi * jnp.arange(S5_P, dtype=f32) + nrm((n_odd, 2, S5_G, S5_P), 0.01),
        's5_log_dt': unif((n_odd, 2, S5_G), math.log(1e-3), math.log(1e-1)),
        's5_B_re': nrm((n_odd, S5_G, S5_P, S5_GS), (2 * S5_GS) ** -0.5),
        's5_B_im': nrm((n_odd, S5_G, S5_P, S5_GS), (2 * S5_GS) ** -0.5),
        's5_C_re': nrm((n_odd, S5_G, S5_GS, S5_P), S5_P ** -0.5),
        's5_C_im': nrm((n_odd, S5_G, S5_GS, S5_P), S5_P ** -0.5),
        's5_D': nrm((n_odd, S5_W), 1.0),
        's5_glu_w': nrm((n_odd, S5_W, 2 * S5_W), S5_W ** -0.5),
        'cd_w_out': nrm((n_odd, SSD_D + S5_W, D), (SSD_D + S5_W) ** -0.5),
        'moe_router': nrm((n_odd, D, N_EXPERTS), D ** -0.5),
        'moe_w_gu': nrm((n_odd, N_EXPERTS, D, 2 * EXPERT_F), D ** -0.5),
        'moe_w_down': nrm((n_odd, N_EXPERTS, EXPERT_F, D), EXPERT_F ** -0.5),
        'final_norm_w': 1.0 + nrm((D,), 0.1),
    }


def reference(x, c, ctx, c_ctx, ada_w, ada_b, ab_w_in, hy_conv_w, hy_conv_b, hy_filt_w1, hy_filt_b1,
              hy_filt_w2, hy_filt_b2, hy_filt_w3, hy_filt_freq, hy_bias, ml_conv_w, ml_conv_b, ml_gate_b,
              ml_norm_w, ab_w_out, ffn_w_gu, ffn_w_down, cd_w_in, ssd_conv_w, ssd_conv_b, ssd_A_log,
              ssd_dt_bias, ssd_D, ssd_norm_w, s5_lam_re, s5_lam_im, s5_log_dt, s5_B_re, s5_B_im, s5_C_re,
              s5_C_im, s5_D, s5_glu_w, cd_w_out, moe_router, moe_w_gu, moe_w_down, final_norm_w):
    rows = x.shape[1] // GRID_W
    xl, xc = x, ctx
    cond_l, cond_c = jax.nn.silu(c), jax.nn.silu(c_ctx)
    for layer in range(DEPTH):
        j = layer // 2
        last = layer == DEPTH - 1
        m_l = jnp.split(cond_l @ ada_w[layer] + ada_b[layer], 6, axis=-1)
        m_c = jnp.split(cond_c @ ada_w[layer] + ada_b[layer], 6, axis=-1)
        hl = modulate(xl, m_l[0][:, None], m_l[1][:, None])
        hc = modulate(xc, m_c[0], m_c[1])
        if layer % 2 == 0:
            yc, yl = mixer_ab(hc, hl, rows, not last, ab_w_in[j], hy_conv_w[j], hy_conv_b[j],
                              (hy_filt_w1[j], hy_filt_b1[j], hy_filt_w2[j], hy_filt_b2[j], hy_filt_w3[j], hy_filt_freq[j]),
                              hy_bias[j], ml_conv_w[j], ml_conv_b[j], ml_gate_b[j], ml_norm_w[j], ab_w_out[j])
            ffn = lambda h: swiglu(h, ffn_w_gu[j], ffn_w_down[j])
        else:
            yc, yl = mixer_cd(hc, hl, rows, not last, cd_w_in[j], ssd_conv_w[j], ssd_conv_b[j], ssd_A_log[j],
                              ssd_dt_bias[j], ssd_D[j], ssd_norm_w[j], s5_lam_re[j], s5_lam_im[j], s5_log_dt[j],
                              s5_B_re[j], s5_B_im[j], s5_C_re[j], s5_C_im[j], s5_D[j], s5_glu_w[j], cd_w_out[j])
            ffn = lambda h: moe_swiglu(h, moe_router[j], moe_w_gu[j], moe_w_down[j])
        xl = xl + m_l[2][:, None] * yl
        xl = xl + m_l[5][:, None] * ffn(modulate(xl, m_l[3][:, None], m_l[4][:, None]))
        if not last:
            xc = xc + m_c[2] * yc
            xc = xc + m_c[5] * ffn(modulate(xc, m_c[3], m_c[4]))
    return rmsnorm(xl, final_norm_w)
```

```cpp
#ifndef EMU
#include <hip/hip_runtime.h>
#endif
#include <stdint.h>
#include <stddef.h>
#include <math.h>
#include <stdio.h>
#include <string.h>

#ifdef CFG_SMALL
#ifndef CFG_SEQ
#define CFG_SEQ 256
#endif
constexpr int D = 256, NB = 2, SEQ = CFG_SEQ, CTX = 128, HYD = 256, MLH = 2, SSDH = 8, S5W = 256, FF = 256;
#else
constexpr int D = 2048, NB = 4, SEQ = 2048, CTX = 256, HYD = 1024, MLH = 8, SSDH = 16, S5W = 512, FF = 5632;
#endif
constexpr int GW = 64, DH = 128, MLD = MLH * DH, CH = 128;
constexpr int ML = NB * SEQ, MC = NB * CTX, MT = ML + MC, NR = NB + 1;
constexpr int NCL = SEQ / CH, NCC = CTX / CH, NCS = NCL + NCC;
constexpr int AB_MAIN = 3 * HYD + 4 * MLD, AB_SIDE = 4 * MLH, AB_IN = AB_MAIN + AB_SIDE;
constexpr int SSDP = 64, SSDD = SSDH * SSDP, SSDG = 2, SSDN = 128, XBC = SSDD + 2 * SSDG * SSDN, HPG = SSDH / SSDG;
constexpr int CD_MAIN = SSDD + XBC + S5W, CD_SIDE = 2 * SSDH, CD_IN = CD_MAIN + CD_SIDE;
constexpr int S5GS = 16, S5G = S5W / S5GS, S5P = 64;
constexpr int NE = 8, HYEMB = 33, HYHID = 64;
constexpr int YC1 = HYD + MLD, YC2 = SSDD + S5W;
constexpr int MOE_ROWS = 2 * ML + NE * 256;
constexpr float EPS = 1e-6f;
constexpr int NTHREADS = 512, NWAVES = 8;
constexpr int KSL = D / 256;
static_assert(D % 256 == 0 && ML % 256 == 0 && MT % 256 == 0 && AB_MAIN % 256 == 0 && CD_MAIN % 256 == 0 && FF % 128 == 0 && S5W % 128 == 0, "tile shapes");
static_assert(AB_SIDE <= 32 && CD_SIDE <= 32 && HPG % 4 == 0, "side widths");

typedef unsigned short bf16_t;
typedef short bf16x8 __attribute__((ext_vector_type(8)));
typedef float f32x4 __attribute__((ext_vector_type(4)));
typedef float f32x2 __attribute__((ext_vector_type(2)));
typedef float f32x16 __attribute__((ext_vector_type(16)));
typedef int i32x8 __attribute__((ext_vector_type(8)));
typedef int i32x4 __attribute__((ext_vector_type(4)));
typedef unsigned u32x4 __attribute__((ext_vector_type(4)));
typedef unsigned u32x2 __attribute__((ext_vector_type(2)));
#ifdef EMU
#define MFMA16(a, b, c) emu_mfma16(a, b, c)
#define MFMA32(a, b, c) emu_mfma32(a, b, c)
#define MFMA_F8(a, b, c) emu_mfma_f8(a, b, c)
#define MFMA_I8(a, b, c) emu_mfma_i8(a, b, c)
#define ALIGNBIT(hi, lo, sh) ((unsigned)(((((unsigned long long)(hi)) << 32) | (unsigned long long)(lo)) >> ((sh) & 31u)))
#define GLDS16(g, l) emu_glds16((const void*)(g), (void*)(l))
#define S_BARRIER() emu::syncthreads()
#define WAIT_VM(n) ((void)0)
#define WAIT_LGKM(n) ((void)0)
#define WAIT_ALL() ((void)0)
#define SCHED_BARRIER() ((void)0)
#define SETPRIO(x) ((void)0)
#define RFL(x) (x)
#define WAVE_SYNC() emu::wave_sync()
#define CFENCE() ((void)0)
#define S_SLEEP(n) emu_spin_pause()
#define FEXP(x) expf(x)
#define NTLD(p) (*(p))
#define NTST(v, p) (*(p) = (v))
#define MFMA_SETTLE() ((void)0)
#define FRCP(x) (1.0f / (x))
#define LAUNDER(x) ((void)0)
#define ATOM_LD(p) emu_atomic_ld((const unsigned*)(p))
#define ATOM_ST(p, v) emu_atomic_st((unsigned*)(p), (v))
#define ATOM_ADD(p, v) emu_atomic_add((unsigned*)(p), (v))
#define FENCE_ACQ() __atomic_thread_fence(__ATOMIC_SEQ_CST)
#define FENCE_REL() __atomic_thread_fence(__ATOMIC_SEQ_CST)
static inline unsigned cvt_pk_bf16(float lo, float hi);
#else
#define LAS __attribute__((address_space(3)))
#define MFMA16(a, b, c) __builtin_amdgcn_mfma_f32_16x16x32_bf16(a, b, c, 0, 0, 0)
#define MFMA32(a, b, c) __builtin_amdgcn_mfma_f32_32x32x16_bf16(a, b, c, 0, 0, 0)
#define MFMA_I8(a, b, c) __builtin_amdgcn_mfma_i32_16x16x64_i8(a, b, c, 0, 0, 0)
#define MFMA_F8(a, b, c) mfma_f8_inplace(a, b, c)
#define ALIGNBIT(hi, lo, sh) __builtin_amdgcn_alignbit(hi, lo, sh)
#define GLDS16(g, l) __builtin_amdgcn_global_load_lds((const unsigned*)(g), (LAS unsigned*)(l), 16, 0, 0)
#define S_BARRIER() __builtin_amdgcn_s_barrier()
#define WAIT_VM(n) asm volatile("s_waitcnt vmcnt(" #n ")" ::: "memory")
#define WAIT_LGKM(n) asm volatile("s_waitcnt lgkmcnt(" #n ")" ::: "memory")
#define WAIT_ALL() asm volatile("s_waitcnt vmcnt(0) lgkmcnt(0)" ::: "memory")
#define SCHED_BARRIER() __builtin_amdgcn_sched_barrier(0)
#define SETPRIO(x) __builtin_amdgcn_s_setprio(x)
#define RFL(x) __builtin_amdgcn_readfirstlane(x)
#define WAVE_SYNC() do { asm volatile("s_waitcnt lgkmcnt(0)" ::: "memory"); __builtin_amdgcn_wave_barrier(); } while (0)
#define CFENCE() asm volatile("" ::: "memory")
#define S_SLEEP(n) __builtin_amdgcn_s_sleep(n)
#define FEXP(x) __expf(x)
#define NTST(v, p) __builtin_nontemporal_store((v), (p))
#define NTLD(p) __builtin_nontemporal_load(p)
#define MFMA_SETTLE() asm volatile("s_nop 15\n\ts_nop 15" ::: "memory")
#define FRCP(x) __builtin_amdgcn_rcpf(x)
#define LAUNDER(x) asm volatile("" : "+v"(x))
#define ATOM_LD(p) __hip_atomic_load((p), __ATOMIC_RELAXED, __HIP_MEMORY_SCOPE_AGENT)
#define ATOM_ST(p, v) __hip_atomic_store((p), (v), __ATOMIC_RELAXED, __HIP_MEMORY_SCOPE_AGENT)
#define ATOM_ADD(p, v) __hip_atomic_fetch_add((p), (v), __ATOMIC_RELAXED, __HIP_MEMORY_SCOPE_AGENT)
#define FENCE_ACQ() __builtin_amdgcn_fence(__ATOMIC_ACQUIRE, "agent")
#define FENCE_REL() __builtin_amdgcn_fence(__ATOMIC_RELEASE, "agent")
#endif

__device__ __forceinline__ unsigned f2bf(float f) { unsigned u = __float_as_uint(f); return (u + 0x7fffu + ((u >> 16) & 1u)) >> 16; }
__device__ __forceinline__ float bf2f(unsigned h) { return __uint_as_float(h << 16); }
__device__ __forceinline__ unsigned pk2(float lo, float hi) { return f2bf(lo) | (f2bf(hi) << 16); }
#ifdef EMU
static inline unsigned cvt_pk_bf16(float lo, float hi) { return pk2(lo, hi); }
#else
__device__ __forceinline__ unsigned cvt_pk_bf16(float lo, float hi) { unsigned r; asm volatile("v_cvt_pk_bf16_f32 %0, %1, %2" : "=v"(r) : "v"(lo), "v"(hi)); return r; }
#endif
#ifdef EMU
static inline unsigned emu_f2e4m3(float f) { const unsigned s = f < 0.f ? 0x80u : 0u; float a = fabsf(f); if (!(a == a)) return 0x7fu; if (a > 448.f) a = 448.f;
    if (a < 0.015625f) { const unsigned man = (unsigned)rintf(a * 512.0f); return s | man; }
    int e; (void)frexpf(a, &e); e -= 1; unsigned man = (unsigned)rintf((a / ldexpf(1.0f, e) - 1.0f) * 8.0f); if (man == 8u) { man = 0u; e += 1; }
    unsigned E = (unsigned)(e + 7); if (E > 15u || (E == 15u && man == 7u)) { E = 15u; man = 6u; } return s | (E << 3) | man; }
static inline float emu_e4m32f(unsigned b) { const float s = (b & 0x80u) ? -1.f : 1.f; const unsigned E = (b >> 3) & 15u, man = b & 7u; if (E == 0) return s * ldexpf((float)man, -9); return s * ldexpf(1.0f + (float)man * 0.125f, (int)E - 7); }
static inline unsigned cvt_pk_fp8x4(float a, float b, float c, float d) { return emu_f2e4m3(a) | (emu_f2e4m3(b) << 8) | (emu_f2e4m3(c) << 16) | (emu_f2e4m3(d) << 24); }
static inline i32x4 emu_mfma_i8(i32x4 a, i32x4 b, i32x4 c) {
    emu::Block* blk = emu::tl_blk; emu::Wave* w = &blk->waves[blk->cur >> 6]; int lane = blk->cur & 63;
    memcpy(w->buf[lane], &a, 16); memcpy(w->buf[lane] + 16, &b, 16); emu::wave_sync();
    const int j = lane & 15; i32x4 d = c;
    for (int r = 0; r < 4; ++r) { const int i = 4 * (lane >> 4) + r; int s = 0;
        for (int kb = 0; kb < 4; ++kb) for (int t = 0; t < 16; ++t) s += (int)(signed char)w->buf[i + 16 * kb][t] * (int)(signed char)w->buf[j + 16 * kb][16 + t];
        d[r] += s; }
    emu::wave_sync(); return d;
}
static inline f32x4 emu_mfma_f8(i32x8 a, i32x8 b, f32x4 c) {
    emu::Block* blk = emu::tl_blk; emu::Wave* w = &blk->waves[blk->cur >> 6]; int lane = blk->cur & 63;
    memcpy(w->buf[lane], &a, 32); memcpy(w->buf[lane] + 32, &b, 32); emu::wave_sync();
    const int j = lane & 15; f32x4 d = c;
    for (int r = 0; r < 4; ++r) { const int i = 4 * (lane >> 4) + r; float s = 0.f;
        for (int kb = 0; kb < 4; ++kb) for (int t = 0; t < 32; ++t) s += emu_e4m32f(w->buf[i + 16 * kb][t]) * emu_e4m32f(w->buf[j + 16 * kb][32 + t]);
        d[r] += s; }
    emu::wave_sync(); return d;
}
#else
__device__ __forceinline__ unsigned cvt_pk_fp8x4(float a, float b, float c, float d) {
    a = fminf(fmaxf(a, -448.f), 448.f); b = fminf(fmaxf(b, -448.f), 448.f); c = fminf(fmaxf(c, -448.f), 448.f); d = fminf(fmaxf(d, -448.f), 448.f);
    int p = __builtin_amdgcn_cvt_pk_fp8_f32(a, b, 0, false); p = __builtin_amdgcn_cvt_pk_fp8_f32(c, d, p, true); return (unsigned)p; }
#endif
#ifndef EMU
__device__ __forceinline__ f32x4 mfma_f8_inplace(i32x8 a, i32x8 b, f32x4 c) {
    asm volatile("v_mfma_scale_f32_16x16x128_f8f6f4 %0, %1, %2, %0, %3, %3 op_sel_hi:[0,0,0]" : "+v"(c) : "v"(a), "v"(b), "v"(0x7F7F7F7F));
    return c; }
#endif
constexpr float W8SCALE = 64.0f, W8INV = 1.0f / 64.0f;
constexpr int KSF8 = ((FF / 128) % 4 == 0) ? 2 : 1;
__device__ __forceinline__ float wave_max(float v) { v = fmaxf(v, __shfl_xor(v, 1)); v = fmaxf(v, __shfl_xor(v, 2)); v = fmaxf(v, __shfl_xor(v, 4)); v = fmaxf(v, __shfl_xor(v, 8)); v = fmaxf(v, __shfl_xor(v, 16)); v = fmaxf(v, __shfl_xor(v, 32)); return v; }
__device__ __forceinline__ unsigned pk_i8x4(float a, float b, float c, float d) { return ((unsigned)(int)rintf(a) & 0xffu) | (((unsigned)(int)rintf(b) & 0xffu) << 8) | (((unsigned)(int)rintf(c) & 0xffu) << 16) | (((unsigned)(int)rintf(d) & 0xffu) << 24); }
__device__ __forceinline__ float wave_sum(float v) { v += __shfl_xor(v, 1); v += __shfl_xor(v, 2); v += __shfl_xor(v, 4); v += __shfl_xor(v, 8); v += __shfl_xor(v, 16); v += __shfl_xor(v, 32); return v; }
__device__ __forceinline__ float siluf(float x) { return x * FRCP(1.0f + FEXP(-x)); }
__device__ __forceinline__ float sigmoidf_(float x) { return FRCP(1.0f + FEXP(-x)); }
__device__ __forceinline__ float logsigmoidf_(float x) { return x < 0.f ? x - log1pf(expf(x)) : -log1pf(expf(-x)); }
__device__ __forceinline__ float softplusf_(float x) { return x > 0.f ? x + log1pf(expf(-x)) : log1pf(expf(x)); }
__device__ __forceinline__ void unpack8(const u32x4 w, float (&f)[8]) {
    f[0] = bf2f(w.x & 0xffffu); f[1] = bf2f(w.x >> 16); f[2] = bf2f(w.y & 0xffffu); f[3] = bf2f(w.y >> 16);
    f[4] = bf2f(w.z & 0xffffu); f[5] = bf2f(w.z >> 16); f[6] = bf2f(w.w & 0xffffu); f[7] = bf2f(w.w >> 16);
}

constexpr size_t al(size_t x) { return (x + 4095) & ~(size_t)4095; }
constexpr size_t WS_CTL = 0, CTL_BYTES = 1u << 20;
constexpr size_t WS_W_ABIN = WS_CTL + CTL_BYTES;
constexpr size_t WS_W_ABSIDE = WS_W_ABIN + al((size_t)AB_MAIN * D * 2);
constexpr size_t WS_W_ABOUT = WS_W_ABSIDE + al((size_t)32 * D * 2);
constexpr size_t WS_W_GU = WS_W_ABOUT + al((size_t)D * YC1 * 2);
constexpr size_t WS_W_DN = WS_W_GU + al((size_t)2 * FF * D * 2);
constexpr size_t WS_W_CDIN = WS_W_DN + al((size_t)D * FF * 2);
constexpr size_t WS_W_CDSIDE = WS_W_CDIN + al((size_t)CD_MAIN * D * 2);
constexpr size_t WS_W_GLU = WS_W_CDSIDE + al((size_t)32 * D * 2);
constexpr size_t WS_W_CDOUT = WS_W_GLU + al((size_t)2 * S5W * S5W * 2);
constexpr size_t WS_W_MGU = WS_W_CDOUT + al((size_t)D * YC2 * 2);
constexpr size_t WS_W_MDN = WS_W_MGU + al((size_t)NE * 2 * FF * D * 2);
constexpr size_t WS_MODP = WS_W_MDN + al((size_t)NE * D * FF * 2);
constexpr size_t WS_MOD = WS_MODP + al((size_t)2 * KSL * NR * 6 * D * 4);
constexpr size_t WS_FILT0 = WS_MOD + al((size_t)2 * NR * 6 * D * 4);
constexpr size_t WS_FILT1 = WS_FILT0 + al((size_t)HYD * 2 * SEQ * 4);
constexpr size_t WS_L1P = WS_FILT1 + al((size_t)HYD * 2 * CTX * 4);
constexpr size_t WS_L1 = WS_L1P + al((size_t)((SEQ + CTX) / 8) * 2 * HYD * 4);
constexpr size_t WS_S5PAR = WS_L1 + al((size_t)2 * HYD * 4);
constexpr size_t WS_XL = WS_S5PAR + al((size_t)2 * S5G * S5P * 36 * 4);
constexpr size_t WS_A = WS_XL + al((size_t)MT * D * 4);
constexpr size_t WS_P = WS_A + al((size_t)MT * D * 2);
constexpr size_t WS_SIDE = WS_P + al((size_t)MT * (AB_MAIN > CD_MAIN ? AB_MAIN : CD_MAIN) * 2);
constexpr size_t WS_YCAT = WS_SIDE + al((size_t)MT * 32 * 4);
constexpr size_t WS_H = WS_YCAT + al((size_t)MT * YC1 * 2);
constexpr size_t WS_AS = WS_H + al((size_t)MOE_ROWS * FF * 2);
constexpr size_t WS_YSLOT = WS_AS + al((size_t)MOE_ROWS * D * 2);
constexpr int MLST_CT = DH * DH / 2;
constexpr int MLST_STRIDE = MLST_CT + DH + 64;
constexpr size_t WS_MLST = WS_YSLOT + al((size_t)2 * ML * D * 4);
constexpr int SSD_HF = SSDP * SSDN / 2;
constexpr int SSDST_STRIDE = SSD_HF + 64;
constexpr size_t WS_SSDST = WS_MLST + al((size_t)2 * NB * MLH * NCS * MLST_STRIDE * 4);
constexpr size_t WS_S5ST = WS_SSDST + al((size_t)2 * NB * SSDH * NCS * SSDST_STRIDE * 4);
constexpr size_t WS_YPRE = WS_S5ST + al((size_t)2 * NB * NCS * S5G * S5P * 2 * 4);
constexpr size_t WS_SSQ = WS_YPRE + al((size_t)ML * SSDD * 4);
constexpr size_t WS_S5G = WS_SSQ + al((size_t)ML * 4 * 4);
constexpr size_t WS_ROUTE = WS_S5G + al((size_t)ML * S5W * 2);
constexpr size_t WS_RPROB = WS_ROUTE + al((size_t)ML * 4 * 4);
constexpr size_t WS_ROWMAP = WS_RPROB + al((size_t)ML * 2 * 4);
constexpr size_t WS_ROWP = WS_ROWMAP + al((size_t)MOE_ROWS * 4);
constexpr size_t WS_PH = WS_ROWP + al((size_t)MOE_ROWS * 4);
constexpr int KSPLIT = 4;
constexpr int KS7 = ((HYD + MLD) / 64) % (2 * KSPLIT) == 0 ? KSPLIT : 2, KS10 = (FF / 128) % (2 * KSPLIT) == 0 ? KSPLIT : ((FF / 128) % 4 == 0 ? 2 : 1);
constexpr size_t WS_PART = WS_PH + al((size_t)3 * HYD * MT * 2);
constexpr int PM_ROWS = 16 * 256;
constexpr size_t WS_PARTM = WS_PART + al((size_t)KSPLIT * MC * D * 4);
constexpr size_t WS_XACT = WS_PARTM + al((size_t)4 * PM_ROWS * D * 4);
constexpr size_t WS_SB_GU = WS_XACT + al((size_t)MT * XBC * 2);
constexpr size_t WS_A8 = WS_SB_GU + al((size_t)2 * FF * 4);
constexpr size_t WS_SA8 = WS_A8 + al((size_t)MT * D);
constexpr size_t WS_END = WS_SA8 + al((size_t)MT * 4);
constexpr int CW_BAR = 4096;
constexpr int CW_CNT = 16384;
constexpr int CW_QNEXT = 20480;
constexpr int CW_ARRIVE = 24576;

#ifdef EMU
struct XcdBarrier { unsigned* bar; unsigned gen; };
static inline XcdBarrier xcd_barrier_post(unsigned* bar, volatile unsigned*) { XcdBarrier b; b.bar = bar; b.gen = 0; return b; }
static inline void xcd_barrier(XcdBarrier& b) {
    __syncthreads();
    if (threadIdx.x == 0) { const unsigned G = gridDim.x; const unsigned old = emu_atomic_add(&b.bar[0], 1u); const unsigned target = (old / G + 1u) * G;
        while (emu_atomic_ld(&b.bar[0]) < target) sched_yield(); }
    __syncthreads();
}
#define XCD_BAR_WORDS 3456
#else
#define XB_TMO      128
#define XB_XCNT(j)  (256  + 64 * (j))
#define XB_XSUB(j)  (1280 + 64 * (j))
#define XB_XGEN(j)  (2304 + 64 * (j))
#define XB_TOP      3328
#define XB_TOPGEN   3392
#define XCD_BAR_WORDS 3456
#define XB_SPIN_CAP (1u << 18)

__device__ __forceinline__ unsigned xb_ld(unsigned* p)              { return __hip_atomic_load(p, __ATOMIC_RELAXED, __HIP_MEMORY_SCOPE_AGENT); }
__device__ __forceinline__ unsigned xb_add(unsigned* p, unsigned v) { return __hip_atomic_fetch_add(p, v, __ATOMIC_RELAXED, __HIP_MEMORY_SCOPE_AGENT); }
__device__ __forceinline__ unsigned xb_xcc_id() { return (unsigned)__builtin_amdgcn_s_getreg((3 << 11) | 20) & 0xFu; }
#define XB_SPIN(cond, bar) do { unsigned _sp = 0; while (cond) { __builtin_amdgcn_s_sleep(1); \
    if ((++_sp & 255u) == 0u) { if (xb_ld(&(bar)[XB_TMO])) break; if (_sp > XB_SPIN_CAP) { atomicAdd(&(bar)[XB_TMO], 1u); break; } } } } while (0)

struct XcdBarrier {
    unsigned* bar; unsigned x;
    volatile LAS unsigned* st;
};

__device__ __forceinline__ XcdBarrier xcd_barrier_post(unsigned* bar, volatile LAS unsigned* st) {
    XcdBarrier b; b.bar = bar; b.x = xb_xcc_id(); b.st = st;
    if (threadIdx.x == 0) (void)xb_add(&bar[XB_XCNT(b.x)], 1u);
    return b;
}
__device__ __forceinline__ void xcd_barrier_complete(unsigned* bar, unsigned x, unsigned& nloc, unsigned& nx) {
    const unsigned G = gridDim.x * gridDim.y * gridDim.z;
    unsigned sum, cnt, mine, sp = 0u;
    for (;;) {
        sum = 0u; cnt = 0u; mine = 0u;
#pragma unroll
        for (unsigned j = 0; j < 16; ++j) { const unsigned c = xb_ld(&bar[XB_XCNT(j)]); sum += c; cnt += (c > 0u) ? 1u : 0u; mine = (j == x) ? c : mine; }
        if (sum == G) break;
        __builtin_amdgcn_s_sleep(1);
        if ((++sp & 255u) == 0u) { if (xb_ld(&bar[XB_TMO])) break; if (sp > XB_SPIN_CAP) { atomicAdd(&bar[XB_TMO], 1u); break; } }
    }
    nloc = mine > 0u ? mine : 1u; nx = cnt > 0u ? cnt : 1u;
}

__device__ __forceinline__ void xcd_barrier(const XcdBarrier& b) {
    asm volatile("s_waitcnt vmcnt(0)" ::: "memory");
    __syncthreads();
    if (threadIdx.x == 0) {
        unsigned* bar = b.bar;
        __builtin_amdgcn_s_waitcnt(0);
        unsigned nloc = b.st[0], nx = b.st[1];
        if (nloc == 0u) { xcd_barrier_complete(bar, b.x, nloc, nx); b.st[0] = nloc; b.st[1] = nx; }
        const unsigned old = xb_add(&bar[XB_XSUB(b.x)], 1u);
        const unsigned gen = old / nloc;
        if (old + 1u == (gen + 1u) * nloc) {
            __builtin_amdgcn_fence(__ATOMIC_RELEASE, "agent");
            asm volatile("s_waitcnt vmcnt(0)" ::: "memory");
            const unsigned og = xb_add(&bar[XB_TOP], 1u);
            const unsigned tg = og / nx;
            if (og + 1u == (tg + 1u) * nx) xb_add(&bar[XB_TOPGEN], 1u);
            else XB_SPIN(xb_ld(&bar[XB_TOPGEN]) == tg, bar);
            __builtin_amdgcn_fence(__ATOMIC_ACQUIRE, "agent");
            xb_add(&bar[XB_XGEN(b.x)], 1u);
            asm volatile("s_waitcnt vmcnt(0)" ::: "memory");
        } else {
            XB_SPIN(xb_ld(&bar[XB_XGEN(b.x)]) == gen, bar);
            __builtin_amdgcn_fence(__ATOMIC_ACQUIRE, "agent");
            asm volatile("s_waitcnt vmcnt(0)" ::: "memory");
        }
    }
    __syncthreads();
}
#endif

namespace pg8 {
constexpr int BM = 256, BK = 64, HALF = 128, HTB = HALF * BK * 2  , STAGE_BYTES = 8 * HTB, NXCD = 8, WGM = 8;

__host__ __device__ __forceinline__ int lds_byte(int r, int c) { const int st = (r >> 4) * 2 + (c >> 5), rr = r & 15, cc = c & 31, ob = rr * 64 + cc * 2; return st * 1024 + (ob ^ (((ob >> 9) & 1) << 5)); }
__host__ __device__ __forceinline__ void stage_rc(int b, int& R, int& C) { const int st = b / 1024, sb = b % 1024, swz = sb ^ (((sb >> 9) & 1) << 5); R = (st >> 1) * 16 + swz / 64; C = (st & 1) * 32 + (swz % 64) / 2; }
__host__ __device__ __forceinline__ int perm32(int rho) { const int n = rho >> 4, i = rho & 15; return 8 * (i >> 2) + 4 * n + (i & 3); }

struct Unit { int pm, pn, k0, nt; };
struct Gemm { const bf16_t* A; const bf16_t* Bt; int M, N, K; };

struct StaticOrder {
    int nM, nN, nwg, G, c;
    __host__ __device__ __forceinline__ void init(int M, int N, int G_, int c_) { nM = M / BM; nN = N / BM; nwg = nM * nN; G = G_; c = c_; }
    __host__ __device__ __forceinline__ bool next(int i, Unit& u) const {
        const long L = (long)i * G + c; if (L >= nwg) return false;
        int wgid = (int)L; { const int q = nwg / NXCD, r = nwg % NXCD, xcd = wgid % NXCD, off = wgid / NXCD; wgid = (xcd < r ? xcd * (q + 1) : r * (q + 1) + (xcd - r) * q) + off; }
        const int nig = WGM * nN, gid = wgid / nig, fm = gid * WGM, gsz = (nM - fm) < WGM ? (nM - fm) : WGM;
        u.pm = fm + ((wgid % nig) % gsz); u.pn = (wgid % nig) / gsz; return true;
    }
    static constexpr bool SPLITK = false;
    __device__ __forceinline__ void a_ready(const Unit&) const {}
    __device__ __forceinline__ void done(const Unit&) const {}
};

template <class Epi, class Sched>
__device__ __forceinline__ void gemm_phase(LAS unsigned char* lds, const Gemm g, const Sched& S, const Epi& E) {
    const int tid = threadIdx.x, wid = RFL(tid >> 6), lane = tid & 63, wr = wid >> 2, wc = wid & 3, fr = lane & 15, fq = lane >> 4;
    const int K = g.K, nt = K / BK;
    unsigned voffA[2], voffB[2];
#pragma unroll
    for (int i = 0; i < 2; ++i) { int R, C; stage_rc(tid * 16 + i * 8192, R, C); const int Rb = Epi::PERM ? ((R & ~31) + perm32(R & 31)) : R;
        voffA[i] = (unsigned)(R * K + C) * 2u; voffB[i] = (unsigned)(Rb * K + C) * 2u; }
    const size_t kstep = (size_t)(BK * 2);
    const size_t hstep = (size_t)HALF * K * 2;
    const size_t tstep = 2 * hstep;
    const unsigned ldsw = (unsigned)wid * 1024u;
    const int aoff = Epi::F8 ? lds_byte(wr * 64 + fr, fq * 16) : lds_byte(wr * 64 + fr, fq * 8), boff = Epi::F8 ? lds_byte(wc * 32 + fr, fq * 16) : lds_byte(wc * 32 + fr, fq * 8);
#define PG8_SA(b, h) (((b) * 2 + (h)) * HTB)
#define PG8_SB(b, h) ((4 + (b) * 2 + (h)) * HTB)
#define PG8_STAGE(bufoff, gbase, voff) do { _Pragma("unroll") for (int _i = 0; _i < 2; ++_i) \
        GLDS16((const char*)(gbase) + (voff)[_i], lds + (bufoff) + ldsw + _i * 8192); } while (0)
#define PG8_LD16(off) (*(const LAS i32x4*)(lds + (off)))
#define PG8_CAT(lo, hi) __builtin_shufflevector((lo), (hi), 0, 1, 2, 3, 4, 5, 6, 7)
#define PG8_LDA(dst, b, h) do { if (Epi::F8) { _Pragma("unroll") for (int m = 0; m < 4; ++m) dst##8[m] = PG8_CAT(PG8_LD16(PG8_SA(b, h) + aoff + m * 2048), PG8_LD16(PG8_SA(b, h) + aoff + m * 2048 + 16)); } \
        else { _Pragma("unroll") for (int m = 0; m < 4; ++m) _Pragma("unroll") for (int k = 0; k < 2; ++k) dst[m][k] = *(const LAS bf16x8*)(lds + PG8_SA(b, h) + aoff + m * 2048 + k * 1024); } } while (0)
#define PG8_LDB(dst, b, h) do { if (Epi::F8) { _Pragma("unroll") for (int n = 0; n < 2; ++n) dst##8[n] = PG8_CAT(PG8_LD16(PG8_SB(b, h) + boff + n * 2048), PG8_LD16(PG8_SB(b, h) + boff + n * 2048 + 16)); } \
        else { _Pragma("unroll") for (int n = 0; n < 2; ++n) _Pragma("unroll") for (int k = 0; k < 2; ++k) dst[n][k] = *(const LAS bf16x8*)(lds + PG8_SB(b, h) + boff + n * 2048 + k * 1024); } } while (0)
#define PG8_MMA(ai, bj, At, Bt) do { SETPRIO(1); if (Epi::F8) { _Pragma("unroll") for (int m = 0; m < 4; ++m) _Pragma("unroll") for (int n = 0; n < 2; ++n) \
            acc[ai][bj][m][n] = MFMA_F8(Bt##8[n], At##8[m], acc[ai][bj][m][n]); } \
        else if (Epi::I8) { _Pragma("unroll") for (int m = 0; m < 4; ++m) _Pragma("unroll") for (int n = 0; n < 2; ++n) _Pragma("unroll") for (int k = 0; k < 2; ++k) \
            acc[ai][bj][m][n] = __builtin_bit_cast(f32x4, MFMA_I8(__builtin_bit_cast(i32x4, Bt[n][k]), __builtin_bit_cast(i32x4, At[m][k]), __builtin_bit_cast(i32x4, acc[ai][bj][m][n]))); } \
        else { _Pragma("unroll") for (int m = 0; m < 4; ++m) _Pragma("unroll") for (int n = 0; n < 2; ++n) _Pragma("unroll") for (int k = 0; k < 2; ++k) \
            acc[ai][bj][m][n] = MFMA16(Bt[n][k], At[m][k], acc[ai][bj][m][n]); } SETPRIO(0); } while (0)
#define PG8_BAR S_BARRIER()
#define PG8_SCHED SCHED_BARRIER()
    Unit cur, nxt; int ui = 0;
    if (!S.next(0, cur)) return;
    f32x4 acc[2][2][4][2];
#pragma unroll
    for (int a = 0; a < 2; ++a)
#pragma unroll
        for (int b = 0; b < 2; ++b)
#pragma unroll
            for (int m = 0; m < 4; ++m)
#pragma unroll
                for (int n = 0; n < 2; ++n) acc[a][b][m][n] = (f32x4){0.f, 0.f, 0.f, 0.f};
    bf16x8 At[4][2], B0[2][2], B1[2][2];
    i32x8 At8[4], B08[2], B18[2];
    const char* cA = (const char*)g.A + (size_t)cur.pm * tstep; const char* cB = (const char*)g.Bt + (size_t)cur.pn * tstep;
    if (Sched::SPLITK) { cA += (size_t)cur.k0 * 2; cB += (size_t)cur.k0 * 2; }
    S.a_ready(cur);
    PG8_STAGE(PG8_SB(0, 0), cB, voffB); PG8_STAGE(PG8_SA(0, 0), cA, voffA); PG8_STAGE(PG8_SB(0, 1), cB + hstep, voffB); PG8_STAGE(PG8_SA(0, 1), cA + hstep, voffA);
    if (wr == 1) PG8_BAR;
    WAIT_VM(4); PG8_BAR;
    PG8_STAGE(PG8_SB(1, 0), cB + kstep, voffB); PG8_STAGE(PG8_SA(1, 0), cA + kstep, voffA); PG8_STAGE(PG8_SB(1, 1), cB + hstep + kstep, voffB);
    WAIT_VM(6); PG8_BAR;
    for (;;) {
        const bool has_next = S.next(ui + 1, nxt);
        const char* nA = has_next ? (const char*)g.A + (size_t)nxt.pm * tstep : cA; const char* nB = has_next ? (const char*)g.Bt + (size_t)nxt.pn * tstep : cB;
        if (Sched::SPLITK && has_next) { nA += (size_t)nxt.k0 * 2; nB += (size_t)nxt.k0 * 2; }
        const int ntu = Sched::SPLITK ? cur.nt : nt;
        for (int t = 0; t < ntu; t += 2) {
            const bool last = (t == ntu - 2);
            const char* a1 = cA + (size_t)(t + 1) * kstep;
            const char* a2 = last ? nA : cA + (size_t)(t + 2) * kstep; const char* b2 = last ? nB : cB + (size_t)(t + 2) * kstep;
            const char* a3 = a2 + kstep; const char* b3 = b2 + kstep;
            if (last && has_next) S.a_ready(nxt);
            PG8_LDB(B0, 0, 0); PG8_SCHED; PG8_LDA(At, 0, 0); PG8_STAGE(PG8_SA(1, 1), a1 + hstep, voffA);
            WAIT_LGKM(8); PG8_BAR; WAIT_LGKM(0); PG8_MMA(0, 0, At, B0); PG8_BAR; PG8_SCHED;
            PG8_LDB(B1, 0, 1); PG8_STAGE(PG8_SB(0, 0), b2, voffB);
            PG8_BAR; WAIT_LGKM(0); PG8_MMA(0, 1, At, B1); PG8_BAR;
            PG8_LDA(At, 0, 1); PG8_STAGE(PG8_SA(0, 0), a2, voffA);
            PG8_BAR; WAIT_LGKM(0); PG8_MMA(1, 0, At, B0); PG8_BAR; PG8_SCHED;
            PG8_STAGE(PG8_SB(0, 1), b2 + hstep, voffB);
            WAIT_VM(6); PG8_BAR; PG8_MMA(1, 1, At, B1); PG8_BAR;
            PG8_LDB(B0, 1, 0); PG8_SCHED; PG8_LDA(At, 1, 0); PG8_STAGE(PG8_SA(0, 1), a2 + hstep, voffA);
            WAIT_LGKM(8); PG8_BAR; WAIT_LGKM(0); PG8_MMA(0, 0, At, B0); PG8_BAR; PG8_SCHED;
            PG8_LDB(B1, 1, 1); PG8_STAGE(PG8_SB(1, 0), b3, voffB);
            PG8_BAR; WAIT_LGKM(0); PG8_MMA(0, 1, At, B1); PG8_BAR;
            PG8_LDA(At, 1, 1); PG8_STAGE(PG8_SA(1, 0), a3, voffA);
            PG8_BAR; WAIT_LGKM(0); PG8_MMA(1, 0, At, B0); PG8_BAR; PG8_SCHED;
            PG8_STAGE(PG8_SB(1, 1), b3 + hstep, voffB);
            WAIT_VM(6); PG8_BAR; PG8_MMA(1, 1, At, B1); PG8_BAR;
        }
        if (Epi::F8) MFMA_SETTLE();
        E(acc, cur, wr, wc, fr, fq); S.done(cur);
        if (!has_next) break;
#pragma unroll
        for (int a = 0; a < 2; ++a)
#pragma unroll
            for (int b = 0; b < 2; ++b)
#pragma unroll
                for (int m = 0; m < 4; ++m)
#pragma unroll
                    for (int n = 0; n < 2; ++n) acc[a][b][m][n] = (f32x4){0.f, 0.f, 0.f, 0.f};
        cur = nxt; cA = nA; cB = nB; ++ui;
    }
    WAIT_VM(0);
    if (wr == 0) PG8_BAR;
    PG8_BAR;
#undef PG8_SA
#undef PG8_SB
#undef PG8_STAGE
#undef PG8_LDA
#undef PG8_LDB
#undef PG8_MMA
#undef PG8_CAT
#undef PG8_LD16
#undef PG8_BAR
#undef PG8_SCHED
}
}

constexpr int LDS_BYTES = 147456;
constexpr int LDS_MISC = LDS_BYTES - 64;
constexpr int TP = 136;
constexpr int TILE_B = 128 * TP * 2;

struct Args { const float* in[44]; float* out; unsigned char* ws; int ph_lo, ph_hi; };

enum InIdx { I_X = 0, I_C, I_CTX, I_CCTX, I_ADAW, I_ADAB, I_ABWIN, I_HYCW, I_HYCB, I_HYW1, I_HYB1, I_HYW2, I_HYB2, I_HYW3, I_HYFREQ, I_HYBIAS,
             I_MLCW, I_MLCB, I_MLGB, I_MLNW, I_ABWOUT, I_FFNGU, I_FFNDN, I_CDWIN, I_SSDCW, I_SSDCB, I_SSDALOG, I_SSDDTB, I_SSDD, I_SSDNW,
             I_S5LRE, I_S5LIM, I_S5LDT, I_S5BRE, I_S5BIM, I_S5CRE, I_S5CIM, I_S5D, I_S5GLU, I_CDWOUT, I_ROUTER, I_MOEGU, I_MOEDN, I_FNW };

struct Frame {
    LAS unsigned char* lds; int tid, lane, wave, G, bid;
    const float* const* in; float* out; unsigned char* ws;
    __device__ __forceinline__ int gw() const { return bid * NWAVES + wave; }
    __device__ __forceinline__ int ngw() const { return G * NWAVES; }
    template <class T> __device__ __forceinline__ T* wsp(size_t off) const { return (T*)(ws + off); }
};

__device__ __forceinline__ int mod_row(int m) { return m < ML ? m / SEQ : NB; }

struct EpiStoreBf16 {
    static constexpr bool PERM = true, F8 = false, I8 = false;
    bf16_t* O; int ldc;
    __device__ __forceinline__ void operator()(const f32x4 (&acc)[2][2][4][2], const pg8::Unit& u, int wr, int wc, int fr, int fq) const {
        const int row0 = u.pm * 256 + wr * 64 + fr, col0 = u.pn * 256 + wc * 32 + 8 * fq;
#pragma unroll
        for (int ai = 0; ai < 2; ++ai)
#pragma unroll
            for (int m = 0; m < 4; ++m) { bf16_t* rowp = O + (size_t)(row0 + ai * 128 + m * 16) * ldc + col0;
#pragma unroll
                for (int bj = 0; bj < 2; ++bj) { const f32x4 v0 = acc[ai][bj][m][0], v1 = acc[ai][bj][m][1];
                    u32x4 w; w.x = cvt_pk_bf16(v0[0], v0[1]); w.y = cvt_pk_bf16(v0[2], v0[3]); w.z = cvt_pk_bf16(v1[0], v1[1]); w.w = cvt_pk_bf16(v1[2], v1[3]);
                    *(u32x4*)(rowp + bj * 128) = w; } }
    }
};
struct EpiInProj0 {
    static constexpr bool PERM = true, F8 = false, I8 = false;
    bf16_t* O; int ldc; bf16_t* PH;
    __device__ __forceinline__ void operator()(const f32x4 (&acc)[2][2][4][2], const pg8::Unit& u, int wr, int wc, int fr, int fq) const {
        const int row0 = u.pm * 256 + wr * 64 + fr, col0 = u.pn * 256 + wc * 32 + 8 * fq;
        if (u.pn * 256 < 3 * HYD) {
#pragma unroll
            for (int ai = 0; ai < 2; ++ai)
#pragma unroll
                for (int m = 0; m < 4; ++m) { const int row = row0 + ai * 128 + m * 16;
#pragma unroll
                    for (int bj = 0; bj < 2; ++bj) { const f32x4 v0 = acc[ai][bj][m][0], v1 = acc[ai][bj][m][1]; const int c = col0 + bj * 128;
                        u32x2 a, b; a.x = cvt_pk_bf16(v0[0], v0[1]); a.y = cvt_pk_bf16(v0[2], v0[3]); b.x = cvt_pk_bf16(v1[0], v1[1]); b.y = cvt_pk_bf16(v1[2], v1[3]);
                        *(u32x2*)(PH + ((size_t)(c >> 2) * MT + row) * 4) = a; *(u32x2*)(PH + ((size_t)((c >> 2) + 1) * MT + row) * 4) = b; } }
        } else {
#pragma unroll
            for (int ai = 0; ai < 2; ++ai)
#pragma unroll
                for (int m = 0; m < 4; ++m) { bf16_t* rowp = O + (size_t)(row0 + ai * 128 + m * 16) * ldc + col0;
#pragma unroll
                    for (int bj = 0; bj < 2; ++bj) { const f32x4 v0 = acc[ai][bj][m][0], v1 = acc[ai][bj][m][1];
                        u32x4 w; w.x = cvt_pk_bf16(v0[0], v0[1]); w.y = cvt_pk_bf16(v0[2], v0[3]); w.z = cvt_pk_bf16(v1[0], v1[1]); w.w = cvt_pk_bf16(v1[2], v1[3]);
                        *(u32x4*)(rowp + bj * 128) = w; } }
        }
    }
};
struct EpiResid {
    static constexpr bool PERM = false, F8 = false, I8 = false;
    const float* xlat; const float* xctx; float* XL; const float* gate;
    __device__ __forceinline__ void operator()(const f32x4 (&acc)[2][2][4][2], const pg8::Unit& u, int wr, int wc, int fr, int fq) const {
        const int row0 = u.pm * 256 + wr * 64 + fr, col0 = u.pn * 256 + wc * 32 + 4 * fq;
#pragma unroll
        for (int ai = 0; ai < 2; ++ai)
#pragma unroll
            for (int m = 0; m < 4; ++m) { const int row = row0 + ai * 128 + m * 16; const int r = mod_row(row);
                const float* src = row < ML ? xlat + (size_t)row * D : xctx + (size_t)(row - ML) * D; float* dst = XL + (size_t)row * D; const float* gp = gate + (size_t)r * 6 * D;
#pragma unroll
                for (int bj = 0; bj < 2; ++bj)
#pragma unroll
                    for (int n = 0; n < 2; ++n) { const int col = col0 + bj * 128 + n * 16; const f32x4 gv = *(const f32x4*)(gp + col); const f32x4 xv = *(const f32x4*)(src + col);
                        *(f32x4*)(dst + col) = xv + gv * acc[ai][bj][m][n]; } }
    }
};
struct EpiResidSplit {
    static constexpr bool PERM = false, F8 = false, I8 = false;
    const float* xlat; float* XL; const float* gate; float* part; int kq;
    __device__ __forceinline__ void operator()(const f32x4 (&acc)[2][2][4][2], const pg8::Unit& u, int wr, int wc, int fr, int fq) const {
        const int row0 = u.pm * 256 + wr * 64 + fr, col0 = u.pn * 256 + wc * 32 + 4 * fq;
        if (u.pm * 256 < ML) {
#pragma unroll
            for (int ai = 0; ai < 2; ++ai)
#pragma unroll
                for (int m = 0; m < 4; ++m) { const int row = row0 + ai * 128 + m * 16; const float* src = xlat + (size_t)row * D; float* dst = XL + (size_t)row * D; const float* gp = gate + (size_t)(row / SEQ) * 6 * D;
#pragma unroll
                    for (int bj = 0; bj < 2; ++bj)
#pragma unroll
                        for (int n = 0; n < 2; ++n) { const int col = col0 + bj * 128 + n * 16; const f32x4 gv = *(const f32x4*)(gp + col); const f32x4 xv = *(const f32x4*)(src + col);
                            *(f32x4*)(dst + col) = xv + gv * acc[ai][bj][m][n]; } }
        } else {
            float* pb = part + (size_t)(u.k0 / kq) * MC * D;
#pragma unroll
            for (int ai = 0; ai < 2; ++ai)
#pragma unroll
                for (int m = 0; m < 4; ++m) { float* dst = pb + (size_t)(row0 + ai * 128 + m * 16 - ML) * D;
#pragma unroll
                    for (int bj = 0; bj < 2; ++bj)
#pragma unroll
                        for (int n = 0; n < 2; ++n) *(f32x4*)(dst + col0 + bj * 128 + n * 16) = acc[ai][bj][m][n]; }
        }
    }
};
struct EpiResidSplitF8 {
    static constexpr bool PERM = false, F8 = true, I8 = false;
    const float* xlat; float* XL; const float* gate; float* part; int kq;
    __device__ __forceinline__ void operator()(const f32x4 (&acc)[2][2][4][2], const pg8::Unit& u, int wr, int wc, int fr, int fq) const {
        const int row0 = u.pm * 256 + wr * 64 + fr, col0 = u.pn * 256 + wc * 32 + 4 * fq;
        if (u.pm * 256 < ML) {
#pragma unroll
            for (int ai = 0; ai < 2; ++ai)
#pragma unroll
                for (int m = 0; m < 4; ++m) { const int row = row0 + ai * 128 + m * 16; const float* src = xlat + (size_t)row * D; float* dst = XL + (size_t)row * D; const float* gp = gate + (size_t)(row / SEQ) * 6 * D;
#pragma unroll
                    for (int bj = 0; bj < 2; ++bj)
#pragma unroll
                        for (int n = 0; n < 2; ++n) { const int col = col0 + bj * 128 + n * 16; const f32x4 gv = *(const f32x4*)(gp + col); const f32x4 xv = *(const f32x4*)(src + col);
                            *(f32x4*)(dst + col) = xv + gv * (acc[ai][bj][m][n] * W8INV); } }
        } else {
            float* pb = part + (size_t)(u.k0 / kq) * MC * D;
#pragma unroll
            for (int ai = 0; ai < 2; ++ai)
#pragma unroll
                for (int m = 0; m < 4; ++m) { float* dst = pb + (size_t)(row0 + ai * 128 + m * 16 - ML) * D;
#pragma unroll
                    for (int bj = 0; bj < 2; ++bj)
#pragma unroll
                        for (int n = 0; n < 2; ++n) *(f32x4*)(dst + col0 + bj * 128 + n * 16) = acc[ai][bj][m][n] * W8INV; }
        }
    }
};
struct CtxSplitOrder {
    static constexpr bool SPLITK = true;
    pg8::StaticOrder so; int nN, KS, ntfull, NCU, G, c;
    __device__ __forceinline__ void init(int N, int K, int KS_, int G_, int c_) { so.init(ML, N, G_, c_); nN = N / 256; KS = KS_; ntfull = K / 64; NCU = (MC / 256) * nN * KS_; G = G_; c = c_; }
    __device__ __forceinline__ bool next(int i, pg8::Unit& u) const {
        const long L = (long)i * G + c; const int nwg = so.nwg; if (L >= (long)nwg + NCU) return false;
        int pm, pn, k0, ntu;
        if (L < nwg) { int wgid = (int)L; { const int q = nwg / pg8::NXCD, r = nwg % pg8::NXCD, xcd = wgid % pg8::NXCD, off = wgid / pg8::NXCD; wgid = (xcd < r ? xcd * (q + 1) : r * (q + 1) + (xcd - r) * q) + off; }
            const int nig = pg8::WGM * so.nN, gid = wgid / nig, fm = gid * pg8::WGM, gsz = (so.nM - fm) < pg8::WGM ? (so.nM - fm) : pg8::WGM;
            pm = fm + ((wgid % nig) % gsz); pn = (wgid % nig) / gsz; k0 = 0; ntu = ntfull; }
        else { const int sub = (int)(L - nwg), ks = sub % KS, t = sub / KS; pm = ML / 256 + t / nN; pn = t % nN; ntu = ntfull / KS; k0 = ks * ntu * 64; }
        u.pm = pm; u.pn = pn; u.k0 = k0; u.nt = ntu; return true;
    }
    __device__ __forceinline__ void a_ready(const pg8::Unit&) const {}
    __device__ __forceinline__ void done(const pg8::Unit&) const {}
};
template <int MODE> struct EpiGated {
    static constexpr bool PERM = true, F8 = false, I8 = false;
    bf16_t* O; int ldc; int col_base; int ntn;
    __device__ __forceinline__ void operator()(const f32x4 (&acc)[2][2][4][2], const pg8::Unit& u, int wr, int wc, int fr, int fq) const {
        const int row0 = u.pm * 256 + wr * 64 + fr, col0 = col_base + (u.pn % ntn) * 128 + wc * 32 + 8 * fq;
#pragma unroll
        for (int ai = 0; ai < 2; ++ai)
#pragma unroll
            for (int m = 0; m < 4; ++m) { bf16_t* rowp = O + (size_t)(row0 + ai * 128 + m * 16) * ldc + col0;
                float o[8];
#pragma unroll
                for (int n = 0; n < 2; ++n)
#pragma unroll
                    for (int j = 0; j < 4; ++j) { const float a = acc[ai][0][m][n][j], b = acc[ai][1][m][n][j];
                        o[n * 4 + j] = MODE == 0 ? (a / (1.0f + FEXP(-a))) * b : a / (1.0f + FEXP(-b)); }
                u32x4 w; w.x = cvt_pk_bf16(o[0], o[1]); w.y = cvt_pk_bf16(o[2], o[3]); w.z = cvt_pk_bf16(o[4], o[5]); w.w = cvt_pk_bf16(o[6], o[7]);
                if (O != nullptr) *(u32x4*)rowp = w; }
    }
};
struct EpiGatedI8 {
    static constexpr bool PERM = true, F8 = false, I8 = true;
    bf16_t* O; int ldc; const float* sa; const float* sb;
    __device__ __forceinline__ void operator()(const f32x4 (&acc)[2][2][4][2], const pg8::Unit& u, int wr, int wc, int fr, int fq) const {
        const int row0 = u.pm * 256 + wr * 64 + fr, c0 = wc * 32 + 8 * fq;
        const f32x4 sga = *(const f32x4*)(sb + u.pn * 256 + c0), sgb = *(const f32x4*)(sb + u.pn * 256 + c0 + 4), sua = *(const f32x4*)(sb + u.pn * 256 + 128 + c0), sub = *(const f32x4*)(sb + u.pn * 256 + 128 + c0 + 4);
#pragma unroll
        for (int ai = 0; ai < 2; ++ai)
#pragma unroll
            for (int m = 0; m < 4; ++m) { const int row = row0 + ai * 128 + m * 16; const float sr = sa[row]; bf16_t* rowp = O + (size_t)row * ldc + u.pn * 128 + c0;
                float o[8];
#pragma unroll
                for (int n = 0; n < 2; ++n)
#pragma unroll
                    for (int j = 0; j < 4; ++j) { const i32x4 ig = __builtin_bit_cast(i32x4, acc[ai][0][m][n]), iu = __builtin_bit_cast(i32x4, acc[ai][1][m][n]);
                        const float a = (float)ig[j] * sr * (n ? sgb[j] : sga[j]), b = (float)iu[j] * sr * (n ? sub[j] : sua[j]); o[n * 4 + j] = a * FRCP(1.0f + FEXP(-a)) * b; }
                u32x4 w; w.x = cvt_pk_bf16(o[0], o[1]); w.y = cvt_pk_bf16(o[2], o[3]); w.z = cvt_pk_bf16(o[4], o[5]); w.w = cvt_pk_bf16(o[6], o[7]);
                *(u32x4*)rowp = w; }
    }
};
struct EpiGatedI8F8 {
    static constexpr bool PERM = true, F8 = false, I8 = true;
    unsigned char* O; int ldc; const float* sa; const float* sb;
    __device__ __forceinline__ void operator()(const f32x4 (&acc)[2][2][4][2], const pg8::Unit& u, int wr, int wc, int fr, int fq) const {
        const int row0 = u.pm * 256 + wr * 64 + fr, c0 = wc * 32 + 8 * fq;
        const f32x4 sga = *(const f32x4*)(sb + u.pn * 256 + c0), sgb = *(const f32x4*)(sb + u.pn * 256 + c0 + 4), sua = *(const f32x4*)(sb + u.pn * 256 + 128 + c0), sub = *(const f32x4*)(sb + u.pn * 256 + 128 + c0 + 4);
#pragma unroll
        for (int ai = 0; ai < 2; ++ai)
#pragma unroll
            for (int m = 0; m < 4; ++m) { const int row = row0 + ai * 128 + m * 16; const float sr = sa[row]; unsigned char* rowp = O + (size_t)row * ldc + u.pn * 128 + c0;
                float o[8];
#pragma unroll
                for (int n = 0; n < 2; ++n)
#pragma unroll
                    for (int j = 0; j < 4; ++j) { const i32x4 ig = __builtin_bit_cast(i32x4, acc[ai][0][m][n]), iu = __builtin_bit_cast(i32x4, acc[ai][1][m][n]);
                        const float a = (float)ig[j] * sr * (n ? sgb[j] : sga[j]), b = (float)iu[j] * sr * (n ? sub[j] : sua[j]); o[n * 4 + j] = a * FRCP(1.0f + FEXP(-a)) * b; }
                u32x2 w; w.x = cvt_pk_fp8x4(o[0], o[1], o[2], o[3]); w.y = cvt_pk_fp8x4(o[4], o[5], o[6], o[7]);
                *(u32x2*)rowp = w; }
    }
};
struct EpiGatedF8 {
    static constexpr bool PERM = true, F8 = true, I8 = false;
    unsigned char* O; int ldc; int ntn;
    __device__ __forceinline__ void operator()(const f32x4 (&acc)[2][2][4][2], const pg8::Unit& u, int wr, int wc, int fr, int fq) const {
        const int row0 = u.pm * 256 + wr * 64 + fr, col0 = (u.pn % ntn) * 128 + wc * 32 + 8 * fq;
#pragma unroll
        for (int ai = 0; ai < 2; ++ai)
#pragma unroll
            for (int m = 0; m < 4; ++m) { unsigned char* rowp = O + (size_t)(row0 + ai * 128 + m * 16) * ldc + col0;
                float o[8];
#pragma unroll
                for (int n = 0; n < 2; ++n)
#pragma unroll
                    for (int j = 0; j < 4; ++j) { const float a = acc[ai][0][m][n][j] * W8INV, b = acc[ai][1][m][n][j] * W8INV; o[n * 4 + j] = a * FRCP(1.0f + FEXP(-a)) * b; }
                u32x2 w; w.x = cvt_pk_fp8x4(o[0], o[1], o[2], o[3]); w.y = cvt_pk_fp8x4(o[4], o[5], o[6], o[7]);
                *(u32x2*)rowp = w; }
    }
};
struct EpiMoeDown {
    static constexpr bool PERM = false, F8 = false, I8 = false;
    const int* rowmap; const float* rowp; float* yslot; int ntn;
    __device__ __forceinline__ void operator()(const f32x4 (&acc)[2][2][4][2], const pg8::Unit& u, int wr, int wc, int fr, int fq) const {
        const int row0 = u.pm * 256 + wr * 64 + fr, col0 = (u.pn % ntn) * 256 + wc * 32 + 4 * fq;
#pragma unroll
        for (int ai = 0; ai < 2; ++ai)
#pragma unroll
            for (int m = 0; m < 4; ++m) { const int row = row0 + ai * 128 + m * 16; const int rm = rowmap[row]; if (rm < 0) continue; const float p = rowp[row];
                float* dst = yslot + ((size_t)(rm & 1) * ML + (size_t)(rm >> 1)) * D;
#pragma unroll
                for (int bj = 0; bj < 2; ++bj)
#pragma unroll
                    for (int n = 0; n < 2; ++n) { const int col = col0 + bj * 128 + n * 16; *(f32x4*)(dst + col) = acc[ai][bj][m][n] * p; } }
    }
};
__device__ __forceinline__ void moe_down_split(int npan, int& nfull, int& ks) { nfull = (npan / 32) * 32; const int lo = npan - nfull; ks = (lo == 0 || lo > 16 || KSF8 == 1) ? 1 : 2; if (ks == 1) nfull = npan; }
struct EpiMoeDownSplit {
    static constexpr bool PERM = false, F8 = true, I8 = false;
    const int* rowmap; const float* rowp; bf16_t* yslot; float* partm; int ntn, row_split, kq; float osc;
    __device__ __forceinline__ void operator()(const f32x4 (&acc)[2][2][4][2], const pg8::Unit& u, int wr, int wc, int fr, int fq) const {
        const int row0 = u.pm * 256 + wr * 64 + fr, col0 = (u.pn % ntn) * 256 + wc * 32 + 4 * fq;
        if (u.pm * 256 < row_split) {
#pragma unroll
            for (int ai = 0; ai < 2; ++ai)
#pragma unroll
                for (int m = 0; m < 4; ++m) { const int row = row0 + ai * 128 + m * 16; const int rm = rowmap[row]; if (rm < 0) continue; const float p = rowp[row] * osc;
                    bf16_t* dst = yslot + ((size_t)(rm & 1) * ML + (size_t)(rm >> 1)) * D;
#pragma unroll
                    for (int bj = 0; bj < 2; ++bj)
#pragma unroll
                        for (int n = 0; n < 2; ++n) { const int col = col0 + bj * 128 + n * 16; const f32x4 v = acc[ai][bj][m][n] * p; u32x2 w; w.x = cvt_pk_bf16(v[0], v[1]); w.y = cvt_pk_bf16(v[2], v[3]); *(u32x2*)(dst + col) = w; } }
        } else {
            float* pb = partm + (size_t)(u.k0 / kq) * PM_ROWS * D;
#pragma unroll
            for (int ai = 0; ai < 2; ++ai)
#pragma unroll
                for (int m = 0; m < 4; ++m) { float* dst = pb + (size_t)(row0 + ai * 128 + m * 16 - row_split) * D;
#pragma unroll
                    for (int bj = 0; bj < 2; ++bj)
#pragma unroll
                        for (int n = 0; n < 2; ++n) *(f32x4*)(dst + col0 + bj * 128 + n * 16) = acc[ai][bj][m][n] * osc; }
        }
    }
};
struct MoeOrder {
    static constexpr bool SPLITK = false;
    int npan, ntn, G, c; int p1, p2, p3, p4, p5, p6, p7;
    __device__ __forceinline__ void init(const Frame& F, int ntn_) {
        const unsigned* cnt = F.wsp<unsigned>(WS_CTL) + CW_CNT; int o = 0;
        o += (int)((cnt[0] + 255u) >> 8); p1 = o; o += (int)((cnt[64] + 255u) >> 8); p2 = o; o += (int)((cnt[128] + 255u) >> 8); p3 = o; o += (int)((cnt[192] + 255u) >> 8); p4 = o;
        o += (int)((cnt[256] + 255u) >> 8); p5 = o; o += (int)((cnt[320] + 255u) >> 8); p6 = o; o += (int)((cnt[384] + 255u) >> 8); p7 = o; o += (int)((cnt[448] + 255u) >> 8); npan = o;
        ntn = ntn_; G = F.G; c = F.bid; }
    __device__ __forceinline__ bool next(int i, pg8::Unit& u) const {
        long f; if ((G & 7) == 0) { const int per = G >> 3; f = ((long)i * 8 + (c & 7)) * per + (c >> 3); } else f = (long)i * G + c;
        if (f >= (long)npan * ntn) return false;
        const int fi = (int)f; const int q1 = p1 * ntn, q2 = p2 * ntn, q3 = p3 * ntn, q4 = p4 * ntn, q5 = p5 * ntn, q6 = p6 * ntn, q7 = p7 * ntn;
        const int e = (fi >= q1) + (fi >= q2) + (fi >= q3) + (fi >= q4) + (fi >= q5) + (fi >= q6) + (fi >= q7);
        const int pb = e == 0 ? 0 : e == 1 ? p1 : e == 2 ? p2 : e == 3 ? p3 : e == 4 ? p4 : e == 5 ? p5 : e == 6 ? p6 : p7;
        const int pe = e == 0 ? p1 : e == 1 ? p2 : e == 2 ? p3 : e == 3 ? p4 : e == 4 ? p5 : e == 5 ? p6 : e == 6 ? p7 : npan;
        const int gw = (ntn & 3) == 0 ? 4 : ((ntn & 1) == 0 ? 2 : 1);
        const int np = pe - pb, r = fi - pb * ntn, gsz = np * gw, tg = r / gsz, rr = r % gsz;
        u.pm = pb + rr / gw; u.pn = e * ntn + tg * gw + rr % gw; u.k0 = 0; u.nt = 0; return true;
    }
    __device__ __forceinline__ void a_ready(const pg8::Unit&) const {}
    __device__ __forceinline__ void done(const pg8::Unit&) const {}
};

struct MoeDownOrder {
    static constexpr bool SPLITK = true;
    MoeOrder mo; int nfull, KS, ntfull;
    __device__ __forceinline__ void init(const Frame& F, int ntn_, int K) { mo.init(F, ntn_); ntfull = K / 64; moe_down_split(mo.npan, nfull, KS); }
    __device__ __forceinline__ bool next(int i, pg8::Unit& u) const {
        const long L = (long)i * mo.G + mo.c; const long nnorm = (long)nfull * mo.ntn; if (L >= nnorm + (long)(mo.npan - nfull) * mo.ntn * KS) return false;
        int pm, pn, k0, ntu;
        if (L < nnorm) { pm = (int)(L / mo.ntn); pn = (int)(L % mo.ntn); k0 = 0; ntu = ntfull; }
        else { const int sub = (int)(L - nnorm), ks = sub % KS, t = sub / KS; pm = nfull + t / mo.ntn; pn = t % mo.ntn; ntu = ntfull / KS; k0 = ks * ntu * 64; }
        const int e = (pm >= mo.p1) + (pm >= mo.p2) + (pm >= mo.p3) + (pm >= mo.p4) + (pm >= mo.p5) + (pm >= mo.p6) + (pm >= mo.p7);
        u.pm = pm; u.pn = e * mo.ntn + pn; u.k0 = k0; u.nt = ntu; return true;
    }
    __device__ __forceinline__ void a_ready(const pg8::Unit&) const {}
    __device__ __forceinline__ void done(const pg8::Unit&) const {}
};

template <int MTN, int NTN, int KS>
__device__ __forceinline__ void wave_mma(f32x4 (&acc)[MTN][NTN], const LAS bf16_t* A, int rowA0, const LAS bf16_t* B, int rowB0, int lane) {
    const int r = lane & 15, q = lane >> 4;
#pragma unroll
    for (int ks = 0; ks < KS; ++ks) {
        bf16x8 a[MTN], b[NTN];
#pragma unroll
        for (int mt = 0; mt < MTN; ++mt) a[mt] = *(const LAS bf16x8*)(A + (rowA0 + 16 * mt + r) * TP + ks * 32 + q * 8);
#pragma unroll
        for (int nt = 0; nt < NTN; ++nt) b[nt] = *(const LAS bf16x8*)(B + (rowB0 + 16 * nt + r) * TP + ks * 32 + q * 8);
#pragma unroll
        for (int mt = 0; mt < MTN; ++mt)
#pragma unroll
            for (int nt = 0; nt < NTN; ++nt) acc[mt][nt] = MFMA16(a[mt], b[nt], acc[mt][nt]);
    }
}
template <int MTN, int NTN> __device__ __forceinline__ void zero_acc(f32x4 (&acc)[MTN][NTN]) {
#pragma unroll
    for (int a = 0; a < MTN; ++a)
#pragma unroll
        for (int b = 0; b < NTN; ++b) acc[a][b] = (f32x4){0.f, 0.f, 0.f, 0.f};
}

template <bool MAXOP> __device__ __forceinline__ void wave_scan128(const LAS float* a, LAS float* out, bool rev, int lane) {
    const int i0 = rev ? CH - 1 - 2 * lane : 2 * lane, i1 = rev ? i0 - 1 : i0 + 1;
    const float x0 = a[i0], x1 = a[i1]; float s = MAXOP ? fmaxf(x0, x1) : x0 + x1;
#pragma unroll
    for (int off = 1; off < 64; off <<= 1) { const float t = __shfl_up(s, off); if (lane >= off) s = MAXOP ? fmaxf(s, t) : s + t; }
    float prev = __shfl_up(s, 1); if (lane == 0) prev = MAXOP ? -INFINITY : 0.f;
    out[i0] = MAXOP ? fmaxf(prev, x0) : prev + x0; out[i1] = s;
}
__device__ __forceinline__ void conv3x8(const bf16_t* base, int ld, bool has_l, bool has_r, const float* w, int wld, const float* b, float (&o)[8]) {
    float xc[8], xl[8], xr[8];
    unpack8(*(const u32x4*)base, xc);
    if (has_l) unpack8(*(const u32x4*)(base - ld), xl); else {
#pragma unroll
        for (int j = 0; j < 8; ++j) xl[j] = 0.f; }
    if (has_r) unpack8(*(const u32x4*)(base + ld), xr); else {
#pragma unroll
        for (int j = 0; j < 8; ++j) xr[j] = 0.f; }
    const f32x4 w0a = *(const f32x4*)(w), w0b = *(const f32x4*)(w + 4), w1a = *(const f32x4*)(w + wld), w1b = *(const f32x4*)(w + wld + 4), w2a = *(const f32x4*)(w + 2 * wld), w2b = *(const f32x4*)(w + 2 * wld + 4);
    const f32x4 ba = *(const f32x4*)(b), bb = *(const f32x4*)(b + 4);
#pragma unroll
    for (int j = 0; j < 4; ++j) { o[j] = ba[j] + w0a[j] * xl[j] + w1a[j] * xc[j] + w2a[j] * xr[j]; o[4 + j] = bb[j] + w0b[j] * xl[4 + j] + w1b[j] * xc[4 + j] + w2b[j] * xr[4 + j]; }
}
__device__ __forceinline__ void conv_nbr(int cs, int s, bool& has_l, bool& has_r) {
    if (cs < NCC) { const int pos = cs * CH + s; has_l = pos > 0; has_r = pos < CTX - 1; }
    else { has_l = (s & (GW - 1)) != 0; has_r = (s & (GW - 1)) != GW - 1; }
}
__device__ __forceinline__ int chunk_row0(int b, int cs) { return cs < NCC ? ML + b * CTX + cs * CH : b * SEQ + (cs - NCC) * CH; }
__device__ __forceinline__ int scan_slot(int d, int q) { return d == 0 ? q : (q < NCC ? NCC - 1 - q : NCS - 1 - (q - NCC)); }

template <int MAP> __device__ __forceinline__ int conv_src_col(int nb, int half) {
    if (MAP == 0) return nb * 128;
    if (MAP == 1) return (nb & 1) * half + (nb >> 1) * 128;
    return nb * 128 < SSDD + XBC ? nb * 128 : nb * 128 + CD_SIDE;
}
template <int MAP> __device__ __forceinline__ void conv_job(const Frame& F, int& base, const float* src, int ld, bf16_t* dst, int K, int nblk, int half) {
    constexpr int PB = 264;
    const int ntile = nblk * (K / 128);
    const int n = F.tid & 127, kq = F.tid >> 7;
    int t = (F.bid - base % F.G + F.G) % F.G;
    base += ntile;
    f32x4 v[8];
    const unsigned ldb = (unsigned)ld * 4u, lane_off = (unsigned)n * 4u + (unsigned)(4 * kq) * ldb;
#define CONV_LOAD(tt) do { const int nb_ = (tt) % nblk, kb_ = (tt) / nblk; const char* sp_ = (const char*)(src + (size_t)(kb_ * 128) * ld + conv_src_col<MAP>(nb_, half)); \
        _Pragma("unroll") for (int i_ = 0; i_ < 8; ++i_) { const unsigned o_ = lane_off + (unsigned)(16 * i_) * ldb; \
            v[i_][0] = NTLD((const float*)(sp_ + o_)); v[i_][1] = NTLD((const float*)(sp_ + o_ + ldb)); v[i_][2] = NTLD((const float*)(sp_ + o_ + 2u * ldb)); v[i_][3] = NTLD((const float*)(sp_ + o_ + 3u * ldb)); } } while (0)
    if (t < ntile) CONV_LOAD(t);
    while (t < ntile) {
#pragma unroll
        for (int i = 0; i < 8; ++i) { u32x2 w; w.x = pk2(v[i][0], v[i][1]); w.y = pk2(v[i][2], v[i][3]); *(LAS u32x2*)(F.lds + n * PB + (kq + 4 * i) * 8) = w; }
        const int tn = t + F.G;
        if (tn < ntile) CONV_LOAD(tn);
        __syncthreads();
        const int nb = t % nblk, kb = t / nblk;
#pragma unroll
        for (int i = 0; i < 4; ++i) { const int ch = F.tid + 512 * i, nn = ch >> 4, kc = ch & 15;
            const u32x2 a = *(const LAS u32x2*)(F.lds + nn * PB + kc * 16), b = *(const LAS u32x2*)(F.lds + nn * PB + kc * 16 + 8);
            u32x4 w; w.x = a.x; w.y = a.y; w.z = b.x; w.w = b.y;
            *(u32x4*)(dst + (size_t)(nb * 128 + nn) * K + kb * 128 + kc * 8) = w; }
        __syncthreads();
        t = tn;
    }
#undef CONV_LOAD
}
constexpr int MQ_TGU = (2 * FF / 128) * (D / 128), MQ_TDN = (D / 128) * (FF / 128), MQ_NT = NE * (MQ_TGU + MQ_TDN);
struct MoeTile { const char* sp; unsigned char* dp; unsigned ldb; int K; };
__device__ __forceinline__ MoeTile moe_tile(const Frame& F, int t) {
    MoeTile m;
    if (t < NE * MQ_TGU) { const int e = t / MQ_TGU, r = t % MQ_TGU, nb = r % (2 * FF / 128), kb = r / (2 * FF / 128);
        m.sp = (const char*)(F.in[I_MOEGU] + (size_t)e * D * 2 * FF + (size_t)(kb * 128) * (2 * FF) + (nb & 1) * FF + (nb >> 1) * 128); m.ldb = 2u * FF * 4u;
        m.dp = F.wsp<unsigned char>(WS_W_MGU) + (size_t)e * 2 * FF * D + (size_t)(nb * 128) * D + kb * 128; m.K = D; }
    else { const int tt = t - NE * MQ_TGU, e = tt / MQ_TDN, r = tt % MQ_TDN, nb = r % (D / 128), kb = r / (D / 128);
        m.sp = (const char*)(F.in[I_MOEDN] + (size_t)e * FF * D + (size_t)(kb * 128) * D + nb * 128); m.ldb = (unsigned)D * 4u;
        m.dp = F.wsp<unsigned char>(WS_W_MDN) + (size_t)e * D * FF + (size_t)(nb * 128) * FF + kb * 128; m.K = FF; }
    return m;
}
#define MQ_LOAD(m, v) do { const unsigned lo_ = (unsigned)(F.tid & 127) * 4u + (unsigned)(4 * (F.tid >> 7)) * (m).ldb; \
        _Pragma("unroll") for (int i_ = 0; i_ < 8; ++i_) { const unsigned o_ = lo_ + (unsigned)(16 * i_) * (m).ldb; \
            v[i_][0] = NTLD((const float*)((m).sp + o_)); v[i_][1] = NTLD((const float*)((m).sp + o_ + (m).ldb)); v[i_][2] = NTLD((const float*)((m).sp + o_ + 2u * (m).ldb)); v[i_][3] = NTLD((const float*)((m).sp + o_ + 3u * (m).ldb)); } } while (0)
#define MQ_TOLDS(v) do { _Pragma("unroll") for (int i_ = 0; i_ < 8; ++i_) *(LAS unsigned*)(F.lds + (F.tid & 127) * 132 + ((F.tid >> 7) + 4 * i_) * 4) = \
        cvt_pk_fp8x4(v[i_][0] * W8SCALE, v[i_][1] * W8SCALE, v[i_][2] * W8SCALE, v[i_][3] * W8SCALE); } while (0)
#define MQ_STORE(m) do { _Pragma("unroll") for (int i_ = 0; i_ < 2; ++i_) { const int ch_ = F.tid + 512 * i_, nn_ = ch_ >> 3, kc_ = ch_ & 7; const LAS unsigned* lp_ = (const LAS unsigned*)(F.lds + nn_ * 132 + kc_ * 16); \
        u32x4 w_; w_.x = lp_[0]; w_.y = lp_[1]; w_.z = lp_[2]; w_.w = lp_[3]; NTST(w_, (u32x4*)((m).dp + (size_t)nn_ * (m).K + kc_ * 16)); } } while (0)
__device__ __forceinline__ void conv_job_f8(const Frame& F, int& base, const float* src, int ld, unsigned char* dst, int K, int nblk) {
    const int ntile = nblk * (K / 128);
    int t = (F.bid - base % F.G + F.G) % F.G; base += ntile;
    f32x4 v[8]; MoeTile m, mn;
    __syncthreads();
#define CF8_TILE(mm, tt) do { const int nb_ = (tt) % nblk, kb_ = (tt) / nblk; (mm).sp = (const char*)(src + (size_t)(kb_ * 128) * ld + nb_ * 128); (mm).ldb = (unsigned)ld * 4u; (mm).dp = dst + (size_t)(nb_ * 128) * K + kb_ * 128; (mm).K = K; } while (0)
    if (t < ntile) { CF8_TILE(m, t); MQ_LOAD(m, v); }
    while (t < ntile) {
        MQ_TOLDS(v);
        const int tn = t + F.G; mn = m;
        if (tn < ntile) { CF8_TILE(mn, tn); MQ_LOAD(mn, v); }
        __syncthreads();
        MQ_STORE(m);
        __syncthreads();
        m = mn; t = tn;
    }
#undef CF8_TILE
}
__device__ __forceinline__ void moe_convert_strided(const Frame& F, int t0, int t1, int st) {
    __syncthreads();
    if (t0 >= t1) return;
    f32x4 v[8]; MoeTile m = moe_tile(F, t0), mn = m; MQ_LOAD(m, v);
#pragma unroll 1
    for (int t = t0; t < t1; t += st) {
        MQ_TOLDS(v);
        const int tn = t + st; mn = m;
        if (tn < t1) { mn = moe_tile(F, tn); MQ_LOAD(mn, v); }
        __syncthreads();
        MQ_STORE(m);
        __syncthreads();
        m = mn;
    }
}
struct MqSlot { int nu, q; };
__device__ __forceinline__ int mq_nu(int slot) {
    constexpr int NU_ML = NB * MLH * NCS, NU7 = (ML / 256) * (D / 256) + (MC / 256) * (D / 256) * KS7, NU9 = (MT / 256) * (2 * FF / 256), NU10 = (ML / 256) * (D / 256) + (MC / 256) * (D / 256) * KS10,
                  NU12 = (MT / 256) * (CD_MAIN / 256), NU13 = NB * NCS * SSDG * 2 * (HPG / 4), NU16 = (ML / 256) * (2 * S5W / 256), NU3 = (MT / 256) * (AB_MAIN / 256);
    return slot == 0 ? NU_ML : slot == 1 ? NU_ML : slot == 2 ? NU7 : slot == 3 ? NU9 : slot == 4 ? NU10 : slot == 5 ? NU12 : slot == 6 ? NU13 : slot == 7 ? NU16 : NU3;
}
__device__ __forceinline__ int mq_q(int slot) { return slot == 0 ? 6 : slot == 1 ? 16 : slot == 2 ? 2 : slot == 3 ? 8 : slot == 4 ? 12 : slot == 5 ? 16 : slot == 6 ? 8 : slot == 7 ? 2 : 16; }
constexpr int MQ_NSLOT = 9;
__device__ __forceinline__ int mq_base(int G, int slot) { int b = 0;
#pragma unroll
    for (int k = 0; k < MQ_NSLOT; ++k) { const int r = mq_nu(k) % G; if (k < slot && r != 0) b += (G - r) * mq_q(k); }
    return b < MQ_NT ? b : MQ_NT; }
__device__ __forceinline__ void help_slot(const Frame& F, int slot) {
    const int r = mq_nu(slot) % F.G; if (r == 0 || F.bid < r) return;
    const int nh = F.G - r, b0 = mq_base(F.G, slot); int b1 = b0 + nh * mq_q(slot); if (b1 > MQ_NT) b1 = MQ_NT;
    moe_convert_strided(F, b0 + (F.bid - r), b1, nh);
}
constexpr int MQ_Q20 = 8;
__device__ __forceinline__ int mq_tail_lo(const Frame& F, int& r) {
    const unsigned* cnt = F.wsp<unsigned>(WS_CTL) + CW_CNT; int npan = 0;
#pragma unroll
    for (int k = 0; k < NE; ++k) npan += (int)((cnt[64 * k] + 255u) >> 8);
    const int U = npan * (2 * FF / 256); r = U % F.G; const int nidle = r ? F.G - r : 0; const int b = mq_base(F.G, MQ_NSLOT);
    int tl = nidle * MQ_Q20; if (tl > MQ_NT - b) tl = MQ_NT - b; if (tl < 0) tl = 0;
    return MQ_NT - tl;
}
__device__ __forceinline__ void help_drain(const Frame& F) {
    int r; const int hi = mq_tail_lo(F, r);
    const int b = mq_base(F.G, MQ_NSLOT); if (hi - b <= 0) return;
    moe_convert_strided(F, b + F.bid, hi, F.G);
}
__device__ __forceinline__ void help_moe_tail(const Frame& F) {
    int r; const int lo = mq_tail_lo(F, r); if (r == 0) return;
    const int pos = (F.G & 7) == 0 ? (F.bid & 7) * (F.G >> 3) + (F.bid >> 3) : F.bid;
    if (pos < r) return;
    moe_convert_strided(F, lo + (pos - r), MQ_NT, F.G - r);
}
template <int MAP> __device__ __forceinline__ void conv_job_i8(const Frame& F, int& base, const float* src, int ld, signed char* dst, float* scale, int K, int nblk, int half) {
    LAS float* cmx = (LAS float*)(F.lds + 128 * 132);
    const int n = F.tid & 127, kq = F.tid >> 7; const unsigned ldb = (unsigned)ld * 4u, lane_off = (unsigned)n * 4u + (unsigned)(4 * kq) * ldb;
    for (int nb = (F.bid - base % F.G + F.G) % F.G; nb < nblk; nb += F.G) {
        const char* sp0 = (const char*)(src + conv_src_col<MAP>(nb, half)); float mx = 0.f;
        for (int kb = 0; kb < K / 128; ++kb) { const char* sp = sp0 + (size_t)(kb * 128) * ldb;
#pragma unroll
            for (int i = 0; i < 8; ++i) { const unsigned o = lane_off + (unsigned)(16 * i) * ldb;
                mx = fmaxf(mx, fmaxf(fmaxf(fabsf(*(const float*)(sp + o)), fabsf(*(const float*)(sp + o + ldb))), fmaxf(fabsf(*(const float*)(sp + o + 2u * ldb)), fabsf(*(const float*)(sp + o + 3u * ldb))))); } }
        __syncthreads();
        cmx[kq * 128 + n] = mx;
        __syncthreads();
        if (F.tid < 128) { const float m4 = fmaxf(fmaxf(cmx[n], cmx[128 + n]), fmaxf(cmx[256 + n], cmx[384 + n])); const float sc = m4 > 0.f ? m4 * (1.0f / 127.0f) : 1.0f; scale[nb * 128 + n] = sc; cmx[512 + n] = 1.0f / sc; }
        __syncthreads();
        const float inv = cmx[512 + n];
        for (int kb = 0; kb < K / 128; ++kb) { const char* sp = sp0 + (size_t)(kb * 128) * ldb;
#pragma unroll
            for (int i = 0; i < 8; ++i) { const unsigned o = lane_off + (unsigned)(16 * i) * ldb;
                *(LAS unsigned*)(F.lds + n * 132 + (kq + 4 * i) * 4) = pk_i8x4(*(const float*)(sp + o) * inv, *(const float*)(sp + o + ldb) * inv, *(const float*)(sp + o + 2u * ldb) * inv, *(const float*)(sp + o + 3u * ldb) * inv); }
            __syncthreads();
#pragma unroll
            for (int i = 0; i < 2; ++i) { const int ch = F.tid + 512 * i, nn = ch >> 3, kc = ch & 7; const LAS unsigned* lp = (const LAS unsigned*)(F.lds + nn * 132 + kc * 16);
                u32x4 w; w.x = lp[0]; w.y = lp[1]; w.z = lp[2]; w.w = lp[3]; *(u32x4*)(dst + (size_t)(nb * 128 + nn) * K + kb * 128 + kc * 16) = w; }
            __syncthreads(); }
    }
    base += nblk;
}
__device__ __forceinline__ void conv_side(const Frame& F, const float* src, int ld, int col0, int nside, bf16_t* dst, int K) {
    for (int idx = F.bid * NTHREADS + F.tid; idx < 32 * K; idx += F.G * NTHREADS) { const int n = idx / K, k = idx % K;
        dst[idx] = (bf16_t)(n < nside ? f2bf(src[(size_t)k * ld + col0 + n]) : 0u); }
}

__device__ __forceinline__ void adaln_units(const Frame& F) {
    LAS float* cond = (LAS float*)F.lds;
    const float* adaw = F.in[I_ADAW]; float* part = F.wsp<float>(WS_MODP);
    constexpr int NCHUNK = 6 * D / 512, NU = 2 * NCHUNK * KSL;
    for (int u = F.bid; u < NU; u += F.G) {
        const int l = u / (NCHUNK * KSL), rem = u % (NCHUNK * KSL), ks = rem / NCHUNK, nc = rem % NCHUNK;
        __syncthreads();
        for (int i = F.tid; i < NR * 256; i += NTHREADS) { const int r = i / 256, k = ks * 256 + (i & 255); const float c = r < NB ? F.in[I_C][r * D + k] : F.in[I_CCTX][k]; cond[i] = siluf(c); }
        __syncthreads();
        const int n = nc * 512 + F.tid; const float* wp = adaw + ((size_t)l * D + ks * 256) * (6 * D) + n;
        float acc[NR];
#pragma unroll
        for (int r = 0; r < NR; ++r) acc[r] = 0.f;
#pragma unroll 1
        for (int k0 = 0; k0 < 256; k0 += 32) { float w[32];
#pragma unroll
            for (int j = 0; j < 32; ++j) w[j] = NTLD(wp + (size_t)(k0 + j) * (6 * D));
#pragma unroll
            for (int j = 0; j < 32; ++j)
#pragma unroll
                for (int r = 0; r < NR; ++r) acc[r] += cond[r * 256 + k0 + j] * w[j]; }
#pragma unroll
        for (int r = 0; r < NR; ++r) part[(((size_t)l * KSL + ks) * NR + r) * (6 * D) + n] = acc[r];
    }
    __syncthreads();
}

__device__ __forceinline__ void hyena_filter_units(const Frame& F, int wg_off) {
    constexpr int H2P = 36, OBP = 33, FC = HYD >= NTHREADS ? HYD / NTHREADS : 1;
    LAS float* feats = (LAS float*)F.lds;
    LAS float* h1 = feats + 32 * 36;
    LAS float* h2 = h1 + 32 * 64;
    LAS float* ob = h2 + 64 * H2P;
    static_assert((32 * 36 + 32 * 64 + 64 * H2P + NTHREADS * OBP) * 4 <= LDS_MISC, "filter LDS");
    static_assert(SEQ % 32 == 0 && CTX % 32 == 0 && (HYD % NTHREADS == 0 || HYD < NTHREADS), "filter shapes");
    const float* w1 = F.in[I_HYW1]; const float* b1 = F.in[I_HYB1]; const float* w2 = F.in[I_HYW2]; const float* b2 = F.in[I_HYB2]; const float* w3 = F.in[I_HYW3]; const float* fq = F.in[I_HYFREQ];
    constexpr int NU0 = 2 * (SEQ / 32), NU = NU0 + 2 * (CTX / 32);
    for (int u = (F.bid - wg_off % F.G + F.G) % F.G; u < NU; u += F.G) {
        const int set = u < NU0 ? 0 : 1, L = set ? CTX : SEQ, ul = set ? u - NU0 : u, dir = ul & 1, p0 = (ul >> 1) * 32, pb = (set ? SEQ / 32 : 0) + (ul >> 1);
        float* filt = F.wsp<float>(set ? WS_FILT1 : WS_FILT0);
        int tid = F.tid; LAUNDER(tid);
        __syncthreads();
        for (int e = tid; e < 32 * HYEMB; e += NTHREADS) { const int p = e / HYEMB, i = e % HYEMB; const float pos = (float)(p0 + dir + p); float v;
            if (i == 0) v = pos / (float)(L - 1);
            else { const int bi = (i - 1) & 15; const float band = 1e-4f + (float)bi * ((15.0f - 1e-4f) / 15.0f); const float ang = (float)(2.0 * M_PI / (double)L) * pos * band; v = i <= 16 ? cosf(ang) : -sinf(ang); }
            feats[p * 36 + i] = v; }
        __syncthreads();
        { const int pq = tid >> 6, j = tid & 63; float wv[HYEMB]; float sa[4];
#pragma unroll
            for (int i = 0; i < HYEMB; ++i) wv[i] = w1[i * HYHID + j];
#pragma unroll
            for (int x = 0; x < 4; ++x) sa[x] = b1[j];
#pragma unroll
            for (int i = 0; i < HYEMB; ++i)
#pragma unroll
                for (int x = 0; x < 4; ++x) sa[x] += feats[(4 * pq + x) * 36 + i] * wv[i];
#pragma unroll
            for (int x = 0; x < 4; ++x) h1[(4 * pq + x) * 64 + j] = fq[j] * sa[x];
#pragma unroll 1
            for (int x = 0; x < 4; ++x) { LAS float* hp = h1 + (4 * pq + x) * 64 + j; *hp = sinf(*hp); } }
        __syncthreads();
        { const int pq = tid >> 6, j = tid & 63; float wv[HYHID]; float sa[4];
#pragma unroll
            for (int i = 0; i < HYHID; ++i) wv[i] = w2[i * HYHID + j];
#pragma unroll
            for (int x = 0; x < 4; ++x) sa[x] = b2[j];
#pragma unroll
            for (int i = 0; i < HYHID; ++i)
#pragma unroll
                for (int x = 0; x < 4; ++x) sa[x] += h1[(4 * pq + x) * 64 + i] * wv[i];
#pragma unroll
            for (int x = 0; x < 4; ++x) h2[j * H2P + 4 * pq + x] = fq[HYHID + j] * sa[x];
#pragma unroll 1
            for (int x = 0; x < 4; ++x) { LAS float* hp = h2 + j * H2P + 4 * pq + x; *hp = sinf(*hp); } }
        __syncthreads();
        float acc[FC][32];
#pragma unroll
        for (int cc = 0; cc < FC; ++cc)
#pragma unroll
            for (int p = 0; p < 32; ++p) acc[cc][p] = 0.f;
        const int cl = tid < HYD ? tid : 0;
#pragma unroll 1
        for (int k0 = 0; k0 < HYHID; k0 += 16) { float w[16][FC];
#pragma unroll
            for (int j = 0; j < 16; ++j)
#pragma unroll
                for (int cc = 0; cc < FC; ++cc) w[j][cc] = w3[(size_t)(k0 + j) * (2 * HYD) + dir * HYD + cl + NTHREADS * cc];
#pragma unroll
            for (int j = 0; j < 16; ++j) {
#pragma unroll
                for (int i = 0; i < 8; ++i) { const f32x4 hv = *(const LAS f32x4*)(h2 + (k0 + j) * H2P + 4 * i);
#pragma unroll
                    for (int cc = 0; cc < FC; ++cc) { acc[cc][4 * i] += hv[0] * w[j][cc]; acc[cc][4 * i + 1] += hv[1] * w[j][cc]; acc[cc][4 * i + 2] += hv[2] * w[j][cc]; acc[cc][4 * i + 3] += hv[3] * w[j][cc]; } } } }
        const int a0 = dir ? L - p0 - 32 : L + p0;
#pragma unroll
        for (int cc = 0; cc < FC; ++cc) { const int c = cl + NTHREADS * cc;
            const float delta = (float)(-log(1e-2) / 1.5) + (float)c * (float)((-log(1e-2) / 0.3 + log(1e-2) / 1.5) / (double)(HYD - 1));
            float l1 = 0.f;
#pragma unroll
            for (int p = 0; p < 32; ++p) { const int pos = p0 + dir + p; const float t = (float)pos / (float)(L - 1); float v = acc[cc][p] * expf(-t * delta);
                if (pos >= L) v = 0.f;
                l1 += fabsf(v); ob[tid * OBP + (dir ? 31 - p : p)] = v; }
            if (tid < HYD) F.wsp<float>(WS_L1P)[(size_t)pb * (2 * HYD) + dir * HYD + c] = l1;
            __syncthreads();
            for (int e = tid; e < (HYD < NTHREADS ? HYD : NTHREADS) * 8; e += NTHREADS) { const int ch = e >> 3, qd = e & 7; const LAS float* op = ob + ch * OBP + 4 * qd;
                const f32x4 v4 = {op[0], op[1], op[2], op[3]};
                *(f32x4*)(filt + (size_t)(ch + NTHREADS * cc) * (2 * L) + a0 + 4 * qd) = v4; }
            __syncthreads();
        }
    }
    __syncthreads();
}

__device__ __forceinline__ void s5_param_units(const Frame& F) {
    float* par = F.wsp<float>(WS_S5PAR);
    for (int i = F.bid + F.G * F.tid; i < 2 * S5G * S5P; i += F.G * NTHREADS) {
        const int d = i / (S5G * S5P), g = (i / S5P) % S5G, p = i % S5P;
        const float dt = expf(F.in[I_S5LDT][d * S5G + g]), lr = F.in[I_S5LRE][i], li = F.in[I_S5LIM][i];
        const float mag = expf(lr * dt), lbr = mag * cosf(li * dt), lbi = mag * sinf(li * dt), den = lr * lr + li * li;
        const float fr = ((lbr - 1.f) * lr + lbi * li) / den, fi = (lbi * lr - (lbr - 1.f) * li) / den;
        float* o = par + (size_t)i * 36; o[0] = lbr; o[1] = lbi;
        const float* bre = F.in[I_S5BRE] + ((size_t)g * S5P + p) * S5GS; const float* bim = F.in[I_S5BIM] + ((size_t)g * S5P + p) * S5GS;
        float br[S5GS], bi[S5GS];
#pragma unroll
        for (int k = 0; k < S5GS; ++k) { br[k] = bre[k]; bi[k] = bim[k]; }
#pragma unroll
        for (int k = 0; k < S5GS; ++k) { o[2 + k] = fr * br[k] - fi * bi[k]; o[18 + k] = fr * bi[k] + fi * br[k]; }
        const float magc = expf(lr * dt * (float)CH); o[34] = magc * cosf(li * dt * (float)CH); o[35] = magc * sinf(li * dt * (float)CH);
    }
}

__device__ __forceinline__ void phase_prologue(const Frame& F, int pm = 0) {
    int base = 0;
    if (pm == 0 || pm == 1) {
    conv_job<0>(F, base, F.in[I_ABWIN], AB_IN, F.wsp<bf16_t>(WS_W_ABIN), D, AB_MAIN / 128, 0);
    conv_job<0>(F, base, F.in[I_ABWOUT], D, F.wsp<bf16_t>(WS_W_ABOUT), YC1, D / 128, 0); }
    const int i8_hi = base + 2 * FF / 128;
    if (pm == 0 || pm == 2)
    conv_job_i8<1>(F, base, F.in[I_FFNGU], 2 * FF, F.wsp<signed char>(WS_W_GU), F.wsp<float>(WS_SB_GU), D, 2 * FF / 128, FF);
    if (pm == 0 || pm == 1) {
    conv_job_f8(F, base, F.in[I_FFNDN], D, F.wsp<unsigned char>(WS_W_DN), FF, D / 128);
    conv_job<2>(F, base, F.in[I_CDWIN], CD_IN, F.wsp<bf16_t>(WS_W_CDIN), D, CD_MAIN / 128, 0);
    conv_job<1>(F, base, F.in[I_S5GLU], 2 * S5W, F.wsp<bf16_t>(WS_W_GLU), S5W, 2 * S5W / 128, S5W);
    conv_job<0>(F, base, F.in[I_CDWOUT], D, F.wsp<bf16_t>(WS_W_CDOUT), YC2, D / 128, 0);
    conv_side(F, F.in[I_ABWIN], AB_IN, AB_MAIN, AB_SIDE, F.wsp<bf16_t>(WS_W_ABSIDE), D);
    conv_side(F, F.in[I_CDWIN], CD_IN, SSDD + XBC, CD_SIDE, F.wsp<bf16_t>(WS_W_CDSIDE), D); }
    if (pm == 0 || pm == 3) adaln_units(F);
    if (pm == 0 || pm == 4) { hyena_filter_units(F, i8_hi);
    s5_param_units(F); }
}

__device__ __forceinline__ void phase_finalize(const Frame& F) {
    const float* part = F.wsp<float>(WS_MODP); float* mod = F.wsp<float>(WS_MOD); const float* adab = F.in[I_ADAB];
    for (int i = F.bid * NTHREADS + F.tid; i < 2 * NR * 6 * D; i += F.G * NTHREADS) {
        const int l = i / (NR * 6 * D), r = (i / (6 * D)) % NR, n = i % (6 * D);
        float s = adab[l * 6 * D + n];
        for (int ks = 0; ks < KSL; ++ks) s += part[(((size_t)l * KSL + ks) * NR + r) * (6 * D) + n];
        mod[i] = s; }
    const float* l1p = F.wsp<float>(WS_L1P); float* l1 = F.wsp<float>(WS_L1);
    for (int i = F.bid * NTHREADS + F.tid; i < 2 * HYD; i += F.G * NTHREADS) {
        const int set = i / HYD, c = i % HYD; const int u0 = set ? SEQ / 32 : 0, nu = set ? CTX / 32 : SEQ / 32; float s = 0.f;
        for (int u = 0; u < nu; ++u) s += l1p[(size_t)(u0 + u) * (2 * HYD) + c] + l1p[(size_t)(u0 + u) * (2 * HYD) + HYD + c];
        l1[i] = 1.0f / s; }
}

template <bool ROUTE, bool OUTI8 = false> __device__ __forceinline__ void modulate_rows(const Frame& F, const float* xlat, const float* xctx, int layer, int si, bf16_t* dst, int m_hi, const float* part = nullptr, const float* pgate = nullptr, int nks = 0, float* xw = nullptr) {
    const float* mod = F.wsp<float>(WS_MOD) + (size_t)layer * NR * 6 * D;
    LAS float* rwl = (LAS float*)F.lds;
    LAS float* mdl = (LAS float*)F.lds + (ROUTE ? NE * D : 0); constexpr int NRL = ROUTE ? NB : NR;
    static_assert(((ROUTE ? NE * D : 0) + NRL * 2 * D) * 4 <= LDS_MISC, "modulate LDS");
    __syncthreads();
    if (ROUTE) { for (int i = F.tid; i < D * NE; i += NTHREADS) rwl[(i % NE) * D + i / NE] = F.in[I_ROUTER][i]; }
    for (int i = F.tid; i < NRL * 2 * D; i += NTHREADS) { const int r = i / (2 * D), w = i % (2 * D); mdl[i] = mod[(size_t)r * 6 * D + (size_t)si * D + w]; }
    __syncthreads();
    constexpr int NV = D / 256;
    for (int m = F.gw(); m < m_hi; m += F.ngw()) {
        const float* xr = m < ML ? xlat + (size_t)m * D : xctx + (size_t)(m - ML) * D; const int r = mod_row(m);
        const LAS float* sh = mdl + r * 2 * D; const LAS float* sc = sh + D;
        f32x4 v[NV]; float ss = 0.f;
#pragma unroll
        for (int i = 0; i < NV; ++i) { const int k = 4 * (F.lane + 64 * i); v[i] = *(const f32x4*)(xr + k);
            if (!ROUTE && part != nullptr && m >= ML) { f32x4 ps = *(const f32x4*)(part + (size_t)(m - ML) * D + k);
                for (int ks = 1; ks < nks; ++ks) ps += *(const f32x4*)(part + ((size_t)ks * MC + (m - ML)) * D + k);
                v[i] += *(const f32x4*)(pgate + k) * ps; *(f32x4*)(xw + (size_t)m * D + k) = v[i]; }
            ss += v[i][0] * v[i][0] + v[i][1] * v[i][1] + v[i][2] * v[i][2] + v[i][3] * v[i][3]; }
        ss = wave_sum(ss); const float rinv = 1.0f / sqrtf(ss * (1.0f / (float)D) + EPS);
        float lg[NE];
        if (ROUTE) {
#pragma unroll
            for (int e = 0; e < NE; ++e) lg[e] = 0.f; }
        if (OUTI8) {
            float mx = 0.f;
#pragma unroll
            for (int i = 0; i < NV; ++i) { const int k = 4 * (F.lane + 64 * i); const f32x4 s4 = *(const LAS f32x4*)(sh + k), c4 = *(const LAS f32x4*)(sc + k); v[i] = v[i] * rinv * (c4 + 1.0f) + s4;
                mx = fmaxf(mx, fmaxf(fmaxf(fabsf(v[i][0]), fabsf(v[i][1])), fmaxf(fabsf(v[i][2]), fabsf(v[i][3])))); }
            mx = wave_max(mx); const float scl = mx > 0.f ? mx * (1.0f / 127.0f) : 1.0f, inv = 1.0f / scl;
            signed char* d8 = F.wsp<signed char>(WS_A8) + (size_t)m * D;
#pragma unroll
            for (int i = 0; i < NV; ++i) *(unsigned*)(d8 + 4 * (F.lane + 64 * i)) = pk_i8x4(v[i][0] * inv, v[i][1] * inv, v[i][2] * inv, v[i][3] * inv);
            if (F.lane == 0) F.wsp<float>(WS_SA8)[m] = scl;
            continue; }
#pragma unroll
        for (int i = 0; i < NV; ++i) { const int k = 4 * (F.lane + 64 * i); const f32x4 s4 = *(const LAS f32x4*)(sh + k), c4 = *(const LAS f32x4*)(sc + k);
            f32x4 y = v[i] * rinv * (c4 + 1.0f) + s4;
            if (ROUTE) *(unsigned*)((unsigned char*)dst + (size_t)m * D + k) = cvt_pk_fp8x4(y[0], y[1], y[2], y[3]);
            else { u32x2 w; w.x = pk2(y[0], y[1]); w.y = pk2(y[2], y[3]); *(u32x2*)(dst + (size_t)m * D + k) = w; }
            if (ROUTE) {
#pragma unroll
                for (int e = 0; e < NE; ++e) { const f32x4 rv = *(const LAS f32x4*)(rwl + e * D + k); lg[e] += y[0] * rv[0] + y[1] * rv[1] + y[2] * rv[2] + y[3] * rv[3]; } SCHED_BARRIER(); } }
        if (ROUTE) {
#pragma unroll
            for (int e = 0; e < NE; ++e) lg[e] = wave_sum(lg[e]);
            if (F.lane == 0) { int e0 = 0; float v0 = lg[0];
#pragma unroll
                for (int e = 1; e < NE; ++e) if (lg[e] > v0) { v0 = lg[e]; e0 = e; }
                int e1 = -1; float v1 = -INFINITY;
#pragma unroll
                for (int e = 0; e < NE; ++e) if (e != e0 && lg[e] > v1) { v1 = lg[e]; e1 = e; }
                const float p1 = 1.0f / (1.0f + expf(v0 - v1)), p0 = 1.0f - p1;
                unsigned* cnt = F.wsp<unsigned>(WS_CTL) + CW_CNT;
                const unsigned pos0 = ATOM_ADD(cnt + 64 * e0, 1u), pos1 = ATOM_ADD(cnt + 64 * e1, 1u);
                int* rt = F.wsp<int>(WS_ROUTE) + (size_t)m * 4; rt[0] = e0; rt[1] = e1; rt[2] = (int)pos0; rt[3] = (int)pos1;
                float* rp = F.wsp<float>(WS_RPROB) + (size_t)m * 2; rp[0] = p0; rp[1] = p1; } }
    }
}

__device__ __forceinline__ void side_gemm(const Frame& F, const bf16_t* A, const bf16_t* Ws, float* out, int M) {
    const int r = F.lane & 15, q = F.lane >> 4; constexpr int KW = D / NWAVES; static_assert(KW % 32 == 0 && NTHREADS == 16 * 32, "side gemm split");
    LAS float* red = (LAS float*)F.lds;
    for (int blk = F.bid; blk < M / 16; blk += F.G) {
        f32x4 acc0 = (f32x4){0.f, 0.f, 0.f, 0.f}, acc1 = acc0; const int k0 = F.wave * KW;
        const bf16_t* ap = A + (size_t)(blk * 16 + r) * D + k0 + q * 8; const bf16_t* b0 = Ws + (size_t)r * D + k0 + q * 8; const bf16_t* b1 = Ws + (size_t)(16 + r) * D + k0 + q * 8;
#pragma unroll
        for (int k = 0; k < KW; k += 32) { const bf16x8 a = *(const bf16x8*)(ap + k), x0 = *(const bf16x8*)(b0 + k), x1 = *(const bf16x8*)(b1 + k);
            acc0 = MFMA16(a, x0, acc0); acc1 = MFMA16(a, x1, acc1); }
        __syncthreads();
#pragma unroll
        for (int j = 0; j < 4; ++j) { red[(F.wave * 16 + 4 * q + j) * 32 + r] = acc0[j]; red[(F.wave * 16 + 4 * q + j) * 32 + 16 + r] = acc1[j]; }
        __syncthreads();
        { const int row = F.tid >> 5, col = F.tid & 31; float sm = 0.f;
#pragma unroll
            for (int w = 0; w < NWAVES; ++w) sm += red[(w * 16 + row) * 32 + col];
            out[(size_t)(blk * 16 + row) * 32 + col] = sm; }
    }
    __syncthreads();
}

__device__ __forceinline__ void conv3x4(const bf16_t* rec, bool has_l, bool has_r, const float* w, int wld, const float* b, float (&o)[4]) {
    const u32x2 c = *(const u32x2*)rec; u32x2 l = (u32x2){0u, 0u}, r = (u32x2){0u, 0u};
    if (has_l) l = *(const u32x2*)(rec - 4);
    if (has_r) r = *(const u32x2*)(rec + 4);
    const f32x4 w0 = *(const f32x4*)w, w1 = *(const f32x4*)(w + wld), w2 = *(const f32x4*)(w + 2 * wld), bb = *(const f32x4*)b;
    const float xc[4] = {bf2f(c.x & 0xffffu), bf2f(c.x >> 16), bf2f(c.y & 0xffffu), bf2f(c.y >> 16)};
    const float xl[4] = {bf2f(l.x & 0xffffu), bf2f(l.x >> 16), bf2f(l.y & 0xffffu), bf2f(l.y >> 16)};
    const float xr[4] = {bf2f(r.x & 0xffffu), bf2f(r.x >> 16), bf2f(r.y & 0xffffu), bf2f(r.y >> 16)};
#pragma unroll
    for (int j = 0; j < 4; ++j) o[j] = bb[j] + w0[j] * xl[j] + w1[j] * xc[j] + w2[j] * xr[j];
}
template <int L, bool LAT> __device__ __forceinline__ void hyena_unit(const Frame& F0, int cg, int hymode = 0) {
    Frame F = F0; LAUNDER(F.tid); F.lane = F.tid & 63;
    constexpr int NT1 = L / 128, ZP = 136, ZCH = NB * NT1 * ZP, KRP = 2 * L + 8;
    static_assert(4 * ZCH * 2 + 8 * KRP * 2 + ZP * 2 <= LDS_MISC && 4 * NB * L * 4 <= LDS_MISC && NB <= 4 && NT1 <= 16, "hyena LDS");
    LAS bf16_t* zl = (LAS bf16_t*)F.lds;
    LAS bf16_t* kr = zl + 4 * ZCH;
    LAS bf16_t* zz = kr + 8 * KRP;
    LAS float* res = (LAS float*)F.lds;
    const bf16_t* PH = F.wsp<bf16_t>(WS_PH); const float* cw = F.in[I_HYCW]; const float* cb = F.in[I_HYCB];
    const float* filt = F.wsp<float>(LAT ? WS_FILT0 : WS_FILT1);
    const int c0 = cg * 4;
    __syncthreads();
    constexpr int ZB = 4;
    for (int idx0 = F.tid; idx0 < ((hymode & 2) ? 0 : NB * L); idx0 += ZB * NTHREADS) { float a[ZB][4], v[ZB][4];
#pragma unroll
        for (int j = 0; j < ZB; ++j) { const int idx = idx0 + j * NTHREADS < NB * L ? idx0 + j * NTHREADS : idx0; const int b = idx / L, t = idx % L; const int m = LAT ? b * SEQ + t : ML + b * CTX + t;
            bool hl, hr; if (LAT) { hl = (t & (GW - 1)) != 0; hr = (t & (GW - 1)) != GW - 1; } else { hl = t > 0; hr = t < L - 1; }
            conv3x4(PH + ((size_t)(HYD / 4 + cg) * MT + m) * 4, hl, hr, cw + HYD + c0, 3 * HYD, cb + HYD + c0, a[j]);
            conv3x4(PH + ((size_t)(2 * HYD / 4 + cg) * MT + m) * 4, hl, hr, cw + 2 * HYD + c0, 3 * HYD, cb + 2 * HYD + c0, v[j]); }
#pragma unroll
        for (int j = 0; j < ZB; ++j) { const int idx = idx0 + j * NTHREADS; if (idx < NB * L) { const int b = idx / L, t = idx % L;
#pragma unroll
            for (int c = 0; c < 4; ++c) zl[c * ZCH + (b * NT1 + (t >> 7)) * ZP + (t & 127)] = (bf16_t)f2bf(a[j][c] * v[j][c]); } } }
    constexpr int KB = 8;
    for (int idx0 = F.tid; idx0 < 4 * KRP; idx0 += KB * NTHREADS) { float tv[KB];
#pragma unroll
        for (int j = 0; j < KB; ++j) { const int idx = idx0 + j * NTHREADS; const int c = idx / KRP, i = idx % KRP;
            tv[j] = (idx < 4 * KRP && i >= 1 && i <= 2 * L - 1) ? filt[(size_t)(c0 + c) * (2 * L) + 2 * L - i] : 0.f; }
#pragma unroll
        for (int j = 0; j < KB; ++j) { const int idx = idx0 + j * NTHREADS; if (idx < 4 * KRP) { const int c = idx / KRP, i = idx % KRP;
            const bf16_t v = (bf16_t)((i >= 1 && i <= 2 * L - 1) ? f2bf(tv[j]) : 0u);
            kr[(c * 2) * KRP + i] = v; if (i >= 1) kr[(c * 2 + 1) * KRP + i - 1] = v; else kr[(c * 2 + 1) * KRP + KRP - 1] = 0; } } }
    if (F.tid < ZP) zz[F.tid] = 0;
    __syncthreads();
    const int ch = F.wave >> 1, h = F.wave & 1, i = F.lane & 31, q = F.lane >> 5;
    const int cb_ = i >> 3, t1 = 8 * h + (i & 7); const bool colok = cb_ < NB && t1 < NT1;
    f32x16 acc[4];
#pragma unroll
    for (int mt = 0; mt < 4; ++mt)
#pragma unroll
        for (int r = 0; r < 16; ++r) acc[mt][r] = 0.f;
    if (8 * h < NT1) {
        const int d_lo = 8 * h - (NT1 - 1), d_hi = (hymode & 1) ? d_lo - 1 : ((8 * h + 7 < NT1 - 1) ? 8 * h + 7 : NT1 - 1);
        const LAS unsigned* kbase = (const LAS unsigned*)(kr + (ch * 2 + (i & 1)) * KRP) + (L / 2 + 4 * q - ((i + 1) >> 1));
        const LAS bf16_t* zc = zl + ch * ZCH + (colok ? cb_ : 0) * NT1 * ZP + 8 * q;
        bf16x8 fa[14], fb[14];
#define HY_LOADF(dst, dd) do { const LAS unsigned* kb_ = kbase - 8 * (8 * (dd) - 7); _Pragma("unroll") for (int fi_ = 0; fi_ < 14; ++fi_) { const LAS unsigned* p_ = kb_ - 8 * fi_; \
            u32x4 fw_; fw_.x = p_[0]; fw_.y = p_[1]; fw_.z = p_[2]; fw_.w = p_[3]; dst[fi_] = __builtin_bit_cast(bf16x8, fw_); } } while (0)
#define HY_STEP(cur, nxt, dd) do { const int s1_ = t1 - (dd); const bool ok_ = colok && s1_ >= 0 && s1_ < NT1; const LAS bf16_t* zp_ = ok_ ? zc + s1_ * ZP : zz + 8 * q; const int zs_ = ok_ ? 16 : 0; \
            bf16x8 zf_[8]; _Pragma("unroll") for (int ks_ = 0; ks_ < 8; ++ks_) zf_[ks_] = *(const LAS bf16x8*)(zp_ + zs_ * ks_); \
            if ((dd) + 1 <= d_hi) HY_LOADF(nxt, (dd) + 1); \
            _Pragma("unroll") for (int ks_ = 0; ks_ < 8; ++ks_) _Pragma("unroll") for (int mt_ = 0; mt_ < 4; ++mt_) acc[mt_] = MFMA32(cur[2 * mt_ - ks_ + 7], zf_[ks_], acc[mt_]); } while (0)
        if (d_lo <= d_hi) HY_LOADF(fa, d_lo);
#pragma unroll 1
        for (int d = d_lo; d <= d_hi; d += 2) {
            HY_STEP(fa, fb, d);
            if (d + 1 <= d_hi) HY_STEP(fb, fa, d + 1);
        }
#undef HY_LOADF
#undef HY_STEP
        if (colok) { const float il1 = F.wsp<float>(WS_L1)[(LAT ? 0 : HYD) + c0 + ch], bias = F.in[I_HYBIAS][c0 + ch]; const LAS bf16_t* zr = zl + ch * ZCH + (cb_ * NT1 + t1) * ZP;
#pragma unroll
            for (int mt = 0; mt < 4; ++mt)
#pragma unroll
                for (int r = 0; r < 16; ++r) { const int t0 = 32 * mt + 8 * (r >> 2) + 4 * q + (r & 3); acc[mt][r] = acc[mt][r] * il1 + bias * bf2f(zr[t0]); } }
    }
    __syncthreads();
    if (8 * h < NT1 && colok) {
#pragma unroll
        for (int mt = 0; mt < 4; ++mt)
#pragma unroll
            for (int r = 0; r < 16; ++r) res[(ch * NB + cb_) * L + t1 * 128 + 32 * mt + 8 * (r >> 2) + 4 * q + (r & 3)] = acc[mt][r]; }
    __syncthreads();
    bf16_t* Y = F.wsp<bf16_t>(WS_YCAT);
    for (int idx0 = F.tid; idx0 < ((hymode & 2) ? 0 : NB * L); idx0 += ZB * NTHREADS) { float x0[ZB][4];
#pragma unroll
        for (int j = 0; j < ZB; ++j) { const int idx = idx0 + j * NTHREADS < NB * L ? idx0 + j * NTHREADS : idx0; const int b = idx / L, t = idx % L; const int m = LAT ? b * SEQ + t : ML + b * CTX + t;
            bool hl, hr; if (LAT) { hl = (t & (GW - 1)) != 0; hr = (t & (GW - 1)) != GW - 1; } else { hl = t > 0; hr = t < L - 1; }
            conv3x4(PH + ((size_t)cg * MT + m) * 4, hl, hr, cw + c0, 3 * HYD, cb + c0, x0[j]); }
#pragma unroll
        for (int j = 0; j < ZB; ++j) { const int idx = idx0 + j * NTHREADS; if (idx < NB * L) { const int b = idx / L, t = idx % L; const int m = LAT ? b * SEQ + t : ML + b * CTX + t;
            u32x2 wv; wv.x = pk2(x0[j][0] * res[(0 * NB + b) * L + t], x0[j][1] * res[(1 * NB + b) * L + t]); wv.y = pk2(x0[j][2] * res[(2 * NB + b) * L + t], x0[j][3] * res[(3 * NB + b) * L + t]);
            *(u32x2*)(Y + (size_t)m * YC1 + c0) = wv; } } }
    __syncthreads();
}
__device__ __forceinline__ void hyena_units(const Frame& F, int hymode = 0) {
    for (int u = F.bid; u < HYD / 4; u += F.G) hyena_unit<SEQ, true>(F, u, hymode);
    for (int u = F.bid; u < HYD / 4; u += F.G) hyena_unit<CTX, false>(F, u, hymode);
}

__device__ __forceinline__ float* mlst_slot(const Frame& F, int d, int b, int h, int cs) { return F.wsp<float>(WS_MLST) + ((((size_t)d * NB + b) * MLH + h) * NCS + cs) * MLST_STRIDE; }

__device__ __forceinline__ void mlstm_gates(const Frame& F, LAS float* ga, int m0, int h) {
    if (F.tid < CH) { const float* sd = F.wsp<float>(WS_SIDE) + (size_t)(m0 + F.tid) * 32; const float* gb = F.in[I_MLGB];
        ga[0 * CH + F.tid] = logsigmoidf_(sd[MLH + h] + gb[MLH + h]); ga[1 * CH + F.tid] = sd[h] + gb[h];
        ga[2 * CH + F.tid] = logsigmoidf_(sd[3 * MLH + h] + gb[3 * MLH + h]); ga[3 * CH + F.tid] = sd[2 * MLH + h] + gb[2 * MLH + h]; }
    __syncthreads();
    if (F.wave == 0) wave_scan128<false>(ga + 0 * CH, ga + 4 * CH, false, F.lane);
    else if (F.wave == 1) wave_scan128<false>(ga + 2 * CH, ga + 5 * CH, true, F.lane);
    __syncthreads();
}

__device__ __forceinline__ void mlstm_local_unit(const Frame& F0, int b, int h, int cs) {
    Frame F = F0; LAUNDER(F.tid); F.lane = F.tid & 63;
    LAS bf16_t* KwF = (LAS bf16_t*)F.lds; LAS bf16_t* KwB = (LAS bf16_t*)(F.lds + TILE_B); LAS bf16_t* VT = (LAS bf16_t*)(F.lds + 2 * TILE_B);
    LAS float* ga = (LAS float*)(F.lds + 3 * TILE_B);
    const int m0 = chunk_row0(b, cs);
    __syncthreads();
    mlstm_gates(F, ga, m0, h);
    if (F.tid < 2 * CH) { const int d = F.tid >> 7, i = F.tid & 127; const LAS float* bc = ga + (4 + d) * CH; const LAS float* ig = ga + (1 + 2 * d) * CH; const float g = d ? bc[0] : bc[CH - 1];
        const float a = g - bc[i] + ig[i]; float mx = a;
        mx = fmaxf(mx, __shfl_xor(mx, 1)); mx = fmaxf(mx, __shfl_xor(mx, 2)); mx = fmaxf(mx, __shfl_xor(mx, 4)); mx = fmaxf(mx, __shfl_xor(mx, 8)); mx = fmaxf(mx, __shfl_xor(mx, 16)); mx = fmaxf(mx, __shfl_xor(mx, 32));
        ga[(6 + d) * CH + i] = a; if ((i & 63) == 0) ga[8 * CH + 8 + 2 * d + (i >> 6)] = mx; }
    __syncthreads();
    if (F.tid < 2 * CH) { const int d = F.tid >> 7, i = F.tid & 127; const float mx = fmaxf(ga[8 * CH + 8 + 2 * d], ga[8 * CH + 8 + 2 * d + 1]);
        const LAS float* bc = ga + (4 + d) * CH; ga[(6 + d) * CH + i] = expf(ga[(6 + d) * CH + i] - mx);
        if (i == 0) { ga[8 * CH + 2 * d] = mx; ga[8 * CH + 2 * d + 1] = d ? bc[0] : bc[CH - 1]; } }
    __syncthreads();
    const bf16_t* P = F.wsp<bf16_t>(WS_P); const float* cw = F.in[I_MLCW]; const float* cb = F.in[I_MLCB];
    { const int s = F.tid & 127, fgq = F.tid >> 7; bool hl, hr; conv_nbr(cs, s, hl, hr); const float wf = ga[6 * CH + s], wb = ga[7 * CH + s];
#pragma unroll 2
        for (int i = 0; i < 4; ++i) { const int f0 = (fgq + 4 * i) * 8;
            float kv[8]; conv3x8(P + (size_t)(m0 + s) * AB_MAIN + 3 * HYD + MLD + h * DH + f0, AB_MAIN, hl, hr, cw + MLD + h * DH + f0, 2 * MLD, cb + MLD + h * DH + f0, kv);
            float vv[8]; unpack8(*(const u32x4*)(P + (size_t)(m0 + s) * AB_MAIN + 3 * HYD + 2 * MLD + h * DH + f0), vv);
#pragma unroll
            for (int j = 0; j < 8; ++j) { const float kk = siluf(kv[j]); KwF[(f0 + j) * TP + s] = (bf16_t)f2bf(kk * wf); KwB[(f0 + j) * TP + s] = (bf16_t)f2bf(kk * wb); VT[(f0 + j) * TP + s] = (bf16_t)f2bf(vv[j]); } } }
    __syncthreads();
    const int wm = F.wave >> 1, wn = F.wave & 1, r = F.lane & 15, q = F.lane >> 4;
#pragma unroll
    for (int d = 0; d < 2; ++d) {
        f32x4 acc[2][4]; zero_acc(acc);
        wave_mma<2, 4, 4>(acc, d ? KwB : KwF, 32 * wm, VT, 64 * wn, F.lane);
        bf16_t* ct = (bf16_t*)mlst_slot(F, d, b, h, cs);
#pragma unroll
        for (int mt = 0; mt < 2; ++mt)
#pragma unroll
            for (int nt = 0; nt < 4; ++nt) { u32x2 w; w.x = pk2(acc[mt][nt][0], acc[mt][nt][1]); w.y = pk2(acc[mt][nt][2], acc[mt][nt][3]);
                *(u32x2*)(ct + (64 * wn + 16 * nt + r) * DH + 32 * wm + 16 * mt + 4 * q) = w; }
    }
    if (F.tid < 2 * CH) { const int d = F.tid >> 7, kk = F.tid & 127; const LAS bf16_t* row = (d ? KwB : KwF) + kk * TP; float s = 0.f;
        for (int i = 0; i < CH; i += 8) { float f[8]; unpack8(*(const LAS u32x4*)(row + i), f);
#pragma unroll
            for (int j = 0; j < 8; ++j) s += f[j]; }
        float* sl = mlst_slot(F, d, b, h, cs); sl[MLST_CT + kk] = s;
        if (kk == 0) { sl[MLST_CT + DH] = ga[8 * CH + 2 * d]; sl[MLST_CT + DH + 1] = ga[8 * CH + 2 * d + 1]; } }
    __syncthreads();
}

__device__ __forceinline__ void mlstm_carry(const Frame& F) {
    constexpr int NCI = DH * DH / 8, NVI = NCI + DH / 4, NITEM = 2 * NB * MLH * NVI;
    for (int it = F.bid * NTHREADS + F.tid; it < NITEM; it += F.G * NTHREADS) {
        const int grp = it / NVI, e = it % NVI, d = grp / (NB * MLH), b = (grp / MLH) % NB, h = grp % MLH;
        float st[8];
#pragma unroll
        for (int j = 0; j < 8; ++j) st[j] = 0.f;
        float mp = 0.f;
        u32x4 lc[NCS]; float mls[NCS], gs[NCS];
#pragma unroll
        for (int qi = 0; qi < NCS; ++qi) { const float* sl = mlst_slot(F, d, b, h, scan_slot(d, qi)); mls[qi] = sl[MLST_CT + DH]; gs[qi] = sl[MLST_CT + DH + 1];
            lc[qi] = e < NCI ? *((const u32x4*)sl + e) : __builtin_bit_cast(u32x4, *((const f32x4*)(sl + MLST_CT) + (e - NCI))); }
#pragma unroll
        for (int qi = 0; qi < NCS; ++qi) { float* sl = mlst_slot(F, d, b, h, scan_slot(d, qi));
            const float ml = mls[qi], g = gs[qi];
            const float mn = fmaxf(g + mp, ml), sp = expf(g + mp - mn), slc = expf(ml - mn);
            if (e < NCI) { u32x4* pp = (u32x4*)sl + e; float loc[8]; unpack8(lc[qi], loc);
                u32x4 w; w.x = pk2(st[0], st[1]); w.y = pk2(st[2], st[3]); w.z = pk2(st[4], st[5]); w.w = pk2(st[6], st[7]); *pp = w;
#pragma unroll
                for (int j = 0; j < 8; ++j) st[j] = st[j] * sp + loc[j] * slc; }
            else { f32x4* pp = (f32x4*)(sl + MLST_CT) + (e - NCI); const f32x4 loc = __builtin_bit_cast(f32x4, lc[qi]); *pp = (f32x4){st[0], st[1], st[2], st[3]};
                st[0] = st[0] * sp + loc[0] * slc; st[1] = st[1] * sp + loc[1] * slc; st[2] = st[2] * sp + loc[2] * slc; st[3] = st[3] * sp + loc[3] * slc;
                if (e == NCI) sl[MLST_CT + DH + 2] = mp; }
            mp = mn; }
    }
}

__device__ __forceinline__ void mlstm_out_unit(const Frame& F0, int b, int h, int cs) {
    Frame F = F0; LAUNDER(F.tid); F.lane = F.tid & 63;
    LAS bf16_t* Qs = (LAS bf16_t*)F.lds; LAS bf16_t* Ks = (LAS bf16_t*)(F.lds + TILE_B); LAS bf16_t* VT = (LAS bf16_t*)(F.lds + 2 * TILE_B); LAS bf16_t* Cs = (LAS bf16_t*)(F.lds + 3 * TILE_B);
    LAS bf16_t* Ss = Ks;
    LAS float* Hs = (LAS float*)F.lds;
    LAS float* ga = (LAS float*)(F.lds + 4 * TILE_B);
    LAS float* den2 = ga;
    LAS float* qn = ga + 2 * CH;
    LAS float* nin = ga + 3 * CH;
    static_assert(4 * TILE_B + 14 * CH * 4 <= LDS_MISC, "mLSTM out LDS");
    const int m0 = chunk_row0(b, cs);
    const bf16_t* P = F.wsp<bf16_t>(WS_P); const float* cw = F.in[I_MLCW]; const float* cb = F.in[I_MLCB];
    u32x4 cpre[4], opre[4]; float npre = 0.f;
    { const u32x4* s0 = (const u32x4*)mlst_slot(F, 0, b, h, cs);
#pragma unroll
        for (int i = 0; i < 4; ++i) cpre[i] = s0[F.tid + NTHREADS * i];
        if (F.tid < DH) npre = mlst_slot(F, 0, b, h, cs)[MLST_CT + F.tid];
        const bf16_t* op = P + (size_t)(m0 + (F.tid >> 2)) * AB_MAIN + 3 * HYD + 3 * MLD + h * DH + (F.tid & 3) * 32;
#pragma unroll
        for (int i = 0; i < 4; ++i) opre[i] = *(const u32x4*)(op + 8 * i); }
    __syncthreads();
    mlstm_gates(F, ga, m0, h);
    if (F.wave < 2) { const int d = F.wave; const LAS float* bc = ga + (4 + d) * CH; const LAS float* ig = ga + (1 + 2 * d) * CH;
        const int i0 = d ? CH - 1 - 2 * F.lane : 2 * F.lane, i1 = d ? i0 - 1 : i0 + 1; ga[(6 + d) * CH + i0] = ig[i0] - bc[i0]; ga[(6 + d) * CH + i1] = ig[i1] - bc[i1];
        wave_scan128<true>(ga + (6 + d) * CH, ga + (8 + d) * CH, d != 0, F.lane); }
    { const int fg = F.tid & 15, sr = F.tid >> 4, f0 = fg * 8; const float qs = 0.08838834764831845f;
        const float* wq = cw + h * DH + f0; const float* wk = cw + MLD + h * DH + f0;
        f32x4 wqa[3], wqb[3], wka[3], wkb[3];
#pragma unroll
        for (int tp = 0; tp < 3; ++tp) { wqa[tp] = *(const f32x4*)(wq + tp * 2 * MLD); wqb[tp] = *(const f32x4*)(wq + tp * 2 * MLD + 4); wka[tp] = *(const f32x4*)(wk + tp * 2 * MLD); wkb[tp] = *(const f32x4*)(wk + tp * 2 * MLD + 4); }
        const f32x4 bqa = *(const f32x4*)(cb + h * DH + f0), bqb = *(const f32x4*)(cb + h * DH + f0 + 4), bka = *(const f32x4*)(cb + MLD + h * DH + f0), bkb = *(const f32x4*)(cb + MLD + h * DH + f0 + 4);
#pragma unroll 2
        for (int ps = 0; ps < CH / 32; ++ps) { const int s = 32 * ps + sr; bool hl, hr; conv_nbr(cs, s, hl, hr);
            const bf16_t* qp = P + (size_t)(m0 + s) * AB_MAIN + 3 * HYD + h * DH + f0; const bf16_t* kp = qp + MLD;
            const u32x4 z4 = {0u, 0u, 0u, 0u};
            const u32x4 qc = *(const u32x4*)qp, kc = *(const u32x4*)kp;
            u32x4 ql = z4, qr = z4, kl = z4, kr_ = z4;
            if (hl) { ql = *(const u32x4*)(qp - AB_MAIN); kl = *(const u32x4*)(kp - AB_MAIN); }
            if (hr) { qr = *(const u32x4*)(qp + AB_MAIN); kr_ = *(const u32x4*)(kp + AB_MAIN); }
            float xl[8], xc[8], xr[8], qv[8], kv[8];
            unpack8(ql, xl); unpack8(qc, xc); unpack8(qr, xr);
#pragma unroll
            for (int j = 0; j < 4; ++j) { qv[j] = bqa[j] + wqa[0][j] * xl[j] + wqa[1][j] * xc[j] + wqa[2][j] * xr[j]; qv[4 + j] = bqb[j] + wqb[0][j] * xl[4 + j] + wqb[1][j] * xc[4 + j] + wqb[2][j] * xr[4 + j]; }
            unpack8(kl, xl); unpack8(kc, xc); unpack8(kr_, xr);
#pragma unroll
            for (int j = 0; j < 4; ++j) { kv[j] = bka[j] + wka[0][j] * xl[j] + wka[1][j] * xc[j] + wka[2][j] * xr[j]; kv[4 + j] = bkb[j] + wkb[0][j] * xl[4 + j] + wkb[1][j] * xc[4 + j] + wkb[2][j] * xr[4 + j]; }
            u32x4 qw, kw; qw.x = pk2(siluf(qv[0]) * qs, siluf(qv[1]) * qs); qw.y = pk2(siluf(qv[2]) * qs, siluf(qv[3]) * qs); qw.z = pk2(siluf(qv[4]) * qs, siluf(qv[5]) * qs); qw.w = pk2(siluf(qv[6]) * qs, siluf(qv[7]) * qs);
            kw.x = pk2(siluf(kv[0]), siluf(kv[1])); kw.y = pk2(siluf(kv[2]), siluf(kv[3])); kw.z = pk2(siluf(kv[4]), siluf(kv[5])); kw.w = pk2(siluf(kv[6]), siluf(kv[7]));
            *(LAS u32x4*)(Qs + s * TP + f0) = qw; *(LAS u32x4*)(Ks + s * TP + f0) = kw; } }
    { const int s = F.tid & 127, fgq = F.tid >> 7;
#pragma unroll
        for (int i = 0; i < 4; ++i) { const int f0 = (fgq + 4 * i) * 8;
            float vv[8]; unpack8(*(const u32x4*)(P + (size_t)(m0 + s) * AB_MAIN + 3 * HYD + 2 * MLD + h * DH + f0), vv);
#pragma unroll
            for (int j = 0; j < 8; ++j) VT[(f0 + j) * TP + s] = (bf16_t)f2bf(vv[j]); } }
    __syncthreads();
    if (F.tid < 2 * CH) { const int d = F.tid >> 7, i = F.tid & 127; const float m_in = mlst_slot(F, d, b, h, cs)[MLST_CT + DH + 2]; const float M = fmaxf(ga[(8 + d) * CH + i], m_in);
        const float bci = ga[(4 + d) * CH + i]; ga[(8 + d) * CH + i] = M; ga[(10 + d) * CH + i] = expf(m_in - M); ga[(12 + d) * CH + i] = expf(-(bci + M)); }
    const int wm = F.wave >> 1, wn = F.wave & 1, r = F.lane & 15, q = F.lane >> 4;
    f32x4 sraw[2][4]; zero_acc(sraw);
    wave_mma<2, 4, 4>(sraw, Qs, 32 * wm, Ks, 64 * wn, F.lane);
    f32x4 hsum[2][4]; zero_acc(hsum);
    __syncthreads();
#pragma unroll 1
    for (int d = 0; d < 2; ++d) {
#pragma unroll
        for (int i = 0; i < 4; ++i) { const int it = F.tid + NTHREADS * i, vv = (8 * it) / DH, kk = (8 * it) % DH; *(LAS u32x4*)(Cs + vv * TP + kk) = cpre[i]; }
        if (F.tid < DH) nin[F.tid] = npre;
        if (d == 0) { const u32x4* s1 = (const u32x4*)mlst_slot(F, 1, b, h, cs);
#pragma unroll
            for (int i = 0; i < 4; ++i) cpre[i] = s1[F.tid + NTHREADS * i];
            if (F.tid < DH) npre = mlst_slot(F, 1, b, h, cs)[MLST_CT + F.tid]; }
        const LAS float* ea = ga + (6 + d) * CH; const LAS float* Ma = ga + (8 + d) * CH;
#pragma unroll
        for (int mt = 0; mt < 2; ++mt)
#pragma unroll
            for (int j = 0; j < 4; ++j) { const int t = 32 * wm + 16 * mt + 4 * q + j; const float Mt = Ma[t]; float rs = 0.f;
#pragma unroll
                for (int nt = 0; nt < 4; ++nt) { const int s = 64 * wn + 16 * nt + r; const bool ok = d ? (s >= t) : (s <= t);
                    const float v = ok ? sraw[mt][nt][j] * FEXP(ea[s] - Mt) : 0.f; rs += v; Ss[t * TP + s] = (bf16_t)f2bf(v); }
                rs += __shfl_xor(rs, 1); rs += __shfl_xor(rs, 2); rs += __shfl_xor(rs, 4); rs += __shfl_xor(rs, 8);
                if (r == 0) den2[wn * CH + t] = rs; }
        __syncthreads();
        if (F.tid < CH) { const LAS bf16_t* row = Qs + F.tid * TP; float s = 0.f;
            for (int i = 0; i < DH; i += 8) { float f[8]; unpack8(*(const LAS u32x4*)(row + i), f);
#pragma unroll
                for (int j = 0; j < 8; ++j) s += f[j] * nin[i + j]; }
            qn[F.tid] = s; }
        f32x4 asv[2][4], aqc[2][4]; zero_acc(asv); zero_acc(aqc);
        wave_mma<2, 4, 4>(asv, Ss, 32 * wm, VT, 64 * wn, F.lane);
        wave_mma<2, 4, 4>(aqc, Qs, 32 * wm, Cs, 64 * wn, F.lane);
        __syncthreads();
        const LAS float* wi = ga + (10 + d) * CH; const LAS float* emt = ga + (12 + d) * CH;
#pragma unroll
        for (int mt = 0; mt < 2; ++mt)
#pragma unroll
            for (int j = 0; j < 4; ++j) { const int t = 32 * wm + 16 * mt + 4 * q + j; const float w = wi[t];
                const float den = den2[t] + den2[CH + t] + w * qn[t]; const float inv = 1.0f / fmaxf(fabsf(den), emt[t]);
#pragma unroll
                for (int nt = 0; nt < 4; ++nt) hsum[mt][nt][j] += (asv[mt][nt][j] + w * aqc[mt][nt][j]) * inv; }
        __syncthreads();
    }
#pragma unroll
    for (int mt = 0; mt < 2; ++mt)
#pragma unroll
        for (int nt = 0; nt < 4; ++nt)
#pragma unroll
            for (int j = 0; j < 4; ++j) Hs[(32 * wm + 16 * mt + 4 * q + j) * 132 + 64 * wn + 16 * nt + r] = hsum[mt][nt][j];
    __syncthreads();
    { const int t = F.tid >> 2, part = F.tid & 3; const LAS float* hr_ = Hs + t * 132 + part * 32; float v[32]; float s = 0.f;
#pragma unroll
        for (int i = 0; i < 32; ++i) { v[i] = hr_[i]; s += v[i]; }
        s += __shfl_xor(s, 1); s += __shfl_xor(s, 2); const float mu = s * (1.0f / DH); float qv = 0.f;
#pragma unroll
        for (int i = 0; i < 32; ++i) { v[i] -= mu; qv += v[i] * v[i]; }
        qv += __shfl_xor(qv, 1); qv += __shfl_xor(qv, 2); const float inv = 1.0f / sqrtf(qv * (1.0f / DH) + EPS);
        const float* nw = F.in[I_MLNW] + h * DH + part * 32;
        f32x4 nwv[8];
#pragma unroll
        for (int i = 0; i < 8; ++i) nwv[i] = *(const f32x4*)(nw + 4 * i);
        bf16_t* yp = F.wsp<bf16_t>(WS_YCAT) + (size_t)(m0 + t) * YC1 + HYD + h * DH + part * 32;
#pragma unroll
        for (int i = 0; i < 32; i += 8) { float o[8]; unpack8(opre[i >> 3], o); float y[8];
#pragma unroll
            for (int j = 0; j < 8; ++j) y[j] = v[i + j] * inv * nwv[(i + j) >> 2][(i + j) & 3] * sigmoidf_(o[j]);
            u32x4 w; w.x = pk2(y[0], y[1]); w.y = pk2(y[2], y[3]); w.z = pk2(y[4], y[5]); w.w = pk2(y[6], y[7]); *(u32x4*)(yp + i) = w; } }
    __syncthreads();
}

__device__ __forceinline__ float* ssd_slot(const Frame& F, int d, int b, int hd, int cs) { return F.wsp<float>(WS_SSDST) + ((((size_t)d * NB + b) * SSDH + hd) * NCS + cs) * SSDST_STRIDE; }
constexpr int XB_B = SSDD + SSDD, XB_C = SSDD + SSDD + SSDG * SSDN;

__device__ __forceinline__ void ssd_act_pass(const Frame& F) {
    const bf16_t* P = F.wsp<bf16_t>(WS_P); bf16_t* XA = F.wsp<bf16_t>(WS_XACT); const float* cw = F.in[I_SSDCW]; const float* cb = F.in[I_SSDCB];
    constexpr int NFG = XBC / 8;
    const int stride = F.G * NTHREADS;
    for (int idx = F.bid * NTHREADS + F.tid; idx < MT * NFG; idx += 2 * stride) {
        const int idx1 = idx + stride; const bool ok1 = idx1 < MT * NFG; const int i1 = ok1 ? idx1 : idx;
        const int m0 = idx / NFG, c0 = (idx % NFG) * 8, m1 = i1 / NFG, c1 = (i1 % NFG) * 8; bool hl0, hr0, hl1, hr1;
        if (m0 < ML) { hl0 = (m0 & (GW - 1)) != 0; hr0 = (m0 & (GW - 1)) != GW - 1; } else { const int pos = (m0 - ML) % CTX; hl0 = pos > 0; hr0 = pos < CTX - 1; }
        if (m1 < ML) { hl1 = (m1 & (GW - 1)) != 0; hr1 = (m1 & (GW - 1)) != GW - 1; } else { const int pos = (m1 - ML) % CTX; hl1 = pos > 0; hr1 = pos < CTX - 1; }
        float v[8], y[8]; conv3x8(P + (size_t)m0 * CD_MAIN + SSDD + c0, CD_MAIN, hl0, hr0, cw + c0, XBC, cb + c0, v); conv3x8(P + (size_t)m1 * CD_MAIN + SSDD + c1, CD_MAIN, hl1, hr1, cw + c1, XBC, cb + c1, y);
        u32x4 w; w.x = pk2(siluf(v[0]), siluf(v[1])); w.y = pk2(siluf(v[2]), siluf(v[3])); w.z = pk2(siluf(v[4]), siluf(v[5])); w.w = pk2(siluf(v[6]), siluf(v[7]));
        u32x4 z; z.x = pk2(siluf(y[0]), siluf(y[1])); z.y = pk2(siluf(y[2]), siluf(y[3])); z.z = pk2(siluf(y[4]), siluf(y[5])); z.w = pk2(siluf(y[6]), siluf(y[7]));
        *(u32x4*)(XA + (size_t)m0 * XBC + c0) = w;
        if (ok1) *(u32x4*)(XA + (size_t)m1 * XBC + c1) = z; }
}
__device__ __forceinline__ void ssd_local_unit(const Frame& F0, int b, int cs, int g, int d, int hh) {
    Frame F = F0; LAUNDER(F.tid); F.lane = F.tid & 63;
    LAS bf16_t* BT = (LAS bf16_t*)F.lds; LAS bf16_t* XwT = (LAS bf16_t*)(F.lds + TILE_B);
    LAS float* ar = (LAS float*)(F.lds + 3 * TILE_B);
    const int m0 = chunk_row0(b, cs); const bf16_t* P = F.wsp<bf16_t>(WS_P); const float* sd = F.wsp<float>(WS_SIDE);
    const float* cw = F.in[I_SSDCW]; const float* cb = F.in[I_SSDCB];
    __syncthreads();
    { const int s = F.tid & 127, j = F.tid >> 7, hd = g * HPG + hh * 4 + j;
        const float dtv = softplusf_(sd[(size_t)(m0 + s) * 32 + d * SSDH + hd] + F.in[I_SSDDTB][d * SSDH + hd]);
        ar[j * CH + s] = dtv; ar[(4 + j) * CH + s] = -dtv * expf(F.in[I_SSDALOG][d * SSDH + hd]); }
    __syncthreads();
    if (F.wave < 4) { const int j = F.wave; LAS float* la = ar + (4 + j) * CH; wave_scan128<false>(la, la, d != 0, F.lane);
        if (F.lane == 0) ssd_slot(F, d, b, g * HPG + hh * 4 + j, cs)[SSD_HF] = expf(d ? la[0] : la[CH - 1]); }
    __syncthreads();
    { const int i = F.tid & 127, j = F.tid >> 7; const LAS float* la = ar + (4 + j) * CH; const float aend = d ? la[0] : la[CH - 1]; ar[(8 + j) * CH + i] = expf(aend - la[i]) * ar[j * CH + i]; }
    __syncthreads();
    { const int s = F.tid & 127, fgq = F.tid >> 7; const bf16_t* xrow = F.wsp<bf16_t>(WS_XACT) + (size_t)(m0 + s) * XBC;
#pragma unroll
        for (int i = 0; i < 4; ++i) { const int f0 = (fgq + 4 * i) * 8; const u32x4 w = *(const u32x4*)(xrow + SSDD + g * SSDN + f0);
            BT[(f0 + 0) * TP + s] = (bf16_t)(w.x & 0xffffu); BT[(f0 + 1) * TP + s] = (bf16_t)(w.x >> 16); BT[(f0 + 2) * TP + s] = (bf16_t)(w.y & 0xffffu); BT[(f0 + 3) * TP + s] = (bf16_t)(w.y >> 16);
            BT[(f0 + 4) * TP + s] = (bf16_t)(w.z & 0xffffu); BT[(f0 + 5) * TP + s] = (bf16_t)(w.z >> 16); BT[(f0 + 6) * TP + s] = (bf16_t)(w.w & 0xffffu); BT[(f0 + 7) * TP + s] = (bf16_t)(w.w >> 16); }
#pragma unroll
        for (int i = 0; i < 8; ++i) { const int fg = fgq + 4 * i, j = fg >> 3, p0 = (fg & 7) * 8; float v[8]; unpack8(*(const u32x4*)(xrow + (g * HPG + hh * 4 + j) * SSDP + p0), v); const float we = ar[(8 + j) * CH + s];
#pragma unroll
            for (int jj = 0; jj < 8; ++jj) XwT[(j * 64 + p0 + jj) * TP + s] = (bf16_t)f2bf(v[jj] * we); } }
    __syncthreads();
    f32x4 acc[8][2]; zero_acc(acc);
    wave_mma<8, 2, 4>(acc, BT, 0, XwT, 32 * F.wave, F.lane);
    const int r = F.lane & 15, q = F.lane >> 4;
#pragma unroll
    for (int nt = 0; nt < 2; ++nt) { const int jp = 32 * F.wave + 16 * nt + r, j = jp >> 6, p = jp & 63; bf16_t* sl = (bf16_t*)ssd_slot(F, d, b, g * HPG + hh * 4 + j, cs) + p * SSDN;
#pragma unroll
        for (int mt = 0; mt < 8; ++mt) { u32x2 w; w.x = pk2(acc[mt][nt][0], acc[mt][nt][1]); w.y = pk2(acc[mt][nt][2], acc[mt][nt][3]); *(u32x2*)(sl + 16 * mt + 4 * q) = w; } }
    __syncthreads();
}

__device__ __forceinline__ void ssd_carry(const Frame& F) {
    constexpr int NVI = SSDP * SSDN / 8, NITEM = 2 * NB * SSDH * NVI;
    for (int it = F.bid * NTHREADS + F.tid; it < NITEM; it += F.G * NTHREADS) {
        const int grp = it / NVI, e = it % NVI, d = grp / (NB * SSDH), b = (grp / SSDH) % NB, hd = grp % SSDH;
        float st[8];
#pragma unroll
        for (int j = 0; j < 8; ++j) st[j] = 0.f;
        u32x4 lc[NCS]; float decs[NCS];
#pragma unroll
        for (int qi = 0; qi < NCS; ++qi) { const float* sl = ssd_slot(F, d, b, hd, scan_slot(d, qi)); lc[qi] = *((const u32x4*)sl + e); decs[qi] = sl[SSD_HF]; }
#pragma unroll
        for (int qi = 0; qi < NCS; ++qi) { float* sl = ssd_slot(F, d, b, hd, scan_slot(d, qi)); u32x4* pp = (u32x4*)sl + e; float loc[8]; unpack8(lc[qi], loc); const float dec = decs[qi];
            u32x4 w; w.x = pk2(st[0], st[1]); w.y = pk2(st[2], st[3]); w.z = pk2(st[4], st[5]); w.w = pk2(st[6], st[7]); *pp = w;
#pragma unroll
            for (int j = 0; j < 8; ++j) st[j] = st[j] * dec + loc[j]; }
    }
}

__device__ __forceinline__ void ssd_out_unit(const Frame& F0, int b, int lc, int g, int hh) {
    Frame F = F0; LAUNDER(F.tid); F.lane = F.tid & 63;
    LAS bf16_t* Cs = (LAS bf16_t*)F.lds; LAS bf16_t* Bs = (LAS bf16_t*)(F.lds + TILE_B); LAS bf16_t* Ls = Bs;
    LAS bf16_t* XT = (LAS bf16_t*)(F.lds + 2 * TILE_B); LAS bf16_t* Hs = (LAS bf16_t*)(F.lds + 2 * TILE_B + 64 * TP * 2);
    LAS float* ar = (LAS float*)(F.lds + 3 * TILE_B);
    const int cs = NCC + lc, m0 = b * SEQ + lc * CH; const bf16_t* P = F.wsp<bf16_t>(WS_P); const float* sd = F.wsp<float>(WS_SIDE);
    const float* cw = F.in[I_SSDCW]; const float* cb = F.in[I_SSDCB];
    __syncthreads();
    { const int s = F.tid & 127, j = F.tid >> 7, hd = g * HPG + hh * 4 + j;
#pragma unroll
        for (int d = 0; d < 2; ++d) { const float dtv = softplusf_(sd[(size_t)(m0 + s) * 32 + d * SSDH + hd] + F.in[I_SSDDTB][d * SSDH + hd]);
            ar[(d * 4 + j) * CH + s] = dtv; ar[(8 + d * 4 + j) * CH + s] = -dtv * expf(F.in[I_SSDALOG][d * SSDH + hd]); } }
    __syncthreads();
    { const int k = F.wave, d = k >> 2; LAS float* la = ar + (8 + k) * CH; wave_scan128<false>(la, la, d != 0, F.lane); }
    { const int s = F.tid & 127, fgq = F.tid >> 7; const bf16_t* xrow = F.wsp<bf16_t>(WS_XACT) + (size_t)(m0 + s) * XBC;
#pragma unroll
        for (int i = 0; i < 4; ++i) { const int f0 = (fgq + 4 * i) * 8;
            *(LAS u32x4*)(Bs + s * TP + f0) = *(const u32x4*)(xrow + SSDD + g * SSDN + f0);
            *(LAS u32x4*)(Cs + s * TP + f0) = *(const u32x4*)(xrow + SSDD + SSDG * SSDN + g * SSDN + f0); } }
    __syncthreads();
    const int wm = F.wave >> 1, wn = F.wave & 1, r = F.lane & 15, q = F.lane >> 4;
    f32x4 cbm[2][4]; zero_acc(cbm);
    wave_mma<2, 4, 4>(cbm, Cs, 32 * wm, Bs, 64 * wn, F.lane);
    float ssq[2][4];
#pragma unroll
    for (int mt = 0; mt < 2; ++mt)
#pragma unroll
        for (int jj = 0; jj < 4; ++jj) ssq[mt][jj] = 0.f;
    LAS bf16_t* Hs2 = (LAS bf16_t*)(F.lds + 3 * TILE_B + 18 * CH * 4);
    static_assert(3 * TILE_B + 18 * CH * 4 + 64 * TP * 2 <= LDS_MISC, "ssd out LDS");
    u32x4 hpre[4], xpre[2];
    const int xs_ = F.tid & 127, xfq = F.tid >> 7; const bf16_t* xrow = F.wsp<bf16_t>(WS_XACT) + (size_t)(m0 + xs_) * XBC;
#define SSD_LOADH(jn) do { const u32x4* sf_ = (const u32x4*)ssd_slot(F, 0, b, g * HPG + hh * 4 + (jn), cs); const u32x4* sb_ = (const u32x4*)ssd_slot(F, 1, b, g * HPG + hh * 4 + (jn), cs); \
        hpre[0] = sf_[F.tid]; hpre[1] = sf_[F.tid + NTHREADS]; hpre[2] = sb_[F.tid]; hpre[3] = sb_[F.tid + NTHREADS]; } while (0)
#define SSD_LOADX(jn) do { xpre[0] = *(const u32x4*)(xrow + (g * HPG + hh * 4 + (jn)) * SSDP + xfq * 8); xpre[1] = *(const u32x4*)(xrow + (g * HPG + hh * 4 + (jn)) * SSDP + (xfq + 4) * 8); } while (0)
    SSD_LOADH(0); SSD_LOADX(0);
#pragma unroll 1
    for (int j = 0; j < 4; ++j) {
        const int hd = g * HPG + hh * 4 + j;
        __syncthreads();
#pragma unroll
        for (int i = 0; i < 2; ++i) { const int f0 = (xfq + 4 * i) * 8; const u32x4 w = xpre[i];
            XT[(f0 + 0) * TP + xs_] = (bf16_t)(w.x & 0xffffu); XT[(f0 + 1) * TP + xs_] = (bf16_t)(w.x >> 16); XT[(f0 + 2) * TP + xs_] = (bf16_t)(w.y & 0xffffu); XT[(f0 + 3) * TP + xs_] = (bf16_t)(w.y >> 16);
            XT[(f0 + 4) * TP + xs_] = (bf16_t)(w.z & 0xffffu); XT[(f0 + 5) * TP + xs_] = (bf16_t)(w.z >> 16); XT[(f0 + 6) * TP + xs_] = (bf16_t)(w.w & 0xffffu); XT[(f0 + 7) * TP + xs_] = (bf16_t)(w.w >> 16); }
#pragma unroll
        for (int i = 0; i < 2; ++i) { const int it = F.tid + NTHREADS * i, p = (8 * it) / SSDN, n = (8 * it) % SSDN; *(LAS u32x4*)(Hs + p * TP + n) = hpre[i]; *(LAS u32x4*)(Hs2 + p * TP + n) = hpre[2 + i]; }
        if (j < 3) { SSD_LOADX(j + 1); SSD_LOADH(j + 1); }
        bf16_t zpre[2][4][2];
#pragma unroll
        for (int mt = 0; mt < 2; ++mt)
#pragma unroll
            for (int jj = 0; jj < 4; ++jj)
#pragma unroll
                for (int nt = 0; nt < 2; ++nt) zpre[mt][jj][nt] = P[(size_t)(m0 + 32 * wm + 16 * mt + 4 * q + jj) * CD_MAIN + hd * SSDP + 32 * wn + 16 * nt + r];
        const LAS float* dtf = ar + j * CH; const LAS float* dtb = ar + (4 + j) * CH; const LAS float* acf = ar + (8 + j) * CH; const LAS float* acb = ar + (12 + j) * CH;
#pragma unroll
        for (int mt = 0; mt < 2; ++mt)
#pragma unroll
            for (int jj = 0; jj < 4; ++jj) { const int t = 32 * wm + 16 * mt + 4 * q + jj; const float atf = acf[t], atb = acb[t];
#pragma unroll
                for (int nt = 0; nt < 4; ++nt) { const int s_ = 64 * wn + 16 * nt + r;
                    const float vf = s_ <= t ? FEXP(atf - acf[s_]) * dtf[s_] : 0.f, vb = s_ >= t ? FEXP(atb - acb[s_]) * dtb[s_] : 0.f;
                    Ls[t * TP + s_] = (bf16_t)f2bf(cbm[mt][nt][jj] * (vf + vb)); } }
        __syncthreads();
        f32x4 ysum[2][2], yof[2][2], yob[2][2]; zero_acc(ysum); zero_acc(yof); zero_acc(yob);
        wave_mma<2, 2, 4>(ysum, Ls, 32 * wm, XT, 32 * wn, F.lane);
        wave_mma<2, 2, 4>(yof, Cs, 32 * wm, Hs, 32 * wn, F.lane);
        wave_mma<2, 2, 4>(yob, Cs, 32 * wm, Hs2, 32 * wn, F.lane);
#pragma unroll
        for (int mt = 0; mt < 2; ++mt)
#pragma unroll
            for (int jj = 0; jj < 4; ++jj) { const int t = 32 * wm + 16 * mt + 4 * q + jj; const float eaf = FEXP(acf[t]), eab = FEXP(acb[t]);
#pragma unroll
                for (int nt = 0; nt < 2; ++nt) ysum[mt][nt][jj] += eaf * yof[mt][nt][jj] + eab * yob[mt][nt][jj]; }
        const float dsk = F.in[I_SSDD][hd];
#pragma unroll
        for (int mt = 0; mt < 2; ++mt)
#pragma unroll
            for (int jj = 0; jj < 4; ++jj) { const int t = 32 * wm + 16 * mt + 4 * q + jj;
#pragma unroll
                for (int nt = 0; nt < 2; ++nt) { const int p = 32 * wn + 16 * nt + r; const float xs = bf2f(XT[p * TP + t]);
                    const float z = bf2f(zpre[mt][jj][nt]); const float y = (ysum[mt][nt][jj] + dsk * xs) * siluf(z);
                    F.wsp<float>(WS_YPRE)[(size_t)(m0 + t) * SSDD + hd * SSDP + p] = y; ssq[mt][jj] += y * y; } }
    }
#undef SSD_LOADH
#undef SSD_LOADX
    LAS float* ssq2 = ar + 16 * CH;
#pragma unroll
    for (int mt = 0; mt < 2; ++mt)
#pragma unroll
        for (int jj = 0; jj < 4; ++jj) { float s = ssq[mt][jj]; s += __shfl_xor(s, 1); s += __shfl_xor(s, 2); s += __shfl_xor(s, 4); s += __shfl_xor(s, 8);
            if (r == 0) ssq2[wn * CH + 32 * wm + 16 * mt + 4 * q + jj] = s; }
    __syncthreads();
    if (F.tid < CH) F.wsp<float>(WS_SSQ)[(size_t)(m0 + F.tid) * 4 + g * 2 + hh] = ssq2[F.tid] + ssq2[CH + F.tid];
    __syncthreads();
}

__device__ __forceinline__ void ssd_norm_rows(const Frame& F, int wg_lo, int wg_cnt) {
    const float* yp = F.wsp<float>(WS_YPRE); const float* sq = F.wsp<float>(WS_SSQ); const float* nw = F.in[I_SSDNW]; bf16_t* Y = F.wsp<bf16_t>(WS_YCAT);
    if (F.bid < wg_lo || F.bid >= wg_lo + wg_cnt) return;
    constexpr int NI = SSDD / 256; static_assert(SSDD % 256 == 0, "ssd norm row pieces");
    f32x4 w4[NI];
#pragma unroll
    for (int i = 0; i < NI; ++i) w4[i] = *(const f32x4*)(nw + 4 * F.lane + 256 * i);
    for (int m = (F.bid - wg_lo) * NWAVES + F.wave; m < ML; m += wg_cnt * NWAVES) { const f32x4 s4 = *(const f32x4*)(sq + (size_t)m * 4); f32x4 y[NI];
#pragma unroll
        for (int i = 0; i < NI; ++i) y[i] = *(const f32x4*)(yp + (size_t)m * SSDD + 4 * F.lane + 256 * i);
        const float rinv = 1.0f / sqrtf((s4[0] + s4[1] + s4[2] + s4[3]) * (1.0f / SSDD) + EPS);
#pragma unroll
        for (int i = 0; i < NI; ++i) { u32x2 w; w.x = pk2(y[i][0] * rinv * w4[i][0], y[i][1] * rinv * w4[i][1]); w.y = pk2(y[i][2] * rinv * w4[i][2], y[i][3] * rinv * w4[i][3]);
            *(u32x2*)(Y + (size_t)m * YC2 + 4 * F.lane + 256 * i) = w; } }
}

__device__ __forceinline__ float* s5_slot(const Frame& F, int d, int b, int cs, int g) { return F.wsp<float>(WS_S5ST) + ((((size_t)d * NB + b) * NCS + cs) * S5G + g) * (S5P * 2); }
__device__ __forceinline__ void s5_load_u(const Frame& F, LAS float* ub, int m0, int g) {
    const bf16_t* P = F.wsp<bf16_t>(WS_P);
#pragma unroll
    for (int k = 0; k < 2; ++k) { const int s = F.lane + 64 * k; const bf16_t* up = P + (size_t)(m0 + s) * CD_MAIN + SSDD + XBC + g * S5GS; float f[8];
        unpack8(*(const u32x4*)up, f);
#pragma unroll
        for (int j = 0; j < 8; ++j) ub[s * 16 + j] = f[j];
        unpack8(*(const u32x4*)(up + 8), f);
#pragma unroll
        for (int j = 0; j < 8; ++j) ub[s * 16 + 8 + j] = f[j]; }
    WAVE_SYNC();
}
#define S5_STEP(s) do { const f32x4 u0 = *(const LAS f32x4*)(ub + (s) * 16), u1 = *(const LAS f32x4*)(ub + (s) * 16 + 4), u2 = *(const LAS f32x4*)(ub + (s) * 16 + 8), u3 = *(const LAS f32x4*)(ub + (s) * 16 + 12); \
    f32x2 b0 = {0.f, 0.f}, b1 = {0.f, 0.f}, b2 = {0.f, 0.f}, b3 = {0.f, 0.f}; _Pragma("unroll") for (int k = 0; k < 4; ++k) { b0 += bb2[k] * (f32x2){u0[k], u0[k]}; b1 += bb2[4 + k] * (f32x2){u1[k], u1[k]}; b2 += bb2[8 + k] * (f32x2){u2[k], u2[k]}; b3 += bb2[12 + k] * (f32x2){u3[k], u3[k]}; } \
    const f32x2 bs = (b0 + b1) + (b2 + b3); \
    const float nr = lbr * xr - lbi * xi + bs[0], ni = lbr * xi + lbi * xr + bs[1]; xr = nr; xi = ni; } while (0)
#define S5_LOAD_PAR(d, g) const float* par = F.wsp<float>(WS_S5PAR) + ((size_t)((d) * S5G + (g)) * S5P + F.lane) * 36; const float lbr = par[0], lbi = par[1]; f32x2 bb2[16]; \
    _Pragma("unroll") for (int k = 0; k < 16; ++k) { bb2[k][0] = par[2 + k]; bb2[k][1] = par[18 + k]; }

__device__ __forceinline__ void s5_local_units(const Frame& F) {
    LAS float* ub = (LAS float*)(F.lds + F.wave * 8192);
    constexpr int NU = 2 * NB * NCS * S5G;
    for (int u = F.gw(); u < NU; u += F.ngw()) { const int g = u % S5G, cs = (u / S5G) % NCS, b = (u / (S5G * NCS)) % NB, d = u / (S5G * NCS * NB);
        WAVE_SYNC();
        s5_load_u(F, ub, chunk_row0(b, cs), g);
        S5_LOAD_PAR(d, g)
        float xr = 0.f, xi = 0.f;
        _Pragma("unroll 4") for (int ii = 0; ii < CH; ++ii) { const int s = d ? CH - 1 - ii : ii; S5_STEP(s); }
        float* sl = s5_slot(F, d, b, cs, g); sl[F.lane * 2] = xr; sl[F.lane * 2 + 1] = xi; }
}
__device__ __forceinline__ void s5_carry(const Frame& F) {
    for (int it = F.bid * NTHREADS + F.tid; it < 2 * NB * S5G * S5P; it += F.G * NTHREADS) { const int p = it % S5P, g = (it / S5P) % S5G, b = (it / (S5P * S5G)) % NB, d = it / (S5P * S5G * NB);
        const float* par = F.wsp<float>(WS_S5PAR) + ((size_t)(d * S5G + g) * S5P + p) * 36; const float pr = par[34], pi = par[35]; float xr = 0.f, xi = 0.f;
        float lrs[NCS], lis[NCS];
#pragma unroll
        for (int qi = 0; qi < NCS; ++qi) { const float* sl = s5_slot(F, d, b, scan_slot(d, qi), g) + p * 2; lrs[qi] = sl[0]; lis[qi] = sl[1]; }
#pragma unroll
        for (int qi = 0; qi < NCS; ++qi) { float* sl = s5_slot(F, d, b, scan_slot(d, qi), g) + p * 2; const float lr = lrs[qi], li = lis[qi]; sl[0] = xr; sl[1] = xi;
            const float nr = pr * xr - pi * xi + lr, ni = pr * xi + pi * xr + li; xr = nr; xi = ni; } }
}
__device__ __forceinline__ void s5_out_units(const Frame& F) {
    LAS float* ub = (LAS float*)(F.lds + F.wave * 16896); LAS bf16_t* xb = (LAS bf16_t*)(F.lds + F.wave * 16896 + 8192);
    const int r = F.lane & 15, q = F.lane >> 4;
    constexpr int NU = NB * NCL * S5G;
    for (int u = F.gw(); u < NU; u += F.ngw()) { const int g = u % S5G, lc = (u / S5G) % NCL, b = u / (S5G * NCL); const int cs = NCC + lc, m0 = b * SEQ + lc * CH;
        WAVE_SYNC();
        s5_load_u(F, ub, m0, g);
        bf16x8 cf[4];
#pragma unroll
        for (int ks = 0; ks < 4; ++ks) { const int k0 = 32 * ks + 8 * q; const bool im = k0 >= 64; const float* cp = (im ? F.in[I_S5CIM] : F.in[I_S5CRE]) + ((size_t)g * S5GS + r) * S5P + (k0 & 63);
#pragma unroll
            for (int j = 0; j < 8; ++j) cf[ks][j] = (short)f2bf(im ? -cp[j] : cp[j]); }
        f32x4 acc[8];
#pragma unroll
        for (int i = 0; i < 8; ++i) acc[i] = (f32x4){0.f, 0.f, 0.f, 0.f};
#pragma unroll
        for (int d = 0; d < 2; ++d) {
            S5_LOAD_PAR(d, g)
            const float* sl = s5_slot(F, d, b, cs, g); float xr = sl[F.lane * 2], xi = sl[F.lane * 2 + 1];
#pragma unroll
            for (int sbi = 0; sbi < 4; ++sbi) { const int sb = d ? 3 - sbi : sbi;
                for (int ii = 0; ii < 32; ++ii) { const int sl_ = d ? 31 - ii : ii; const int s = 32 * sb + sl_; S5_STEP(s);
                    xb[sl_ * TP + F.lane] = (bf16_t)f2bf(xr); xb[sl_ * TP + 64 + F.lane] = (bf16_t)f2bf(xi); }
                WAVE_SYNC();
#pragma unroll
                for (int mt = 0; mt < 2; ++mt)
#pragma unroll
                    for (int ks = 0; ks < 4; ++ks) { const bf16x8 a = *(const LAS bf16x8*)(xb + (16 * mt + r) * TP + 32 * ks + 8 * q); acc[2 * sb + mt] = MFMA16(a, cf[ks], acc[2 * sb + mt]); }
                WAVE_SYNC(); }
        }
        const float dsk = F.in[I_S5D][g * S5GS + r]; bf16_t* out = F.wsp<bf16_t>(WS_S5G);
#pragma unroll
        for (int mtile = 0; mtile < 8; ++mtile)
#pragma unroll
            for (int j = 0; j < 4; ++j) { const int t = 16 * mtile + 4 * q + j; const float v = acc[mtile][j] + dsk * ub[t * 16 + r];
                out[(size_t)(m0 + t) * S5W + g * S5GS + r] = (bf16_t)f2bf(0.5f * v * (1.0f + erff(v * 0.70710678118654752f))); }
    }
}

__device__ __forceinline__ int moe_off(const Frame& F, int e) {
    const unsigned* cnt = F.wsp<unsigned>(WS_CTL) + CW_CNT; int o = 0;
#pragma unroll
    for (int k = 0; k < NE; ++k) o += (k < e) ? (int)((cnt[64 * k] + 255u) & ~255u) : 0;
    return o;
}
__device__ __forceinline__ void phase_moe_scatter(const Frame& F) {
    const unsigned char* A = F.wsp<unsigned char>(WS_A); unsigned char* As = F.wsp<unsigned char>(WS_AS); const int* rt = F.wsp<int>(WS_ROUTE); const float* rp = F.wsp<float>(WS_RPROB);
    int* rowmap = F.wsp<int>(WS_ROWMAP); float* rowp = F.wsp<float>(WS_ROWP);
    constexpr int SBN = 4, SNJ = (D + 1023) / 1024; static_assert(SNJ <= 2 && D % 16 == 0, "scatter row chunks");
    for (int it = F.gw(); it < 2 * ML; it += SBN * F.ngw()) {
        int mm[SBN], ee[SBN], pp[SBN]; u32x4 va[SBN][2];
#pragma unroll
        for (int k = 0; k < SBN; ++k) { const int itk = it + k * F.ngw(); const bool ok = itk < 2 * ML; const int m = ok ? itk >> 1 : 0, slot = itk & 1; mm[k] = ok ? m * 2 + slot : -1;
            ee[k] = rt[m * 4 + slot]; pp[k] = rt[m * 4 + 2 + slot];
#pragma unroll
            for (int j = 0; j < SNJ; ++j) if (16 * F.lane + 1024 * j < D) va[k][j] = *(const u32x4*)(A + (size_t)m * D + 16 * F.lane + 1024 * j); }
#pragma unroll
        for (int k = 0; k < SBN; ++k) { if (mm[k] < 0) continue; const int dst = moe_off(F, ee[k]) + pp[k];
#pragma unroll
            for (int j = 0; j < SNJ; ++j) if (16 * F.lane + 1024 * j < D) *(u32x4*)(As + (size_t)dst * D + 16 * F.lane + 1024 * j) = va[k][j];
            if (F.lane == 0) { rowmap[dst] = mm[k]; rowp[dst] = rp[mm[k]]; } } }
    const unsigned* cnt = F.wsp<unsigned>(WS_CTL) + CW_CNT;
    for (int i = F.bid * NTHREADS + F.tid; i < NE * 256; i += F.G * NTHREADS) { const int e = i >> 8, k = i & 255; const int row = moe_off(F, e) + (int)cnt[64 * e] + k; if (row < moe_off(F, e + 1)) { rowmap[row] = -1; rowp[row] = 0.f; } }
}

__device__ __forceinline__ void phase_final(const Frame& F) {
    const float* XL = F.wsp<float>(WS_XL); const bf16_t* ys = F.wsp<bf16_t>(WS_YSLOT); const float* mod = F.wsp<float>(WS_MOD) + (size_t)1 * NR * 6 * D; const float* fw = F.in[I_FNW];
    const float* pmb = F.wsp<float>(WS_PARTM); const int* rt = F.wsp<int>(WS_ROUTE); const float* rp = F.wsp<float>(WS_RPROB);
    int nfull, KS; moe_down_split(moe_off(F, NE) / 256, nfull, KS); const int row_split = nfull * 256;
    constexpr int NV = D / 256;
    LAS float* gl = (LAS float*)F.lds;
    __syncthreads();
    for (int i = F.tid; i < (NB + 1) * D; i += NTHREADS) gl[i] = i < NB * D ? mod[(size_t)(i / D) * 6 * D + 5 * D + i % D] : fw[i - NB * D];
    __syncthreads();
    i32x4 rtn = {0, 0, 0, 0}; float p0n = 0.f, p1n = 0.f;
    if (F.gw() < ML) { rtn = *(const i32x4*)(rt + F.gw() * 4); p0n = rp[F.gw() * 2]; p1n = rp[F.gw() * 2 + 1]; }
    for (int m = F.gw(); m < ML; m += F.ngw()) { const LAS float* gp = gl + mod_row(m) * D; f32x4 v[NV]; float ss = 0.f;
        const i32x4 rtv = rtn; const float p0 = p0n, p1 = p1n;
        { const int mn = m + F.ngw(); if (mn < ML) { rtn = *(const i32x4*)(rt + mn * 4); p0n = rp[mn * 2]; p1n = rp[mn * 2 + 1]; } }
        const int r0 = moe_off(F, rtv[0]) + rtv[2], r1 = moe_off(F, rtv[1]) + rtv[3]; const bool s0 = r0 >= row_split, s1 = r1 >= row_split;
#pragma unroll
        for (int i = 0; i < NV; ++i) { const int k = 4 * (F.lane + 64 * i); const f32x4 x = *(const f32x4*)(XL + (size_t)m * D + k), g = *(const LAS f32x4*)(gp + k); f32x4 a, b;
            if (s0) { a = *(const f32x4*)(pmb + (size_t)(r0 - row_split) * D + k); for (int ks = 1; ks < KS; ++ks) a += *(const f32x4*)(pmb + ((size_t)ks * PM_ROWS + (r0 - row_split)) * D + k); a *= p0; }
            else { const u32x2 w = *(const u32x2*)(ys + (size_t)m * D + k); a = (f32x4){bf2f(w.x & 0xffffu), bf2f(w.x >> 16), bf2f(w.y & 0xffffu), bf2f(w.y >> 16)}; }
            if (s1) { b = *(const f32x4*)(pmb + (size_t)(r1 - row_split) * D + k); for (int ks = 1; ks < KS; ++ks) b += *(const f32x4*)(pmb + ((size_t)ks * PM_ROWS + (r1 - row_split)) * D + k); b *= p1; }
            else { const u32x2 w = *(const u32x2*)(ys + ((size_t)ML + m) * D + k); b = (f32x4){bf2f(w.x & 0xffffu), bf2f(w.x >> 16), bf2f(w.y & 0xffffu), bf2f(w.y >> 16)}; }
            v[i] = x + g * (a + b); ss += v[i][0] * v[i][0] + v[i][1] * v[i][1] + v[i][2] * v[i][2] + v[i][3] * v[i][3]; }
        ss = wave_sum(ss); const float rinv = 1.0f / sqrtf(ss * (1.0f / (float)D) + EPS);
#pragma unroll
        for (int i = 0; i < NV; ++i) { const int k = 4 * (F.lane + 64 * i); const f32x4 w4 = *(const LAS f32x4*)(gl + NB * D + k); NTST(v[i] * rinv * w4, (f32x4*)(F.out + (size_t)m * D + k)); } }
}

constexpr int NPHASE = 23;
__global__ void __launch_bounds__(NTHREADS, 2) fwd_kernel(Args args) {
#ifdef EMU
    unsigned char* lds_raw = emu::tl_blk->lds;
#else
    extern __shared__ __attribute__((aligned(16))) unsigned char lds_raw[];
#endif
    const int tid0 = threadIdx.x;
    volatile LAS unsigned* misc = (volatile LAS unsigned*)((LAS unsigned char*)lds_raw + LDS_MISC);
    if (tid0 < 16) misc[tid0] = 0u;
    __syncthreads();
    const int lo = args.ph_lo, hi = args.ph_hi;
    XcdBarrier bar = xcd_barrier_post((unsigned*)(args.ws + WS_CTL) + CW_BAR, misc);
#ifndef ONLY_PHASE
#define ONLY_PHASE -1
#endif
#define IN(k) ((ONLY_PHASE < 0 || ONLY_PHASE == (k)) && lo <= (k) && (k) < hi)
#define SEAM(k) do { if (IN(k) && IN((k) + 1)) xcd_barrier(bar); } while (0)
#define MKF() Frame F; { int t_ = tid0; LAUNDER(t_); F.lds = (LAS unsigned char*)lds_raw; F.tid = t_; F.lane = t_ & 63; F.wave = RFL(t_ >> 6); F.G = gridDim.x; F.bid = blockIdx.x; F.in = args.in; F.out = args.out; F.ws = args.ws; } \
    float* XL = F.wsp<float>(WS_XL); bf16_t* A = F.wsp<bf16_t>(WS_A); bf16_t* P = F.wsp<bf16_t>(WS_P); bf16_t* Y = F.wsp<bf16_t>(WS_YCAT); bf16_t* H = F.wsp<bf16_t>(WS_H); \
    const float* mod0 = F.wsp<float>(WS_MOD); const float* mod1 = mod0 + (size_t)NR * 6 * D; (void)XL; (void)A; (void)P; (void)Y; (void)H; (void)mod0; (void)mod1;

    if (IN(0)) { MKF() phase_prologue(F); }
    SEAM(0);
    if (IN(1)) { MKF() phase_finalize(F); }
    SEAM(1);
    if (IN(2)) { MKF() modulate_rows<false>(F, F.in[I_X], F.in[I_CTX], 0, 0, A, MT); }
    SEAM(2);
    if (IN(3)) {
        MKF()
        pg8::Gemm g{A, F.wsp<bf16_t>(WS_W_ABIN), MT, AB_MAIN, D}; pg8::StaticOrder S; S.init(MT, AB_MAIN, F.G, F.bid);
        EpiInProj0 E{P, AB_MAIN, F.wsp<bf16_t>(WS_PH)};
        pg8::gemm_phase(F.lds, g, S, E);
        side_gemm(F, A, F.wsp<bf16_t>(WS_W_ABSIDE), F.wsp<float>(WS_SIDE), MT);
    }
    if (IN(3)) { MKF() help_slot(F, 8); }
    SEAM(3);
    if (IN(4)) {
        MKF()
        hyena_units(F);
        for (int u = F.bid; u < NB * MLH * NCS; u += F.G) mlstm_local_unit(F, u / (MLH * NCS), (u / NCS) % MLH, u % NCS);
    }
    if (IN(4)) { MKF() help_slot(F, 0); }
    SEAM(4);
    if (IN(5)) { MKF() mlstm_carry(F); }
    SEAM(5);
    if (IN(6)) { MKF() for (int u = F.bid; u < NB * MLH * NCS; u += F.G) mlstm_out_unit(F, u / (MLH * NCS), (u / NCS) % MLH, u % NCS); }
    if (IN(6)) { MKF() help_slot(F, 1); }
    SEAM(6);
    if (IN(7)) {
        MKF()
        pg8::Gemm g{Y, F.wsp<bf16_t>(WS_W_ABOUT), MT, D, YC1}; CtxSplitOrder S; S.init(D, YC1, KS7, F.G, F.bid);
        EpiResidSplit E{F.in[I_X], XL, mod0 + 2 * D, F.wsp<float>(WS_PART), YC1 / KS7};
        pg8::gemm_phase(F.lds, g, S, E);
    }
    if (IN(7)) { MKF() help_slot(F, 2); }
    SEAM(7);
    if (IN(8)) { MKF() modulate_rows<false, true>(F, XL, F.in[I_CTX], 0, 3, A, MT, F.wsp<float>(WS_PART), mod0 + (size_t)NB * 6 * D + 2 * D, KS7, XL); }
    SEAM(8);
    if (IN(9)) {
        MKF()
        pg8::Gemm g{F.wsp<bf16_t>(WS_A8), F.wsp<bf16_t>(WS_W_GU), MT, 2 * FF, D / 2}; pg8::StaticOrder S; S.init(MT, 2 * FF, F.G, F.bid);
        EpiGatedI8F8 E{F.wsp<unsigned char>(WS_H), FF, F.wsp<float>(WS_SA8), F.wsp<float>(WS_SB_GU)};
        pg8::gemm_phase(F.lds, g, S, E);
    }
    if (IN(9)) { MKF() help_slot(F, 3); }
    SEAM(9);
    if (IN(10)) {
        MKF()
        pg8::Gemm g{H, F.wsp<bf16_t>(WS_W_DN), MT, D, FF / 2}; CtxSplitOrder S; S.init(D, FF / 2, KS10, F.G, F.bid);
        EpiResidSplitF8 E{XL, XL, mod0 + 5 * D, F.wsp<float>(WS_PART), FF / 2 / KS10};
        pg8::gemm_phase(F.lds, g, S, E);
    }
    if (IN(10)) { MKF() help_slot(F, 4); }
    SEAM(10);
    if (IN(11)) { MKF() modulate_rows<false>(F, XL, XL + (size_t)ML * D, 1, 0, A, MT, F.wsp<float>(WS_PART), mod0 + (size_t)NB * 6 * D + 5 * D, KS10, XL); }
    SEAM(11);
    if (IN(12)) {
        MKF()
        pg8::Gemm g{A, F.wsp<bf16_t>(WS_W_CDIN), MT, CD_MAIN, D}; pg8::StaticOrder S; S.init(MT, CD_MAIN, F.G, F.bid);
        EpiStoreBf16 E{P, CD_MAIN};
        pg8::gemm_phase(F.lds, g, S, E);
        side_gemm(F, A, F.wsp<bf16_t>(WS_W_CDSIDE), F.wsp<float>(WS_SIDE), MT);
    }
    if (IN(12)) { MKF() help_slot(F, 5); }
    SEAM(12);
    if (IN(13)) {
        MKF()
        ssd_act_pass(F);
        xcd_barrier(bar);
        for (int u = F.bid; u < NB * NCS * SSDG * 2 * (HPG / 4); u += F.G) { int r = u; const int hh = r % (HPG / 4); r /= (HPG / 4); const int d = r % 2; r /= 2; const int g = r % SSDG; r /= SSDG; const int cs = r % NCS; r /= NCS;
            ssd_local_unit(F, r, cs, g, d, hh); }
        s5_local_units(F);
    }
    if (IN(13)) { MKF() help_slot(F, 6); }
    SEAM(13);
    if (IN(14)) { MKF() ssd_carry(F); s5_carry(F); }
    SEAM(14);
    if (IN(15)) {
        MKF()
        for (int u = F.bid; u < NB * NCL * SSDG * (HPG / 4); u += F.G) { int r = u; const int hh = r % (HPG / 4); r /= (HPG / 4); const int g = r % SSDG; r /= SSDG; const int lc = r % NCL; r /= NCL;
            ssd_out_unit(F, r, lc, g, hh); }
        __syncthreads();
        s5_out_units(F);
    }
    SEAM(15);
    if (IN(16)) {
        MKF()
        pg8::Gemm g{F.wsp<bf16_t>(WS_S5G), F.wsp<bf16_t>(WS_W_GLU), ML, 2 * S5W, S5W}; pg8::StaticOrder S; S.init(ML, 2 * S5W, F.G, F.bid);
        EpiGated<1> E{Y, YC2, SSDD, 2 * S5W / 256};
        constexpr int NU16 = (ML / 256) * (2 * S5W / 256); const int r16 = NU16 < F.G ? NU16 : 0;
        if (r16 != 0 && F.bid >= r16) ssd_norm_rows(F, r16, F.G - r16);
        pg8::gemm_phase(F.lds, g, S, E);
        if (r16 == 0) ssd_norm_rows(F, 0, F.G);
    }
    if (IN(16)) { MKF() help_slot(F, 7); }
    SEAM(16);
    if (IN(17)) {
        MKF()
        pg8::Gemm g{Y, F.wsp<bf16_t>(WS_W_CDOUT), ML, D, YC2}; pg8::StaticOrder S; S.init(ML, D, F.G, F.bid);
        EpiResid E{XL, XL + (size_t)ML * D, XL, mod1 + 2 * D};
        pg8::gemm_phase(F.lds, g, S, E);
    }
    SEAM(17);
    if (IN(18)) { MKF() modulate_rows<true>(F, XL, XL + (size_t)ML * D, 1, 3, A, ML); }
    SEAM(18);
    if (IN(19)) { MKF() phase_moe_scatter(F); }
    if (IN(19)) { MKF() help_drain(F); }
    SEAM(19);
    if (IN(20)) {
        MKF()
        MoeOrder S; S.init(F, 2 * FF / 256);
        pg8::Gemm g{F.wsp<bf16_t>(WS_AS), F.wsp<bf16_t>(WS_W_MGU), 0, 0, D / 2};
        EpiGatedF8 E{F.wsp<unsigned char>(WS_H), FF, 2 * FF / 256};
        pg8::gemm_phase(F.lds, g, S, E);
    }
    if (IN(20)) { MKF() help_moe_tail(F); }
    SEAM(20);
    if (IN(21)) {
        MKF()
        MoeDownOrder S; S.init(F, D / 256, FF / 2);
        pg8::Gemm g{H, F.wsp<bf16_t>(WS_W_MDN), 0, 0, FF / 2};
        EpiMoeDownSplit E{F.wsp<int>(WS_ROWMAP), F.wsp<float>(WS_ROWP), F.wsp<bf16_t>(WS_YSLOT), F.wsp<float>(WS_PARTM), D / 256, S.nfull * 256, FF / 2 / S.KS, W8INV};
        pg8::gemm_phase(F.lds, g, S, E);
    }
    SEAM(21);
    if (IN(22)) { MKF() phase_final(F); }
#undef IN
#undef SEAM
}

#ifndef N_LAUNCH_MODE
#define N_LAUNCH_MODE 0
#endif
extern "C" void kernel_launch(void* const* d_in, const int* in_sizes, int n_in, void* d_out, int out_size, void* d_ws, size_t ws_size, hipStream_t stream) {
    (void)in_sizes; (void)out_size;
    static int grid = 0;
    if (grid == 0) {
        if (n_in != 44 || ws_size < WS_END) { fprintf(stderr, "kernel_launch: expected 44 inputs and >= %zu bytes of workspace (got %d, %zu)\n", (size_t)WS_END, n_in, ws_size); grid = -1; return; }
#ifdef EMU
        grid = emu_grid_override();
#else
        int dev = 0, cus = 0, per_cu = 0;
        if (hipGetDevice(&dev) != hipSuccess || hipDeviceGetAttribute(&cus, hipDeviceAttributeMultiprocessorCount, dev) != hipSuccess) { grid = -1; return; }
        if (hipFuncSetAttribute((const void*)fwd_kernel, hipFuncAttributeMaxDynamicSharedMemorySize, LDS_BYTES) != hipSuccess) { fprintf(stderr, "kernel_launch: hipFuncSetAttribute failed\n"); grid = -1; return; }
        if (hipOccupancyMaxActiveBlocksPerMultiprocessor(&per_cu, (const void*)fwd_kernel, NTHREADS, LDS_BYTES) != hipSuccess || per_cu < 1) { fprintf(stderr, "kernel_launch: occupancy query says %d\n", per_cu); (void)hipGetLastError(); }
        grid = cus;
#endif
    }
    if (grid < 0) return;
    (void)hipMemsetAsync((char*)d_ws + WS_CTL, 0, CTL_BYTES, stream);
    Args a; memset(&a, 0, sizeof(a));
    for (int i = 0; i < 44; ++i) a.in[i] = (const float*)d_in[i];
    a.out = (float*)d_out; a.ws = (unsigned char*)d_ws;
#if N_LAUNCH_MODE == 0
    a.ph_lo = 0; a.ph_hi = NPHASE;
#ifdef EMU
    emu::launch([](void* p) { fwd_kernel(*(Args*)p); }, &a, dim3(grid), dim3(NTHREADS), LDS_BYTES);
#else
    hipLaunchKernelGGL(fwd_kernel, dim3(grid), dim3(NTHREADS), LDS_BYTES, stream, a);
#endif
#else
    for (int ph = 0; ph < NPHASE; ++ph) { a.ph_lo = ph; a.ph_hi = ph + 1;
#ifdef EMU
        emu::launch([](void* p) { fwd_kernel(*(Args*)p); }, &a, dim3(grid), dim3(NTHREADS), LDS_BYTES);
#else
        hipLaunchKernelGGL(fwd_kernel, dim3(grid), dim3(NTHREADS), LDS_BYTES, stream, a);
#endif
    }
#endif
}
#ifdef EMU
#include <string.h>
extern "C" size_t emu_ws_dump_offset(const char* name, size_t* bytes) {
    struct E { const char* n; size_t off, b; };
    const E tab[] = { {"MOD", WS_MOD, (size_t)2 * NR * 6 * D * 4}, {"A", WS_A, (size_t)MT * D * 2}, {"P", WS_P, (size_t)MT * AB_MAIN * 2}, {"SIDE", WS_SIDE, (size_t)MT * 32 * 4},
        {"YCAT", WS_YCAT, (size_t)MT * YC1 * 2}, {"XL", WS_XL, (size_t)MT * D * 4}, {"FILT0", WS_FILT0, (size_t)HYD * 2 * SEQ * 4}, {"L1", WS_L1, (size_t)2 * HYD * 4}, {"H", WS_H, (size_t)MT * FF * 2},
        {"YPRE", WS_YPRE, (size_t)ML * SSDD * 4}, {"S5G", WS_S5G, (size_t)ML * S5W * 2}, {"SSQ", WS_SSQ, (size_t)ML * 4 * 4}, {"MLST", WS_MLST, (size_t)2 * NB * MLH * NCS * MLST_STRIDE * 4} };
    for (const E& e : tab) if (!strcmp(e.n, name)) { *bytes = e.b; return e.off; }
    *bytes = 0; return 0;
}
#endif
```

```cpp
#ifndef EMU
#include <hip/hip_runtime.h>
#endif
#include <stdint.h>
#include <stddef.h>
#include <math.h>
#include <stdio.h>
#include <string.h>

#ifdef CFG_SMALL
#ifndef CFG_SEQ
#define CFG_SEQ 256
#endif
constexpr int D = 256, NB = 2, SEQ = CFG_SEQ, CTX = 128, HYD = 256, MLH = 2, SSDH = 8, S5W = 256, FF = 256;
#else
constexpr int D = 2048, NB = 4, SEQ = 2048, CTX = 256, HYD = 1024, MLH = 8, SSDH = 16, S5W = 512, FF = 5632;
#endif
constexpr int GW = 64, DH = 128, MLD = MLH * DH, CH = 128;
constexpr int ML = NB * SEQ, MC = NB * CTX, MT = ML + MC, NR = NB + 1;
constexpr int NCL = SEQ / CH, NCC = CTX / CH, NCS = NCL + NCC;
constexpr int AB_MAIN = 3 * HYD + 4 * MLD, AB_SIDE = 4 * MLH, AB_IN = AB_MAIN + AB_SIDE;
constexpr int SSDP = 64, SSDD = SSDH * SSDP, SSDG = 2, SSDN = 128, XBC = SSDD + 2 * SSDG * SSDN, HPG = SSDH / SSDG;
constexpr int CD_MAIN = SSDD + XBC + S5W, CD_SIDE = 2 * SSDH, CD_IN = CD_MAIN + CD_SIDE;
constexpr int S5GS = 16, S5G = S5W / S5GS, S5P = 64;
constexpr int NE = 8, HYEMB = 33, HYHID = 64;
constexpr int YC1 = HYD + MLD, YC2 = SSDD + S5W;
constexpr int MOE_ROWS = 2 * ML + NE * 256;
constexpr float EPS = 1e-6f;
constexpr int NTHREADS = 512, NWAVES = 8;
constexpr int KSL = D / 256;
static_assert(D % 256 == 0 && ML % 256 == 0 && MT % 256 == 0 && AB_MAIN % 256 == 0 && CD_MAIN % 256 == 0 && FF % 128 == 0 && S5W % 128 == 0, "tile shapes");
static_assert(AB_SIDE <= 32 && CD_SIDE <= 32 && HPG % 4 == 0, "side widths");

typedef unsigned short bf16_t;
typedef short bf16x8 __attribute__((ext_vector_type(8)));
typedef float f32x4 __attribute__((ext_vector_type(4)));
typedef float f32x2 __attribute__((ext_vector_type(2)));
typedef float f32x16 __attribute__((ext_vector_type(16)));
typedef int i32x8 __attribute__((ext_vector_type(8)));
typedef int i32x4 __attribute__((ext_vector_type(4)));
typedef unsigned u32x4 __attribute__((ext_vector_type(4)));
typedef unsigned u32x2 __attribute__((ext_vector_type(2)));
#ifdef EMU
#define MFMA16(a, b, c) emu_mfma16(a, b, c)
#define MFMA32(a, b, c) emu_mfma32(a, b, c)
#define MFMA_F8(a, b, c) emu_mfma_f8(a, b, c)
#define MFMA_I8(a, b, c) emu_mfma_i8(a, b, c)
#define ALIGNBIT(hi, lo, sh) ((unsigned)(((((unsigned long long)(hi)) << 32) | (unsigned long long)(lo)) >> ((sh) & 31u)))
#define GLDS16(g, l) emu_glds16((const void*)(g), (void*)(l))
#define S_BARRIER() emu::syncthreads()
#define WAIT_VM(n) ((void)0)
#define WAIT_LGKM(n) ((void)0)
#define WAIT_ALL() ((void)0)
#define SCHED_BARRIER() ((void)0)
#define SETPRIO(x) ((void)0)
#define RFL(x) (x)
#define WAVE_SYNC() emu::wave_sync()
#define CFENCE() ((void)0)
#define S_SLEEP(n) emu_spin_pause()
#define FEXP(x) expf(x)
#define NTLD(p) (*(p))
#define NTST(v, p) (*(p) = (v))
#define MFMA_SETTLE() ((void)0)
#define FRCP(x) (1.0f / (x))
#define LAUNDER(x) ((void)0)
#define ATOM_LD(p) emu_atomic_ld((const unsigned*)(p))
#define ATOM_ST(p, v) emu_atomic_st((unsigned*)(p), (v))
#define ATOM_ADD(p, v) emu_atomic_add((unsigned*)(p), (v))
#define FENCE_ACQ() __atomic_thread_fence(__ATOMIC_SEQ_CST)
#define FENCE_REL() __atomic_thread_fence(__ATOMIC_SEQ_CST)
static inline unsigned cvt_pk_bf16(float lo, float hi);
#else
#define LAS __attribute__((address_space(3)))
#define MFMA16(a, b, c) __builtin_amdgcn_mfma_f32_16x16x32_bf16(a, b, c, 0, 0, 0)
#define MFMA32(a, b, c) __builtin_amdgcn_mfma_f32_32x32x16_bf16(a, b, c, 0, 0, 0)
#define MFMA_I8(a, b, c) __builtin_amdgcn_mfma_i32_16x16x64_i8(a, b, c, 0, 0, 0)
#define MFMA_F8(a, b, c) mfma_f8_inplace(a, b, c)
#define ALIGNBIT(hi, lo, sh) __builtin_amdgcn_alignbit(hi, lo, sh)
#define GLDS16(g, l) __builtin_amdgcn_global_load_lds((const unsigned*)(g), (LAS unsigned*)(l), 16, 0, 0)
#define S_BARRIER() __builtin_amdgcn_s_barrier()
#define WAIT_VM(n) asm volatile("s_waitcnt vmcnt(" #n ")" ::: "memory")
#define WAIT_LGKM(n) asm volatile("s_waitcnt lgkmcnt(" #n ")" ::: "memory")
#define WAIT_ALL() asm volatile("s_waitcnt vmcnt(0) lgkmcnt(0)" ::: "memory")
#define SCHED_BARRIER() __builtin_amdgcn_sched_barrier(0)
#define SETPRIO(x) __builtin_amdgcn_s_setprio(x)
#define RFL(x) __builtin_amdgcn_readfirstlane(x)
#define WAVE_SYNC() do { asm volatile("s_waitcnt lgkmcnt(0)" ::: "memory"); __builtin_amdgcn_wave_barrier(); } while (0)
#define CFENCE() asm volatile("" ::: "memory")
#define S_SLEEP(n) __builtin_amdgcn_s_sleep(n)
#define FEXP(x) __expf(x)
#define NTST(v, p) __builtin_nontemporal_store((v), (p))
#define NTLD(p) __builtin_nontemporal_load(p)
#define MFMA_SETTLE() asm volatile("s_nop 15\n\ts_nop 15" ::: "memory")
#define FRCP(x) __builtin_amdgcn_rcpf(x)
#define LAUNDER(x) asm volatile("" : "+v"(x))
#define ATOM_LD(p) __hip_atomic_load((p), __ATOMIC_RELAXED, __HIP_MEMORY_SCOPE_AGENT)
#define ATOM_ST(p, v) __hip_atomic_store((p), (v), __ATOMIC_RELAXED, __HIP_MEMORY_SCOPE_AGENT)
#define ATOM_ADD(p, v) __hip_atomic_fetch_add((p), (v), __ATOMIC_RELAXED, __HIP_MEMORY_SCOPE_AGENT)
#define FENCE_ACQ() __builtin_amdgcn_fence(__ATOMIC_ACQUIRE, "agent")
#define FENCE_REL() __builtin_amdgcn_fence(__ATOMIC_RELEASE, "agent")
#endif

__device__ __forceinline__ unsigned f2bf(float f) { unsigned u = __float_as_uint(f); return (u + 0x7fffu + ((u >> 16) & 1u)) >> 16; }
__device__ __forceinline__ float bf2f(unsigned h) { return __uint_as_float(h << 16); }
__device__ __forceinline__ unsigned pk2(float lo, float hi) { return f2bf(lo) | (f2bf(hi) << 16); }
#ifdef EMU
static inline unsigned cvt_pk_bf16(float lo, float hi) { return pk2(lo, hi); }
#else
__device__ __forceinline__ unsigned cvt_pk_bf16(float lo, float hi) { unsigned r; asm volatile("v_cvt_pk_bf16_f32 %0, %1, %2" : "=v"(r) : "v"(lo), "v"(hi)); return r; }
#endif
#ifdef EMU
static inline unsigned emu_f2e4m3(float f) { const unsigned s = f < 0.f ? 0x80u : 0u; float a = fabsf(f); if (!(a == a)) return 0x7fu; if (a > 448.f) a = 448.f;
    if (a < 0.015625f) { const unsigned man = (unsigned)rintf(a * 512.0f); return s | man; }
    int e; (void)frexpf(a, &e); e -= 1; unsigned man = (unsigned)rintf((a / ldexpf(1.0f, e) - 1.0f) * 8.0f); if (man == 8u) { man = 0u; e += 1; }
    unsigned E = (unsigned)(e + 7); if (E > 15u || (E == 15u && man == 7u)) { E = 15u; man = 6u; } return s | (E << 3) | man; }
static inline float emu_e4m32f(unsigned b) { const float s = (b & 0x80u) ? -1.f : 1.f; const unsigned E = (b >> 3) & 15u, man = b & 7u; if (E == 0) return s * ldexpf((float)man, -9); return s * ldexpf(1.0f + (float)man * 0.125f, (int)E - 7); }
static inline unsigned cvt_pk_fp8x4(float a, float b, float c, float d) { return emu_f2e4m3(a) | (emu_f2e4m3(b) << 8) | (emu_f2e4m3(c) << 16) | (emu_f2e4m3(d) << 24); }
static inline i32x4 emu_mfma_i8(i32x4 a, i32x4 b, i32x4 c) {
    emu::Block* blk = emu::tl_blk; emu::Wave* w = &blk->waves[blk->cur >> 6]; int lane = blk->cur & 63;
    memcpy(w->buf[lane], &a, 16); memcpy(w->buf[lane] + 16, &b, 16); emu::wave_sync();
    const int j = lane & 15; i32x4 d = c;
    for (int r = 0; r < 4; ++r) { const int i = 4 * (lane >> 4) + r; int s = 0;
        for (int kb = 0; kb < 4; ++kb) for (int t = 0; t < 16; ++t) s += (int)(signed char)w->buf[i + 16 * kb][t] * (int)(signed char)w->buf[j + 16 * kb][16 + t];
        d[r] += s; }
    emu::wave_sync(); return d;
}
static inline f32x4 emu_mfma_f8(i32x8 a, i32x8 b, f32x4 c) {
    emu::Block* blk = emu::tl_blk; emu::Wave* w = &blk->waves[blk->cur >> 6]; int lane = blk->cur & 63;
    memcpy(w->buf[lane], &a, 32); memcpy(w->buf[lane] + 32, &b, 32); emu::wave_sync();
    const int j = lane & 15; f32x4 d = c;
    for (int r = 0; r < 4; ++r) { const int i = 4 * (lane >> 4) + r; float s = 0.f;
        for (int kb = 0; kb < 4; ++kb) for (int t = 0; t < 32; ++t) s += emu_e4m32f(w->buf[i + 16 * kb][t]) * emu_e4m32f(w->buf[j + 16 * kb][32 + t]);
        d[r] += s; }
    emu::wave_sync(); return d;
}
#else
__device__ __forceinline__ unsigned cvt_pk_fp8x4(float a, float b, float c, float d) {
    a = fminf(fmaxf(a, -448.f), 448.f); b = fminf(fmaxf(b, -448.f), 448.f); c = fminf(fmaxf(c, -448.f), 448.f); d = fminf(fmaxf(d, -448.f), 448.f);
    int p = __builtin_amdgcn_cvt_pk_fp8_f32(a, b, 0, false); p = __builtin_amdgcn_cvt_pk_fp8_f32(c, d, p, true); return (unsigned)p; }
#endif
#ifndef EMU
__device__ __forceinline__ f32x4 mfma_f8_inplace(i32x8 a, i32x8 b, f32x4 c) {
    asm volatile("v_mfma_scale_f32_16x16x128_f8f6f4 %0, %1, %2, %0, %3, %3 op_sel_hi:[0,0,0]" : "+v"(c) : "v"(a), "v"(b), "v"(0x7F7F7F7F));
    return c; }
#endif
constexpr float W8SCALE = 64.0f, W8INV = 1.0f / 64.0f;
constexpr int KSF8 = ((FF / 128) % 4 == 0) ? 2 : 1;
__device__ __forceinline__ float wave_max(float v) { v = fmaxf(v, __shfl_xor(v, 1)); v = fmaxf(v, __shfl_xor(v, 2)); v = fmaxf(v, __shfl_xor(v, 4)); v = fmaxf(v, __shfl_xor(v, 8)); v = fmaxf(v, __shfl_xor(v, 16)); v = fmaxf(v, __shfl_xor(v, 32)); return v; }
__device__ __forceinline__ unsigned pk_i8x4(float a, float b, float c, float d) { return ((unsigned)(int)rintf(a) & 0xffu) | (((unsigned)(int)rintf(b) & 0xffu) << 8) | (((unsigned)(int)rintf(c) & 0xffu) << 16) | (((unsigned)(int)rintf(d) & 0xffu) << 24); }
__device__ __forceinline__ float wave_sum(float v) { v += __shfl_xor(v, 1); v += __shfl_xor(v, 2); v += __shfl_xor(v, 4); v += __shfl_xor(v, 8); v += __shfl_xor(v, 16); v += __shfl_xor(v, 32); return v; }
__device__ __forceinline__ float siluf(float x) { return x * FRCP(1.0f + FEXP(-x)); }
__device__ __forceinline__ float sigmoidf_(float x) { return FRCP(1.0f + FEXP(-x)); }
__device__ __forceinline__ float logsigmoidf_(float x) { return x < 0.f ? x - log1pf(expf(x)) : -log1pf(expf(-x)); }
__device__ __forceinline__ float softplusf_(float x) { return x > 0.f ? x + log1pf(expf(-x)) : log1pf(expf(x)); }
__device__ __forceinline__ void unpack8(const u32x4 w, float (&f)[8]) {
    f[0] = bf2f(w.x & 0xffffu); f[1] = bf2f(w.x >> 16); f[2] = bf2f(w.y & 0xffffu); f[3] = bf2f(w.y >> 16);
    f[4] = bf2f(w.z & 0xffffu); f[5] = bf2f(w.z >> 16); f[6] = bf2f(w.w & 0xffffu); f[7] = bf2f(w.w >> 16);
}

constexpr size_t al(size_t x) { return (x + 4095) & ~(size_t)4095; }
constexpr size_t WS_CTL = 0, CTL_BYTES = 1u << 20;
constexpr size_t WS_W_ABIN = WS_CTL + CTL_BYTES;
constexpr size_t WS_W_ABSIDE = WS_W_ABIN + al((size_t)AB_MAIN * D * 2);
constexpr size_t WS_W_ABOUT = WS_W_ABSIDE + al((size_t)32 * D * 2);
constexpr size_t WS_W_GU = WS_W_ABOUT + al((size_t)D * YC1 * 2);
constexpr size_t WS_W_DN = WS_W_GU + al((size_t)2 * FF * D * 2);
constexpr size_t WS_W_CDIN = WS_W_DN + al((size_t)D * FF * 2);
constexpr size_t WS_W_CDSIDE = WS_W_CDIN + al((size_t)CD_MAIN * D * 2);
constexpr size_t WS_W_GLU = WS_W_CDSIDE + al((size_t)32 * D * 2);
constexpr size_t WS_W_CDOUT = WS_W_GLU + al((size_t)2 * S5W * S5W * 2);
constexpr size_t WS_W_MGU = WS_W_CDOUT + al((size_t)D * YC2 * 2);
constexpr size_t WS_W_MDN = WS_W_MGU + al((size_t)NE * 2 * FF * D * 2);
constexpr size_t WS_MODP = WS_W_MDN + al((size_t)NE * D * FF * 2);
constexpr size_t WS_MOD = WS_MODP + al((size_t)2 * KSL * NR * 6 * D * 4);
constexpr size_t WS_FILT0 = WS_MOD + al((size_t)2 * NR * 6 * D * 4);
constexpr size_t WS_FILT1 = WS_FILT0 + al((size_t)HYD * 2 * SEQ * 4);
constexpr size_t WS_L1P = WS_FILT1 + al((size_t)HYD * 2 * CTX * 4);
constexpr size_t WS_L1 = WS_L1P + al((size_t)((SEQ + CTX) / 8) * 2 * HYD * 4);
constexpr size_t WS_S5PAR = WS_L1 + al((size_t)2 * HYD * 4);
constexpr size_t WS_XL = WS_S5PAR + al((size_t)2 * S5G * S5P * 36 * 4);
constexpr size_t WS_A = WS_XL + al((size_t)MT * D * 4);
constexpr size_t WS_P = WS_A + al((size_t)MT * D * 2);
constexpr size_t WS_SIDE = WS_P + al((size_t)MT * (AB_MAIN > CD_MAIN ? AB_MAIN : CD_MAIN) * 2);
constexpr size_t WS_YCAT = WS_SIDE + al((size_t)MT * 32 * 4);
constexpr size_t WS_H = WS_YCAT + al((size_t)MT * YC1 * 2);
constexpr size_t WS_AS = WS_H + al((size_t)MOE_ROWS * FF * 2);
constexpr size_t WS_YSLOT = WS_AS + al((size_t)MOE_ROWS * D * 2);
constexpr int MLST_CT = DH * DH / 2;
constexpr int MLST_STRIDE = MLST_CT + DH + 64;
constexpr size_t WS_MLST = WS_YSLOT + al((size_t)2 * ML * D * 4);
constexpr int SSD_HF = SSDP * SSDN / 2;
constexpr int SSDST_STRIDE = SSD_HF + 64;
constexpr size_t WS_SSDST = WS_MLST + al((size_t)2 * NB * MLH * NCS * MLST_STRIDE * 4);
constexpr size_t WS_S5ST = WS_SSDST + al((size_t)2 * NB * SSDH * NCS * SSDST_STRIDE * 4);
constexpr size_t WS_YPRE = WS_S5ST + al((size_t)2 * NB * NCS * S5G * S5P * 2 * 4);
constexpr size_t WS_SSQ = WS_YPRE + al((size_t)ML * SSDD * 4);
constexpr size_t WS_S5G = WS_SSQ + al((size_t)ML * 4 * 4);
constexpr size_t WS_ROUTE = WS_S5G + al((size_t)ML * S5W * 2);
constexpr size_t WS_RPROB = WS_ROUTE + al((size_t)ML * 4 * 4);
constexpr size_t WS_ROWMAP = WS_RPROB + al((size_t)ML * 2 * 4);
constexpr size_t WS_ROWP = WS_ROWMAP + al((size_t)MOE_ROWS * 4);
constexpr size_t WS_PH = WS_ROWP + al((size_t)MOE_ROWS * 4);
constexpr int KSPLIT = 4;
constexpr int KS7 = ((HYD + MLD) / 64) % (2 * KSPLIT) == 0 ? KSPLIT : 2, KS10 = (FF / 128) % (2 * KSPLIT) == 0 ? KSPLIT : ((FF / 128) % 4 == 0 ? 2 : 1);
constexpr size_t WS_PART = WS_PH + al((size_t)3 * HYD * MT * 2);
constexpr int PM_ROWS = 16 * 256;
constexpr size_t WS_PARTM = WS_PART + al((size_t)KSPLIT * MC * D * 4);
constexpr size_t WS_XACT = WS_PARTM + al((size_t)4 * PM_ROWS * D * 4);
constexpr size_t WS_SB_GU = WS_XACT + al((size_t)MT * XBC * 2);
constexpr size_t WS_A8 = WS_SB_GU + al((size_t)2 * FF * 4);
constexpr size_t WS_SA8 = WS_A8 + al((size_t)MT * D);
constexpr size_t WS_END = WS_SA8 + al((size_t)MT * 4);
constexpr int CW_BAR = 4096;
constexpr int CW_CNT = 16384;
constexpr int CW_QNEXT = 20480;
constexpr int CW_ARRIVE = 24576;

#ifdef EMU
struct XcdBarrier { unsigned* bar; unsigned gen; };
static inline XcdBarrier xcd_barrier_post(unsigned* bar, volatile unsigned*) { XcdBarrier b; b.bar = bar; b.gen = 0; return b; }
static inline void xcd_barrier(XcdBarrier& b) {
    __syncthreads();
    if (threadIdx.x == 0) { const unsigned G = gridDim.x; const unsigned old = emu_atomic_add(&b.bar[0], 1u); const unsigned target = (old / G + 1u) * G;
        while (emu_atomic_ld(&b.bar[0]) < target) sched_yield(); }
    __syncthreads();
}
#define XCD_BAR_WORDS 3456
#else
#define XB_TMO      128
#define XB_XCNT(j)  (256  + 64 * (j))
#define XB_XSUB(j)  (1280 + 64 * (j))
#define XB_XGEN(j)  (2304 + 64 * (j))
#define XB_TOP      3328
#define XB_TOPGEN   3392
#define XCD_BAR_WORDS 3456
#define XB_SPIN_CAP (1u << 18)

__device__ __forceinline__ unsigned xb_ld(unsigned* p)              { return __hip_atomic_load(p, __ATOMIC_RELAXED, __HIP_MEMORY_SCOPE_AGENT); }
__device__ __forceinline__ unsigned xb_add(unsigned* p, unsigned v) { return __hip_atomic_fetch_add(p, v, __ATOMIC_RELAXED, __HIP_MEMORY_SCOPE_AGENT); }
__device__ __forceinline__ unsigned xb_xcc_id() { return (unsigned)__builtin_amdgcn_s_getreg((3 << 11) | 20) & 0xFu; }
#define XB_SPIN(cond, bar) do { unsigned _sp = 0; while (cond) { __builtin_amdgcn_s_sleep(1); \
    if ((++_sp & 255u) == 0u) { if (xb_ld(&(bar)[XB_TMO])) break; if (_sp > XB_SPIN_CAP) { atomicAdd(&(bar)[XB_TMO], 1u); break; } } } } while (0)

struct XcdBarrier {
    unsigned* bar; unsigned x;
    volatile LAS unsigned* st;
};

__device__ __forceinline__ XcdBarrier xcd_barrier_post(unsigned* bar, volatile LAS unsigned* st) {
    XcdBarrier b; b.bar = bar; b.x = xb_xcc_id(); b.st = st;
    if (threadIdx.x == 0) (void)xb_add(&bar[XB_XCNT(b.x)], 1u);
    return b;
}
__device__ __forceinline__ void xcd_barrier_complete(unsigned* bar, unsigned x, unsigned& nloc, unsigned& nx) {
    const unsigned G = gridDim.x * gridDim.y * gridDim.z;
    unsigned sum, cnt, mine, sp = 0u;
    for (;;) {
        sum = 0u; cnt = 0u; mine = 0u;
#pragma unroll
        for (unsigned j = 0; j < 16; ++j) { const unsigned c = xb_ld(&bar[XB_XCNT(j)]); sum += c; cnt += (c > 0u) ? 1u : 0u; mine = (j == x) ? c : mine; }
        if (sum == G) break;
        __builtin_amdgcn_s_sleep(1);
        if ((++sp & 255u) == 0u) { if (xb_ld(&bar[XB_TMO])) break; if (sp > XB_SPIN_CAP) { atomicAdd(&bar[XB_TMO], 1u); break; } }
    }
    nloc = mine > 0u ? mine : 1u; nx = cnt > 0u ? cnt : 1u;
}

__device__ __forceinline__ void xcd_barrier(const XcdBarrier& b) {
    asm volatile("s_waitcnt vmcnt(0)" ::: "memory");
    __syncthreads();
    if (threadIdx.x == 0) {
        unsigned* bar = b.bar;
        __builtin_amdgcn_s_waitcnt(0);
        unsigned nloc = b.st[0], nx = b.st[1];
        if (nloc == 0u) { xcd_barrier_complete(bar, b.x, nloc, nx); b.st[0] = nloc; b.st[1] = nx; }
        const unsigned old = xb_add(&bar[XB_XSUB(b.x)], 1u);
        const unsigned gen = old / nloc;
        if (old + 1u == (gen + 1u) * nloc) {
            __builtin_amdgcn_fence(__ATOMIC_RELEASE, "agent");
            asm volatile("s_waitcnt vmcnt(0)" ::: "memory");
            const unsigned og = xb_add(&bar[XB_TOP], 1u);
            const unsigned tg = og / nx;
            if (og + 1u == (tg + 1u) * nx) xb_add(&bar[XB_TOPGEN], 1u);
            else XB_SPIN(xb_ld(&bar[XB_TOPGEN]) == tg, bar);
            __builtin_amdgcn_fence(__ATOMIC_ACQUIRE, "agent");
            xb_add(&bar[XB_XGEN(b.x)], 1u);
            asm volatile("s_waitcnt vmcnt(0)" ::: "memory");
        } else {
            XB_SPIN(xb_ld(&bar[XB_XGEN(b.x)]) == gen, bar);
            __builtin_amdgcn_fence(__ATOMIC_ACQUIRE, "agent");
            asm volatile("s_waitcnt vmcnt(0)" ::: "memory");
        }
    }
    __syncthreads();
}
#endif

namespace pg8 {
constexpr int BM = 256, BK = 64, HALF = 128, HTB = HALF * BK * 2  , STAGE_BYTES = 8 * HTB, NXCD = 8, WGM = 8;

__host__ __device__ __forceinline__ int lds_byte(int r, int c) { const int st = (r >> 4) * 2 + (c >> 5), rr = r & 15, cc = c & 31, ob = rr * 64 + cc * 2; return st * 1024 + (ob ^ (((ob >> 9) & 1) << 5)); }
__host__ __device__ __forceinline__ void stage_rc(int b, int& R, int& C) { const int st = b / 1024, sb = b % 1024, swz = sb ^ (((sb >> 9) & 1) << 5); R = (st >> 1) * 16 + swz / 64; C = (st & 1) * 32 + (swz % 64) / 2; }
__host__ __device__ __forceinline__ int perm32(int rho) { const int n = rho >> 4, i = rho & 15; return 8 * (i >> 2) + 4 * n + (i & 3); }

struct Unit { int pm, pn, k0, nt; };
struct Gemm { const bf16_t* A; const bf16_t* Bt; int M, N, K; };

struct StaticOrder {
    int nM, nN, nwg, G, c;
    __host__ __device__ __forceinline__ void init(int M, int N, int G_, int c_) { nM = M / BM; nN = N / BM; nwg = nM * nN; G = G_; c = c_; }
    __host__ __device__ __forceinline__ bool next(int i, Unit& u) const {
        const long L = (long)i * G + c; if (L >= nwg) return false;
        int wgid = (int)L; { const int q = nwg / NXCD, r = nwg % NXCD, xcd = wgid % NXCD, off = wgid / NXCD; wgid = (xcd < r ? xcd * (q + 1) : r * (q + 1) + (xcd - r) * q) + off; }
        const int nig = WGM * nN, gid = wgid / nig, fm = gid * WGM, gsz = (nM - fm) < WGM ? (nM - fm) : WGM;
        u.pm = fm + ((wgid % nig) % gsz); u.pn = (wgid % nig) / gsz; return true;
    }
    static constexpr bool SPLITK = false;
    __device__ __forceinline__ void a_ready(const Unit&) const {}
    __device__ __forceinline__ void done(const Unit&) const {}
};

template <class Epi, class Sched>
__device__ __forceinline__ void gemm_phase(LAS unsigned char* lds, const Gemm g, const Sched& S, const Epi& E) {
    const int tid = threadIdx.x, wid = RFL(tid >> 6), lane = tid & 63, wr = wid >> 2, wc = wid & 3, fr = lane & 15, fq = lane >> 4;
    const int K = g.K, nt = K / BK;
    unsigned voffA[2], voffB[2];
#pragma unroll
    for (int i = 0; i < 2; ++i) { int R, C; stage_rc(tid * 16 + i * 8192, R, C); const int Rb = Epi::PERM ? ((R & ~31) + perm32(R & 31)) : R;
        voffA[i] = (unsigned)(R * K + C) * 2u; voffB[i] = (unsigned)(Rb * K + C) * 2u; }
    const size_t kstep = (size_t)(BK * 2);
    const size_t hstep = (size_t)HALF * K * 2;
    const size_t tstep = 2 * hstep;
    const unsigned ldsw = (unsigned)wid * 1024u;
    const int aoff = Epi::F8 ? lds_byte(wr * 64 + fr, fq * 16) : lds_byte(wr * 64 + fr, fq * 8), boff = Epi::F8 ? lds_byte(wc * 32 + fr, fq * 16) : lds_byte(wc * 32 + fr, fq * 8);
#define PG8_SA(b, h) (((b) * 2 + (h)) * HTB)
#define PG8_SB(b, h) ((4 + (b) * 2 + (h)) * HTB)
#define PG8_STAGE(bufoff, gbase, voff) do { _Pragma("unroll") for (int _i = 0; _i < 2; ++_i) \
        GLDS16((const char*)(gbase) + (voff)[_i], lds + (bufoff) + ldsw + _i * 8192); } while (0)
#define PG8_LD16(off) (*(const LAS i32x4*)(lds + (off)))
#define PG8_CAT(lo, hi) __builtin_shufflevector((lo), (hi), 0, 1, 2, 3, 4, 5, 6, 7)
#define PG8_LDA(dst, b, h) do { if (Epi::F8) { _Pragma("unroll") for (int m = 0; m < 4; ++m) dst##8[m] = PG8_CAT(PG8_LD16(PG8_SA(b, h) + aoff + m * 2048), PG8_LD16(PG8_SA(b, h) + aoff + m * 2048 + 16)); } \
        else { _Pragma("unroll") for (int m = 0; m < 4; ++m) _Pragma("unroll") for (int k = 0; k < 2; ++k) dst[m][k] = *(const LAS bf16x8*)(lds + PG8_SA(b, h) + aoff + m * 2048 + k * 1024); } } while (0)
#define PG8_LDB(dst, b, h) do { if (Epi::F8) { _Pragma("unroll") for (int n = 0; n < 2; ++n) dst##8[n] = PG8_CAT(PG8_LD16(PG8_SB(b, h) + boff + n * 2048), PG8_LD16(PG8_SB(b, h) + boff + n * 2048 + 16)); } \
        else { _Pragma("unroll") for (int n = 0; n < 2; ++n) _Pragma("unroll") for (int k = 0; k < 2; ++k) dst[n][k] = *(const LAS bf16x8*)(lds + PG8_SB(b, h) + boff + n * 2048 + k * 1024); } } while (0)
#define PG8_MMA(ai, bj, At, Bt) do { SETPRIO(1); if (Epi::F8) { _Pragma("unroll") for (int m = 0; m < 4; ++m) _Pragma("unroll") for (int n = 0; n < 2; ++n) \
            acc[ai][bj][m][n] = MFMA_F8(Bt##8[n], At##8[m], acc[ai][bj][m][n]); } \
        else if (Epi::I8) { _Pragma("unroll") for (int m = 0; m < 4; ++m) _Pragma("unroll") for (int n = 0; n < 2; ++n) _Pragma("unroll") for (int k = 0; k < 2; ++k) \
            acc[ai][bj][m][n] = __builtin_bit_cast(f32x4, MFMA_I8(__builtin_bit_cast(i32x4, Bt[n][k]), __builtin_bit_cast(i32x4, At[m][k]), __builtin_bit_cast(i32x4, acc[ai][bj][m][n]))); } \
        else { _Pragma("unroll") for (int m = 0; m < 4; ++m) _Pragma("unroll") for (int n = 0; n < 2; ++n) _Pragma("unroll") for (int k = 0; k < 2; ++k) \
            acc[ai][bj][m][n] = MFMA16(Bt[n][k], At[m][k], acc[ai][bj][m][n]); } SETPRIO(0); } while (0)
#define PG8_BAR S_BARRIER()
#define PG8_SCHED SCHED_BARRIER()
    Unit cur, nxt; int ui = 0;
    if (!S.next(0, cur)) return;
    f32x4 acc[2][2][4][2];
#pragma unroll
    for (int a = 0; a < 2; ++a)
#pragma unroll
        for (int b = 0; b < 2; ++b)
#pragma unroll
            for (int m = 0; m < 4; ++m)
#pragma unroll
                for (int n = 0; n < 2; ++n) acc[a][b][m][n] = (f32x4){0.f, 0.f, 0.f, 0.f};
    bf16x8 At[4][2], B0[2][2], B1[2][2];
    i32x8 At8[4], B08[2], B18[2];
    const char* cA = (const char*)g.A + (size_t)cur.pm * tstep; const char* cB = (const char*)g.Bt + (size_t)cur.pn * tstep;
    if (Sched::SPLITK) { cA += (size_t)cur.k0 * 2; cB += (size_t)cur.k0 * 2; }
    S.a_ready(cur);
    PG8_STAGE(PG8_SB(0, 0), cB, voffB); PG8_STAGE(PG8_SA(0, 0), cA, voffA); PG8_STAGE(PG8_SB(0, 1), cB + hstep, voffB); PG8_STAGE(PG8_SA(0, 1), cA + hstep, voffA);
    if (wr == 1) PG8_BAR;
    WAIT_VM(4); PG8_BAR;
    PG8_STAGE(PG8_SB(1, 0), cB + kstep, voffB); PG8_STAGE(PG8_SA(1, 0), cA + kstep, voffA); PG8_STAGE(PG8_SB(1, 1), cB + hstep + kstep, voffB);
    WAIT_VM(6); PG8_BAR;
    for (;;) {
        const bool has_next = S.next(ui + 1, nxt);
        const char* nA = has_next ? (const char*)g.A + (size_t)nxt.pm * tstep : cA; const char* nB = has_next ? (const char*)g.Bt + (size_t)nxt.pn * tstep : cB;
        if (Sched::SPLITK && has_next) { nA += (size_t)nxt.k0 * 2; nB += (size_t)nxt.k0 * 2; }
        const int ntu = Sched::SPLITK ? cur.nt : nt;
        for (int t = 0; t < ntu; t += 2) {
            const bool last = (t == ntu - 2);
            const char* a1 = cA + (size_t)(t + 1) * kstep;
            const char* a2 = last ? nA : cA + (size_t)(t + 2) * kstep; const char* b2 = last ? nB : cB + (size_t)(t + 2) * kstep;
            const char* a3 = a2 + kstep; const char* b3 = b2 + kstep;
            if (last && has_next) S.a_ready(nxt);
            PG8_LDB(B0, 0, 0); PG8_SCHED; PG8_LDA(At, 0, 0); PG8_STAGE(PG8_SA(1, 1), a1 + hstep, voffA);
            WAIT_LGKM(8); PG8_BAR; WAIT_LGKM(0); PG8_MMA(0, 0, At, B0); PG8_BAR; PG8_SCHED;
            PG8_LDB(B1, 0, 1); PG8_STAGE(PG8_SB(0, 0), b2, voffB);
            PG8_BAR; WAIT_LGKM(0); PG8_MMA(0, 1, At, B1); PG8_BAR;
            PG8_LDA(At, 0, 1); PG8_STAGE(PG8_SA(0, 0), a2, voffA);
            PG8_BAR; WAIT_LGKM(0); PG8_MMA(1, 0, At, B0); PG8_BAR; PG8_SCHED;
            PG8_STAGE(PG8_SB(0, 1), b2 + hstep, voffB);
            WAIT_VM(6); PG8_BAR; PG8_MMA(1, 1, At, B1); PG8_BAR;
            PG8_LDB(B0, 1, 0); PG8_SCHED; PG8_LDA(At, 1, 0); PG8_STAGE(PG8_SA(0, 1), a2 + hstep, voffA);
            WAIT_LGKM(8); PG8_BAR; WAIT_LGKM(0); PG8_MMA(0, 0, At, B0); PG8_BAR; PG8_SCHED;
            PG8_LDB(B1, 1, 1); PG8_STAGE(PG8_SB(1, 0), b3, voffB);
            PG8_BAR; WAIT_LGKM(0); PG8_MMA(0, 1, At, B1); PG8_BAR;
            PG8_LDA(At, 1, 1); PG8_STAGE(PG8_SA(1, 0), a3, voffA);
            PG8_BAR; WAIT_LGKM(0); PG8_MMA(1, 0, At, B0); PG8_BAR; PG8_SCHED;
            PG8_STAGE(PG8_SB(1, 1), b3 + hstep, voffB);
            WAIT_VM(6); PG8_BAR; PG8_MMA(1, 1, At, B1); PG8_BAR;
        }
        if (Epi::F8) MFMA_SETTLE();
        E(acc, cur, wr, wc, fr, fq); S.done(cur);
        if (!has_next) break;
#pragma unroll
        for (int a = 0; a < 2; ++a)
#pragma unroll
            for (int b = 0; b < 2; ++b)
#pragma unroll
                for (int m = 0; m < 4; ++m)
#pragma unroll
                    for (int n = 0; n < 2; ++n) acc[a][b][m][n] = (f32x4){0.f, 0.f, 0.f, 0.f};
        cur = nxt; cA = nA; cB = nB; ++ui;
    }
    WAIT_VM(0);
    if (wr == 0) PG8_BAR;
    PG8_BAR;
#undef PG8_SA
#undef PG8_SB
#undef PG8_STAGE
#undef PG8_LDA
#undef PG8_LDB
#undef PG8_MMA
#undef PG8_CAT
#undef PG8_LD16
#undef PG8_BAR
#undef PG8_SCHED
}
}

constexpr int LDS_BYTES = 147456;
constexpr int LDS_MISC = LDS_BYTES - 64;
constexpr int TP = 136;
constexpr int TILE_B = 128 * TP * 2;

struct Args { const float* in[44]; float* out; unsigned char* ws; int ph_lo, ph_hi; };

enum InIdx { I_X = 0, I_C, I_CTX, I_CCTX, I_ADAW, I_ADAB, I_ABWIN, I_HYCW, I_HYCB, I_HYW1, I_HYB1, I_HYW2, I_HYB2, I_HYW3, I_HYFREQ, I_HYBIAS,
             I_MLCW, I_MLCB, I_MLGB, I_MLNW, I_ABWOUT, I_FFNGU, I_FFNDN, I_CDWIN, I_SSDCW, I_SSDCB, I_SSDALOG, I_SSDDTB, I_SSDD, I_SSDNW,
             I_S5LRE, I_S5LIM, I_S5LDT, I_S5BRE, I_S5BIM, I_S5CRE, I_S5CIM, I_S5D, I_S5GLU, I_CDWOUT, I_ROUTER, I_MOEGU, I_MOEDN, I_FNW };

struct Frame {
    LAS unsigned char* lds; int tid, lane, wave, G, bid;
    const float* const* in; float* out; unsigned char* ws;
    __device__ __forceinline__ int gw() const { return bid * NWAVES + wave; }
    __device__ __forceinline__ int ngw() const { return G * NWAVES; }
    template <class T> __device__ __forceinline__ T* wsp(size_t off) const { return (T*)(ws + off); }
};

__device__ __forceinline__ int mod_row(int m) { return m < ML ? m / SEQ : NB; }

struct EpiStoreBf16 {
    static constexpr bool PERM = true, F8 = false, I8 = false;
    bf16_t* O; int ldc;
    __device__ __forceinline__ void operator()(const f32x4 (&acc)[2][2][4][2], const pg8::Unit& u, int wr, int wc, int fr, int fq) const {
        const int row0 = u.pm * 256 + wr * 64 + fr, col0 = u.pn * 256 + wc * 32 + 8 * fq;
#pragma unroll
        for (int ai = 0; ai < 2; ++ai)
#pragma unroll
            for (int m = 0; m < 4; ++m) { bf16_t* rowp = O + (size_t)(row0 + ai * 128 + m * 16) * ldc + col0;
#pragma unroll
                for (int bj = 0; bj < 2; ++bj) { const f32x4 v0 = acc[ai][bj][m][0], v1 = acc[ai][bj][m][1];
                    u32x4 w; w.x = cvt_pk_bf16(v0[0], v0[1]); w.y = cvt_pk_bf16(v0[2], v0[3]); w.z = cvt_pk_bf16(v1[0], v1[1]); w.w = cvt_pk_bf16(v1[2], v1[3]);
                    *(u32x4*)(rowp + bj * 128) = w; } }
    }
};
struct EpiInProj0 {
    static constexpr bool PERM = true, F8 = false, I8 = false;
    bf16_t* O; int ldc; bf16_t* PH;
    __device__ __forceinline__ void operator()(const f32x4 (&acc)[2][2][4][2], const pg8::Unit& u, int wr, int wc, int fr, int fq) const {
        const int row0 = u.pm * 256 + wr * 64 + fr, col0 = u.pn * 256 + wc * 32 + 8 * fq;
        if (u.pn * 256 < 3 * HYD) {
#pragma unroll
            for (int ai = 0; ai < 2; ++ai)
#pragma unroll
                for (int m = 0; m < 4; ++m) { const int row = row0 + ai * 128 + m * 16;
#pragma unroll
                    for (int bj = 0; bj < 2; ++bj) { const f32x4 v0 = acc[ai][bj][m][0], v1 = acc[ai][bj][m][1]; const int c = col0 + bj * 128;
                        u32x2 a, b; a.x = cvt_pk_bf16(v0[0], v0[1]); a.y = cvt_pk_bf16(v0[2], v0[3]); b.x = cvt_pk_bf16(v1[0], v1[1]); b.y = cvt_pk_bf16(v1[2], v1[3]);
                        *(u32x2*)(PH + ((size_t)(c >> 2) * MT + row) * 4) = a; *(u32x2*)(PH + ((size_t)((c >> 2) + 1) * MT + row) * 4) = b; } }
        } else {
#pragma unroll
            for (int ai = 0; ai < 2; ++ai)
#pragma unroll
                for (int m = 0; m < 4; ++m) { bf16_t* rowp = O + (size_t)(row0 + ai * 128 + m * 16) * ldc + col0;
#pragma unroll
                    for (int bj = 0; bj < 2; ++bj) { const f32x4 v0 = acc[ai][bj][m][0], v1 = acc[ai][bj][m][1];
                        u32x4 w; w.x = cvt_pk_bf16(v0[0], v0[1]); w.y = cvt_pk_bf16(v0[2], v0[3]); w.z = cvt_pk_bf16(v1[0], v1[1]); w.w = cvt_pk_bf16(v1[2], v1[3]);
                        *(u32x4*)(rowp + bj * 128) = w; } }
        }
    }
};
struct EpiResid {
    static constexpr bool PERM = false, F8 = false, I8 = false;
    const float* xlat; const float* xctx; float* XL; const float* gate;
    __device__ __forceinline__ void operator()(const f32x4 (&acc)[2][2][4][2], const pg8::Unit& u, int wr, int wc, int fr, int fq) const {
        const int row0 = u.pm * 256 + wr * 64 + fr, col0 = u.pn * 256 + wc * 32 + 4 * fq;
#pragma unroll
        for (int ai = 0; ai < 2; ++ai)
#pragma unroll
            for (int m = 0; m < 4; ++m) { const int row = row0 + ai * 128 + m * 16; const int r = mod_row(row);
                const float* src = row < ML ? xlat + (size_t)row * D : xctx + (size_t)(row - ML) * D; float* dst = XL + (size_t)row * D; const float* gp = gate + (size_t)r * 6 * D;
#pragma unroll
                for (int bj = 0; bj < 2; ++bj)
#pragma unroll
                    for (int n = 0; n < 2; ++n) { const int col = col0 + bj * 128 + n * 16; const f32x4 gv = *(const f32x4*)(gp + col); const f32x4 xv = *(const f32x4*)(src + col);
                        *(f32x4*)(dst + col) = xv + gv * acc[ai][bj][m][n]; } }
    }
};
struct EpiResidSplit {
    static constexpr bool PERM = false, F8 = false, I8 = false;
    const float* xlat; float* XL; const float* gate; float* part; int kq;
    __device__ __forceinline__ void operator()(const f32x4 (&acc)[2][2][4][2], const pg8::Unit& u, int wr, int wc, int fr, int fq) const {
        const int row0 = u.pm * 256 + wr * 64 + fr, col0 = u.pn * 256 + wc * 32 + 4 * fq;
        if (u.pm * 256 < ML) {
#pragma unroll
            for (int ai = 0; ai < 2; ++ai)
#pragma unroll
                for (int m = 0; m < 4; ++m) { const int row = row0 + ai * 128 + m * 16; const float* src = xlat + (size_t)row * D; float* dst = XL + (size_t)row * D; const float* gp = gate + (size_t)(row / SEQ) * 6 * D;
#pragma unroll
                    for (int bj = 0; bj < 2; ++bj)
#pragma unroll
                        for (int n = 0; n < 2; ++n) { const int col = col0 + bj * 128 + n * 16; const f32x4 gv = *(const f32x4*)(gp + col); const f32x4 xv = *(const f32x4*)(src + col);
                            *(f32x4*)(dst + col) = xv + gv * acc[ai][bj][m][n]; } }
        } else {
            float* pb = part + (size_t)(u.k0 / kq) * MC * D;
#pragma unroll
            for (int ai = 0; ai < 2; ++ai)
#pragma unroll
                for (int m = 0; m < 4; ++m) { float* dst = pb + (size_t)(row0 + ai * 128 + m * 16 - ML) * D;
#pragma unroll
                    for (int bj = 0; bj < 2; ++bj)
#pragma unroll
                        for (int n = 0; n < 2; ++n) *(f32x4*)(dst + col0 + bj * 128 + n * 16) = acc[ai][bj][m][n]; }
        }
    }
};
struct EpiResidSplitF8 {
    static constexpr bool PERM = false, F8 = true, I8 = false;
    const float* xlat; float* XL; const float* gate; float* part; int kq;
    __device__ __forceinline__ void operator()(const f32x4 (&acc)[2][2][4][2], const pg8::Unit& u, int wr, int wc, int fr, int fq) const {
        const int row0 = u.pm * 256 + wr * 64 + fr, col0 = u.pn * 256 + wc * 32 + 4 * fq;
        if (u.pm * 256 < ML) {
#pragma unroll
            for (int ai = 0; ai < 2; ++ai)
#pragma unroll
                for (int m = 0; m < 4; ++m) { const int row = row0 + ai * 128 + m * 16; const float* src = xlat + (size_t)row * D; float* dst = XL + (size_t)row * D; const float* gp = gate + (size_t)(row / SEQ) * 6 * D;
#pragma unroll
                    for (int bj = 0; bj < 2; ++bj)
#pragma unroll
                        for (int n = 0; n < 2; ++n) { const int col = col0 + bj * 128 + n * 16; const f32x4 gv = *(const f32x4*)(gp + col); const f32x4 xv = *(const f32x4*)(src + col);
                            *(f32x4*)(dst + col) = xv + gv * (acc[ai][bj][m][n] * W8INV); } }
        } else {
            float* pb = part + (size_t)(u.k0 / kq) * MC * D;
#pragma unroll
            for (int ai = 0; ai < 2; ++ai)
#pragma unroll
                for (int m = 0; m < 4; ++m) { float* dst = pb + (size_t)(row0 + ai * 128 + m * 16 - ML) * D;
#pragma unroll
                    for (int bj = 0; bj < 2; ++bj)
#pragma unroll
                        for (int n = 0; n < 2; ++n) *(f32x4*)(dst + col0 + bj * 128 + n * 16) = acc[ai][bj][m][n] * W8INV; }
        }
    }
};
struct CtxSplitOrder {
    static constexpr bool SPLITK = true;
    pg8::StaticOrder so; int nN, KS, ntfull, NCU, G, c;
    __device__ __forceinline__ void init(int N, int K, int KS_, int G_, int c_) { so.init(ML, N, G_, c_); nN = N / 256; KS = KS_; ntfull = K / 64; NCU = (MC / 256) * nN * KS_; G = G_; c = c_; }
    __device__ __forceinline__ bool next(int i, pg8::Unit& u) const {
        const long L = (long)i * G + c; const int nwg = so.nwg; if (L >= (long)nwg + NCU) return false;
        int pm, pn, k0, ntu;
        if (L < nwg) { int wgid = (int)L; { const int q = nwg / pg8::NXCD, r = nwg % pg8::NXCD, xcd = wgid % pg8::NXCD, off = wgid / pg8::NXCD; wgid = (xcd < r ? xcd * (q + 1) : r * (q + 1) + (xcd - r) * q) + off; }
            const int nig = pg8::WGM * so.nN, gid = wgid / nig, fm = gid * pg8::WGM, gsz = (so.nM - fm) < pg8::WGM ? (so.nM - fm) : pg8::WGM;
            pm = fm + ((wgid % nig) % gsz); pn = (wgid % nig) / gsz; k0 = 0; ntu = ntfull; }
        else { const int sub = (int)(L - nwg), ks = sub % KS, t = sub / KS; pm = ML / 256 + t / nN; pn = t % nN; ntu = ntfull / KS; k0 = ks * ntu * 64; }
        u.pm = pm; u.pn = pn; u.k0 = k0; u.nt = ntu; return true;
    }
    __device__ __forceinline__ void a_ready(const pg8::Unit&) const {}
    __device__ __forceinline__ void done(const pg8::Unit&) const {}
};
template <int MODE> struct EpiGated {
    static constexpr bool PERM = true, F8 = false, I8 = false;
    bf16_t* O; int ldc; int col_base; int ntn;
    __device__ __forceinline__ void operator()(const f32x4 (&acc)[2][2][4][2], const pg8::Unit& u, int wr, int wc, int fr, int fq) const {
        const int row0 = u.pm * 256 + wr * 64 + fr, col0 = col_base + (u.pn % ntn) * 128 + wc * 32 + 8 * fq;
#pragma unroll
        for (int ai = 0; ai < 2; ++ai)
#pragma unroll
            for (int m = 0; m < 4; ++m) { bf16_t* rowp = O + (size_t)(row0 + ai * 128 + m * 16) * ldc + col0;
                float o[8];
#pragma unroll
                for (int n = 0; n < 2; ++n)
#pragma unroll
                    for (int j = 0; j < 4; ++j) { const float a = acc[ai][0][m][n][j], b = acc[ai][1][m][n][j];
                        o[n * 4 + j] = MODE == 0 ? (a / (1.0f + FEXP(-a))) * b : a / (1.0f + FEXP(-b)); }
                u32x4 w; w.x = cvt_pk_bf16(o[0], o[1]); w.y = cvt_pk_bf16(o[2], o[3]); w.z = cvt_pk_bf16(o[4], o[5]); w.w = cvt_pk_bf16(o[6], o[7]);
                if (O != nullptr) *(u32x4*)rowp = w; }
    }
};
struct EpiGatedI8 {
    static constexpr bool PERM = true, F8 = false, I8 = true;
    bf16_t* O; int ldc; const float* sa; const float* sb;
    __device__ __forceinline__ void operator()(const f32x4 (&acc)[2][2][4][2], const pg8::Unit& u, int wr, int wc, int fr, int fq) const {
        const int row0 = u.pm * 256 + wr * 64 + fr, c0 = wc * 32 + 8 * fq;
        const f32x4 sga = *(const f32x4*)(sb + u.pn * 256 + c0), sgb = *(const f32x4*)(sb + u.pn * 256 + c0 + 4), sua = *(const f32x4*)(sb + u.pn * 256 + 128 + c0), sub = *(const f32x4*)(sb + u.pn * 256 + 128 + c0 + 4);
#pragma unroll
        for (int ai = 0; ai < 2; ++ai)
#pragma unroll
            for (int m = 0; m < 4; ++m) { const int row = row0 + ai * 128 + m * 16; const float sr = sa[row]; bf16_t* rowp = O + (size_t)row * ldc + u.pn * 128 + c0;
                float o[8];
#pragma unroll
                for (int n = 0; n < 2; ++n)
#pragma unroll
                    for (int j = 0; j < 4; ++j) { const i32x4 ig = __builtin_bit_cast(i32x4, acc[ai][0][m][n]), iu = __builtin_bit_cast(i32x4, acc[ai][1][m][n]);
                        const float a = (float)ig[j] * sr * (n ? sgb[j] : sga[j]), b = (float)iu[j] * sr * (n ? sub[j] : sua[j]); o[n * 4 + j] = a * FRCP(1.0f + FEXP(-a)) * b; }
                u32x4 w; w.x = cvt_pk_bf16(o[0], o[1]); w.y = cvt_pk_bf16(o[2], o[3]); w.z = cvt_pk_bf16(o[4], o[5]); w.w = cvt_pk_bf16(o[6], o[7]);
                *(u32x4*)rowp = w; }
    }
};
struct EpiGatedI8F8 {
    static constexpr bool PERM = true, F8 = false, I8 = true;
    unsigned char* O; int ldc; const float* sa; const float* sb;
    __device__ __forceinline__ void operator()(const f32x4 (&acc)[2][2][4][2], const pg8::Unit& u, int wr, int wc, int fr, int fq) const {
        const int row0 = u.pm * 256 + wr * 64 + fr, c0 = wc * 32 + 8 * fq;
        const f32x4 sga = *(const f32x4*)(sb + u.pn * 256 + c0), sgb = *(const f32x4*)(sb + u.pn * 256 + c0 + 4), sua = *(const f32x4*)(sb + u.pn * 256 + 128 + c0), sub = *(const f32x4*)(sb + u.pn * 256 + 128 + c0 + 4);
#pragma unroll
        for (int ai = 0; ai < 2; ++ai)
#pragma unroll
            for (int m = 0; m < 4; ++m) { const int row = row0 + ai * 128 + m * 16; const float sr = sa[row]; unsigned char* rowp = O + (size_t)row * ldc + u.pn * 128 + c0;
                float o[8];
#pragma unroll
                for (int n = 0; n < 2; ++n)
#pragma unroll
                    for (int j = 0; j < 4; ++j) { const i32x4 ig = __builtin_bit_cast(i32x4, acc[ai][0][m][n]), iu = __builtin_bit_cast(i32x4, acc[ai][1][m][n]);
                        const float a = (float)ig[j] * sr * (n ? sgb[j] : sga[j]), b = (float)iu[j] * sr * (n ? sub[j] : sua[j]); o[n * 4 + j] = a * FRCP(1.0f + FEXP(-a)) * b; }
                u32x2 w; w.x = cvt_pk_fp8x4(o[0], o[1], o[2], o[3]); w.y = cvt_pk_fp8x4(o[4], o[5], o[6], o[7]);
                *(u32x2*)rowp = w; }
    }
};
struct EpiGatedF8 {
    static constexpr bool PERM = true, F8 = true, I8 = false;
    unsigned char* O; int ldc; int ntn;
    __device__ __forceinline__ void operator()(const f32x4 (&acc)[2][2][4][2], const pg8::Unit& u, int wr, int wc, int fr, int fq) const {
        const int row0 = u.pm * 256 + wr * 64 + fr, col0 = (u.pn % ntn) * 128 + wc * 32 + 8 * fq;
#pragma unroll
        for (int ai = 0; ai < 2; ++ai)
#pragma unroll
            for (int m = 0; m < 4; ++m) { unsigned char* rowp = O + (size_t)(row0 + ai * 128 + m * 16) * ldc + col0;
                float o[8];
#pragma unroll
                for (int n = 0; n < 2; ++n)
#pragma unroll
                    for (int j = 0; j < 4; ++j) { const float a = acc[ai][0][m][n][j] * W8INV, b = acc[ai][1][m][n][j] * W8INV; o[n * 4 + j] = a * FRCP(1.0f + FEXP(-a)) * b; }
                u32x2 w; w.x = cvt_pk_fp8x4(o[0], o[1], o[2], o[3]); w.y = cvt_pk_fp8x4(o[4], o[5], o[6], o[7]);
                *(u32x2*)rowp = w; }
    }
};
struct EpiMoeDown {
    static constexpr bool PERM = false, F8 = false, I8 = false;
    const int* rowmap; const float* rowp; float* yslot; int ntn;
    __device__ __forceinline__ void operator()(const f32x4 (&acc)[2][2][4][2], const pg8::Unit& u, int wr, int wc, int fr, int fq) const {
        const int row0 = u.pm * 256 + wr * 64 + fr, col0 = (u.pn % ntn) * 256 + wc * 32 + 4 * fq;
#pragma unroll
        for (int ai = 0; ai < 2; ++ai)
#pragma unroll
            for (int m = 0; m < 4; ++m) { const int row = row0 + ai * 128 + m * 16; const int rm = rowmap[row]; if (rm < 0) continue; const float p = rowp[row];
                float* dst = yslot + ((size_t)(rm & 1) * ML + (size_t)(rm >> 1)) * D;
#pragma unroll
                for (int bj = 0; bj < 2; ++bj)
#pragma unroll
                    for (int n = 0; n < 2; ++n) { const int col = col0 + bj * 128 + n * 16; *(f32x4*)(dst + col) = acc[ai][bj][m][n] * p; } }
    }
};
__device__ __forceinline__ void moe_down_split(int npan, int& nfull, int& ks) { nfull = (npan / 32) * 32; const int lo = npan - nfull; ks = (lo == 0 || lo > 16 || KSF8 == 1) ? 1 : 2; if (ks == 1) nfull = npan; }
struct EpiMoeDownSplit {
    static constexpr bool PERM = false, F8 = true, I8 = false;
    const int* rowmap; const float* rowp; bf16_t* yslot; float* partm; int ntn, row_split, kq; float osc;
    __device__ __forceinline__ void operator()(const f32x4 (&acc)[2][2][4][2], const pg8::Unit& u, int wr, int wc, int fr, int fq) const {
        const int row0 = u.pm * 256 + wr * 64 + fr, col0 = (u.pn % ntn) * 256 + wc * 32 + 4 * fq;
        if (u.pm * 256 < row_split) {
#pragma unroll
            for (int ai = 0; ai < 2; ++ai)
#pragma unroll
                for (int m = 0; m < 4; ++m) { const int row = row0 + ai * 128 + m * 16; const int rm = rowmap[row]; if (rm < 0) continue; const float p = rowp[row] * osc;
                    bf16_t* dst = yslot + ((size_t)(rm & 1) * ML + (size_t)(rm >> 1)) * D;
#pragma unroll
                    for (int bj = 0; bj < 2; ++bj)
#pragma unroll
                        for (int n = 0; n < 2; ++n) { const int col = col0 + bj * 128 + n * 16; const f32x4 v = acc[ai][bj][m][n] * p; u32x2 w; w.x = cvt_pk_bf16(v[0], v[1]); w.y = cvt_pk_bf16(v[2], v[3]); *(u32x2*)(dst + col) = w; } }
        } else {
            float* pb = partm + (size_t)(u.k0 / kq) * PM_ROWS * D;
#pragma unroll
            for (int ai = 0; ai < 2; ++ai)
#pragma unroll
                for (int m = 0; m < 4; ++m) { float* dst = pb + (size_t)(row0 + ai * 128 + m * 16 - row_split) * D;
#pragma unroll
                    for (int bj = 0; bj < 2; ++bj)
#pragma unroll
                        for (int n = 0; n < 2; ++n) *(f32x4*)(dst + col0 + bj * 128 + n * 16) = acc[ai][bj][m][n] * osc; }
        }
    }
};
struct MoeOrder {
    static constexpr bool SPLITK = false;
    int npan, ntn, G, c; int p1, p2, p3, p4, p5, p6, p7;
    __device__ __forceinline__ void init(const Frame& F, int ntn_) {
        const unsigned* cnt = F.wsp<unsigned>(WS_CTL) + CW_CNT; int o = 0;
        o += (int)((cnt[0] + 255u) >> 8); p1 = o; o += (int)((cnt[64] + 255u) >> 8); p2 = o; o += (int)((cnt[128] + 255u) >> 8); p3 = o; o += (int)((cnt[192] + 255u) >> 8); p4 = o;
        o += (int)((cnt[256] + 255u) >> 8); p5 = o; o += (int)((cnt[320] + 255u) >> 8); p6 = o; o += (int)((cnt[384] + 255u) >> 8); p7 = o; o += (int)((cnt[448] + 255u) >> 8); npan = o;
        ntn = ntn_; G = F.G; c = F.bid; }
    __device__ __forceinline__ bool next(int i, pg8::Unit& u) const {
        long f; if ((G & 7) == 0) { const int per = G >> 3; f = ((long)i * 8 + (c & 7)) * per + (c >> 3); } else f = (long)i * G + c;
        if (f >= (long)npan * ntn) return false;
        const int fi = (int)f; const int q1 = p1 * ntn, q2 = p2 * ntn, q3 = p3 * ntn, q4 = p4 * ntn, q5 = p5 * ntn, q6 = p6 * ntn, q7 = p7 * ntn;
        const int e = (fi >= q1) + (fi >= q2) + (fi >= q3) + (fi >= q4) + (fi >= q5) + (fi >= q6) + (fi >= q7);
        const int pb = e == 0 ? 0 : e == 1 ? p1 : e == 2 ? p2 : e == 3 ? p3 : e == 4 ? p4 : e == 5 ? p5 : e == 6 ? p6 : p7;
        const int pe = e == 0 ? p1 : e == 1 ? p2 : e == 2 ? p3 : e == 3 ? p4 : e == 4 ? p5 : e == 5 ? p6 : e == 6 ? p7 : npan;
        const int gw = (ntn & 3) == 0 ? 4 : ((ntn & 1) == 0 ? 2 : 1);
        const int np = pe - pb, r = fi - pb * ntn, gsz = np * gw, tg = r / gsz, rr = r % gsz;
        u.pm = pb + rr / gw; u.pn = e * ntn + tg * gw + rr % gw; u.k0 = 0; u.nt = 0; return true;
    }
    __device__ __forceinline__ void a_ready(const pg8::Unit&) const {}
    __device__ __forceinline__ void done(const pg8::Unit&) const {}
};

struct MoeDownOrder {
    static constexpr bool SPLITK = true;
    MoeOrder mo; int nfull, KS, ntfull;
    __device__ __forceinline__ void init(const Frame& F, int ntn_, int K) { mo.init(F, ntn_); ntfull = K / 64; moe_down_split(mo.npan, nfull, KS); }
    __device__ __forceinline__ bool next(int i, pg8::Unit& u) const {
        const long L = (long)i * mo.G + mo.c; const long nnorm = (long)nfull * mo.ntn; if (L >= nnorm + (long)(mo.npan - nfull) * mo.ntn * KS) return false;
        int pm, pn, k0, ntu;
        if (L < nnorm) { pm = (int)(L / mo.ntn); pn = (int)(L % mo.ntn); k0 = 0; ntu = ntfull; }
        else { const int sub = (int)(L - nnorm), ks = sub % KS, t = sub / KS; pm = nfull + t / mo.ntn; pn = t % mo.ntn; ntu = ntfull / KS; k0 = ks * ntu * 64; }
        const int e = (pm >= mo.p1) + (pm >= mo.p2) + (pm >= mo.p3) + (pm >= mo.p4) + (pm >= mo.p5) + (pm >= mo.p6) + (pm >= mo.p7);
        u.pm = pm; u.pn = e * mo.ntn + pn; u.k0 = k0; u.nt = ntu; return true;
    }
    __device__ __forceinline__ void a_ready(const pg8::Unit&) const {}
    __device__ __forceinline__ void done(const pg8::Unit&) const {}
};

template <int MTN, int NTN, int KS>
__device__ __forceinline__ void wave_mma(f32x4 (&acc)[MTN][NTN], const LAS bf16_t* A, int rowA0, const LAS bf16_t* B, int rowB0, int lane) {
    const int r = lane & 15, q = lane >> 4;
#pragma unroll
    for (int ks = 0; ks < KS; ++ks) {
        bf16x8 a[MTN], b[NTN];
#pragma unroll
        for (int mt = 0; mt < MTN; ++mt) a[mt] = *(const LAS bf16x8*)(A + (rowA0 + 16 * mt + r) * TP + ks * 32 + q * 8);
#pragma unroll
        for (int nt = 0; nt < NTN; ++nt) b[nt] = *(const LAS bf16x8*)(B + (rowB0 + 16 * nt + r) * TP + ks * 32 + q * 8);
#pragma unroll
        for (int mt = 0; mt < MTN; ++mt)
#pragma unroll
            for (int nt = 0; nt < NTN; ++nt) acc[mt][nt] = MFMA16(a[mt], b[nt], acc[mt][nt]);
    }
}
template <int MTN, int NTN> __device__ __forceinline__ void zero_acc(f32x4 (&acc)[MTN][NTN]) {
#pragma unroll
    for (int a = 0; a < MTN; ++a)
#pragma unroll
        for (int b = 0; b < NTN; ++b) acc[a][b] = (f32x4){0.f, 0.f, 0.f, 0.f};
}

template <bool MAXOP> __device__ __forceinline__ void wave_scan128(const LAS float* a, LAS float* out, bool rev, int lane) {
    const int i0 = rev ? CH - 1 - 2 * lane : 2 * lane, i1 = rev ? i0 - 1 : i0 + 1;
    const float x0 = a[i0], x1 = a[i1]; float s = MAXOP ? fmaxf(x0, x1) : x0 + x1;
#pragma unroll
    for (int off = 1; off < 64; off <<= 1) { const float t = __shfl_up(s, off); if (lane >= off) s = MAXOP ? fmaxf(s, t) : s + t; }
    float prev = __shfl_up(s, 1); if (lane == 0) prev = MAXOP ? -INFINITY : 0.f;
    out[i0] = MAXOP ? fmaxf(prev, x0) : prev + x0; out[i1] = s;
}
__device__ __forceinline__ void conv3x8(const bf16_t* base, int ld, bool has_l, bool has_r, const float* w, int wld, const float* b, float (&o)[8]) {
    float xc[8], xl[8], xr[8];
    unpack8(*(const u32x4*)base, xc);
    if (has_l) unpack8(*(const u32x4*)(base - ld), xl); else {
#pragma unroll
        for (int j = 0; j < 8; ++j) xl[j] = 0.f; }
    if (has_r) unpack8(*(const u32x4*)(base + ld), xr); else {
#pragma unroll
        for (int j = 0; j < 8; ++j) xr[j] = 0.f; }
    const f32x4 w0a = *(const f32x4*)(w), w0b = *(const f32x4*)(w + 4), w1a = *(const f32x4*)(w + wld), w1b = *(const f32x4*)(w + wld + 4), w2a = *(const f32x4*)(w + 2 * wld), w2b = *(const f32x4*)(w + 2 * wld + 4);
    const f32x4 ba = *(const f32x4*)(b), bb = *(const f32x4*)(b + 4);
#pragma unroll
    for (int j = 0; j < 4; ++j) { o[j] = ba[j] + w0a[j] * xl[j] + w1a[j] * xc[j] + w2a[j] * xr[j]; o[4 + j] = bb[j] + w0b[j] * xl[4 + j] + w1b[j] * xc[4 + j] + w2b[j] * xr[4 + j]; }
}
__device__ __forceinline__ void conv_nbr(int cs, int s, bool& has_l, bool& has_r) {
    if (cs < NCC) { const int pos = cs * CH + s; has_l = pos > 0; has_r = pos < CTX - 1; }
    else { has_l = (s & (GW - 1)) != 0; has_r = (s & (GW - 1)) != GW - 1; }
}
__device__ __forceinline__ int chunk_row0(int b, int cs) { return cs < NCC ? ML + b * CTX + cs * CH : b * SEQ + (cs - NCC) * CH; }
__device__ __forceinline__ int scan_slot(int d, int q) { return d == 0 ? q : (q < NCC ? NCC - 1 - q : NCS - 1 - (q - NCC)); }

template <int MAP> __device__ __forceinline__ int conv_src_col(int nb, int half) {
    if (MAP == 0) return nb * 128;
    if (MAP == 1) return (nb & 1) * half + (nb >> 1) * 128;
    return nb * 128 < SSDD + XBC ? nb * 128 : nb * 128 + CD_SIDE;
}
template <int MAP> __device__ __forceinline__ void conv_job(const Frame& F, int& base, const float* src, int ld, bf16_t* dst, int K, int nblk, int half) {
    constexpr int PB = 264;
    const int ntile = nblk * (K / 128);
    const int n = F.tid & 127, kq = F.tid >> 7;
    int t = (F.bid - base % F.G + F.G) % F.G;
    base += ntile;
    f32x4 v[8];
    const unsigned ldb = (unsigned)ld * 4u, lane_off = (unsigned)n * 4u + (unsigned)(4 * kq) * ldb;
#define CONV_LOAD(tt) do { const int nb_ = (tt) % nblk, kb_ = (tt) / nblk; const char* sp_ = (const char*)(src + (size_t)(kb_ * 128) * ld + conv_src_col<MAP>(nb_, half)); \
        _Pragma("unroll") for (int i_ = 0; i_ < 8; ++i_) { const unsigned o_ = lane_off + (unsigned)(16 * i_) * ldb; \
            v[i_][0] = NTLD((const float*)(sp_ + o_)); v[i_][1] = NTLD((const float*)(sp_ + o_ + ldb)); v[i_][2] = NTLD((const float*)(sp_ + o_ + 2u * ldb)); v[i_][3] = NTLD((const float*)(sp_ + o_ + 3u * ldb)); } } while (0)
    if (t < ntile) CONV_LOAD(t);
    while (t < ntile) {
#pragma unroll
        for (int i = 0; i < 8; ++i) { u32x2 w; w.x = pk2(v[i][0], v[i][1]); w.y = pk2(v[i][2], v[i][3]); *(LAS u32x2*)(F.lds + n * PB + (kq + 4 * i) * 8) = w; }
        const int tn = t + F.G;
        if (tn < ntile) CONV_LOAD(tn);
        __syncthreads();
        const int nb = t % nblk, kb = t / nblk;
#pragma unroll
        for (int i = 0; i < 4; ++i) { const int ch = F.tid + 512 * i, nn = ch >> 4, kc = ch & 15;
            const u32x2 a = *(const LAS u32x2*)(F.lds + nn * PB + kc * 16), b = *(const LAS u32x2*)(F.lds + nn * PB + kc * 16 + 8);
            u32x4 w; w.x = a.x; w.y = a.y; w.z = b.x; w.w = b.y;
            *(u32x4*)(dst + (size_t)(nb * 128 + nn) * K + kb * 128 + kc * 8) = w; }
        __syncthreads();
        t = tn;
    }
#undef CONV_LOAD
}
constexpr int MQ_TGU = (2 * FF / 128) * (D / 128), MQ_TDN = (D / 128) * (FF / 128), MQ_NT = NE * (MQ_TGU + MQ_TDN);
struct MoeTile { const char* sp; unsigned char* dp; unsigned ldb; int K; };
__device__ __forceinline__ MoeTile moe_tile(const Frame& F, int t) {
    MoeTile m;
    if (t < NE * MQ_TGU) { const int e = t / MQ_TGU, r = t % MQ_TGU, nb = r % (2 * FF / 128), kb = r / (2 * FF / 128);
        m.sp = (const char*)(F.in[I_MOEGU] + (size_t)e * D * 2 * FF + (size_t)(kb * 128) * (2 * FF) + (nb & 1) * FF + (nb >> 1) * 128); m.ldb = 2u * FF * 4u;
        m.dp = F.wsp<unsigned char>(WS_W_MGU) + (size_t)e * 2 * FF * D + (size_t)(nb * 128) * D + kb * 128; m.K = D; }
    else { const int tt = t - NE * MQ_TGU, e = tt / MQ_TDN, r = tt % MQ_TDN, nb = r % (D / 128), kb = r / (D / 128);
        m.sp = (const char*)(F.in[I_MOEDN] + (size_t)e * FF * D + (size_t)(kb * 128) * D + nb * 128); m.ldb = (unsigned)D * 4u;
        m.dp = F.wsp<unsigned char>(WS_W_MDN) + (size_t)e * D * FF + (size_t)(nb * 128) * FF + kb * 128; m.K = FF; }
    return m;
}
#define MQ_LOAD(m, v) do { const unsigned lo_ = (unsigned)(F.tid & 127) * 4u + (unsigned)(4 * (F.tid >> 7)) * (m).ldb; \
        _Pragma("unroll") for (int i_ = 0; i_ < 8; ++i_) { const unsigned o_ = lo_ + (unsigned)(16 * i_) * (m).ldb; \
            v[i_][0] = NTLD((const float*)((m).sp + o_)); v[i_][1] = NTLD((const float*)((m).sp + o_ + (m).ldb)); v[i_][2] = NTLD((const float*)((m).sp + o_ + 2u * (m).ldb)); v[i_][3] = NTLD((const float*)((m).sp + o_ + 3u * (m).ldb)); } } while (0)
#define MQ_TOLDS(v) do { _Pragma("unroll") for (int i_ = 0; i_ < 8; ++i_) *(LAS unsigned*)(F.lds + (F.tid & 127) * 132 + ((F.tid >> 7) + 4 * i_) * 4) = \
        cvt_pk_fp8x4(v[i_][0] * W8SCALE, v[i_][1] * W8SCALE, v[i_][2] * W8SCALE, v[i_][3] * W8SCALE); } while (0)
#define MQ_STORE(m) do { _Pragma("unroll") for (int i_ = 0; i_ < 2; ++i_) { const int ch_ = F.tid + 512 * i_, nn_ = ch_ >> 3, kc_ = ch_ & 7; const LAS unsigned* lp_ = (const LAS unsigned*)(F.lds + nn_ * 132 + kc_ * 16); \
        u32x4 w_; w_.x = lp_[0]; w_.y = lp_[1]; w_.z = lp_[2]; w_.w = lp_[3]; NTST(w_, (u32x4*)((m).dp + (size_t)nn_ * (m).K + kc_ * 16)); } } while (0)
__device__ __forceinline__ void conv_job_f8(const Frame& F, int& base, const float* src, int ld, unsigned char* dst, int K, int nblk) {
    const int ntile = nblk * (K / 128);
    int t = (F.bid - base % F.G + F.G) % F.G; base += ntile;
    f32x4 v[8]; MoeTile m, mn;
    __syncthreads();
#define CF8_TILE(mm, tt) do { const int nb_ = (tt) % nblk, kb_ = (tt) / nblk; (mm).sp = (const char*)(src + (size_t)(kb_ * 128) * ld + nb_ * 128); (mm).ldb = (unsigned)ld * 4u; (mm).dp = dst + (size_t)(nb_ * 128) * K + kb_ * 128; (mm).K = K; } while (0)
    if (t < ntile) { CF8_TILE(m, t); MQ_LOAD(m, v); }
    while (t < ntile) {
        MQ_TOLDS(v);
        const int tn = t + F.G; mn = m;
        if (tn < ntile) { CF8_TILE(mn, tn); MQ_LOAD(mn, v); }
        __syncthreads();
        MQ_STORE(m);
        __syncthreads();
        m = mn; t = tn;
    }
#undef CF8_TILE
}
__device__ __forceinline__ void moe_convert_strided(const Frame& F, int t0, int t1, int st) {
    __syncthreads();
    if (t0 >= t1) return;
    f32x4 v[8]; MoeTile m = moe_tile(F, t0), mn = m; MQ_LOAD(m, v);
#pragma unroll 1
    for (int t = t0; t < t1; t += st) {
        MQ_TOLDS(v);
        const int tn = t + st; mn = m;
        if (tn < t1) { mn = moe_tile(F, tn); MQ_LOAD(mn, v); }
        __syncthreads();
        MQ_STORE(m);
        __syncthreads();
        m = mn;
    }
}
struct MqSlot { int nu, q; };
__device__ __forceinline__ int mq_nu(int slot) {
    constexpr int NU_ML = NB * MLH * NCS, NU7 = (ML / 256) * (D / 256) + (MC / 256) * (D / 256) * KS7, NU9 = (MT / 256) * (2 * FF / 256), NU10 = (ML / 256) * (D / 256) + (MC / 256) * (D / 256) * KS10,
                  NU12 = (MT / 256) * (CD_MAIN / 256), NU13 = NB * NCS * SSDG * 2 * (HPG / 4), NU16 = (ML / 256) * (2 * S5W / 256);
    return slot == 0 ? NU_ML : slot == 1 ? NU_ML : slot == 2 ? NU7 : slot == 3 ? NU9 : slot == 4 ? NU10 : slot == 5 ? NU12 : slot == 6 ? NU13 : NU16;
}
__device__ __forceinline__ int mq_q(int slot) { return slot == 0 ? 6 : slot == 1 ? 16 : slot == 2 ? 2 : slot == 3 ? 8 : slot == 4 ? 12 : slot == 5 ? 16 : slot == 6 ? 8 : 2; }
constexpr int MQ_NSLOT = 8;
__device__ __forceinline__ int mq_base(int G, int slot) { int b = 0;
#pragma unroll
    for (int k = 0; k < MQ_NSLOT; ++k) { const int r = mq_nu(k) % G; if (k < slot && r != 0) b += (G - r) * mq_q(k); }
    return b < MQ_NT ? b : MQ_NT; }
__device__ __forceinline__ void help_slot(const Frame& F, int slot) {
    const int r = mq_nu(slot) % F.G; if (r == 0 || F.bid < r) return;
    const int nh = F.G - r, b0 = mq_base(F.G, slot); int b1 = b0 + nh * mq_q(slot); if (b1 > MQ_NT) b1 = MQ_NT;
    moe_convert_strided(F, b0 + (F.bid - r), b1, nh);
}
constexpr int MQ_Q20 = 8;
__device__ __forceinline__ int mq_tail_lo(const Frame& F, int& r) {
    const unsigned* cnt = F.wsp<unsigned>(WS_CTL) + CW_CNT; int npan = 0;
#pragma unroll
    for (int k = 0; k < NE; ++k) npan += (int)((cnt[64 * k] + 255u) >> 8);
    const int U = npan * (2 * FF / 256); r = U % F.G; const int nidle = r ? F.G - r : 0; const int b = mq_base(F.G, MQ_NSLOT);
    int tl = nidle * MQ_Q20; if (tl > MQ_NT - b) tl = MQ_NT - b; if (tl < 0) tl = 0;
    return MQ_NT - tl;
}
__device__ __forceinline__ void help_drain(const Frame& F) {
    int r; const int hi = mq_tail_lo(F, r);
    const int b = mq_base(F.G, MQ_NSLOT); if (hi - b <= 0) return;
    moe_convert_strided(F, b + F.bid, hi, F.G);
}
__device__ __forceinline__ void help_moe_tail(const Frame& F) {
    int r; const int lo = mq_tail_lo(F, r); if (r == 0) return;
    const int pos = (F.G & 7) == 0 ? (F.bid & 7) * (F.G >> 3) + (F.bid >> 3) : F.bid;
    if (pos < r) return;
    moe_convert_strided(F, lo + (pos - r), MQ_NT, F.G - r);
}
template <int MAP> __device__ __forceinline__ void conv_job_i8(const Frame& F, int& base, const float* src, int ld, signed char* dst, float* scale, int K, int nblk, int half) {
    LAS float* cmx = (LAS float*)(F.lds + 128 * 132);
    const int n = F.tid & 127, kq = F.tid >> 7; const unsigned ldb = (unsigned)ld * 4u, lane_off = (unsigned)n * 4u + (unsigned)(4 * kq) * ldb;
    for (int nb = (F.bid - base % F.G + F.G) % F.G; nb < nblk; nb += F.G) {
        const char* sp0 = (const char*)(src + conv_src_col<MAP>(nb, half)); float mx = 0.f;
        for (int kb = 0; kb < K / 128; ++kb) { const char* sp = sp0 + (size_t)(kb * 128) * ldb;
#pragma unroll
            for (int i = 0; i < 8; ++i) { const unsigned o = lane_off + (unsigned)(16 * i) * ldb;
                mx = fmaxf(mx, fmaxf(fmaxf(fabsf(*(const float*)(sp + o)), fabsf(*(const float*)(sp + o + ldb))), fmaxf(fabsf(*(const float*)(sp + o + 2u * ldb)), fabsf(*(const float*)(sp + o + 3u * ldb))))); } }
        __syncthreads();
        cmx[kq * 128 + n] = mx;
        __syncthreads();
        if (F.tid < 128) { const float m4 = fmaxf(fmaxf(cmx[n], cmx[128 + n]), fmaxf(cmx[256 + n], cmx[384 + n])); const float sc = m4 > 0.f ? m4 * (1.0f / 127.0f) : 1.0f; scale[nb * 128 + n] = sc; cmx[512 + n] = 1.0f / sc; }
        __syncthreads();
        const float inv = cmx[512 + n];
        for (int kb = 0; kb < K / 128; ++kb) { const char* sp = sp0 + (size_t)(kb * 128) * ldb;
#pragma unroll
            for (int i = 0; i < 8; ++i) { const unsigned o = lane_off + (unsigned)(16 * i) * ldb;
                *(LAS unsigned*)(F.lds + n * 132 + (kq + 4 * i) * 4) = pk_i8x4(*(const float*)(sp + o) * inv, *(const float*)(sp + o + ldb) * inv, *(const float*)(sp + o + 2u * ldb) * inv, *(const float*)(sp + o + 3u * ldb) * inv); }
            __syncthreads();
#pragma unroll
            for (int i = 0; i < 2; ++i) { const int ch = F.tid + 512 * i, nn = ch >> 3, kc = ch & 7; const LAS unsigned* lp = (const LAS unsigned*)(F.lds + nn * 132 + kc * 16);
                u32x4 w; w.x = lp[0]; w.y = lp[1]; w.z = lp[2]; w.w = lp[3]; *(u32x4*)(dst + (size_t)(nb * 128 + nn) * K + kb * 128 + kc * 16) = w; }
            __syncthreads(); }
    }
    base += nblk;
}
__device__ __forceinline__ void conv_side(const Frame& F, const float* src, int ld, int col0, int nside, bf16_t* dst, int K) {
    for (int idx = F.bid * NTHREADS + F.tid; idx < 32 * K; idx += F.G * NTHREADS) { const int n = idx / K, k = idx % K;
        dst[idx] = (bf16_t)(n < nside ? f2bf(src[(size_t)k * ld + col0 + n]) : 0u); }
}

__device__ __forceinline__ void adaln_units(const Frame& F) {
    LAS float* cond = (LAS float*)F.lds;
    const float* adaw = F.in[I_ADAW]; float* part = F.wsp<float>(WS_MODP);
    constexpr int NCHUNK = 6 * D / 512, NU = 2 * NCHUNK * KSL;
    for (int u = F.bid; u < NU; u += F.G) {
        const int l = u / (NCHUNK * KSL), rem = u % (NCHUNK * KSL), ks = rem / NCHUNK, nc = rem % NCHUNK;
        __syncthreads();
        for (int i = F.tid; i < NR * 256; i += NTHREADS) { const int r = i / 256, k = ks * 256 + (i & 255); const float c = r < NB ? F.in[I_C][r * D + k] : F.in[I_CCTX][k]; cond[i] = siluf(c); }
        __syncthreads();
        const int n = nc * 512 + F.tid; const float* wp = adaw + ((size_t)l * D + ks * 256) * (6 * D) + n;
        float acc[NR];
#pragma unroll
        for (int r = 0; r < NR; ++r) acc[r] = 0.f;
#pragma unroll 1
        for (int k0 = 0; k0 < 256; k0 += 32) { float w[32];
#pragma unroll
            for (int j = 0; j < 32; ++j) w[j] = NTLD(wp + (size_t)(k0 + j) * (6 * D));
#pragma unroll
            for (int j = 0; j < 32; ++j)
#pragma unroll
                for (int r = 0; r < NR; ++r) acc[r] += cond[r * 256 + k0 + j] * w[j]; }
#pragma unroll
        for (int r = 0; r < NR; ++r) part[(((size_t)l * KSL + ks) * NR + r) * (6 * D) + n] = acc[r];
    }
    __syncthreads();
}

__device__ __forceinline__ void hyena_filter_units(const Frame& F, int wg_off) {
    constexpr int H2P = 36, OBP = 33, FC = HYD >= NTHREADS ? HYD / NTHREADS : 1;
    LAS float* feats = (LAS float*)F.lds;
    LAS float* h1 = feats + 32 * 36;
    LAS float* h2 = h1 + 32 * 64;
    LAS float* ob = h2 + 64 * H2P;
    static_assert((32 * 36 + 32 * 64 + 64 * H2P + NTHREADS * OBP) * 4 <= LDS_MISC, "filter LDS");
    static_assert(SEQ % 32 == 0 && CTX % 32 == 0 && (HYD % NTHREADS == 0 || HYD < NTHREADS), "filter shapes");
    const float* w1 = F.in[I_HYW1]; const float* b1 = F.in[I_HYB1]; const float* w2 = F.in[I_HYW2]; const float* b2 = F.in[I_HYB2]; const float* w3 = F.in[I_HYW3]; const float* fq = F.in[I_HYFREQ];
    constexpr int NU0 = 2 * (SEQ / 32), NU = NU0 + 2 * (CTX / 32);
    for (int u = (F.bid - wg_off % F.G + F.G) % F.G; u < NU; u += F.G) {
        const int set = u < NU0 ? 0 : 1, L = set ? CTX : SEQ, ul = set ? u - NU0 : u, dir = ul & 1, p0 = (ul >> 1) * 32, pb = (set ? SEQ / 32 : 0) + (ul >> 1);
        float* filt = F.wsp<float>(set ? WS_FILT1 : WS_FILT0);
        int tid = F.tid; LAUNDER(tid);
        __syncthreads();
        for (int e = tid; e < 32 * HYEMB; e += NTHREADS) { const int p = e / HYEMB, i = e % HYEMB; const float pos = (float)(p0 + dir + p); float v;
            if (i == 0) v = pos / (float)(L - 1);
            else { const int bi = (i - 1) & 15; const float band = 1e-4f + (float)bi * ((15.0f - 1e-4f) / 15.0f); const float ang = (float)(2.0 * M_PI / (double)L) * pos * band; v = i <= 16 ? cosf(ang) : -sinf(ang); }
            feats[p * 36 + i] = v; }
        __syncthreads();
        { const int pq = tid >> 6, j = tid & 63; float wv[HYEMB]; float sa[4];
#pragma unroll
            for (int i = 0; i < HYEMB; ++i) wv[i] = w1[i * HYHID + j];
#pragma unroll
            for (int x = 0; x < 4; ++x) sa[x] = b1[j];
#pragma unroll
            for (int i = 0; i < HYEMB; ++i)
#pragma unroll
                for (int x = 0; x < 4; ++x) sa[x] += feats[(4 * pq + x) * 36 + i] * wv[i];
#pragma unroll
            for (int x = 0; x < 4; ++x) h1[(4 * pq + x) * 64 + j] = fq[j] * sa[x];
#pragma unroll 1
            for (int x = 0; x < 4; ++x) { LAS float* hp = h1 + (4 * pq + x) * 64 + j; *hp = sinf(*hp); } }
        __syncthreads();
        { const int pq = tid >> 6, j = tid & 63; float wv[HYHID]; float sa[4];
#pragma unroll
            for (int i = 0; i < HYHID; ++i) wv[i] = w2[i * HYHID + j];
#pragma unroll
            for (int x = 0; x < 4; ++x) sa[x] = b2[j];
#pragma unroll
            for (int i = 0; i < HYHID; ++i)
#pragma unroll
                for (int x = 0; x < 4; ++x) sa[x] += h1[(4 * pq + x) * 64 + i] * wv[i];
#pragma unroll
            for (int x = 0; x < 4; ++x) h2[j * H2P + 4 * pq + x] = fq[HYHID + j] * sa[x];
#pragma unroll 1
            for (int x = 0; x < 4; ++x) { LAS float* hp = h2 + j * H2P + 4 * pq + x; *hp = sinf(*hp); } }
        __syncthreads();
        float acc[FC][32];
#pragma unroll
        for (int cc = 0; cc < FC; ++cc)
#pragma unroll
            for (int p = 0; p < 32; ++p) acc[cc][p] = 0.f;
        const int cl = tid < HYD ? tid : 0;
#pragma unroll 1
        for (int k0 = 0; k0 < HYHID; k0 += 16) { float w[16][FC];
#pragma unroll
            for (int j = 0; j < 16; ++j)
#pragma unroll
                for (int cc = 0; cc < FC; ++cc) w[j][cc] = w3[(size_t)(k0 + j) * (2 * HYD) + dir * HYD + cl + NTHREADS * cc];
#pragma unroll
            for (int j = 0; j < 16; ++j) {
#pragma unroll
                for (int i = 0; i < 8; ++i) { const f32x4 hv = *(const LAS f32x4*)(h2 + (k0 + j) * H2P + 4 * i);
#pragma unroll
                    for (int cc = 0; cc < FC; ++cc) { acc[cc][4 * i] += hv[0] * w[j][cc]; acc[cc][4 * i + 1] += hv[1] * w[j][cc]; acc[cc][4 * i + 2] += hv[2] * w[j][cc]; acc[cc][4 * i + 3] += hv[3] * w[j][cc]; } } } }
        const int a0 = dir ? L - p0 - 32 : L + p0;
#pragma unroll
        for (int cc = 0; cc < FC; ++cc) { const int c = cl + NTHREADS * cc;
            const float delta = (float)(-log(1e-2) / 1.5) + (float)c * (float)((-log(1e-2) / 0.3 + log(1e-2) / 1.5) / (double)(HYD - 1));
            float l1 = 0.f;
#pragma unroll
            for (int p = 0; p < 32; ++p) { const int pos = p0 + dir + p; const float t = (float)pos / (float)(L - 1); float v = acc[cc][p] * expf(-t * delta);
                if (pos >= L) v = 0.f;
                l1 += fabsf(v); ob[tid * OBP + (dir ? 31 - p : p)] = v; }
            if (tid < HYD) F.wsp<float>(WS_L1P)[(size_t)pb * (2 * HYD) + dir * HYD + c] = l1;
            __syncthreads();
            for (int e = tid; e < (HYD < NTHREADS ? HYD : NTHREADS) * 8; e += NTHREADS) { const int ch = e >> 3, qd = e & 7; const LAS float* op = ob + ch * OBP + 4 * qd;
                const f32x4 v4 = {op[0], op[1], op[2], op[3]};
                *(f32x4*)(filt + (size_t)(ch + NTHREADS * cc) * (2 * L) + a0 + 4 * qd) = v4; }
            __syncthreads();
        }
    }
    __syncthreads();
}

__device__ __forceinline__ void s5_param_units(const Frame& F) {
    float* par = F.wsp<float>(WS_S5PAR);
    for (int i = F.bid + F.G * F.tid; i < 2 * S5G * S5P; i += F.G * NTHREADS) {
        const int d = i / (S5G * S5P), g = (i / S5P) % S5G, p = i % S5P;
        const float dt = expf(F.in[I_S5LDT][d * S5G + g]), lr = F.in[I_S5LRE][i], li = F.in[I_S5LIM][i];
        const float mag = expf(lr * dt), lbr = mag * cosf(li * dt), lbi = mag * sinf(li * dt), den = lr * lr + li * li;
        const float fr = ((lbr - 1.f) * lr + lbi * li) / den, fi = (lbi * lr - (lbr - 1.f) * li) / den;
        float* o = par + (size_t)i * 36; o[0] = lbr; o[1] = lbi;
        const float* bre = F.in[I_S5BRE] + ((size_t)g * S5P + p) * S5GS; const float* bim = F.in[I_S5BIM] + ((size_t)g * S5P + p) * S5GS;
        float br[S5GS], bi[S5GS];
#pragma unroll
        for (int k = 0; k < S5GS; ++k) { br[k] = bre[k]; bi[k] = bim[k]; }
#pragma unroll
        for (int k = 0; k < S5GS; ++k) { o[2 + k] = fr * br[k] - fi * bi[k]; o[18 + k] = fr * bi[k] + fi * br[k]; }
        const float magc = expf(lr * dt * (float)CH); o[34] = magc * cosf(li * dt * (float)CH); o[35] = magc * sinf(li * dt * (float)CH);
    }
}

__device__ __forceinline__ void phase_prologue(const Frame& F, int pm = 0) {
    int base = 0;
    if (pm == 0 || pm == 1) {
    conv_job<0>(F, base, F.in[I_ABWIN], AB_IN, F.wsp<bf16_t>(WS_W_ABIN), D, AB_MAIN / 128, 0);
    conv_job<0>(F, base, F.in[I_ABWOUT], D, F.wsp<bf16_t>(WS_W_ABOUT), YC1, D / 128, 0); }
    const int i8_hi = base + 2 * FF / 128;
    if (pm == 0 || pm == 2)
    conv_job_i8<1>(F, base, F.in[I_FFNGU], 2 * FF, F.wsp<signed char>(WS_W_GU), F.wsp<float>(WS_SB_GU), D, 2 * FF / 128, FF);
    if (pm == 0 || pm == 1) {
    conv_job_f8(F, base, F.in[I_FFNDN], D, F.wsp<unsigned char>(WS_W_DN), FF, D / 128);
    conv_job<2>(F, base, F.in[I_CDWIN], CD_IN, F.wsp<bf16_t>(WS_W_CDIN), D, CD_MAIN / 128, 0);
    conv_job<1>(F, base, F.in[I_S5GLU], 2 * S5W, F.wsp<bf16_t>(WS_W_GLU), S5W, 2 * S5W / 128, S5W);
    conv_job<0>(F, base, F.in[I_CDWOUT], D, F.wsp<bf16_t>(WS_W_CDOUT), YC2, D / 128, 0);
    conv_side(F, F.in[I_ABWIN], AB_IN, AB_MAIN, AB_SIDE, F.wsp<bf16_t>(WS_W_ABSIDE), D);
    conv_side(F, F.in[I_CDWIN], CD_IN, SSDD + XBC, CD_SIDE, F.wsp<bf16_t>(WS_W_CDSIDE), D); }
    if (pm == 0 || pm == 3) adaln_units(F);
    if (pm == 0 || pm == 4) { hyena_filter_units(F, i8_hi);
    s5_param_units(F); }
}

__device__ __forceinline__ void phase_finalize(const Frame& F) {
    const float* part = F.wsp<float>(WS_MODP); float* mod = F.wsp<float>(WS_MOD); const float* adab = F.in[I_ADAB];
    for (int i = F.bid * NTHREADS + F.tid; i < 2 * NR * 6 * D; i += F.G * NTHREADS) {
        const int l = i / (NR * 6 * D), r = (i / (6 * D)) % NR, n = i % (6 * D);
        float s = adab[l * 6 * D + n];
        for (int ks = 0; ks < KSL; ++ks) s += part[(((size_t)l * KSL + ks) * NR + r) * (6 * D) + n];
        mod[i] = s; }
    const float* l1p = F.wsp<float>(WS_L1P); float* l1 = F.wsp<float>(WS_L1);
    for (int i = F.bid * NTHREADS + F.tid; i < 2 * HYD; i += F.G * NTHREADS) {
        const int set = i / HYD, c = i % HYD; const int u0 = set ? SEQ / 32 : 0, nu = set ? CTX / 32 : SEQ / 32; float s = 0.f;
        for (int u = 0; u < nu; ++u) s += l1p[(size_t)(u0 + u) * (2 * HYD) + c] + l1p[(size_t)(u0 + u) * (2 * HYD) + HYD + c];
        l1[i] = 1.0f / s; }
}

template <bool ROUTE, bool OUTI8 = false> __device__ __forceinline__ void modulate_rows(const Frame& F, const float* xlat, const float* xctx, int layer, int si, bf16_t* dst, int m_hi, const float* part = nullptr, const float* pgate = nullptr, int nks = 0, float* xw = nullptr) {
    const float* mod = F.wsp<float>(WS_MOD) + (size_t)layer * NR * 6 * D;
    LAS float* rwl = (LAS float*)F.lds;
    LAS float* mdl = (LAS float*)F.lds + (ROUTE ? NE * D : 0); constexpr int NRL = ROUTE ? NB : NR;
    static_assert(((ROUTE ? NE * D : 0) + NRL * 2 * D) * 4 <= LDS_MISC, "modulate LDS");
    __syncthreads();
    if (ROUTE) { for (int i = F.tid; i < D * NE; i += NTHREADS) rwl[(i % NE) * D + i / NE] = F.in[I_ROUTER][i]; }
    for (int i = F.tid; i < NRL * 2 * D; i += NTHREADS) { const int r = i / (2 * D), w = i % (2 * D); mdl[i] = mod[(size_t)r * 6 * D + (size_t)si * D + w]; }
    __syncthreads();
    constexpr int NV = D / 256;
    for (int m = F.gw(); m < m_hi; m += F.ngw()) {
        const float* xr = m < ML ? xlat + (size_t)m * D : xctx + (size_t)(m - ML) * D; const int r = mod_row(m);
        const LAS float* sh = mdl + r * 2 * D; const LAS float* sc = sh + D;
        f32x4 v[NV]; float ss = 0.f;
#pragma unroll
        for (int i = 0; i < NV; ++i) { const int k = 4 * (F.lane + 64 * i); v[i] = *(const f32x4*)(xr + k);
            if (!ROUTE && part != nullptr && m >= ML) { f32x4 ps = *(const f32x4*)(part + (size_t)(m - ML) * D + k);
                for (int ks = 1; ks < nks; ++ks) ps += *(const f32x4*)(part + ((size_t)ks * MC + (m - ML)) * D + k);
                v[i] += *(const f32x4*)(pgate + k) * ps; *(f32x4*)(xw + (size_t)m * D + k) = v[i]; }
            ss += v[i][0] * v[i][0] + v[i][1] * v[i][1] + v[i][2] * v[i][2] + v[i][3] * v[i][3]; }
        ss = wave_sum(ss); const float rinv = 1.0f / sqrtf(ss * (1.0f / (float)D) + EPS);
        float lg[NE];
        if (ROUTE) {
#pragma unroll
            for (int e = 0; e < NE; ++e) lg[e] = 0.f; }
        if (OUTI8) {
            float mx = 0.f;
#pragma unroll
            for (int i = 0; i < NV; ++i) { const int k = 4 * (F.lane + 64 * i); const f32x4 s4 = *(const LAS f32x4*)(sh + k), c4 = *(const LAS f32x4*)(sc + k); v[i] = v[i] * rinv * (c4 + 1.0f) + s4;
                mx = fmaxf(mx, fmaxf(fmaxf(fabsf(v[i][0]), fabsf(v[i][1])), fmaxf(fabsf(v[i][2]), fabsf(v[i][3])))); }
            mx = wave_max(mx); const float scl = mx > 0.f ? mx * (1.0f / 127.0f) : 1.0f, inv = 1.0f / scl;
            signed char* d8 = F.wsp<signed char>(WS_A8) + (size_t)m * D;
#pragma unroll
            for (int i = 0; i < NV; ++i) *(unsigned*)(d8 + 4 * (F.lane + 64 * i)) = pk_i8x4(v[i][0] * inv, v[i][1] * inv, v[i][2] * inv, v[i][3] * inv);
            if (F.lane == 0) F.wsp<float>(WS_SA8)[m] = scl;
            continue; }
#pragma unroll
        for (int i = 0; i < NV; ++i) { const int k = 4 * (F.lane + 64 * i); const f32x4 s4 = *(const LAS f32x4*)(sh + k), c4 = *(const LAS f32x4*)(sc + k);
            f32x4 y = v[i] * rinv * (c4 + 1.0f) + s4;
            if (ROUTE) *(unsigned*)((unsigned char*)dst + (size_t)m * D + k) = cvt_pk_fp8x4(y[0], y[1], y[2], y[3]);
            else { u32x2 w; w.x = pk2(y[0], y[1]); w.y = pk2(y[2], y[3]); *(u32x2*)(dst + (size_t)m * D + k) = w; }
            if (ROUTE) {
#pragma unroll
                for (int e = 0; e < NE; ++e) { const f32x4 rv = *(const LAS f32x4*)(rwl + e * D + k); lg[e] += y[0] * rv[0] + y[1] * rv[1] + y[2] * rv[2] + y[3] * rv[3]; } SCHED_BARRIER(); } }
        if (ROUTE) {
#pragma unroll
            for (int e = 0; e < NE; ++e) lg[e] = wave_sum(lg[e]);
            if (F.lane == 0) { int e0 = 0; float v0 = lg[0];
#pragma unroll
                for (int e = 1; e < NE; ++e) if (lg[e] > v0) { v0 = lg[e]; e0 = e; }
                int e1 = -1; float v1 = -INFINITY;
#pragma unroll
                for (int e = 0; e < NE; ++e) if (e != e0 && lg[e] > v1) { v1 = lg[e]; e1 = e; }
                const float p1 = 1.0f / (1.0f + expf(v0 - v1)), p0 = 1.0f - p1;
                unsigned* cnt = F.wsp<unsigned>(WS_CTL) + CW_CNT;
                const unsigned pos0 = ATOM_ADD(cnt + 64 * e0, 1u), pos1 = ATOM_ADD(cnt + 64 * e1, 1u);
                int* rt = F.wsp<int>(WS_ROUTE) + (size_t)m * 4; rt[0] = e0; rt[1] = e1; rt[2] = (int)pos0; rt[3] = (int)pos1;
                float* rp = F.wsp<float>(WS_RPROB) + (size_t)m * 2; rp[0] = p0; rp[1] = p1; } }
    }
}

__device__ __forceinline__ void side_gemm(const Frame& F, const bf16_t* A, const bf16_t* Ws, float* out, int M) {
    const int r = F.lane & 15, q = F.lane >> 4; constexpr int KW = D / NWAVES; static_assert(KW % 32 == 0 && NTHREADS == 16 * 32, "side gemm split");
    LAS float* red = (LAS float*)F.lds;
    for (int blk = F.bid; blk < M / 16; blk += F.G) {
        f32x4 acc0 = (f32x4){0.f, 0.f, 0.f, 0.f}, acc1 = acc0; const int k0 = F.wave * KW;
        const bf16_t* ap = A + (size_t)(blk * 16 + r) * D + k0 + q * 8; const bf16_t* b0 = Ws + (size_t)r * D + k0 + q * 8; const bf16_t* b1 = Ws + (size_t)(16 + r) * D + k0 + q * 8;
#pragma unroll
        for (int k = 0; k < KW; k += 32) { const bf16x8 a = *(const bf16x8*)(ap + k), x0 = *(const bf16x8*)(b0 + k), x1 = *(const bf16x8*)(b1 + k);
            acc0 = MFMA16(a, x0, acc0); acc1 = MFMA16(a, x1, acc1); }
        __syncthreads();
#pragma unroll
        for (int j = 0; j < 4; ++j) { red[(F.wave * 16 + 4 * q + j) * 32 + r] = acc0[j]; red[(F.wave * 16 + 4 * q + j) * 32 + 16 + r] = acc1[j]; }
        __syncthreads();
        { const int row = F.tid >> 5, col = F.tid & 31; float sm = 0.f;
#pragma unroll
            for (int w = 0; w < NWAVES; ++w) sm += red[(w * 16 + row) * 32 + col];
            out[(size_t)(blk * 16 + row) * 32 + col] = sm; }
    }
    __syncthreads();
}

__device__ __forceinline__ void conv3x4(const bf16_t* rec, bool has_l, bool has_r, const float* w, int wld, const float* b, float (&o)[4]) {
    const u32x2 c = *(const u32x2*)rec; u32x2 l = (u32x2){0u, 0u}, r = (u32x2){0u, 0u};
    if (has_l) l = *(const u32x2*)(rec - 4);
    if (has_r) r = *(const u32x2*)(rec + 4);
    const f32x4 w0 = *(const f32x4*)w, w1 = *(const f32x4*)(w + wld), w2 = *(const f32x4*)(w + 2 * wld), bb = *(const f32x4*)b;
    const float xc[4] = {bf2f(c.x & 0xffffu), bf2f(c.x >> 16), bf2f(c.y & 0xffffu), bf2f(c.y >> 16)};
    const float xl[4] = {bf2f(l.x & 0xffffu), bf2f(l.x >> 16), bf2f(l.y & 0xffffu), bf2f(l.y >> 16)};
    const float xr[4] = {bf2f(r.x & 0xffffu), bf2f(r.x >> 16), bf2f(r.y & 0xffffu), bf2f(r.y >> 16)};
#pragma unroll
    for (int j = 0; j < 4; ++j) o[j] = bb[j] + w0[j] * xl[j] + w1[j] * xc[j] + w2[j] * xr[j];
}
template <int L, bool LAT> __device__ __forceinline__ void hyena_unit(const Frame& F0, int cg, int hymode = 0) {
    Frame F = F0; LAUNDER(F.tid); F.lane = F.tid & 63;
    constexpr int NT1 = L / 128, ZP = 136, ZCH = NB * NT1 * ZP, KRP = 2 * L + 8;
    static_assert(4 * ZCH * 2 + 8 * KRP * 2 + ZP * 2 <= LDS_MISC && 4 * NB * L * 4 <= LDS_MISC && NB <= 4 && NT1 <= 16, "hyena LDS");
    LAS bf16_t* zl = (LAS bf16_t*)F.lds;
    LAS bf16_t* kr = zl + 4 * ZCH;
    LAS bf16_t* zz = kr + 8 * KRP;
    LAS float* res = (LAS float*)F.lds;
    const bf16_t* PH = F.wsp<bf16_t>(WS_PH); const float* cw = F.in[I_HYCW]; const float* cb = F.in[I_HYCB];
    const float* filt = F.wsp<float>(LAT ? WS_FILT0 : WS_FILT1);
    const int c0 = cg * 4;
    __syncthreads();
    constexpr int ZB = 8;
    for (int idx0 = F.tid; idx0 < ((hymode & 2) ? 0 : NB * L); idx0 += ZB * NTHREADS) { float a[ZB][4], v[ZB][4];
#pragma unroll
        for (int j = 0; j < ZB; ++j) { const int idx = idx0 + j * NTHREADS < NB * L ? idx0 + j * NTHREADS : idx0; const int b = idx / L, t = idx % L; const int m = LAT ? b * SEQ + t : ML + b * CTX + t;
            bool hl, hr; if (LAT) { hl = (t & (GW - 1)) != 0; hr = (t & (GW - 1)) != GW - 1; } else { hl = t > 0; hr = t < L - 1; }
            conv3x4(PH + ((size_t)(HYD / 4 + cg) * MT + m) * 4, hl, hr, cw + HYD + c0, 3 * HYD, cb + HYD + c0, a[j]);
            conv3x4(PH + ((size_t)(2 * HYD / 4 + cg) * MT + m) * 4, hl, hr, cw + 2 * HYD + c0, 3 * HYD, cb + 2 * HYD + c0, v[j]); }
#pragma unroll
        for (int j = 0; j < ZB; ++j) { const int idx = idx0 + j * NTHREADS; if (idx < NB * L) { const int b = idx / L, t = idx % L;
#pragma unroll
            for (int c = 0; c < 4; ++c) zl[c * ZCH + (b * NT1 + (t >> 7)) * ZP + (t & 127)] = (bf16_t)f2bf(a[j][c] * v[j][c]); } } }
    constexpr int KB = 8;
    for (int idx0 = F.tid; idx0 < 4 * KRP; idx0 += KB * NTHREADS) { float tv[KB];
#pragma unroll
        for (int j = 0; j < KB; ++j) { const int idx = idx0 + j * NTHREADS; const int c = idx / KRP, i = idx % KRP;
            tv[j] = (idx < 4 * KRP && i >= 1 && i <= 2 * L - 1) ? filt[(size_t)(c0 + c) * (2 * L) + 2 * L - i] : 0.f; }
#pragma unroll
        for (int j = 0; j < KB; ++j) { const int idx = idx0 + j * NTHREADS; if (idx < 4 * KRP) { const int c = idx / KRP, i = idx % KRP;
            const bf16_t v = (bf16_t)((i >= 1 && i <= 2 * L - 1) ? f2bf(tv[j]) : 0u);
            kr[(c * 2) * KRP + i] = v; if (i >= 1) kr[(c * 2 + 1) * KRP + i - 1] = v; else kr[(c * 2 + 1) * KRP + KRP - 1] = 0; } } }
    if (F.tid < ZP) zz[F.tid] = 0;
    __syncthreads();
    const int ch = F.wave >> 1, h = F.wave & 1, i = F.lane & 31, q = F.lane >> 5;
    const int cb_ = i >> 3, t1 = 8 * h + (i & 7); const bool colok = cb_ < NB && t1 < NT1;
    f32x16 acc[4];
#pragma unroll
    for (int mt = 0; mt < 4; ++mt)
#pragma unroll
        for (int r = 0; r < 16; ++r) acc[mt][r] = 0.f;
    if (8 * h < NT1) {
        const int d_lo = 8 * h - (NT1 - 1), d_hi = (hymode & 1) ? d_lo - 1 : ((8 * h + 7 < NT1 - 1) ? 8 * h + 7 : NT1 - 1);
        const LAS unsigned* kbase = (const LAS unsigned*)(kr + (ch * 2 + (i & 1)) * KRP) + (L / 2 + 4 * q - ((i + 1) >> 1));
        const LAS bf16_t* zc = zl + ch * ZCH + (colok ? cb_ : 0) * NT1 * ZP + 8 * q;
        bf16x8 fa[14], fb[14];
#define HY_LOADF(dst, dd) do { const LAS unsigned* kb_ = kbase - 8 * (8 * (dd) - 7); _Pragma("unroll") for (int fi_ = 0; fi_ < 14; ++fi_) { const LAS unsigned* p_ = kb_ - 8 * fi_; \
            u32x4 fw_; fw_.x = p_[0]; fw_.y = p_[1]; fw_.z = p_[2]; fw_.w = p_[3]; dst[fi_] = __builtin_bit_cast(bf16x8, fw_); } } while (0)
#define HY_STEP(cur, nxt, dd) do { const int s1_ = t1 - (dd); const bool ok_ = colok && s1_ >= 0 && s1_ < NT1; const LAS bf16_t* zp_ = ok_ ? zc + s1_ * ZP : zz + 8 * q; const int zs_ = ok_ ? 16 : 0; \
            bf16x8 zf_[8]; _Pragma("unroll") for (int ks_ = 0; ks_ < 8; ++ks_) zf_[ks_] = *(const LAS bf16x8*)(zp_ + zs_ * ks_); \
            if ((dd) + 1 <= d_hi) HY_LOADF(nxt, (dd) + 1); \
            _Pragma("unroll") for (int ks_ = 0; ks_ < 8; ++ks_) _Pragma("unroll") for (int mt_ = 0; mt_ < 4; ++mt_) acc[mt_] = MFMA32(cur[2 * mt_ - ks_ + 7], zf_[ks_], acc[mt_]); } while (0)
        if (d_lo <= d_hi) HY_LOADF(fa, d_lo);
#pragma unroll 1
        for (int d = d_lo; d <= d_hi; d += 2) {
            HY_STEP(fa, fb, d);
            if (d + 1 <= d_hi) HY_STEP(fb, fa, d + 1);
        }
#undef HY_LOADF
#undef HY_STEP
        if (colok) { const float il1 = F.wsp<float>(WS_L1)[(LAT ? 0 : HYD) + c0 + ch], bias = F.in[I_HYBIAS][c0 + ch]; const LAS bf16_t* zr = zl + ch * ZCH + (cb_ * NT1 + t1) * ZP;
#pragma unroll
            for (int mt = 0; mt < 4; ++mt)
#pragma unroll
                for (int r = 0; r < 16; ++r) { const int t0 = 32 * mt + 8 * (r >> 2) + 4 * q + (r & 3); acc[mt][r] = acc[mt][r] * il1 + bias * bf2f(zr[t0]); } }
    }
    __syncthreads();
    if (8 * h < NT1 && colok) {
#pragma unroll
        for (int mt = 0; mt < 4; ++mt)
#pragma unroll
            for (int r = 0; r < 16; ++r) res[(ch * NB + cb_) * L + t1 * 128 + 32 * mt + 8 * (r >> 2) + 4 * q + (r & 3)] = acc[mt][r]; }
    __syncthreads();
    bf16_t* Y = F.wsp<bf16_t>(WS_YCAT);
    for (int idx0 = F.tid; idx0 < ((hymode & 2) ? 0 : NB * L); idx0 += ZB * NTHREADS) { float x0[ZB][4];
#pragma unroll
        for (int j = 0; j < ZB; ++j) { const int idx = idx0 + j * NTHREADS < NB * L ? idx0 + j * NTHREADS : idx0; const int b = idx / L, t = idx % L; const int m = LAT ? b * SEQ + t : ML + b * CTX + t;
            bool hl, hr; if (LAT) { hl = (t & (GW - 1)) != 0; hr = (t & (GW - 1)) != GW - 1; } else { hl = t > 0; hr = t < L - 1; }
            conv3x4(PH + ((size_t)cg * MT + m) * 4, hl, hr, cw + c0, 3 * HYD, cb + c0, x0[j]); }
#pragma unroll
        for (int j = 0; j < ZB; ++j) { const int idx = idx0 + j * NTHREADS; if (idx < NB * L) { const int b = idx / L, t = idx % L; const int m = LAT ? b * SEQ + t : ML + b * CTX + t;
            u32x2 wv; wv.x = pk2(x0[j][0] * res[(0 * NB + b) * L + t], x0[j][1] * res[(1 * NB + b) * L + t]); wv.y = pk2(x0[j][2] * res[(2 * NB + b) * L + t], x0[j][3] * res[(3 * NB + b) * L + t]);
            *(u32x2*)(Y + (size_t)m * YC1 + c0) = wv; } } }
    __syncthreads();
}
__device__ __forceinline__ void hyena_units(const Frame& F, int hymode = 0) {
    for (int u = F.bid; u < HYD / 4; u += F.G) hyena_unit<SEQ, true>(F, u, hymode);
    for (int u = F.bid; u < HYD / 4; u += F.G) hyena_unit<CTX, false>(F, u, hymode);
}

__device__ __forceinline__ float* mlst_slot(const Frame& F, int d, int b, int h, int cs) { return F.wsp<float>(WS_MLST) + ((((size_t)d * NB + b) * MLH + h) * NCS + cs) * MLST_STRIDE; }

__device__ __forceinline__ void mlstm_gates(const Frame& F, LAS float* ga, int m0, int h) {
    if (F.tid < CH) { const float* sd = F.wsp<float>(WS_SIDE) + (size_t)(m0 + F.tid) * 32; const float* gb = F.in[I_MLGB];
        ga[0 * CH + F.tid] = logsigmoidf_(sd[MLH + h] + gb[MLH + h]); ga[1 * CH + F.tid] = sd[h] + gb[h];
        ga[2 * CH + F.tid] = logsigmoidf_(sd[3 * MLH + h] + gb[3 * MLH + h]); ga[3 * CH + F.tid] = sd[2 * MLH + h] + gb[2 * MLH + h]; }
    __syncthreads();
    if (F.wave == 0) wave_scan128<false>(ga + 0 * CH, ga + 4 * CH, false, F.lane);
    else if (F.wave == 1) wave_scan128<false>(ga + 2 * CH, ga + 5 * CH, true, F.lane);
    __syncthreads();
}

__device__ __forceinline__ void mlstm_local_unit(const Frame& F0, int b, int h, int cs) {
    Frame F = F0; LAUNDER(F.tid); F.lane = F.tid & 63;
    LAS bf16_t* KwF = (LAS bf16_t*)F.lds; LAS bf16_t* KwB = (LAS bf16_t*)(F.lds + TILE_B); LAS bf16_t* VT = (LAS bf16_t*)(F.lds + 2 * TILE_B);
    LAS float* ga = (LAS float*)(F.lds + 3 * TILE_B);
    const int m0 = chunk_row0(b, cs);
    __syncthreads();
    mlstm_gates(F, ga, m0, h);
    if (F.tid < 2 * CH) { const int d = F.tid >> 7, i = F.tid & 127; const LAS float* bc = ga + (4 + d) * CH; const LAS float* ig = ga + (1 + 2 * d) * CH; const float g = d ? bc[0] : bc[CH - 1];
        const float a = g - bc[i] + ig[i]; float mx = a;
        mx = fmaxf(mx, __shfl_xor(mx, 1)); mx = fmaxf(mx, __shfl_xor(mx, 2)); mx = fmaxf(mx, __shfl_xor(mx, 4)); mx = fmaxf(mx, __shfl_xor(mx, 8)); mx = fmaxf(mx, __shfl_xor(mx, 16)); mx = fmaxf(mx, __shfl_xor(mx, 32));
        ga[(6 + d) * CH + i] = a; if ((i & 63) == 0) ga[8 * CH + 8 + 2 * d + (i >> 6)] = mx; }
    __syncthreads();
    if (F.tid < 2 * CH) { const int d = F.tid >> 7, i = F.tid & 127; const float mx = fmaxf(ga[8 * CH + 8 + 2 * d], ga[8 * CH + 8 + 2 * d + 1]);
        const LAS float* bc = ga + (4 + d) * CH; ga[(6 + d) * CH + i] = expf(ga[(6 + d) * CH + i] - mx);
        if (i == 0) { ga[8 * CH + 2 * d] = mx; ga[8 * CH + 2 * d + 1] = d ? bc[0] : bc[CH - 1]; } }
    __syncthreads();
    const bf16_t* P = F.wsp<bf16_t>(WS_P); const float* cw = F.in[I_MLCW]; const float* cb = F.in[I_MLCB];
    { const int s = F.tid & 127, fgq = F.tid >> 7; bool hl, hr; conv_nbr(cs, s, hl, hr); const float wf = ga[6 * CH + s], wb = ga[7 * CH + s];
#pragma unroll 2
        for (int i = 0; i < 4; ++i) { const int f0 = (fgq + 4 * i) * 8;
            float kv[8]; conv3x8(P + (size_t)(m0 + s) * AB_MAIN + 3 * HYD + MLD + h * DH + f0, AB_MAIN, hl, hr, cw + MLD + h * DH + f0, 2 * MLD, cb + MLD + h * DH + f0, kv);
            float vv[8]; unpack8(*(const u32x4*)(P + (size_t)(m0 + s) * AB_MAIN + 3 * HYD + 2 * MLD + h * DH + f0), vv);
#pragma unroll
            for (int j = 0; j < 8; ++j) { const float kk = siluf(kv[j]); KwF[(f0 + j) * TP + s] = (bf16_t)f2bf(kk * wf); KwB[(f0 + j) * TP + s] = (bf16_t)f2bf(kk * wb); VT[(f0 + j) * TP + s] = (bf16_t)f2bf(vv[j]); } } }
    __syncthreads();
    const int wm = F.wave >> 1, wn = F.wave & 1, r = F.lane & 15, q = F.lane >> 4;
#pragma unroll
    for (int d = 0; d < 2; ++d) {
        f32x4 acc[2][4]; zero_acc(acc);
        wave_mma<2, 4, 4>(acc, d ? KwB : KwF, 32 * wm, VT, 64 * wn, F.lane);
        bf16_t* ct = (bf16_t*)mlst_slot(F, d, b, h, cs);
#pragma unroll
        for (int mt = 0; mt < 2; ++mt)
#pragma unroll
            for (int nt = 0; nt < 4; ++nt) { u32x2 w; w.x = pk2(acc[mt][nt][0], acc[mt][nt][1]); w.y = pk2(acc[mt][nt][2], acc[mt][nt][3]);
                *(u32x2*)(ct + (64 * wn + 16 * nt + r) * DH + 32 * wm + 16 * mt + 4 * q) = w; }
    }
    if (F.tid < 2 * CH) { const int d = F.tid >> 7, kk = F.tid & 127; const LAS bf16_t* row = (d ? KwB : KwF) + kk * TP; float s = 0.f;
        for (int i = 0; i < CH; i += 8) { float f[8]; unpack8(*(const LAS u32x4*)(row + i), f);
#pragma unroll
            for (int j = 0; j < 8; ++j) s += f[j]; }
        float* sl = mlst_slot(F, d, b, h, cs); sl[MLST_CT + kk] = s;
        if (kk == 0) { sl[MLST_CT + DH] = ga[8 * CH + 2 * d]; sl[MLST_CT + DH + 1] = ga[8 * CH + 2 * d + 1]; } }
    __syncthreads();
}

__device__ __forceinline__ void mlstm_carry(const Frame& F) {
    constexpr int NCI = DH * DH / 8, NVI = NCI + DH / 4, NITEM = 2 * NB * MLH * NVI;
    for (int it = F.bid * NTHREADS + F.tid; it < NITEM; it += F.G * NTHREADS) {
        const int grp = it / NVI, e = it % NVI, d = grp / (NB * MLH), b = (grp / MLH) % NB, h = grp % MLH;
        float st[8];
#pragma unroll
        for (int j = 0; j < 8; ++j) st[j] = 0.f;
        float mp = 0.f;
        u32x4 lc[NCS]; float mls[NCS], gs[NCS];
#pragma unroll
        for (int qi = 0; qi < NCS; ++qi) { const float* sl = mlst_slot(F, d, b, h, scan_slot(d, qi)); mls[qi] = sl[MLST_CT + DH]; gs[qi] = sl[MLST_CT + DH + 1];
            lc[qi] = e < NCI ? *((const u32x4*)sl + e) : __builtin_bit_cast(u32x4, *((const f32x4*)(sl + MLST_CT) + (e - NCI))); }
#pragma unroll
        for (int qi = 0; qi < NCS; ++qi) { float* sl = mlst_slot(F, d, b, h, scan_slot(d, qi));
            const float ml = mls[qi], g = gs[qi];
            const float mn = fmaxf(g + mp, ml), sp = expf(g + mp - mn), slc = expf(ml - mn);
            if (e < NCI) { u32x4* pp = (u32x4*)sl + e; float loc[8]; unpack8(lc[qi], loc);
                u32x4 w; w.x = pk2(st[0], st[1]); w.y = pk2(st[2], st[3]); w.z = pk2(st[4], st[5]); w.w = pk2(st[6], st[7]); *pp = w;
#pragma unroll
                for (int j = 0; j < 8; ++j) st[j] = st[j] * sp + loc[j] * slc; }
            else { f32x4* pp = (f32x4*)(sl + MLST_CT) + (e - NCI); const f32x4 loc = __builtin_bit_cast(f32x4, lc[qi]); *pp = (f32x4){st[0], st[1], st[2], st[3]};
                st[0] = st[0] * sp + loc[0] * slc; st[1] = st[1] * sp + loc[1] * slc; st[2] = st[2] * sp + loc[2] * slc; st[3] = st[3] * sp + loc[3] * slc;
                if (e == NCI) sl[MLST_CT + DH + 2] = mp; }
            mp = mn; }
    }
}

__device__ __forceinline__ void mlstm_out_unit(const Frame& F0, int b, int h, int cs) {
    Frame F = F0; LAUNDER(F.tid); F.lane = F.tid & 63;
    LAS bf16_t* Qs = (LAS bf16_t*)F.lds; LAS bf16_t* Ks = (LAS bf16_t*)(F.lds + TILE_B); LAS bf16_t* VT = (LAS bf16_t*)(F.lds + 2 * TILE_B); LAS bf16_t* Cs = (LAS bf16_t*)(F.lds + 3 * TILE_B);
    LAS bf16_t* Ss = Ks;
    LAS float* Hs = (LAS float*)F.lds;
    LAS float* ga = (LAS float*)(F.lds + 4 * TILE_B);
    LAS float* den2 = ga;
    LAS float* qn = ga + 2 * CH;
    LAS float* nin = ga + 3 * CH;
    static_assert(4 * TILE_B + 14 * CH * 4 <= LDS_MISC, "mLSTM out LDS");
    const int m0 = chunk_row0(b, cs);
    const bf16_t* P = F.wsp<bf16_t>(WS_P); const float* cw = F.in[I_MLCW]; const float* cb = F.in[I_MLCB];
    u32x4 cpre[4], opre[4]; float npre = 0.f;
    { const u32x4* s0 = (const u32x4*)mlst_slot(F, 0, b, h, cs);
#pragma unroll
        for (int i = 0; i < 4; ++i) cpre[i] = s0[F.tid + NTHREADS * i];
        if (F.tid < DH) npre = mlst_slot(F, 0, b, h, cs)[MLST_CT + F.tid];
        const bf16_t* op = P + (size_t)(m0 + (F.tid >> 2)) * AB_MAIN + 3 * HYD + 3 * MLD + h * DH + (F.tid & 3) * 32;
#pragma unroll
        for (int i = 0; i < 4; ++i) opre[i] = *(const u32x4*)(op + 8 * i); }
    __syncthreads();
    mlstm_gates(F, ga, m0, h);
    if (F.wave < 2) { const int d = F.wave; const LAS float* bc = ga + (4 + d) * CH; const LAS float* ig = ga + (1 + 2 * d) * CH;
        const int i0 = d ? CH - 1 - 2 * F.lane : 2 * F.lane, i1 = d ? i0 - 1 : i0 + 1; ga[(6 + d) * CH + i0] = ig[i0] - bc[i0]; ga[(6 + d) * CH + i1] = ig[i1] - bc[i1];
        wave_scan128<true>(ga + (6 + d) * CH, ga + (8 + d) * CH, d != 0, F.lane); }
    { const int fg = F.tid & 15, sr = F.tid >> 4, f0 = fg * 8; const float qs = 0.08838834764831845f;
        const float* wq = cw + h * DH + f0; const float* wk = cw + MLD + h * DH + f0;
        f32x4 wqa[3], wqb[3], wka[3], wkb[3];
#pragma unroll
        for (int tp = 0; tp < 3; ++tp) { wqa[tp] = *(const f32x4*)(wq + tp * 2 * MLD); wqb[tp] = *(const f32x4*)(wq + tp * 2 * MLD + 4); wka[tp] = *(const f32x4*)(wk + tp * 2 * MLD); wkb[tp] = *(const f32x4*)(wk + tp * 2 * MLD + 4); }
        const f32x4 bqa = *(const f32x4*)(cb + h * DH + f0), bqb = *(const f32x4*)(cb + h * DH + f0 + 4), bka = *(const f32x4*)(cb + MLD + h * DH + f0), bkb = *(const f32x4*)(cb + MLD + h * DH + f0 + 4);
#pragma unroll 2
        for (int ps = 0; ps < CH / 32; ++ps) { const int s = 32 * ps + sr; bool hl, hr; conv_nbr(cs, s, hl, hr);
            const bf16_t* qp = P + (size_t)(m0 + s) * AB_MAIN + 3 * HYD + h * DH + f0; const bf16_t* kp = qp + MLD;
            const u32x4 z4 = {0u, 0u, 0u, 0u};
            const u32x4 qc = *(const u32x4*)qp, kc = *(const u32x4*)kp;
            u32x4 ql = z4, qr = z4, kl = z4, kr_ = z4;
            if (hl) { ql = *(const u32x4*)(qp - AB_MAIN); kl = *(const u32x4*)(kp - AB_MAIN); }
            if (hr) { qr = *(const u32x4*)(qp + AB_MAIN); kr_ = *(const u32x4*)(kp + AB_MAIN); }
            float xl[8], xc[8], xr[8], qv[8], kv[8];
            unpack8(ql, xl); unpack8(qc, xc); unpack8(qr, xr);
#pragma unroll
            for (int j = 0; j < 4; ++j) { qv[j] = bqa[j] + wqa[0][j] * xl[j] + wqa[1][j] * xc[j] + wqa[2][j] * xr[j]; qv[4 + j] = bqb[j] + wqb[0][j] * xl[4 + j] + wqb[1][j] * xc[4 + j] + wqb[2][j] * xr[4 + j]; }
            unpack8(kl, xl); unpack8(kc, xc); unpack8(kr_, xr);
#pragma unroll
            for (int j = 0; j < 4; ++j) { kv[j] = bka[j] + wka[0][j] * xl[j] + wka[1][j] * xc[j] + wka[2][j] * xr[j]; kv[4 + j] = bkb[j] + wkb[0][j] * xl[4 + j] + wkb[1][j] * xc[4 + j] + wkb[2][j] * xr[4 + j]; }
            u32x4 qw, kw; qw.x = pk2(siluf(qv[0]) * qs, siluf(qv[1]) * qs); qw.y = pk2(siluf(qv[2]) * qs, siluf(qv[3]) * qs); qw.z = pk2(siluf(qv[4]) * qs, siluf(qv[5]) * qs); qw.w = pk2(siluf(qv[6]) * qs, siluf(qv[7]) * qs);
            kw.x = pk2(siluf(kv[0]), siluf(kv[1])); kw.y = pk2(siluf(kv[2]), siluf(kv[3])); kw.z = pk2(siluf(kv[4]), siluf(kv[5])); kw.w = pk2(siluf(kv[6]), siluf(kv[7]));
            *(LAS u32x4*)(Qs + s * TP + f0) = qw; *(LAS u32x4*)(Ks + s * TP + f0) = kw; } }
    { const int s = F.tid & 127, fgq = F.tid >> 7;
#pragma unroll
        for (int i = 0; i < 4; ++i) { const int f0 = (fgq + 4 * i) * 8;
            float vv[8]; unpack8(*(const u32x4*)(P + (size_t)(m0 + s) * AB_MAIN + 3 * HYD + 2 * MLD + h * DH + f0), vv);
#pragma unroll
            for (int j = 0; j < 8; ++j) VT[(f0 + j) * TP + s] = (bf16_t)f2bf(vv[j]); } }
    __syncthreads();
    if (F.tid < 2 * CH) { const int d = F.tid >> 7, i = F.tid & 127; const float m_in = mlst_slot(F, d, b, h, cs)[MLST_CT + DH + 2]; const float M = fmaxf(ga[(8 + d) * CH + i], m_in);
        const float bci = ga[(4 + d) * CH + i]; ga[(8 + d) * CH + i] = M; ga[(10 + d) * CH + i] = expf(m_in - M); ga[(12 + d) * CH + i] = expf(-(bci + M)); }
    const int wm = F.wave >> 1, wn = F.wave & 1, r = F.lane & 15, q = F.lane >> 4;
    f32x4 sraw[2][4]; zero_acc(sraw);
    wave_mma<2, 4, 4>(sraw, Qs, 32 * wm, Ks, 64 * wn, F.lane);
    f32x4 hsum[2][4]; zero_acc(hsum);
    __syncthreads();
#pragma unroll 1
    for (int d = 0; d < 2; ++d) {
#pragma unroll
        for (int i = 0; i < 4; ++i) { const int it = F.tid + NTHREADS * i, vv = (8 * it) / DH, kk = (8 * it) % DH; *(LAS u32x4*)(Cs + vv * TP + kk) = cpre[i]; }
        if (F.tid < DH) nin[F.tid] = npre;
        if (d == 0) { const u32x4* s1 = (const u32x4*)mlst_slot(F, 1, b, h, cs);
#pragma unroll
            for (int i = 0; i < 4; ++i) cpre[i] = s1[F.tid + NTHREADS * i];
            if (F.tid < DH) npre = mlst_slot(F, 1, b, h, cs)[MLST_CT + F.tid]; }
        const LAS float* ea = ga + (6 + d) * CH; const LAS float* Ma = ga + (8 + d) * CH;
#pragma unroll
        for (int mt = 0; mt < 2; ++mt)
#pragma unroll
            for (int j = 0; j < 4; ++j) { const int t = 32 * wm + 16 * mt + 4 * q + j; const float Mt = Ma[t]; float rs = 0.f;
#pragma unroll
                for (int nt = 0; nt < 4; ++nt) { const int s = 64 * wn + 16 * nt + r; const bool ok = d ? (s >= t) : (s <= t);
                    const float v = ok ? sraw[mt][nt][j] * FEXP(ea[s] - Mt) : 0.f; rs += v; Ss[t * TP + s] = (bf16_t)f2bf(v); }
                rs += __shfl_xor(rs, 1); rs += __shfl_xor(rs, 2); rs += __shfl_xor(rs, 4); rs += __shfl_xor(rs, 8);
                if (r == 0) den2[wn * CH + t] = rs; }
        __syncthreads();
        if (F.tid < CH) { const LAS bf16_t* row = Qs + F.tid * TP; float s = 0.f;
            for (int i = 0; i < DH; i += 8) { float f[8]; unpack8(*(const LAS u32x4*)(row + i), f);
#pragma unroll
                for (int j = 0; j < 8; ++j) s += f[j] * nin[i + j]; }
            qn[F.tid] = s; }
        f32x4 asv[2][4], aqc[2][4]; zero_acc(asv); zero_acc(aqc);
        wave_mma<2, 4, 4>(asv, Ss, 32 * wm, VT, 64 * wn, F.lane);
        wave_mma<2, 4, 4>(aqc, Qs, 32 * wm, Cs, 64 * wn, F.lane);
        __syncthreads();
        const LAS float* wi = ga + (10 + d) * CH; const LAS float* emt = ga + (12 + d) * CH;
#pragma unroll
        for (int mt = 0; mt < 2; ++mt)
#pragma unroll
            for (int j = 0; j < 4; ++j) { const int t = 32 * wm + 16 * mt + 4 * q + j; const float w = wi[t];
                const float den = den2[t] + den2[CH + t] + w * qn[t]; const float inv = 1.0f / fmaxf(fabsf(den), emt[t]);
#pragma unroll
                for (int nt = 0; nt < 4; ++nt) hsum[mt][nt][j] += (asv[mt][nt][j] + w * aqc[mt][nt][j]) * inv; }
        __syncthreads();
    }
#pragma unroll
    for (int mt = 0; mt < 2; ++mt)
#pragma unroll
        for (int nt = 0; nt < 4; ++nt)
#pragma unroll
            for (int j = 0; j < 4; ++j) Hs[(32 * wm + 16 * mt + 4 * q + j) * 132 + 64 * wn + 16 * nt + r] = hsum[mt][nt][j];
    __syncthreads();
    { const int t = F.tid >> 2, part = F.tid & 3; const LAS float* hr_ = Hs + t * 132 + part * 32; float v[32]; float s = 0.f;
#pragma unroll
        for (int i = 0; i < 32; ++i) { v[i] = hr_[i]; s += v[i]; }
        s += __shfl_xor(s, 1); s += __shfl_xor(s, 2); const float mu = s * (1.0f / DH); float qv = 0.f;
#pragma unroll
        for (int i = 0; i < 32; ++i) { v[i] -= mu; qv += v[i] * v[i]; }
        qv += __shfl_xor(qv, 1); qv += __shfl_xor(qv, 2); const float inv = 1.0f / sqrtf(qv * (1.0f / DH) + EPS);
        const float* nw = F.in[I_MLNW] + h * DH + part * 32;
        f32x4 nwv[8];
#pragma unroll
        for (int i = 0; i < 8; ++i) nwv[i] = *(const f32x4*)(nw + 4 * i);
        bf16_t* yp = F.wsp<bf16_t>(WS_YCAT) + (size_t)(m0 + t) * YC1 + HYD + h * DH + part * 32;
#pragma unroll
        for (int i = 0; i < 32; i += 8) { float o[8]; unpack8(opre[i >> 3], o); float y[8];
#pragma unroll
            for (int j = 0; j < 8; ++j) y[j] = v[i + j] * inv * nwv[(i + j) >> 2][(i + j) & 3] * sigmoidf_(o[j]);
            u32x4 w; w.x = pk2(y[0], y[1]); w.y = pk2(y[2], y[3]); w.z = pk2(y[4], y[5]); w.w = pk2(y[6], y[7]); *(u32x4*)(yp + i) = w; } }
    __syncthreads();
}

__device__ __forceinline__ float* ssd_slot(const Frame& F, int d, int b, int hd, int cs) { return F.wsp<float>(WS_SSDST) + ((((size_t)d * NB + b) * SSDH + hd) * NCS + cs) * SSDST_STRIDE; }
constexpr int XB_B = SSDD + SSDD, XB_C = SSDD + SSDD + SSDG * SSDN;

__device__ __forceinline__ void ssd_act_pass(const Frame& F) {
    const bf16_t* P = F.wsp<bf16_t>(WS_P); bf16_t* XA = F.wsp<bf16_t>(WS_XACT); const float* cw = F.in[I_SSDCW]; const float* cb = F.in[I_SSDCB];
    constexpr int NFG = XBC / 8;
    const int stride = F.G * NTHREADS;
    for (int idx = F.bid * NTHREADS + F.tid; idx < MT * NFG; idx += 2 * stride) {
        const int idx1 = idx + stride; const bool ok1 = idx1 < MT * NFG; const int i1 = ok1 ? idx1 : idx;
        const int m0 = idx / NFG, c0 = (idx % NFG) * 8, m1 = i1 / NFG, c1 = (i1 % NFG) * 8; bool hl0, hr0, hl1, hr1;
        if (m0 < ML) { hl0 = (m0 & (GW - 1)) != 0; hr0 = (m0 & (GW - 1)) != GW - 1; } else { const int pos = (m0 - ML) % CTX; hl0 = pos > 0; hr0 = pos < CTX - 1; }
        if (m1 < ML) { hl1 = (m1 & (GW - 1)) != 0; hr1 = (m1 & (GW - 1)) != GW - 1; } else { const int pos = (m1 - ML) % CTX; hl1 = pos > 0; hr1 = pos < CTX - 1; }
        float v[8], y[8]; conv3x8(P + (size_t)m0 * CD_MAIN + SSDD + c0, CD_MAIN, hl0, hr0, cw + c0, XBC, cb + c0, v); conv3x8(P + (size_t)m1 * CD_MAIN + SSDD + c1, CD_MAIN, hl1, hr1, cw + c1, XBC, cb + c1, y);
        u32x4 w; w.x = pk2(siluf(v[0]), siluf(v[1])); w.y = pk2(siluf(v[2]), siluf(v[3])); w.z = pk2(siluf(v[4]), siluf(v[5])); w.w = pk2(siluf(v[6]), siluf(v[7]));
        u32x4 z; z.x = pk2(siluf(y[0]), siluf(y[1])); z.y = pk2(siluf(y[2]), siluf(y[3])); z.z = pk2(siluf(y[4]), siluf(y[5])); z.w = pk2(siluf(y[6]), siluf(y[7]));
        *(u32x4*)(XA + (size_t)m0 * XBC + c0) = w;
        if (ok1) *(u32x4*)(XA + (size_t)m1 * XBC + c1) = z; }
}
__device__ __forceinline__ void ssd_local_unit(const Frame& F0, int b, int cs, int g, int d, int hh) {
    Frame F = F0; LAUNDER(F.tid); F.lane = F.tid & 63;
    LAS bf16_t* BT = (LAS bf16_t*)F.lds; LAS bf16_t* XwT = (LAS bf16_t*)(F.lds + TILE_B);
    LAS float* ar = (LAS float*)(F.lds + 3 * TILE_B);
    const int m0 = chunk_row0(b, cs); const bf16_t* P = F.wsp<bf16_t>(WS_P); const float* sd = F.wsp<float>(WS_SIDE);
    const float* cw = F.in[I_SSDCW]; const float* cb = F.in[I_SSDCB];
    __syncthreads();
    { const int s = F.tid & 127, j = F.tid >> 7, hd = g * HPG + hh * 4 + j;
        const float dtv = softplusf_(sd[(size_t)(m0 + s) * 32 + d * SSDH + hd] + F.in[I_SSDDTB][d * SSDH + hd]);
        ar[j * CH + s] = dtv; ar[(4 + j) * CH + s] = -dtv * expf(F.in[I_SSDALOG][d * SSDH + hd]); }
    __syncthreads();
    if (F.wave < 4) { const int j = F.wave; LAS float* la = ar + (4 + j) * CH; wave_scan128<false>(la, la, d != 0, F.lane);
        if (F.lane == 0) ssd_slot(F, d, b, g * HPG + hh * 4 + j, cs)[SSD_HF] = expf(d ? la[0] : la[CH - 1]); }
    __syncthreads();
    { const int i = F.tid & 127, j = F.tid >> 7; const LAS float* la = ar + (4 + j) * CH; const float aend = d ? la[0] : la[CH - 1]; ar[(8 + j) * CH + i] = expf(aend - la[i]) * ar[j * CH + i]; }
    __syncthreads();
    { const int s = F.tid & 127, fgq = F.tid >> 7; const bf16_t* xrow = F.wsp<bf16_t>(WS_XACT) + (size_t)(m0 + s) * XBC;
#pragma unroll
        for (int i = 0; i < 4; ++i) { const int f0 = (fgq + 4 * i) * 8; const u32x4 w = *(const u32x4*)(xrow + SSDD + g * SSDN + f0);
            BT[(f0 + 0) * TP + s] = (bf16_t)(w.x & 0xffffu); BT[(f0 + 1) * TP + s] = (bf16_t)(w.x >> 16); BT[(f0 + 2) * TP + s] = (bf16_t)(w.y & 0xffffu); BT[(f0 + 3) * TP + s] = (bf16_t)(w.y >> 16);
            BT[(f0 + 4) * TP + s] = (bf16_t)(w.z & 0xffffu); BT[(f0 + 5) * TP + s] = (bf16_t)(w.z >> 16); BT[(f0 + 6) * TP + s] = (bf16_t)(w.w & 0xffffu); BT[(f0 + 7) * TP + s] = (bf16_t)(w.w >> 16); }
#pragma unroll
        for (int i = 0; i < 8; ++i) { const int fg = fgq + 4 * i, j = fg >> 3, p0 = (fg & 7) * 8; float v[8]; unpack8(*(const u32x4*)(xrow + (g * HPG + hh * 4 + j) * SSDP + p0), v); const float we = ar[(8 + j) * CH + s];
#pragma unroll
            for (int jj = 0; jj < 8; ++jj) XwT[(j * 64 + p0 + jj) * TP + s] = (bf16_t)f2bf(v[jj] * we); } }
    __syncthreads();
    f32x4 acc[8][2]; zero_acc(acc);
    wave_mma<8, 2, 4>(acc, BT, 0, XwT, 32 * F.wave, F.lane);
    const int r = F.lane & 15, q = F.lane >> 4;
#pragma unroll
    for (int nt = 0; nt < 2; ++nt) { const int jp = 32 * F.wave + 16 * nt + r, j = jp >> 6, p = jp & 63; bf16_t* sl = (bf16_t*)ssd_slot(F, d, b, g * HPG + hh * 4 + j, cs) + p * SSDN;
#pragma unroll
        for (int mt = 0; mt < 8; ++mt) { u32x2 w; w.x = pk2(acc[mt][nt][0], acc[mt][nt][1]); w.y = pk2(acc[mt][nt][2], acc[mt][nt][3]); *(u32x2*)(sl + 16 * mt + 4 * q) = w; } }
    __syncthreads();
}

__device__ __forceinline__ void ssd_carry(const Frame& F) {
    constexpr int NVI = SSDP * SSDN / 8, NITEM = 2 * NB * SSDH * NVI;
    for (int it = F.bid * NTHREADS + F.tid; it < NITEM; it += F.G * NTHREADS) {
        const int grp = it / NVI, e = it % NVI, d = grp / (NB * SSDH), b = (grp / SSDH) % NB, hd = grp % SSDH;
        float st[8];
#pragma unroll
        for (int j = 0; j < 8; ++j) st[j] = 0.f;
        u32x4 lc[NCS]; float decs[NCS];
#pragma unroll
        for (int qi = 0; qi < NCS; ++qi) { const float* sl = ssd_slot(F, d, b, hd, scan_slot(d, qi)); lc[qi] = *((const u32x4*)sl + e); decs[qi] = sl[SSD_HF]; }
#pragma unroll
        for (int qi = 0; qi < NCS; ++qi) { float* sl = ssd_slot(F, d, b, hd, scan_slot(d, qi)); u32x4* pp = (u32x4*)sl + e; float loc[8]; unpack8(lc[qi], loc); const float dec = decs[qi];
            u32x4 w; w.x = pk2(st[0], st[1]); w.y = pk2(st[2], st[3]); w.z = pk2(st[4], st[5]); w.w = pk2(st[6], st[7]); *pp = w;
#pragma unroll
            for (int j = 0; j < 8; ++j) st[j] = st[j] * dec + loc[j]; }
    }
}

__device__ __forceinline__ void ssd_out_unit(const Frame& F0, int b, int lc, int g, int hh) {
    Frame F = F0; LAUNDER(F.tid); F.lane = F.tid & 63;
    LAS bf16_t* Cs = (LAS bf16_t*)F.lds; LAS bf16_t* Bs = (LAS bf16_t*)(F.lds + TILE_B); LAS bf16_t* Ls = Bs;
    LAS bf16_t* XT = (LAS bf16_t*)(F.lds + 2 * TILE_B); LAS bf16_t* Hs = (LAS bf16_t*)(F.lds + 2 * TILE_B + 64 * TP * 2);
    LAS float* ar = (LAS float*)(F.lds + 3 * TILE_B);
    const int cs = NCC + lc, m0 = b * SEQ + lc * CH; const bf16_t* P = F.wsp<bf16_t>(WS_P); const float* sd = F.wsp<float>(WS_SIDE);
    const float* cw = F.in[I_SSDCW]; const float* cb = F.in[I_SSDCB];
    __syncthreads();
    { const int s = F.tid & 127, j = F.tid >> 7, hd = g * HPG + hh * 4 + j;
#pragma unroll
        for (int d = 0; d < 2; ++d) { const float dtv = softplusf_(sd[(size_t)(m0 + s) * 32 + d * SSDH + hd] + F.in[I_SSDDTB][d * SSDH + hd]);
            ar[(d * 4 + j) * CH + s] = dtv; ar[(8 + d * 4 + j) * CH + s] = -dtv * expf(F.in[I_SSDALOG][d * SSDH + hd]); } }
    __syncthreads();
    { const int k = F.wave, d = k >> 2; LAS float* la = ar + (8 + k) * CH; wave_scan128<false>(la, la, d != 0, F.lane); }
    { const int s = F.tid & 127, fgq = F.tid >> 7; const bf16_t* xrow = F.wsp<bf16_t>(WS_XACT) + (size_t)(m0 + s) * XBC;
#pragma unroll
        for (int i = 0; i < 4; ++i) { const int f0 = (fgq + 4 * i) * 8;
            *(LAS u32x4*)(Bs + s * TP + f0) = *(const u32x4*)(xrow + SSDD + g * SSDN + f0);
            *(LAS u32x4*)(Cs + s * TP + f0) = *(const u32x4*)(xrow + SSDD + SSDG * SSDN + g * SSDN + f0); } }
    __syncthreads();
    const int wm = F.wave >> 1, wn = F.wave & 1, r = F.lane & 15, q = F.lane >> 4;
    f32x4 cbm[2][4]; zero_acc(cbm);
    wave_mma<2, 4, 4>(cbm, Cs, 32 * wm, Bs, 64 * wn, F.lane);
    float ssq[2][4];
#pragma unroll
    for (int mt = 0; mt < 2; ++mt)
#pragma unroll
        for (int jj = 0; jj < 4; ++jj) ssq[mt][jj] = 0.f;
    LAS bf16_t* Hs2 = (LAS bf16_t*)(F.lds + 3 * TILE_B + 18 * CH * 4);
    static_assert(3 * TILE_B + 18 * CH * 4 + 64 * TP * 2 <= LDS_MISC, "ssd out LDS");
    u32x4 hpre[4], xpre[2];
    const int xs_ = F.tid & 127, xfq = F.tid >> 7; const bf16_t* xrow = F.wsp<bf16_t>(WS_XACT) + (size_t)(m0 + xs_) * XBC;
#define SSD_LOADH(jn) do { const u32x4* sf_ = (const u32x4*)ssd_slot(F, 0, b, g * HPG + hh * 4 + (jn), cs); const u32x4* sb_ = (const u32x4*)ssd_slot(F, 1, b, g * HPG + hh * 4 + (jn), cs); \
        hpre[0] = sf_[F.tid]; hpre[1] = sf_[F.tid + NTHREADS]; hpre[2] = sb_[F.tid]; hpre[3] = sb_[F.tid + NTHREADS]; } while (0)
#define SSD_LOADX(jn) do { xpre[0] = *(const u32x4*)(xrow + (g * HPG + hh * 4 + (jn)) * SSDP + xfq * 8); xpre[1] = *(const u32x4*)(xrow + (g * HPG + hh * 4 + (jn)) * SSDP + (xfq + 4) * 8); } while (0)
    SSD_LOADH(0); SSD_LOADX(0);
#pragma unroll 1
    for (int j = 0; j < 4; ++j) {
        const int hd = g * HPG + hh * 4 + j;
        __syncthreads();
#pragma unroll
        for (int i = 0; i < 2; ++i) { const int f0 = (xfq + 4 * i) * 8; const u32x4 w = xpre[i];
            XT[(f0 + 0) * TP + xs_] = (bf16_t)(w.x & 0xffffu); XT[(f0 + 1) * TP + xs_] = (bf16_t)(w.x >> 16); XT[(f0 + 2) * TP + xs_] = (bf16_t)(w.y & 0xffffu); XT[(f0 + 3) * TP + xs_] = (bf16_t)(w.y >> 16);
            XT[(f0 + 4) * TP + xs_] = (bf16_t)(w.z & 0xffffu); XT[(f0 + 5) * TP + xs_] = (bf16_t)(w.z >> 16); XT[(f0 + 6) * TP + xs_] = (bf16_t)(w.w & 0xffffu); XT[(f0 + 7) * TP + xs_] = (bf16_t)(w.w >> 16); }
#pragma unroll
        for (int i = 0; i < 2; ++i) { const int it = F.tid + NTHREADS * i, p = (8 * it) / SSDN, n = (8 * it) % SSDN; *(LAS u32x4*)(Hs + p * TP + n) = hpre[i]; *(LAS u32x4*)(Hs2 + p * TP + n) = hpre[2 + i]; }
        if (j < 3) { SSD_LOADX(j + 1); SSD_LOADH(j + 1); }
        bf16_t zpre[2][4][2];
#pragma unroll
        for (int mt = 0; mt < 2; ++mt)
#pragma unroll
            for (int jj = 0; jj < 4; ++jj)
#pragma unroll
                for (int nt = 0; nt < 2; ++nt) zpre[mt][jj][nt] = P[(size_t)(m0 + 32 * wm + 16 * mt + 4 * q + jj) * CD_MAIN + hd * SSDP + 32 * wn + 16 * nt + r];
        const LAS float* dtf = ar + j * CH; const LAS float* dtb = ar + (4 + j) * CH; const LAS float* acf = ar + (8 + j) * CH; const LAS float* acb = ar + (12 + j) * CH;
#pragma unroll
        for (int mt = 0; mt < 2; ++mt)
#pragma unroll
            for (int jj = 0; jj < 4; ++jj) { const int t = 32 * wm + 16 * mt + 4 * q + jj; const float atf = acf[t], atb = acb[t];
#pragma unroll
                for (int nt = 0; nt < 4; ++nt) { const int s_ = 64 * wn + 16 * nt + r;
                    const float vf = s_ <= t ? FEXP(atf - acf[s_]) * dtf[s_] : 0.f, vb = s_ >= t ? FEXP(atb - acb[s_]) * dtb[s_] : 0.f;
                    Ls[t * TP + s_] = (bf16_t)f2bf(cbm[mt][nt][jj] * (vf + vb)); } }
        __syncthreads();
        f32x4 ysum[2][2], yof[2][2], yob[2][2]; zero_acc(ysum); zero_acc(yof); zero_acc(yob);
        wave_mma<2, 2, 4>(ysum, Ls, 32 * wm, XT, 32 * wn, F.lane);
        wave_mma<2, 2, 4>(yof, Cs, 32 * wm, Hs, 32 * wn, F.lane);
        wave_mma<2, 2, 4>(yob, Cs, 32 * wm, Hs2, 32 * wn, F.lane);
#pragma unroll
        for (int mt = 0; mt < 2; ++mt)
#pragma unroll
            for (int jj = 0; jj < 4; ++jj) { const int t = 32 * wm + 16 * mt + 4 * q + jj; const float eaf = FEXP(acf[t]), eab = FEXP(acb[t]);
#pragma unroll
                for (int nt = 0; nt < 2; ++nt) ysum[mt][nt][jj] += eaf * yof[mt][nt][jj] + eab * yob[mt][nt][jj]; }
        const float dsk = F.in[I_SSDD][hd];
#pragma unroll
        for (int mt = 0; mt < 2; ++mt)
#pragma unroll
            for (int jj = 0; jj < 4; ++jj) { const int t = 32 * wm + 16 * mt + 4 * q + jj;
#pragma unroll
                for (int nt = 0; nt < 2; ++nt) { const int p = 32 * wn + 16 * nt + r; const float xs = bf2f(XT[p * TP + t]);
                    const float z = bf2f(zpre[mt][jj][nt]); const float y = (ysum[mt][nt][jj] + dsk * xs) * siluf(z);
                    F.wsp<float>(WS_YPRE)[(size_t)(m0 + t) * SSDD + hd * SSDP + p] = y; ssq[mt][jj] += y * y; } }
    }
#undef SSD_LOADH
#undef SSD_LOADX
    LAS float* ssq2 = ar + 16 * CH;
#pragma unroll
    for (int mt = 0; mt < 2; ++mt)
#pragma unroll
        for (int jj = 0; jj < 4; ++jj) { float s = ssq[mt][jj]; s += __shfl_xor(s, 1); s += __shfl_xor(s, 2); s += __shfl_xor(s, 4); s += __shfl_xor(s, 8);
            if (r == 0) ssq2[wn * CH + 32 * wm + 16 * mt + 4 * q + jj] = s; }
    __syncthreads();
    if (F.tid < CH) F.wsp<float>(WS_SSQ)[(size_t)(m0 + F.tid) * 4 + g * 2 + hh] = ssq2[F.tid] + ssq2[CH + F.tid];
    __syncthreads();
}

__device__ __forceinline__ void ssd_norm_rows(const Frame& F, int wg_lo, int wg_cnt) {
    const float* yp = F.wsp<float>(WS_YPRE); const float* sq = F.wsp<float>(WS_SSQ); const float* nw = F.in[I_SSDNW]; bf16_t* Y = F.wsp<bf16_t>(WS_YCAT);
    if (F.bid < wg_lo || F.bid >= wg_lo + wg_cnt) return;
    constexpr int NI = SSDD / 256; static_assert(SSDD % 256 == 0, "ssd norm row pieces");
    f32x4 w4[NI];
#pragma unroll
    for (int i = 0; i < NI; ++i) w4[i] = *(const f32x4*)(nw + 4 * F.lane + 256 * i);
    for (int m = (F.bid - wg_lo) * NWAVES + F.wave; m < ML; m += wg_cnt * NWAVES) { const f32x4 s4 = *(const f32x4*)(sq + (size_t)m * 4); f32x4 y[NI];
#pragma unroll
        for (int i = 0; i < NI; ++i) y[i] = *(const f32x4*)(yp + (size_t)m * SSDD + 4 * F.lane + 256 * i);
        const float rinv = 1.0f / sqrtf((s4[0] + s4[1] + s4[2] + s4[3]) * (1.0f / SSDD) + EPS);
#pragma unroll
        for (int i = 0; i < NI; ++i) { u32x2 w; w.x = pk2(y[i][0] * rinv * w4[i][0], y[i][1] * rinv * w4[i][1]); w.y = pk2(y[i][2] * rinv * w4[i][2], y[i][3] * rinv * w4[i][3]);
            *(u32x2*)(Y + (size_t)m * YC2 + 4 * F.lane + 256 * i) = w; } }
}

__device__ __forceinline__ float* s5_slot(const Frame& F, int d, int b, int cs, int g) { return F.wsp<float>(WS_S5ST) + ((((size_t)d * NB + b) * NCS + cs) * S5G + g) * (S5P * 2); }
__device__ __forceinline__ void s5_load_u(const Frame& F, LAS float* ub, int m0, int g) {
    const bf16_t* P = F.wsp<bf16_t>(WS_P);
#pragma unroll
    for (int k = 0; k < 2; ++k) { const int s = F.lane + 64 * k; const bf16_t* up = P + (size_t)(m0 + s) * CD_MAIN + SSDD + XBC + g * S5GS; float f[8];
        unpack8(*(const u32x4*)up, f);
#pragma unroll
        for (int j = 0; j < 8; ++j) ub[s * 16 + j] = f[j];
        unpack8(*(const u32x4*)(up + 8), f);
#pragma unroll
        for (int j = 0; j < 8; ++j) ub[s * 16 + 8 + j] = f[j]; }
    WAVE_SYNC();
}
#define S5_STEP(s) do { const f32x4 u0 = *(const LAS f32x4*)(ub + (s) * 16), u1 = *(const LAS f32x4*)(ub + (s) * 16 + 4), u2 = *(const LAS f32x4*)(ub + (s) * 16 + 8), u3 = *(const LAS f32x4*)(ub + (s) * 16 + 12); \
    f32x2 b0 = {0.f, 0.f}, b1 = {0.f, 0.f}, b2 = {0.f, 0.f}, b3 = {0.f, 0.f}; _Pragma("unroll") for (int k = 0; k < 4; ++k) { b0 += bb2[k] * (f32x2){u0[k], u0[k]}; b1 += bb2[4 + k] * (f32x2){u1[k], u1[k]}; b2 += bb2[8 + k] * (f32x2){u2[k], u2[k]}; b3 += bb2[12 + k] * (f32x2){u3[k], u3[k]}; } \
    const f32x2 bs = (b0 + b1) + (b2 + b3); \
    const float nr = lbr * xr - lbi * xi + bs[0], ni = lbr * xi + lbi * xr + bs[1]; xr = nr; xi = ni; } while (0)
#define S5_LOAD_PAR(d, g) const float* par = F.wsp<float>(WS_S5PAR) + ((size_t)((d) * S5G + (g)) * S5P + F.lane) * 36; const float lbr = par[0], lbi = par[1]; f32x2 bb2[16]; \
    _Pragma("unroll") for (int k = 0; k < 16; ++k) { bb2[k][0] = par[2 + k]; bb2[k][1] = par[18 + k]; }

__device__ __forceinline__ void s5_local_units(const Frame& F) {
    LAS float* ub = (LAS float*)(F.lds + F.wave * 8192);
    constexpr int NU = 2 * NB * NCS * S5G;
    for (int u = F.gw(); u < NU; u += F.ngw()) { const int g = u % S5G, cs = (u / S5G) % NCS, b = (u / (S5G * NCS)) % NB, d = u / (S5G * NCS * NB);
        WAVE_SYNC();
        s5_load_u(F, ub, chunk_row0(b, cs), g);
        S5_LOAD_PAR(d, g)
        float xr = 0.f, xi = 0.f;
        _Pragma("unroll 4") for (int ii = 0; ii < CH; ++ii) { const int s = d ? CH - 1 - ii : ii; S5_STEP(s); }
        float* sl = s5_slot(F, d, b, cs, g); sl[F.lane * 2] = xr; sl[F.lane * 2 + 1] = xi; }
}
__device__ __forceinline__ void s5_carry(const Frame& F) {
    for (int it = F.bid * NTHREADS + F.tid; it < 2 * NB * S5G * S5P; it += F.G * NTHREADS) { const int p = it % S5P, g = (it / S5P) % S5G, b = (it / (S5P * S5G)) % NB, d = it / (S5P * S5G * NB);
        const float* par = F.wsp<float>(WS_S5PAR) + ((size_t)(d * S5G + g) * S5P + p) * 36; const float pr = par[34], pi = par[35]; float xr = 0.f, xi = 0.f;
        float lrs[NCS], lis[NCS];
#pragma unroll
        for (int qi = 0; qi < NCS; ++qi) { const float* sl = s5_slot(F, d, b, scan_slot(d, qi), g) + p * 2; lrs[qi] = sl[0]; lis[qi] = sl[1]; }
#pragma unroll
        for (int qi = 0; qi < NCS; ++qi) { float* sl = s5_slot(F, d, b, scan_slot(d, qi), g) + p * 2; const float lr = lrs[qi], li = lis[qi]; sl[0] = xr; sl[1] = xi;
            const float nr = pr * xr - pi * xi + lr, ni = pr * xi + pi * xr + li; xr = nr; xi = ni; } }
}
__device__ __forceinline__ void s5_out_units(const Frame& F) {
    LAS float* ub = (LAS float*)(F.lds + F.wave * 16896); LAS bf16_t* xb = (LAS bf16_t*)(F.lds + F.wave * 16896 + 8192);
    const int r = F.lane & 15, q = F.lane >> 4;
    constexpr int NU = NB * NCL * S5G;
    for (int u = F.gw(); u < NU; u += F.ngw()) { const int g = u % S5G, lc = (u / S5G) % NCL, b = u / (S5G * NCL); const int cs = NCC + lc, m0 = b * SEQ + lc * CH;
        WAVE_SYNC();
        s5_load_u(F, ub, m0, g);
        bf16x8 cf[4];
#pragma unroll
        for (int ks = 0; ks < 4; ++ks) { const int k0 = 32 * ks + 8 * q; const bool im = k0 >= 64; const float* cp = (im ? F.in[I_S5CIM] : F.in[I_S5CRE]) + ((size_t)g * S5GS + r) * S5P + (k0 & 63);
#pragma unroll
            for (int j = 0; j < 8; ++j) cf[ks][j] = (short)f2bf(im ? -cp[j] : cp[j]); }
        f32x4 acc[8];
#pragma unroll
        for (int i = 0; i < 8; ++i) acc[i] = (f32x4){0.f, 0.f, 0.f, 0.f};
#pragma unroll
        for (int d = 0; d < 2; ++d) {
            S5_LOAD_PAR(d, g)
            const float* sl = s5_slot(F, d, b, cs, g); float xr = sl[F.lane * 2], xi = sl[F.lane * 2 + 1];
#pragma unroll
            for (int sbi = 0; sbi < 4; ++sbi) { const int sb = d ? 3 - sbi : sbi;
                for (int ii = 0; ii < 32; ++ii) { const int sl_ = d ? 31 - ii : ii; const int s = 32 * sb + sl_; S5_STEP(s);
                    xb[sl_ * TP + F.lane] = (bf16_t)f2bf(xr); xb[sl_ * TP + 64 + F.lane] = (bf16_t)f2bf(xi); }
                WAVE_SYNC();
#pragma unroll
                for (int mt = 0; mt < 2; ++mt)
#pragma unroll
                    for (int ks = 0; ks < 4; ++ks) { const bf16x8 a = *(const LAS bf16x8*)(xb + (16 * mt + r) * TP + 32 * ks + 8 * q); acc[2 * sb + mt] = MFMA16(a, cf[ks], acc[2 * sb + mt]); }
                WAVE_SYNC(); }
        }
        const float dsk = F.in[I_S5D][g * S5GS + r]; bf16_t* out = F.wsp<bf16_t>(WS_S5G);
#pragma unroll
        for (int mtile = 0; mtile < 8; ++mtile)
#pragma unroll
            for (int j = 0; j < 4; ++j) { const int t = 16 * mtile + 4 * q + j; const float v = acc[mtile][j] + dsk * ub[t * 16 + r];
                out[(size_t)(m0 + t) * S5W + g * S5GS + r] = (bf16_t)f2bf(0.5f * v * (1.0f + erff(v * 0.70710678118654752f))); }
    }
}

__device__ __forceinline__ int moe_off(const Frame& F, int e) {
    const unsigned* cnt = F.wsp<unsigned>(WS_CTL) + CW_CNT; int o = 0;
#pragma unroll
    for (int k = 0; k < NE; ++k) o += (k < e) ? (int)((cnt[64 * k] + 255u) & ~255u) : 0;
    return o;
}
__device__ __forceinline__ void phase_moe_scatter(const Frame& F) {
    const unsigned char* A = F.wsp<unsigned char>(WS_A); unsigned char* As = F.wsp<unsigned char>(WS_AS); const int* rt = F.wsp<int>(WS_ROUTE); const float* rp = F.wsp<float>(WS_RPROB);
    int* rowmap = F.wsp<int>(WS_ROWMAP); float* rowp = F.wsp<float>(WS_ROWP);
    constexpr int SBN = 4, SNJ = (D + 1023) / 1024; static_assert(SNJ <= 2 && D % 16 == 0, "scatter row chunks");
    for (int it = F.gw(); it < 2 * ML; it += SBN * F.ngw()) {
        int mm[SBN], ee[SBN], pp[SBN]; u32x4 va[SBN][2];
#pragma unroll
        for (int k = 0; k < SBN; ++k) { const int itk = it + k * F.ngw(); const bool ok = itk < 2 * ML; const int m = ok ? itk >> 1 : 0, slot = itk & 1; mm[k] = ok ? m * 2 + slot : -1;
            ee[k] = rt[m * 4 + slot]; pp[k] = rt[m * 4 + 2 + slot];
#pragma unroll
            for (int j = 0; j < SNJ; ++j) if (16 * F.lane + 1024 * j < D) va[k][j] = *(const u32x4*)(A + (size_t)m * D + 16 * F.lane + 1024 * j); }
#pragma unroll
        for (int k = 0; k < SBN; ++k) { if (mm[k] < 0) continue; const int dst = moe_off(F, ee[k]) + pp[k];
#pragma unroll
            for (int j = 0; j < SNJ; ++j) if (16 * F.lane + 1024 * j < D) *(u32x4*)(As + (size_t)dst * D + 16 * F.lane + 1024 * j) = va[k][j];
            if (F.lane == 0) { rowmap[dst] = mm[k]; rowp[dst] = rp[mm[k]]; } } }
    const unsigned* cnt = F.wsp<unsigned>(WS_CTL) + CW_CNT;
    for (int i = F.bid * NTHREADS + F.tid; i < NE * 256; i += F.G * NTHREADS) { const int e = i >> 8, k = i & 255; const int row = moe_off(F, e) + (int)cnt[64 * e] + k; if (row < moe_off(F, e + 1)) { rowmap[row] = -1; rowp[row] = 0.f; } }
}

__device__ __forceinline__ void phase_final(const Frame& F) {
    const float* XL = F.wsp<float>(WS_XL); const bf16_t* ys = F.wsp<bf16_t>(WS_YSLOT); const float* mod = F.wsp<float>(WS_MOD) + (size_t)1 * NR * 6 * D; const float* fw = F.in[I_FNW];
    const float* pmb = F.wsp<float>(WS_PARTM); const int* rt = F.wsp<int>(WS_ROUTE); const float* rp = F.wsp<float>(WS_RPROB);
    int nfull, KS; moe_down_split(moe_off(F, NE) / 256, nfull, KS); const int row_split = nfull * 256;
    constexpr int NV = D / 256;
    LAS float* gl = (LAS float*)F.lds;
    __syncthreads();
    for (int i = F.tid; i < (NB + 1) * D; i += NTHREADS) gl[i] = i < NB * D ? mod[(size_t)(i / D) * 6 * D + 5 * D + i % D] : fw[i - NB * D];
    __syncthreads();
    i32x4 rtn = {0, 0, 0, 0}; float p0n = 0.f, p1n = 0.f;
    if (F.gw() < ML) { rtn = *(const i32x4*)(rt + F.gw() * 4); p0n = rp[F.gw() * 2]; p1n = rp[F.gw() * 2 + 1]; }
    for (int m = F.gw(); m < ML; m += F.ngw()) { const LAS float* gp = gl + mod_row(m) * D; f32x4 v[NV]; float ss = 0.f;
        const i32x4 rtv = rtn; const float p0 = p0n, p1 = p1n;
        { const int mn = m + F.ngw(); if (mn < ML) { rtn = *(const i32x4*)(rt + mn * 4); p0n = rp[mn * 2]; p1n = rp[mn * 2 + 1]; } }
        const int r0 = moe_off(F, rtv[0]) + rtv[2], r1 = moe_off(F, rtv[1]) + rtv[3]; const bool s0 = r0 >= row_split, s1 = r1 >= row_split;
#pragma unroll
        for (int i = 0; i < NV; ++i) { const int k = 4 * (F.lane + 64 * i); const f32x4 x = *(const f32x4*)(XL + (size_t)m * D + k), g = *(const LAS f32x4*)(gp + k); f32x4 a, b;
            if (s0) { a = *(const f32x4*)(pmb + (size_t)(r0 - row_split) * D + k); for (int ks = 1; ks < KS; ++ks) a += *(const f32x4*)(pmb + ((size_t)ks * PM_ROWS + (r0 - row_split)) * D + k); a *= p0; }
            else { const u32x2 w = *(const u32x2*)(ys + (size_t)m * D + k); a = (f32x4){bf2f(w.x & 0xffffu), bf2f(w.x >> 16), bf2f(w.y & 0xffffu), bf2f(w.y >> 16)}; }
            if (s1) { b = *(const f32x4*)(pmb + (size_t)(r1 - row_split) * D + k); for (int ks = 1; ks < KS; ++ks) b += *(const f32x4*)(pmb + ((size_t)ks * PM_ROWS + (r1 - row_split)) * D + k); b *= p1; }
            else { const u32x2 w = *(const u32x2*)(ys + ((size_t)ML + m) * D + k); b = (f32x4){bf2f(w.x & 0xffffu), bf2f(w.x >> 16), bf2f(w.y & 0xffffu), bf2f(w.y >> 16)}; }
            v[i] = x + g * (a + b); ss += v[i][0] * v[i][0] + v[i][1] * v[i][1] + v[i][2] * v[i][2] + v[i][3] * v[i][3]; }
        ss = wave_sum(ss); const float rinv = 1.0f / sqrtf(ss * (1.0f / (float)D) + EPS);
#pragma unroll
        for (int i = 0; i < NV; ++i) { const int k = 4 * (F.lane + 64 * i); const f32x4 w4 = *(const LAS f32x4*)(gl + NB * D + k); NTST(v[i] * rinv * w4, (f32x4*)(F.out + (size_t)m * D + k)); } }
}

constexpr int NPHASE = 23;
__global__ void __launch_bounds__(NTHREADS, 2) fwd_kernel(Args args) {
#ifdef EMU
    unsigned char* lds_raw = emu::tl_blk->lds;
#else
    extern __shared__ __attribute__((aligned(16))) unsigned char lds_raw[];
#endif
    const int tid0 = threadIdx.x;
    volatile LAS unsigned* misc = (volatile LAS unsigned*)((LAS unsigned char*)lds_raw + LDS_MISC);
    if (tid0 < 16) misc[tid0] = 0u;
    __syncthreads();
    const int lo = args.ph_lo, hi = args.ph_hi;
    XcdBarrier bar = xcd_barrier_post((unsigned*)(args.ws + WS_CTL) + CW_BAR, misc);
#ifndef ONLY_PHASE
#define ONLY_PHASE -1
#endif
#define IN(k) ((ONLY_PHASE < 0 || ONLY_PHASE == (k)) && lo <= (k) && (k) < hi)
#define SEAM(k) do { if (IN(k) && IN((k) + 1)) xcd_barrier(bar); } while (0)
#define MKF() Frame F; { int t_ = tid0; LAUNDER(t_); F.lds = (LAS unsigned char*)lds_raw; F.tid = t_; F.lane = t_ & 63; F.wave = RFL(t_ >> 6); F.G = gridDim.x; F.bid = blockIdx.x; F.in = args.in; F.out = args.out; F.ws = args.ws; } \
    float* XL = F.wsp<float>(WS_XL); bf16_t* A = F.wsp<bf16_t>(WS_A); bf16_t* P = F.wsp<bf16_t>(WS_P); bf16_t* Y = F.wsp<bf16_t>(WS_YCAT); bf16_t* H = F.wsp<bf16_t>(WS_H); \
    const float* mod0 = F.wsp<float>(WS_MOD); const float* mod1 = mod0 + (size_t)NR * 6 * D; (void)XL; (void)A; (void)P; (void)Y; (void)H; (void)mod0; (void)mod1;

    if (IN(0)) { MKF() phase_prologue(F); }
    SEAM(0);
    if (IN(1)) { MKF() phase_finalize(F); }
    SEAM(1);
    if (IN(2)) { MKF() modulate_rows<false>(F, F.in[I_X], F.in[I_CTX], 0, 0, A, MT); }
    SEAM(2);
    if (IN(3)) {
        MKF()
        pg8::Gemm g{A, F.wsp<bf16_t>(WS_W_ABIN), MT, AB_MAIN, D}; pg8::StaticOrder S; S.init(MT, AB_MAIN, F.G, F.bid);
        EpiInProj0 E{P, AB_MAIN, F.wsp<bf16_t>(WS_PH)};
        pg8::gemm_phase(F.lds, g, S, E);
        side_gemm(F, A, F.wsp<bf16_t>(WS_W_ABSIDE), F.wsp<float>(WS_SIDE), MT);
    }
    SEAM(3);
    if (IN(4)) {
        MKF()
        hyena_units(F);
        for (int u = F.bid; u < NB * MLH * NCS; u += F.G) mlstm_local_unit(F, u / (MLH * NCS), (u / NCS) % MLH, u % NCS);
    }
    if (IN(4)) { MKF() help_slot(F, 0); }
    SEAM(4);
    if (IN(5)) { MKF() mlstm_carry(F); }
    SEAM(5);
    if (IN(6)) { MKF() for (int u = F.bid; u < NB * MLH * NCS; u += F.G) mlstm_out_unit(F, u / (MLH * NCS), (u / NCS) % MLH, u % NCS); }
    if (IN(6)) { MKF() help_slot(F, 1); }
    SEAM(6);
    if (IN(7)) {
        MKF()
        pg8::Gemm g{Y, F.wsp<bf16_t>(WS_W_ABOUT), MT, D, YC1}; CtxSplitOrder S; S.init(D, YC1, KS7, F.G, F.bid);
        EpiResidSplit E{F.in[I_X], XL, mod0 + 2 * D, F.wsp<float>(WS_PART), YC1 / KS7};
        pg8::gemm_phase(F.lds, g, S, E);
    }
    if (IN(7)) { MKF() help_slot(F, 2); }
    SEAM(7);
    if (IN(8)) { MKF() modulate_rows<false, true>(F, XL, F.in[I_CTX], 0, 3, A, MT, F.wsp<float>(WS_PART), mod0 + (size_t)NB * 6 * D + 2 * D, KS7, XL); }
    SEAM(8);
    if (IN(9)) {
        MKF()
        pg8::Gemm g{F.wsp<bf16_t>(WS_A8), F.wsp<bf16_t>(WS_W_GU), MT, 2 * FF, D / 2}; pg8::StaticOrder S; S.init(MT, 2 * FF, F.G, F.bid);
        EpiGatedI8F8 E{F.wsp<unsigned char>(WS_H), FF, F.wsp<float>(WS_SA8), F.wsp<float>(WS_SB_GU)};
        pg8::gemm_phase(F.lds, g, S, E);
    }
    if (IN(9)) { MKF() help_slot(F, 3); }
    SEAM(9);
    if (IN(10)) {
        MKF()
        pg8::Gemm g{H, F.wsp<bf16_t>(WS_W_DN), MT, D, FF / 2}; CtxSplitOrder S; S.init(D, FF / 2, KS10, F.G, F.bid);
        EpiResidSplitF8 E{XL, XL, mod0 + 5 * D, F.wsp<float>(WS_PART), FF / 2 / KS10};
        pg8::gemm_phase(F.lds, g, S, E);
    }
    if (IN(10)) { MKF() help_slot(F, 4); }
    SEAM(10);
    if (IN(11)) { MKF() modulate_rows<false>(F, XL, XL + (size_t)ML * D, 1, 0, A, MT, F.wsp<float>(WS_PART), mod0 + (size_t)NB * 6 * D + 5 * D, KS10, XL); }
    SEAM(11);
    if (IN(12)) {
        MKF()
        pg8::Gemm g{A, F.wsp<bf16_t>(WS_W_CDIN), MT, CD_MAIN, D}; pg8::StaticOrder S; S.init(MT, CD_MAIN, F.G, F.bid);
        EpiStoreBf16 E{P, CD_MAIN};
        pg8::gemm_phase(F.lds, g, S, E);
        side_gemm(F, A, F.wsp<bf16_t>(WS_W_CDSIDE), F.wsp<float>(WS_SIDE), MT);
    }
    if (IN(12)) { MKF() help_slot(F, 5); }
    SEAM(12);
    if (IN(13)) {
        MKF()
        ssd_act_pass(F);
        xcd_barrier(bar);
        for (int u = F.bid; u < NB * NCS * SSDG * 2 * (HPG / 4); u += F.G) { int r = u; const int hh = r % (HPG / 4); r /= (HPG / 4); const int d = r % 2; r /= 2; const int g = r % SSDG; r /= SSDG; const int cs = r % NCS; r /= NCS;
            ssd_local_unit(F, r, cs, g, d, hh); }
        s5_local_units(F);
    }
    if (IN(13)) { MKF() help_slot(F, 6); }
    SEAM(13);
    if (IN(14)) { MKF() ssd_carry(F); s5_carry(F); }
    SEAM(14);
    if (IN(15)) {
        MKF()
        for (int u = F.bid; u < NB * NCL * SSDG * (HPG / 4); u += F.G) { int r = u; const int hh = r % (HPG / 4); r /= (HPG / 4); const int g = r % SSDG; r /= SSDG; const int lc = r % NCL; r /= NCL;
            ssd_out_unit(F, r, lc, g, hh); }
        __syncthreads();
        s5_out_units(F);
    }
    SEAM(15);
    if (IN(16)) {
        MKF()
        pg8::Gemm g{F.wsp<bf16_t>(WS_S5G), F.wsp<bf16_t>(WS_W_GLU), ML, 2 * S5W, S5W}; pg8::StaticOrder S; S.init(ML, 2 * S5W, F.G, F.bid);
        EpiGated<1> E{Y, YC2, SSDD, 2 * S5W / 256};
        constexpr int NU16 = (ML / 256) * (2 * S5W / 256); const int r16 = NU16 < F.G ? NU16 : 0;
        if (r16 != 0 && F.bid >= r16) ssd_norm_rows(F, r16, F.G - r16);
        pg8::gemm_phase(F.lds, g, S, E);
        if (r16 == 0) ssd_norm_rows(F, 0, F.G);
    }
    if (IN(16)) { MKF() help_slot(F, 7); }
    SEAM(16);
    if (IN(17)) {
        MKF()
        pg8::Gemm g{Y, F.wsp<bf16_t>(WS_W_CDOUT), ML, D, YC2}; pg8::StaticOrder S; S.init(ML, D, F.G, F.bid);
        EpiResid E{XL, XL + (size_t)ML * D, XL, mod1 + 2 * D};
        pg8::gemm_phase(F.lds, g, S, E);
    }
    SEAM(17);
    if (IN(18)) { MKF() modulate_rows<true>(F, XL, XL + (size_t)ML * D, 1, 3, A, ML); }
    SEAM(18);
    if (IN(19)) { MKF() phase_moe_scatter(F); }
    if (IN(19)) { MKF() help_drain(F); }
    SEAM(19);
    if (IN(20)) {
        MKF()
        MoeOrder S; S.init(F, 2 * FF / 256);
        pg8::Gemm g{F.wsp<bf16_t>(WS_AS), F.wsp<bf16_t>(WS_W_MGU), 0, 0, D / 2};
        EpiGatedF8 E{F.wsp<unsigned char>(WS_H), FF, 2 * FF / 256};
        pg8::gemm_phase(F.lds, g, S, E);
    }
    if (IN(20)) { MKF() help_moe_tail(F); }
    SEAM(20);
    if (IN(21)) {
        MKF()
        MoeDownOrder S; S.init(F, D / 256, FF / 2);
        pg8::Gemm g{H, F.wsp<bf16_t>(WS_W_MDN), 0, 0, FF / 2};
        EpiMoeDownSplit E{F.wsp<int>(WS_ROWMAP), F.wsp<float>(WS_ROWP), F.wsp<bf16_t>(WS_YSLOT), F.wsp<float>(WS_PARTM), D / 256, S.nfull * 256, FF / 2 / S.KS, W8INV};
        pg8::gemm_phase(F.lds, g, S, E);
    }
    SEAM(21);
    if (IN(22)) { MKF() phase_final(F); }
#undef IN
#undef SEAM
}

#ifndef N_LAUNCH_MODE
#define N_LAUNCH_MODE 0
#endif
extern "C" void kernel_launch(void* const* d_in, const int* in_sizes, int n_in, void* d_out, int out_size, void* d_ws, size_t ws_size, hipStream_t stream) {
    (void)in_sizes; (void)out_size;
    static int grid = 0;
    if (grid == 0) {
        if (n_in != 44 || ws_size < WS_END) { fprintf(stderr, "kernel_launch: expected 44 inputs and >= %zu bytes of workspace (got %d, %zu)\n", (size_t)WS_END, n_in, ws_size); grid = -1; return; }
#ifdef EMU
        grid = emu_grid_override();
#else
        int dev = 0, cus = 0, per_cu = 0;
        if (hipGetDevice(&dev) != hipSuccess || hipDeviceGetAttribute(&cus, hipDeviceAttributeMultiprocessorCount, dev) != hipSuccess) { grid = -1; return; }
        if (hipFuncSetAttribute((const void*)fwd_kernel, hipFuncAttributeMaxDynamicSharedMemorySize, LDS_BYTES) != hipSuccess) { fprintf(stderr, "kernel_launch: hipFuncSetAttribute failed\n"); grid = -1; return; }
        if (hipOccupancyMaxActiveBlocksPerMultiprocessor(&per_cu, (const void*)fwd_kernel, NTHREADS, LDS_BYTES) != hipSuccess || per_cu < 1) { fprintf(stderr, "kernel_launch: occupancy query says %d\n", per_cu); (void)hipGetLastError(); }
        grid = cus;
#endif
    }
    if (grid < 0) return;
    (void)hipMemsetAsync((char*)d_ws + WS_CTL, 0, CTL_BYTES, stream);
    Args a; memset(&a, 0, sizeof(a));
    for (int i = 0; i < 44; ++i) a.in[i] = (const float*)d_in[i];
    a.out = (float*)d_out; a.ws = (unsigned char*)d_ws;
#if N_LAUNCH_MODE == 0
    a.ph_lo = 0; a.ph_hi = NPHASE;
#ifdef EMU
    emu::launch([](void* p) { fwd_kernel(*(Args*)p); }, &a, dim3(grid), dim3(NTHREADS), LDS_BYTES);
#else
    hipLaunchKernelGGL(fwd_kernel, dim3(grid), dim3(NTHREADS), LDS_BYTES, stream, a);
#endif
#else
    for (int ph = 0; ph < NPHASE; ++ph) { a.ph_lo = ph; a.ph_hi = ph + 1;
#ifdef EMU
        emu::launch([](void* p) { fwd_kernel(*(Args*)p); }, &a, dim3(grid), dim3(NTHREADS), LDS_BYTES);
#else
        hipLaunchKernelGGL(fwd_kernel, dim3(grid), dim3(NTHREADS), LDS_BYTES, stream, a);
#endif
    }
#endif
}
#ifdef EMU
#include <string.h>
extern "C" size_t emu_ws_dump_offset(const char* name, size_t* bytes) {
    struct E { const char* n; size_t off, b; };
    const E tab[] = { {"MOD", WS_MOD, (size_t)2 * NR * 6 * D * 4}, {"A", WS_A, (size_t)MT * D * 2}, {"P", WS_P, (size_t)MT * AB_MAIN * 2}, {"SIDE", WS_SIDE, (size_t)MT * 32 * 4},
        {"YCAT", WS_YCAT, (size_t)MT * YC1 * 2}, {"XL", WS_XL, (size_t)MT * D * 4}, {"FILT0", WS_FILT0, (size_t)HYD * 2 * SEQ * 4}, {"L1", WS_L1, (size_t)2 * HYD * 4}, {"H", WS_H, (size_t)MT * FF * 2},
        {"YPRE", WS_YPRE, (size_t)ML * SSDD * 4}, {"S5G", WS_S5G, (size_t)ML * S5W * 2}, {"SSQ", WS_SSQ, (size_t)ML * 4 * 4}, {"MLST", WS_MLST, (size_t)2 * NB * MLH * NCS * MLST_STRIDE * 4} };
    for (const E& e : tab) if (!strcmp(e.n, name)) { *bytes = e.b; return e.off; }
    *bytes = 0; return 0;
}
#endif
```

```cpp
#ifndef EMU
#include <hip/hip_runtime.h>
#endif
#include <stdint.h>
#include <stddef.h>
#include <math.h>
#include <stdio.h>
#include <string.h>

#ifdef CFG_SMALL
#ifndef CFG_SEQ
#define CFG_SEQ 256
#endif
constexpr int D = 256, NB = 2, SEQ = CFG_SEQ, CTX = 128, HYD = 256, MLH = 2, SSDH = 8, S5W = 256, FF = 256;
#else
constexpr int D = 2048, NB = 4, SEQ = 2048, CTX = 256, HYD = 1024, MLH = 8, SSDH = 16, S5W = 512, FF = 5632;
#endif
constexpr int GW = 64, DH = 128, MLD = MLH * DH, CH = 128;
constexpr int ML = NB * SEQ, MC = NB * CTX, MT = ML + MC, NR = NB + 1;
constexpr int NCL = SEQ / CH, NCC = CTX / CH, NCS = NCL + NCC;
constexpr int AB_MAIN = 3 * HYD + 4 * MLD, AB_SIDE = 4 * MLH, AB_IN = AB_MAIN + AB_SIDE;
constexpr int SSDP = 64, SSDD = SSDH * SSDP, SSDG = 2, SSDN = 128, XBC = SSDD + 2 * SSDG * SSDN, HPG = SSDH / SSDG;
constexpr int CD_MAIN = SSDD + XBC + S5W, CD_SIDE = 2 * SSDH, CD_IN = CD_MAIN + CD_SIDE;
constexpr int S5GS = 16, S5G = S5W / S5GS, S5P = 64;
constexpr int NE = 8, HYEMB = 33, HYHID = 64;
constexpr int YC1 = HYD + MLD, YC2 = SSDD + S5W;
constexpr int MOE_ROWS = 2 * ML + NE * 256;
constexpr float EPS = 1e-6f;
constexpr int NTHREADS = 512, NWAVES = 8;
constexpr int KSL = D / 256;
static_assert(D % 256 == 0 && ML % 256 == 0 && MT % 256 == 0 && AB_MAIN % 256 == 0 && CD_MAIN % 256 == 0 && FF % 128 == 0 && S5W % 128 == 0, "tile shapes");
static_assert(AB_SIDE <= 32 && CD_SIDE <= 32 && HPG % 4 == 0, "side widths");

typedef unsigned short bf16_t;
typedef short bf16x8 __attribute__((ext_vector_type(8)));
typedef float f32x4 __attribute__((ext_vector_type(4)));
typedef float f32x2 __attribute__((ext_vector_type(2)));
typedef float f32x16 __attribute__((ext_vector_type(16)));
typedef int i32x8 __attribute__((ext_vector_type(8)));
typedef int i32x4 __attribute__((ext_vector_type(4)));
typedef unsigned u32x4 __attribute__((ext_vector_type(4)));
typedef unsigned u32x2 __attribute__((ext_vector_type(2)));
#ifdef EMU
#define MFMA16(a, b, c) emu_mfma16(a, b, c)
#define MFMA32(a, b, c) emu_mfma32(a, b, c)
#define MFMA_F8(a, b, c) emu_mfma_f8(a, b, c)
#define MFMA_I8(a, b, c) emu_mfma_i8(a, b, c)
#define ALIGNBIT(hi, lo, sh) ((unsigned)(((((unsigned long long)(hi)) << 32) | (unsigned long long)(lo)) >> ((sh) & 31u)))
#define GLDS16(g, l) emu_glds16((const void*)(g), (void*)(l))
#define S_BARRIER() emu::syncthreads()
#define WAIT_VM(n) ((void)0)
#define WAIT_LGKM(n) ((void)0)
#define WAIT_ALL() ((void)0)
#define SCHED_BARRIER() ((void)0)
#define SETPRIO(x) ((void)0)
#define RFL(x) (x)
#define WAVE_SYNC() emu::wave_sync()
#define CFENCE() ((void)0)
#define S_SLEEP(n) emu_spin_pause()
#define FEXP(x) expf(x)
#define NTLD(p) (*(p))
#define NTST(v, p) (*(p) = (v))
#define MFMA_SETTLE() ((void)0)
#define FRCP(x) (1.0f / (x))
#define LAUNDER(x) ((void)0)
#define ATOM_LD(p) emu_atomic_ld((const unsigned*)(p))
#define ATOM_ST(p, v) emu_atomic_st((unsigned*)(p), (v))
#define ATOM_ADD(p, v) emu_atomic_add((unsigned*)(p), (v))
#define FENCE_ACQ() __atomic_thread_fence(__ATOMIC_SEQ_CST)
#define FENCE_REL() __atomic_thread_fence(__ATOMIC_SEQ_CST)
static inline unsigned cvt_pk_bf16(float lo, float hi);
#else
#define LAS __attribute__((address_space(3)))
#define MFMA16(a, b, c) __builtin_amdgcn_mfma_f32_16x16x32_bf16(a, b, c, 0, 0, 0)
#define MFMA32(a, b, c) __builtin_amdgcn_mfma_f32_32x32x16_bf16(a, b, c, 0, 0, 0)
#define MFMA_I8(a, b, c) __builtin_amdgcn_mfma_i32_16x16x64_i8(a, b, c, 0, 0, 0)
#define MFMA_F8(a, b, c) mfma_f8_inplace(a, b, c)
#define ALIGNBIT(hi, lo, sh) __builtin_amdgcn_alignbit(hi, lo, sh)
#define GLDS16(g, l) __builtin_amdgcn_global_load_lds((const unsigned*)(g), (LAS unsigned*)(l), 16, 0, 0)
#define S_BARRIER() __builtin_amdgcn_s_barrier()
#define WAIT_VM(n) asm volatile("s_waitcnt vmcnt(" #n ")" ::: "memory")
#define WAIT_LGKM(n) asm volatile("s_waitcnt lgkmcnt(" #n ")" ::: "memory")
#define WAIT_ALL() asm volatile("s_waitcnt vmcnt(0) lgkmcnt(0)" ::: "memory")
#define SCHED_BARRIER() __builtin_amdgcn_sched_barrier(0)
#define SETPRIO(x) __builtin_amdgcn_s_setprio(x)
#define RFL(x) __builtin_amdgcn_readfirstlane(x)
#define WAVE_SYNC() do { asm volatile("s_waitcnt lgkmcnt(0)" ::: "memory"); __builtin_amdgcn_wave_barrier(); } while (0)
#define CFENCE() asm volatile("" ::: "memory")
#define S_SLEEP(n) __builtin_amdgcn_s_sleep(n)
#define FEXP(x) __expf(x)
#define NTST(v, p) __builtin_nontemporal_store((v), (p))
#define NTLD(p) __builtin_nontemporal_load(p)
#define MFMA_SETTLE() asm volatile("s_nop 15\n\ts_nop 15" ::: "memory")
#define FRCP(x) __builtin_amdgcn_rcpf(x)
#define LAUNDER(x) asm volatile("" : "+v"(x))
#define ATOM_LD(p) __hip_atomic_load((p), __ATOMIC_RELAXED, __HIP_MEMORY_SCOPE_AGENT)
#define ATOM_ST(p, v) __hip_atomic_store((p), (v), __ATOMIC_RELAXED, __HIP_MEMORY_SCOPE_AGENT)
#define ATOM_ADD(p, v) __hip_atomic_fetch_add((p), (v), __ATOMIC_RELAXED, __HIP_MEMORY_SCOPE_AGENT)
#define FENCE_ACQ() __builtin_amdgcn_fence(__ATOMIC_ACQUIRE, "agent")
#define FENCE_REL() __builtin_amdgcn_fence(__ATOMIC_RELEASE, "agent")
#endif

__device__ __forceinline__ unsigned f2bf(float f) { unsigned u = __float_as_uint(f); return (u + 0x7fffu + ((u >> 16) & 1u)) >> 16; }
__device__ __forceinline__ float bf2f(unsigned h) { return __uint_as_float(h << 16); }
__device__ __forceinline__ unsigned pk2(float lo, float hi) { return f2bf(lo) | (f2bf(hi) << 16); }
#ifdef EMU
static inline unsigned cvt_pk_bf16(float lo, float hi) { return pk2(lo, hi); }
#else
__device__ __forceinline__ unsigned cvt_pk_bf16(float lo, float hi) { unsigned r; asm volatile("v_cvt_pk_bf16_f32 %0, %1, %2" : "=v"(r) : "v"(lo), "v"(hi)); return r; }
#endif
#ifdef EMU
static inline unsigned emu_f2e4m3(float f) { const unsigned s = f < 0.f ? 0x80u : 0u; float a = fabsf(f); if (!(a == a)) return 0x7fu; if (a > 448.f) a = 448.f;
    if (a < 0.015625f) { const unsigned man = (unsigned)rintf(a * 512.0f); return s | man; }
    int e; (void)frexpf(a, &e); e -= 1; unsigned man = (unsigned)rintf((a / ldexpf(1.0f, e) - 1.0f) * 8.0f); if (man == 8u) { man = 0u; e += 1; }
    unsigned E = (unsigned)(e + 7); if (E > 15u || (E == 15u && man == 7u)) { E = 15u; man = 6u; } return s | (E << 3) | man; }
static inline float emu_e4m32f(unsigned b) { const float s = (b & 0x80u) ? -1.f : 1.f; const unsigned E = (b >> 3) & 15u, man = b & 7u; if (E == 0) return s * ldexpf((float)man, -9); return s * ldexpf(1.0f + (float)man * 0.125f, (int)E - 7); }
static inline unsigned cvt_pk_fp8x4(float a, float b, float c, float d) { return emu_f2e4m3(a) | (emu_f2e4m3(b) << 8) | (emu_f2e4m3(c) << 16) | (emu_f2e4m3(d) << 24); }
static inline i32x4 emu_mfma_i8(i32x4 a, i32x4 b, i32x4 c) {
    emu::Block* blk = emu::tl_blk; emu::Wave* w = &blk->waves[blk->cur >> 6]; int lane = blk->cur & 63;
    memcpy(w->buf[lane], &a, 16); memcpy(w->buf[lane] + 16, &b, 16); emu::wave_sync();
    const int j = lane & 15; i32x4 d = c;
    for (int r = 0; r < 4; ++r) { const int i = 4 * (lane >> 4) + r; int s = 0;
        for (int kb = 0; kb < 4; ++kb) for (int t = 0; t < 16; ++t) s += (int)(signed char)w->buf[i + 16 * kb][t] * (int)(signed char)w->buf[j + 16 * kb][16 + t];
        d[r] += s; }
    emu::wave_sync(); return d;
}
static inline f32x4 emu_mfma_f8(i32x8 a, i32x8 b, f32x4 c) {
    emu::Block* blk = emu::tl_blk; emu::Wave* w = &blk->waves[blk->cur >> 6]; int lane = blk->cur & 63;
    memcpy(w->buf[lane], &a, 32); memcpy(w->buf[lane] + 32, &b, 32); emu::wave_sync();
    const int j = lane & 15; f32x4 d = c;
    for (int r = 0; r < 4; ++r) { const int i = 4 * (lane >> 4) + r; float s = 0.f;
        for (int kb = 0; kb < 4; ++kb) for (int t = 0; t < 32; ++t) s += emu_e4m32f(w->buf[i + 16 * kb][t]) * emu_e4m32f(w->buf[j + 16 * kb][32 + t]);
        d[r] += s; }
    emu::wave_sync(); return d;
}
#else
__device__ __forceinline__ unsigned cvt_pk_fp8x4(float a, float b, float c, float d) {
    a = fminf(fmaxf(a, -448.f), 448.f); b = fminf(fmaxf(b, -448.f), 448.f); c = fminf(fmaxf(c, -448.f), 448.f); d = fminf(fmaxf(d, -448.f), 448.f);
    int p = __builtin_amdgcn_cvt_pk_fp8_f32(a, b, 0, false); p = __builtin_amdgcn_cvt_pk_fp8_f32(c, d, p, true); return (unsigned)p; }
#endif
#ifndef EMU
__device__ __forceinline__ f32x4 mfma_f8_inplace(i32x8 a, i32x8 b, f32x4 c) {
    asm volatile("v_mfma_scale_f32_16x16x128_f8f6f4 %0, %1, %2, %0, %3, %3 op_sel_hi:[0,0,0]" : "+v"(c) : "v"(a), "v"(b), "v"(0x7F7F7F7F));
    return c; }
#endif
constexpr float W8SCALE = 64.0f, W8INV = 1.0f / 64.0f;
constexpr int KSF8 = ((FF / 128) % 4 == 0) ? 2 : 1;
__device__ __forceinline__ float wave_max(float v) { v = fmaxf(v, __shfl_xor(v, 1)); v = fmaxf(v, __shfl_xor(v, 2)); v = fmaxf(v, __shfl_xor(v, 4)); v = fmaxf(v, __shfl_xor(v, 8)); v = fmaxf(v, __shfl_xor(v, 16)); v = fmaxf(v, __shfl_xor(v, 32)); return v; }
__device__ __forceinline__ unsigned pk_i8x4(float a, float b, float c, float d) { return ((unsigned)(int)rintf(a) & 0xffu) | (((unsigned)(int)rintf(b) & 0xffu) << 8) | (((unsigned)(int)rintf(c) & 0xffu) << 16) | (((unsigned)(int)rintf(d) & 0xffu) << 24); }
__device__ __forceinline__ float wave_sum(float v) { v += __shfl_xor(v, 1); v += __shfl_xor(v, 2); v += __shfl_xor(v, 4); v += __shfl_xor(v, 8); v += __shfl_xor(v, 16); v += __shfl_xor(v, 32); return v; }
__device__ __forceinline__ float siluf(float x) { return x * FRCP(1.0f + FEXP(-x)); }
__device__ __forceinline__ float sigmoidf_(float x) { return FRCP(1.0f + FEXP(-x)); }
__device__ __forceinline__ float logsigmoidf_(float x) { return x < 0.f ? x - log1pf(expf(x)) : -log1pf(expf(-x)); }
__device__ __forceinline__ float softplusf_(float x) { return x > 0.f ? x + log1pf(expf(-x)) : log1pf(expf(x)); }
__device__ __forceinline__ void unpack8(const u32x4 w, float (&f)[8]) {
    f[0] = bf2f(w.x & 0xffffu); f[1] = bf2f(w.x >> 16); f[2] = bf2f(w.y & 0xffffu); f[3] = bf2f(w.y >> 16);
    f[4] = bf2f(w.z & 0xffffu); f[5] = bf2f(w.z >> 16); f[6] = bf2f(w.w & 0xffffu); f[7] = bf2f(w.w >> 16);
}

constexpr size_t al(size_t x) { return (x + 4095) & ~(size_t)4095; }
constexpr size_t WS_CTL = 0, CTL_BYTES = 1u << 20;
constexpr size_t WS_W_ABIN = WS_CTL + CTL_BYTES;
constexpr size_t WS_W_ABSIDE = WS_W_ABIN + al((size_t)AB_MAIN * D * 2);
constexpr size_t WS_W_ABOUT = WS_W_ABSIDE + al((size_t)32 * D * 2);
constexpr size_t WS_W_GU = WS_W_ABOUT + al((size_t)D * YC1 * 2);
constexpr size_t WS_W_DN = WS_W_GU + al((size_t)2 * FF * D * 2);
constexpr size_t WS_W_CDIN = WS_W_DN + al((size_t)D * FF * 2);
constexpr size_t WS_W_CDSIDE = WS_W_CDIN + al((size_t)CD_MAIN * D * 2);
constexpr size_t WS_W_GLU = WS_W_CDSIDE + al((size_t)32 * D * 2);
constexpr size_t WS_W_CDOUT = WS_W_GLU + al((size_t)2 * S5W * S5W * 2);
constexpr size_t WS_W_MGU = WS_W_CDOUT + al((size_t)D * YC2 * 2);
constexpr size_t WS_W_MDN = WS_W_MGU + al((size_t)NE * 2 * FF * D * 2);
constexpr size_t WS_MODP = WS_W_MDN + al((size_t)NE * D * FF * 2);
constexpr size_t WS_MOD = WS_MODP + al((size_t)2 * KSL * NR * 6 * D * 4);
constexpr size_t WS_FILT0 = WS_MOD + al((size_t)2 * NR * 6 * D * 4);
constexpr size_t WS_FILT1 = WS_FILT0 + al((size_t)HYD * 2 * SEQ * 4);
constexpr size_t WS_L1P = WS_FILT1 + al((size_t)HYD * 2 * CTX * 4);
constexpr size_t WS_L1 = WS_L1P + al((size_t)((SEQ + CTX) / 8) * 2 * HYD * 4);
constexpr size_t WS_S5PAR = WS_L1 + al((size_t)2 * HYD * 4);
constexpr size_t WS_XL = WS_S5PAR + al((size_t)2 * S5G * S5P * 36 * 4);
constexpr size_t WS_A = WS_XL + al((size_t)MT * D * 4);
constexpr size_t WS_P = WS_A + al((size_t)MT * D * 2);
constexpr size_t WS_SIDE = WS_P + al((size_t)MT * (AB_MAIN > CD_MAIN ? AB_MAIN : CD_MAIN) * 2);
constexpr size_t WS_YCAT = WS_SIDE + al((size_t)MT * 32 * 4);
constexpr size_t WS_H = WS_YCAT + al((size_t)MT * YC1 * 2);
constexpr size_t WS_AS = WS_H + al((size_t)MOE_ROWS * FF * 2);
constexpr size_t WS_YSLOT = WS_AS + al((size_t)MOE_ROWS * D * 2);
constexpr int MLST_CT = DH * DH / 2;
constexpr int MLST_STRIDE = MLST_CT + DH + 64;
constexpr size_t WS_MLST = WS_YSLOT + al((size_t)2 * ML * D * 4);
constexpr int SSD_HF = SSDP * SSDN / 2;
constexpr int SSDST_STRIDE = SSD_HF + 64;
constexpr size_t WS_SSDST = WS_MLST + al((size_t)2 * NB * MLH * NCS * MLST_STRIDE * 4);
constexpr size_t WS_S5ST = WS_SSDST + al((size_t)2 * NB * SSDH * NCS * SSDST_STRIDE * 4);
constexpr size_t WS_YPRE = WS_S5ST + al((size_t)2 * NB * NCS * S5G * S5P * 2 * 4);
constexpr size_t WS_SSQ = WS_YPRE + al((size_t)ML * SSDD * 4);
constexpr size_t WS_S5G = WS_SSQ + al((size_t)ML * 4 * 4);
constexpr size_t WS_ROUTE = WS_S5G + al((size_t)ML * S5W * 2);
constexpr size_t WS_RPROB = WS_ROUTE + al((size_t)ML * 4 * 4);
constexpr size_t WS_ROWMAP = WS_RPROB + al((size_t)ML * 2 * 4);
constexpr size_t WS_ROWP = WS_ROWMAP + al((size_t)MOE_ROWS * 4);
constexpr size_t WS_PH = WS_ROWP + al((size_t)MOE_ROWS * 4);
constexpr int KSPLIT = 4;
constexpr int KS7 = ((HYD + MLD) / 64) % (2 * KSPLIT) == 0 ? KSPLIT : 2, KS10 = (FF / 128) % (2 * KSPLIT) == 0 ? KSPLIT : ((FF / 128) % 4 == 0 ? 2 : 1);
constexpr size_t WS_PART = WS_PH + al((size_t)3 * HYD * MT * 2);
constexpr int PM_ROWS = 16 * 256;
constexpr size_t WS_PARTM = WS_PART + al((size_t)KSPLIT * MC * D * 4);
constexpr size_t WS_XACT = WS_PARTM + al((size_t)4 * PM_ROWS * D * 4);
constexpr size_t WS_SB_GU = WS_XACT + al((size_t)MT * XBC * 2);
constexpr size_t WS_A8 = WS_SB_GU + al((size_t)2 * FF * 4);
constexpr size_t WS_SA8 = WS_A8 + al((size_t)MT * D);
constexpr size_t WS_END = WS_SA8 + al((size_t)MT * 4);
constexpr int CW_BAR = 4096;
constexpr int CW_CNT = 16384;
constexpr int CW_QNEXT = 20480;
constexpr int CW_ARRIVE = 24576;

#ifdef EMU
struct XcdBarrier { unsigned* bar; unsigned gen; };
static inline XcdBarrier xcd_barrier_post(unsigned* bar, volatile unsigned*) { XcdBarrier b; b.bar = bar; b.gen = 0; return b; }
static inline void xcd_barrier(XcdBarrier& b) {
    __syncthreads();
    if (threadIdx.x == 0) { const unsigned G = gridDim.x; const unsigned old = emu_atomic_add(&b.bar[0], 1u); const unsigned target = (old / G + 1u) * G;
        while (emu_atomic_ld(&b.bar[0]) < target) sched_yield(); }
    __syncthreads();
}
#define XCD_BAR_WORDS 3456
#else
#define XB_TMO      128
#define XB_XCNT(j)  (256  + 64 * (j))
#define XB_XSUB(j)  (1280 + 64 * (j))
#define XB_XGEN(j)  (2304 + 64 * (j))
#define XB_TOP      3328
#define XB_TOPGEN   3392
#define XCD_BAR_WORDS 3456
#define XB_SPIN_CAP (1u << 18)

__device__ __forceinline__ unsigned xb_ld(unsigned* p)              { return __hip_atomic_load(p, __ATOMIC_RELAXED, __HIP_MEMORY_SCOPE_AGENT); }
__device__ __forceinline__ unsigned xb_add(unsigned* p, unsigned v) { return __hip_atomic_fetch_add(p, v, __ATOMIC_RELAXED, __HIP_MEMORY_SCOPE_AGENT); }
__device__ __forceinline__ unsigned xb_xcc_id() { return (unsigned)__builtin_amdgcn_s_getreg((3 << 11) | 20) & 0xFu; }
#define XB_SPIN(cond, bar) do { unsigned _sp = 0; while (cond) { __builtin_amdgcn_s_sleep(1); \
    if ((++_sp & 255u) == 0u) { if (xb_ld(&(bar)[XB_TMO])) break; if (_sp > XB_SPIN_CAP) { atomicAdd(&(bar)[XB_TMO], 1u); break; } } } } while (0)

struct XcdBarrier {
    unsigned* bar; unsigned x;
    volatile LAS unsigned* st;
};

__device__ __forceinline__ XcdBarrier xcd_barrier_post(unsigned* bar, volatile LAS unsigned* st) {
    XcdBarrier b; b.bar = bar; b.x = xb_xcc_id(); b.st = st;
    if (threadIdx.x == 0) (void)xb_add(&bar[XB_XCNT(b.x)], 1u);
    return b;
}
__device__ __forceinline__ void xcd_barrier_complete(unsigned* bar, unsigned x, unsigned& nloc, unsigned& nx) {
    const unsigned G = gridDim.x * gridDim.y * gridDim.z;
    unsigned sum, cnt, mine, sp = 0u;
    for (;;) {
        sum = 0u; cnt = 0u; mine = 0u;
#pragma unroll
        for (unsigned j = 0; j < 16; ++j) { const unsigned c = xb_ld(&bar[XB_XCNT(j)]); sum += c; cnt += (c > 0u) ? 1u : 0u; mine = (j == x) ? c : mine; }
        if (sum == G) break;
        __builtin_amdgcn_s_sleep(1);
        if ((++sp & 255u) == 0u) { if (xb_ld(&bar[XB_TMO])) break; if (sp > XB_SPIN_CAP) { atomicAdd(&bar[XB_TMO], 1u); break; } }
    }
    nloc = mine > 0u ? mine : 1u; nx = cnt > 0u ? cnt : 1u;
}

__device__ __forceinline__ void xcd_barrier(const XcdBarrier& b) {
    asm volatile("s_waitcnt vmcnt(0)" ::: "memory");
    __syncthreads();
    if (threadIdx.x == 0) {
        unsigned* bar = b.bar;
        __builtin_amdgcn_s_waitcnt(0);
        unsigned nloc = b.st[0], nx = b.st[1];
        if (nloc == 0u) { xcd_barrier_complete(bar, b.x, nloc, nx); b.st[0] = nloc; b.st[1] = nx; }
        const unsigned old = xb_add(&bar[XB_XSUB(b.x)], 1u);
        const unsigned gen = old / nloc;
        if (old + 1u == (gen + 1u) * nloc) {
            __builtin_amdgcn_fence(__ATOMIC_RELEASE, "agent");
            asm volatile("s_waitcnt vmcnt(0)" ::: "memory");
            const unsigned og = xb_add(&bar[XB_TOP], 1u);
            const unsigned tg = og / nx;
            if (og + 1u == (tg + 1u) * nx) xb_add(&bar[XB_TOPGEN], 1u);
            else XB_SPIN(xb_ld(&bar[XB_TOPGEN]) == tg, bar);
            __builtin_amdgcn_fence(__ATOMIC_ACQUIRE, "agent");
            xb_add(&bar[XB_XGEN(b.x)], 1u);
            asm volatile("s_waitcnt vmcnt(0)" ::: "memory");
        } else {
            XB_SPIN(xb_ld(&bar[XB_XGEN(b.x)]) == gen, bar);
            __builtin_amdgcn_fence(__ATOMIC_ACQUIRE, "agent");
            asm volatile("s_waitcnt vmcnt(0)" ::: "memory");
        }
    }
    __syncthreads();
}
#endif

namespace pg8 {
constexpr int BM = 256, BK = 64, HALF = 128, HTB = HALF * BK * 2  , STAGE_BYTES = 8 * HTB, NXCD = 8, WGM = 8;

__host__ __device__ __forceinline__ int lds_byte(int r, int c) { const int st = (r >> 4) * 2 + (c >> 5), rr = r & 15, cc = c & 31, ob = rr * 64 + cc * 2; return st * 1024 + (ob ^ (((ob >> 9) & 1) << 5)); }
__host__ __device__ __forceinline__ void stage_rc(int b, int& R, int& C) { const int st = b / 1024, sb = b % 1024, swz = sb ^ (((sb >> 9) & 1) << 5); R = (st >> 1) * 16 + swz / 64; C = (st & 1) * 32 + (swz % 64) / 2; }
__host__ __device__ __forceinline__ int perm32(int rho) { const int n = rho >> 4, i = rho & 15; return 8 * (i >> 2) + 4 * n + (i & 3); }

struct Unit { int pm, pn, k0, nt; };
struct Gemm { const bf16_t* A; const bf16_t* Bt; int M, N, K; };

struct StaticOrder {
    int nM, nN, nwg, G, c;
    __host__ __device__ __forceinline__ void init(int M, int N, int G_, int c_) { nM = M / BM; nN = N / BM; nwg = nM * nN; G = G_; c = c_; }
    __host__ __device__ __forceinline__ bool next(int i, Unit& u) const {
        const long L = (long)i * G + c; if (L >= nwg) return false;
        int wgid = (int)L; { const int q = nwg / NXCD, r = nwg % NXCD, xcd = wgid % NXCD, off = wgid / NXCD; wgid = (xcd < r ? xcd * (q + 1) : r * (q + 1) + (xcd - r) * q) + off; }
        const int nig = WGM * nN, gid = wgid / nig, fm = gid * WGM, gsz = (nM - fm) < WGM ? (nM - fm) : WGM;
        u.pm = fm + ((wgid % nig) % gsz); u.pn = (wgid % nig) / gsz; return true;
    }
    static constexpr bool SPLITK = false;
    __device__ __forceinline__ void a_ready(const Unit&) const {}
    __device__ __forceinline__ void done(const Unit&) const {}
};

template <class Epi, class Sched>
__device__ __forceinline__ void gemm_phase(LAS unsigned char* lds, const Gemm g, const Sched& S, const Epi& E) {
    const int tid = threadIdx.x, wid = RFL(tid >> 6), lane = tid & 63, wr = wid >> 2, wc = wid & 3, fr = lane & 15, fq = lane >> 4;
    const int K = g.K, nt = K / BK;
    unsigned voffA[2], voffB[2];
#pragma unroll
    for (int i = 0; i < 2; ++i) { int R, C; stage_rc(tid * 16 + i * 8192, R, C); const int Rb = Epi::PERM ? ((R & ~31) + perm32(R & 31)) : R;
        voffA[i] = (unsigned)(R * K + C) * 2u; voffB[i] = (unsigned)(Rb * K + C) * 2u; }
    const size_t kstep = (size_t)(BK * 2);
    const size_t hstep = (size_t)HALF * K * 2;
    const size_t tstep = 2 * hstep;
    const unsigned ldsw = (unsigned)wid * 1024u;
    const int aoff = Epi::F8 ? lds_byte(wr * 64 + fr, fq * 16) : lds_byte(wr * 64 + fr, fq * 8), boff = Epi::F8 ? lds_byte(wc * 32 + fr, fq * 16) : lds_byte(wc * 32 + fr, fq * 8);
#define PG8_SA(b, h) (((b) * 2 + (h)) * HTB)
#define PG8_SB(b, h) ((4 + (b) * 2 + (h)) * HTB)
#define PG8_STAGE(bufoff, gbase, voff) do { _Pragma("unroll") for (int _i = 0; _i < 2; ++_i) \
        GLDS16((const char*)(gbase) + (voff)[_i], lds + (bufoff) + ldsw + _i * 8192); } while (0)
#define PG8_LD16(off) (*(const LAS i32x4*)(lds + (off)))
#define PG8_CAT(lo, hi) __builtin_shufflevector((lo), (hi), 0, 1, 2, 3, 4, 5, 6, 7)
#define PG8_LDA(dst, b, h) do { if (Epi::F8) { _Pragma("unroll") for (int m = 0; m < 4; ++m) dst##8[m] = PG8_CAT(PG8_LD16(PG8_SA(b, h) + aoff + m * 2048), PG8_LD16(PG8_SA(b, h) + aoff + m * 2048 + 16)); } \
        else { _Pragma("unroll") for (int m = 0; m < 4; ++m) _Pragma("unroll") for (int k = 0; k < 2; ++k) dst[m][k] = *(const LAS bf16x8*)(lds + PG8_SA(b, h) + aoff + m * 2048 + k * 1024); } } while (0)
#define PG8_LDB(dst, b, h) do { if (Epi::F8) { _Pragma("unroll") for (int n = 0; n < 2; ++n) dst##8[n] = PG8_CAT(PG8_LD16(PG8_SB(b, h) + boff + n * 2048), PG8_LD16(PG8_SB(b, h) + boff + n * 2048 + 16)); } \
        else { _Pragma("unroll") for (int n = 0; n < 2; ++n) _Pragma("unroll") for (int k = 0; k < 2; ++k) dst[n][k] = *(const LAS bf16x8*)(lds + PG8_SB(b, h) + boff + n * 2048 + k * 1024); } } while (0)
#define PG8_MMA(ai, bj, At, Bt) do { SETPRIO(1); if (Epi::F8) { _Pragma("unroll") for (int m = 0; m < 4; ++m) _Pragma("unroll") for (int n = 0; n < 2; ++n) \
            acc[ai][bj][m][n] = MFMA_F8(Bt##8[n], At##8[m], acc[ai][bj][m][n]); } \
        else if (Epi::I8) { _Pragma("unroll") for (int m = 0; m < 4; ++m) _Pragma("unroll") for (int n = 0; n < 2; ++n) _Pragma("unroll") for (int k = 0; k < 2; ++k) \
            acc[ai][bj][m][n] = __builtin_bit_cast(f32x4, MFMA_I8(__builtin_bit_cast(i32x4, Bt[n][k]), __builtin_bit_cast(i32x4, At[m][k]), __builtin_bit_cast(i32x4, acc[ai][bj][m][n]))); } \
        else { _Pragma("unroll") for (int m = 0; m < 4; ++m) _Pragma("unroll") for (int n = 0; n < 2; ++n) _Pragma("unroll") for (int k = 0; k < 2; ++k) \
            acc[ai][bj][m][n] = MFMA16(Bt[n][k], At[m][k], acc[ai][bj][m][n]); } SETPRIO(0); } while (0)
#define PG8_BAR S_BARRIER()
#define PG8_SCHED SCHED_BARRIER()
    Unit cur, nxt; int ui = 0;
    if (!S.next(0, cur)) return;
    f32x4 acc[2][2][4][2];
#pragma unroll
    for (int a = 0; a < 2; ++a)
#pragma unroll
        for (int b = 0; b < 2; ++b)
#pragma unroll
            for (int m = 0; m < 4; ++m)
#pragma unroll
                for (int n = 0; n < 2; ++n) acc[a][b][m][n] = (f32x4){0.f, 0.f, 0.f, 0.f};
    bf16x8 At[4][2], B0[2][2], B1[2][2];
    i32x8 At8[4], B08[2], B18[2];
    const char* cA = (const char*)g.A + (size_t)cur.pm * tstep; const char* cB = (const char*)g.Bt + (size_t)cur.pn * tstep;
    if (Sched::SPLITK) { cA += (size_t)cur.k0 * 2; cB += (size_t)cur.k0 * 2; }
    S.a_ready(cur);
    PG8_STAGE(PG8_SB(0, 0), cB, voffB); PG8_STAGE(PG8_SA(0, 0), cA, voffA); PG8_STAGE(PG8_SB(0, 1), cB + hstep, voffB); PG8_STAGE(PG8_SA(0, 1), cA + hstep, voffA);
    if (wr == 1) PG8_BAR;
    WAIT_VM(4); PG8_BAR;
    PG8_STAGE(PG8_SB(1, 0), cB + kstep, voffB); PG8_STAGE(PG8_SA(1, 0), cA + kstep, voffA); PG8_STAGE(PG8_SB(1, 1), cB + hstep + kstep, voffB);
    WAIT_VM(6); PG8_BAR;
    for (;;) {
        const bool has_next = S.next(ui + 1, nxt);
        const char* nA = has_next ? (const char*)g.A + (size_t)nxt.pm * tstep : cA; const char* nB = has_next ? (const char*)g.Bt + (size_t)nxt.pn * tstep : cB;
        if (Sched::SPLITK && has_next) { nA += (size_t)nxt.k0 * 2; nB += (size_t)nxt.k0 * 2; }
        const int ntu = Sched::SPLITK ? cur.nt : nt;
        for (int t = 0; t < ntu; t += 2) {
            const bool last = (t == ntu - 2);
            const char* a1 = cA + (size_t)(t + 1) * kstep;
            const char* a2 = last ? nA : cA + (size_t)(t + 2) * kstep; const char* b2 = last ? nB : cB + (size_t)(t + 2) * kstep;
            const char* a3 = a2 + kstep; const char* b3 = b2 + kstep;
            if (last && has_next) S.a_ready(nxt);
            PG8_LDB(B0, 0, 0); PG8_SCHED; PG8_LDA(At, 0, 0); PG8_STAGE(PG8_SA(1, 1), a1 + hstep, voffA);
            WAIT_LGKM(8); PG8_BAR; WAIT_LGKM(0); PG8_MMA(0, 0, At, B0); PG8_BAR; PG8_SCHED;
            PG8_LDB(B1, 0, 1); PG8_STAGE(PG8_SB(0, 0), b2, voffB);
            PG8_BAR; WAIT_LGKM(0); PG8_MMA(0, 1, At, B1); PG8_BAR;
            PG8_LDA(At, 0, 1); PG8_STAGE(PG8_SA(0, 0), a2, voffA);
            PG8_BAR; WAIT_LGKM(0); PG8_MMA(1, 0, At, B0); PG8_BAR; PG8_SCHED;
            PG8_STAGE(PG8_SB(0, 1), b2 + hstep, voffB);
            WAIT_VM(6); PG8_BAR; PG8_MMA(1, 1, At, B1); PG8_BAR;
            PG8_LDB(B0, 1, 0); PG8_SCHED; PG8_LDA(At, 1, 0); PG8_STAGE(PG8_SA(0, 1), a2 + hstep, voffA);
            WAIT_LGKM(8); PG8_BAR; WAIT_LGKM(0); PG8_MMA(0, 0, At, B0); PG8_BAR; PG8_SCHED;
            PG8_LDB(B1, 1, 1); PG8_STAGE(PG8_SB(1, 0), b3, voffB);
            PG8_BAR; WAIT_LGKM(0); PG8_MMA(0, 1, At, B1); PG8_BAR;
            PG8_LDA(At, 1, 1); PG8_STAGE(PG8_SA(1, 0), a3, voffA);
            PG8_BAR; WAIT_LGKM(0); PG8_MMA(1, 0, At, B0); PG8_BAR; PG8_SCHED;
            PG8_STAGE(PG8_SB(1, 1), b3 + hstep, voffB);
            WAIT_VM(6); PG8_BAR; PG8_MMA(1, 1, At, B1); PG8_BAR;
        }
        if (Epi::F8) MFMA_SETTLE();
        E(acc, cur, wr, wc, fr, fq); S.done(cur);
        if (!has_next) break;
#pragma unroll
        for (int a = 0; a < 2; ++a)
#pragma unroll
            for (int b = 0; b < 2; ++b)
#pragma unroll
                for (int m = 0; m < 4; ++m)
#pragma unroll
                    for (int n = 0; n < 2; ++n) acc[a][b][m][n] = (f32x4){0.f, 0.f, 0.f, 0.f};
        cur = nxt; cA = nA; cB = nB; ++ui;
    }
    WAIT_VM(0);
    if (wr == 0) PG8_BAR;
    PG8_BAR;
#undef PG8_SA
#undef PG8_SB
#undef PG8_STAGE
#undef PG8_LDA
#undef PG8_LDB
#undef PG8_MMA
#undef PG8_CAT
#undef PG8_LD16
#undef PG8_BAR
#undef PG8_SCHED
}
}

constexpr int LDS_BYTES = 147456;
constexpr int LDS_MISC = LDS_BYTES - 64;
constexpr int TP = 136;
constexpr int TILE_B = 128 * TP * 2;

struct Args { const float* in[44]; float* out; unsigned char* ws; int ph_lo, ph_hi; };

enum InIdx { I_X = 0, I_C, I_CTX, I_CCTX, I_ADAW, I_ADAB, I_ABWIN, I_HYCW, I_HYCB, I_HYW1, I_HYB1, I_HYW2, I_HYB2, I_HYW3, I_HYFREQ, I_HYBIAS,
             I_MLCW, I_MLCB, I_MLGB, I_MLNW, I_ABWOUT, I_FFNGU, I_FFNDN, I_CDWIN, I_SSDCW, I_SSDCB, I_SSDALOG, I_SSDDTB, I_SSDD, I_SSDNW,
             I_S5LRE, I_S5LIM, I_S5LDT, I_S5BRE, I_S5BIM, I_S5CRE, I_S5CIM, I_S5D, I_S5GLU, I_CDWOUT, I_ROUTER, I_MOEGU, I_MOEDN, I_FNW };

struct Frame {
    LAS unsigned char* lds; int tid, lane, wave, G, bid;
    const float* const* in; float* out; unsigned char* ws;
    __device__ __forceinline__ int gw() const { return bid * NWAVES + wave; }
    __device__ __forceinline__ int ngw() const { return G * NWAVES; }
    template <class T> __device__ __forceinline__ T* wsp(size_t off) const { return (T*)(ws + off); }
};

__device__ __forceinline__ int mod_row(int m) { return m < ML ? m / SEQ : NB; }

struct EpiStoreBf16 {
    static constexpr bool PERM = true, F8 = false, I8 = false;
    bf16_t* O; int ldc;
    __device__ __forceinline__ void operator()(const f32x4 (&acc)[2][2][4][2], const pg8::Unit& u, int wr, int wc, int fr, int fq) const {
        const int row0 = u.pm * 256 + wr * 64 + fr, col0 = u.pn * 256 + wc * 32 + 8 * fq;
#pragma unroll
        for (int ai = 0; ai < 2; ++ai)
#pragma unroll
            for (int m = 0; m < 4; ++m) { bf16_t* rowp = O + (size_t)(row0 + ai * 128 + m * 16) * ldc + col0;
#pragma unroll
                for (int bj = 0; bj < 2; ++bj) { const f32x4 v0 = acc[ai][bj][m][0], v1 = acc[ai][bj][m][1];
                    u32x4 w; w.x = cvt_pk_bf16(v0[0], v0[1]); w.y = cvt_pk_bf16(v0[2], v0[3]); w.z = cvt_pk_bf16(v1[0], v1[1]); w.w = cvt_pk_bf16(v1[2], v1[3]);
                    *(u32x4*)(rowp + bj * 128) = w; } }
    }
};
struct EpiInProj0 {
    static constexpr bool PERM = true, F8 = false, I8 = false;
    bf16_t* O; int ldc; bf16_t* PH;
    __device__ __forceinline__ void operator()(const f32x4 (&acc)[2][2][4][2], const pg8::Unit& u, int wr, int wc, int fr, int fq) const {
        const int row0 = u.pm * 256 + wr * 64 + fr, col0 = u.pn * 256 + wc * 32 + 8 * fq;
        if (u.pn * 256 < 3 * HYD) {
#pragma unroll
            for (int ai = 0; ai < 2; ++ai)
#pragma unroll
                for (int m = 0; m < 4; ++m) { const int row = row0 + ai * 128 + m * 16;
#pragma unroll
                    for (int bj = 0; bj < 2; ++bj) { const f32x4 v0 = acc[ai][bj][m][0], v1 = acc[ai][bj][m][1]; const int c = col0 + bj * 128;
                        u32x2 a, b; a.x = cvt_pk_bf16(v0[0], v0[1]); a.y = cvt_pk_bf16(v0[2], v0[3]); b.x = cvt_pk_bf16(v1[0], v1[1]); b.y = cvt_pk_bf16(v1[2], v1[3]);
                        *(u32x2*)(PH + ((size_t)(c >> 2) * MT + row) * 4) = a; *(u32x2*)(PH + ((size_t)((c >> 2) + 1) * MT + row) * 4) = b; } }
        } else {
#pragma unroll
            for (int ai = 0; ai < 2; ++ai)
#pragma unroll
                for (int m = 0; m < 4; ++m) { bf16_t* rowp = O + (size_t)(row0 + ai * 128 + m * 16) * ldc + col0;
#pragma unroll
                    for (int bj = 0; bj < 2; ++bj) { const f32x4 v0 = acc[ai][bj][m][0], v1 = acc[ai][bj][m][1];
                        u32x4 w; w.x = cvt_pk_bf16(v0[0], v0[1]); w.y = cvt_pk_bf16(v0[2], v0[3]); w.z = cvt_pk_bf16(v1[0], v1[1]); w.w = cvt_pk_bf16(v1[2], v1[3]);
                        *(u32x4*)(rowp + bj * 128) = w; } }
        }
    }
};
struct EpiResid {
    static constexpr bool PERM = false, F8 = false, I8 = false;
    const float* xlat; const float* xctx; float* XL; const float* gate;
    __device__ __forceinline__ void operator()(const f32x4 (&acc)[2][2][4][2], const pg8::Unit& u, int wr, int wc, int fr, int fq) const {
        const int row0 = u.pm * 256 + wr * 64 + fr, col0 = u.pn * 256 + wc * 32 + 4 * fq;
#pragma unroll
        for (int ai = 0; ai < 2; ++ai)
#pragma unroll
            for (int m = 0; m < 4; ++m) { const int row = row0 + ai * 128 + m * 16; const int r = mod_row(row);
                const float* src = row < ML ? xlat + (size_t)row * D : xctx + (size_t)(row - ML) * D; float* dst = XL + (size_t)row * D; const float* gp = gate + (size_t)r * 6 * D;
#pragma unroll
                for (int bj = 0; bj < 2; ++bj)
#pragma unroll
                    for (int n = 0; n < 2; ++n) { const int col = col0 + bj * 128 + n * 16; const f32x4 gv = *(const f32x4*)(gp + col); const f32x4 xv = *(const f32x4*)(src + col);
                        *(f32x4*)(dst + col) = xv + gv * acc[ai][bj][m][n]; } }
    }
};
struct EpiResidSplit {
    static constexpr bool PERM = false, F8 = false, I8 = false;
    const float* xlat; float* XL; const float* gate; float* part; int kq;
    __device__ __forceinline__ void operator()(const f32x4 (&acc)[2][2][4][2], const pg8::Unit& u, int wr, int wc, int fr, int fq) const {
        const int row0 = u.pm * 256 + wr * 64 + fr, col0 = u.pn * 256 + wc * 32 + 4 * fq;
        if (u.pm * 256 < ML) {
#pragma unroll
            for (int ai = 0; ai < 2; ++ai)
#pragma unroll
                for (int m = 0; m < 4; ++m) { const int row = row0 + ai * 128 + m * 16; const float* src = xlat + (size_t)row * D; float* dst = XL + (size_t)row * D; const float* gp = gate + (size_t)(row / SEQ) * 6 * D;
#pragma unroll
                    for (int bj = 0; bj < 2; ++bj)
#pragma unroll
                        for (int n = 0; n < 2; ++n) { const int col = col0 + bj * 128 + n * 16; const f32x4 gv = *(const f32x4*)(gp + col); const f32x4 xv = *(const f32x4*)(src + col);
                            *(f32x4*)(dst + col) = xv + gv * acc[ai][bj][m][n]; } }
        } else {
            float* pb = part + (size_t)(u.k0 / kq) * MC * D;
#pragma unroll
            for (int ai = 0; ai < 2; ++ai)
#pragma unroll
                for (int m = 0; m < 4; ++m) { float* dst = pb + (size_t)(row0 + ai * 128 + m * 16 - ML) * D;
#pragma unroll
                    for (int bj = 0; bj < 2; ++bj)
#pragma unroll
                        for (int n = 0; n < 2; ++n) *(f32x4*)(dst + col0 + bj * 128 + n * 16) = acc[ai][bj][m][n]; }
        }
    }
};
struct EpiResidSplitF8 {
    static constexpr bool PERM = false, F8 = true, I8 = false;
    const float* xlat; float* XL; const float* gate; float* part; int kq;
    __device__ __forceinline__ void operator()(const f32x4 (&acc)[2][2][4][2], const pg8::Unit& u, int wr, int wc, int fr, int fq) const {
        const int row0 = u.pm * 256 + wr * 64 + fr, col0 = u.pn * 256 + wc * 32 + 4 * fq;
        if (u.pm * 256 < ML) {
#pragma unroll
            for (int ai = 0; ai < 2; ++ai)
#pragma unroll
                for (int m = 0; m < 4; ++m) { const int row = row0 + ai * 128 + m * 16; const float* src = xlat + (size_t)row * D; float* dst = XL + (size_t)row * D; const float* gp = gate + (size_t)(row / SEQ) * 6 * D;
#pragma unroll
                    for (int bj = 0; bj < 2; ++bj)
#pragma unroll
                        for (int n = 0; n < 2; ++n) { const int col = col0 + bj * 128 + n * 16; const f32x4 gv = *(const f32x4*)(gp + col); const f32x4 xv = *(const f32x4*)(src + col);
                            *(f32x4*)(dst + col) = xv + gv * (acc[ai][bj][m][n] * W8INV); } }
        } else {
            float* pb = part + (size_t)(u.k0 / kq) * MC * D;
#pragma unroll
            for (int ai = 0; ai < 2; ++ai)
#pragma unroll
                for (int m = 0; m < 4; ++m) { float* dst = pb + (size_t)(row0 + ai * 128 + m * 16 - ML) * D;
#pragma unroll
                    for (int bj = 0; bj < 2; ++bj)
#pragma unroll
                        for (int n = 0; n < 2; ++n) *(f32x4*)(dst + col0 + bj * 128 + n * 16) = acc[ai][bj][m][n] * W8INV; }
        }
    }
};
struct CtxSplitOrder {
    static constexpr bool SPLITK = true;
    pg8::StaticOrder so; int nN, KS, ntfull, NCU, G, c;
    __device__ __forceinline__ void init(int N, int K, int KS_, int G_, int c_) { so.init(ML, N, G_, c_); nN = N / 256; KS = KS_; ntfull = K / 64; NCU = (MC / 256) * nN * KS_; G = G_; c = c_; }
    __device__ __forceinline__ bool next(int i, pg8::Unit& u) const {
        const long L = (long)i * G + c; const int nwg = so.nwg; if (L >= (long)nwg + NCU) return false;
        int pm, pn, k0, ntu;
        if (L < nwg) { int wgid = (int)L; { const int q = nwg / pg8::NXCD, r = nwg % pg8::NXCD, xcd = wgid % pg8::NXCD, off = wgid / pg8::NXCD; wgid = (xcd < r ? xcd * (q + 1) : r * (q + 1) + (xcd - r) * q) + off; }
            const int nig = pg8::WGM * so.nN, gid = wgid / nig, fm = gid * pg8::WGM, gsz = (so.nM - fm) < pg8::WGM ? (so.nM - fm) : pg8::WGM;
            pm = fm + ((wgid % nig) % gsz); pn = (wgid % nig) / gsz; k0 = 0; ntu = ntfull; }
        else { const int sub = (int)(L - nwg), ks = sub % KS, t = sub / KS; pm = ML / 256 + t / nN; pn = t % nN; ntu = ntfull / KS; k0 = ks * ntu * 64; }
        u.pm = pm; u.pn = pn; u.k0 = k0; u.nt = ntu; return true;
    }
    __device__ __forceinline__ void a_ready(const pg8::Unit&) const {}
    __device__ __forceinline__ void done(const pg8::Unit&) const {}
};
template <int MODE> struct EpiGated {
    static constexpr bool PERM = true, F8 = false, I8 = false;
    bf16_t* O; int ldc; int col_base; int ntn;
    __device__ __forceinline__ void operator()(const f32x4 (&acc)[2][2][4][2], const pg8::Unit& u, int wr, int wc, int fr, int fq) const {
        const int row0 = u.pm * 256 + wr * 64 + fr, col0 = col_base + (u.pn % ntn) * 128 + wc * 32 + 8 * fq;
#pragma unroll
        for (int ai = 0; ai < 2; ++ai)
#pragma unroll
            for (int m = 0; m < 4; ++m) { bf16_t* rowp = O + (size_t)(row0 + ai * 128 + m * 16) * ldc + col0;
                float o[8];
#pragma unroll
                for (int n = 0; n < 2; ++n)
#pragma unroll
                    for (int j = 0; j < 4; ++j) { const float a = acc[ai][0][m][n][j], b = acc[ai][1][m][n][j];
                        o[n * 4 + j] = MODE == 0 ? (a / (1.0f + FEXP(-a))) * b : a / (1.0f + FEXP(-b)); }
                u32x4 w; w.x = cvt_pk_bf16(o[0], o[1]); w.y = cvt_pk_bf16(o[2], o[3]); w.z = cvt_pk_bf16(o[4], o[5]); w.w = cvt_pk_bf16(o[6], o[7]);
                if (O != nullptr) *(u32x4*)rowp = w; }
    }
};
struct EpiGatedI8 {
    static constexpr bool PERM = true, F8 = false, I8 = true;
    bf16_t* O; int ldc; const float* sa; const float* sb;
    __device__ __forceinline__ void operator()(const f32x4 (&acc)[2][2][4][2], const pg8::Unit& u, int wr, int wc, int fr, int fq) const {
        const int row0 = u.pm * 256 + wr * 64 + fr, c0 = wc * 32 + 8 * fq;
        const f32x4 sga = *(const f32x4*)(sb + u.pn * 256 + c0), sgb = *(const f32x4*)(sb + u.pn * 256 + c0 + 4), sua = *(const f32x4*)(sb + u.pn * 256 + 128 + c0), sub = *(const f32x4*)(sb + u.pn * 256 + 128 + c0 + 4);
#pragma unroll
        for (int ai = 0; ai < 2; ++ai)
#pragma unroll
            for (int m = 0; m < 4; ++m) { const int row = row0 + ai * 128 + m * 16; const float sr = sa[row]; bf16_t* rowp = O + (size_t)row * ldc + u.pn * 128 + c0;
                float o[8];
#pragma unroll
                for (int n = 0; n < 2; ++n)
#pragma unroll
                    for (int j = 0; j < 4; ++j) { const i32x4 ig = __builtin_bit_cast(i32x4, acc[ai][0][m][n]), iu = __builtin_bit_cast(i32x4, acc[ai][1][m][n]);
                        const float a = (float)ig[j] * sr * (n ? sgb[j] : sga[j]), b = (float)iu[j] * sr * (n ? sub[j] : sua[j]); o[n * 4 + j] = a * FRCP(1.0f + FEXP(-a)) * b; }
                u32x4 w; w.x = cvt_pk_bf16(o[0], o[1]); w.y = cvt_pk_bf16(o[2], o[3]); w.z = cvt_pk_bf16(o[4], o[5]); w.w = cvt_pk_bf16(o[6], o[7]);
                *(u32x4*)rowp = w; }
    }
};
struct EpiGatedI8F8 {
    static constexpr bool PERM = true, F8 = false, I8 = true;
    unsigned char* O; int ldc; const float* sa; const float* sb;
    __device__ __forceinline__ void operator()(const f32x4 (&acc)[2][2][4][2], const pg8::Unit& u, int wr, int wc, int fr, int fq) const {
        const int row0 = u.pm * 256 + wr * 64 + fr, c0 = wc * 32 + 8 * fq;
        const f32x4 sga = *(const f32x4*)(sb + u.pn * 256 + c0), sgb = *(const f32x4*)(sb + u.pn * 256 + c0 + 4), sua = *(const f32x4*)(sb + u.pn * 256 + 128 + c0), sub = *(const f32x4*)(sb + u.pn * 256 + 128 + c0 + 4);
#pragma unroll
        for (int ai = 0; ai < 2; ++ai)
#pragma unroll
            for (int m = 0; m < 4; ++m) { const int row = row0 + ai * 128 + m * 16; const float sr = sa[row]; unsigned char* rowp = O + (size_t)row * ldc + u.pn * 128 + c0;
                float o[8];
#pragma unroll
                for (int n = 0; n < 2; ++n)
#pragma unroll
                    for (int j = 0; j < 4; ++j) { const i32x4 ig = __builtin_bit_cast(i32x4, acc[ai][0][m][n]), iu = __builtin_bit_cast(i32x4, acc[ai][1][m][n]);
                        const float a = (float)ig[j] * sr * (n ? sgb[j] : sga[j]), b = (float)iu[j] * sr * (n ? sub[j] : sua[j]); o[n * 4 + j] = a * FRCP(1.0f + FEXP(-a)) * b; }
                u32x2 w; w.x = cvt_pk_fp8x4(o[0], o[1], o[2], o[3]); w.y = cvt_pk_fp8x4(o[4], o[5], o[6], o[7]);
                *(u32x2*)rowp = w; }
    }
};
struct EpiGatedF8 {
    static constexpr bool PERM = true, F8 = true, I8 = false;
    unsigned char* O; int ldc; int ntn;
    __device__ __forceinline__ void operator()(const f32x4 (&acc)[2][2][4][2], const pg8::Unit& u, int wr, int wc, int fr, int fq) const {
        const int row0 = u.pm * 256 + wr * 64 + fr, col0 = (u.pn % ntn) * 128 + wc * 32 + 8 * fq;
#pragma unroll
        for (int ai = 0; ai < 2; ++ai)
#pragma unroll
            for (int m = 0; m < 4; ++m) { unsigned char* rowp = O + (size_t)(row0 + ai * 128 + m * 16) * ldc + col0;
                float o[8];
#pragma unroll
                for (int n = 0; n < 2; ++n)
#pragma unroll
                    for (int j = 0; j < 4; ++j) { const float a = acc[ai][0][m][n][j] * W8INV, b = acc[ai][1][m][n][j] * W8INV; o[n * 4 + j] = a * FRCP(1.0f + FEXP(-a)) * b; }
                u32x2 w; w.x = cvt_pk_fp8x4(o[0], o[1], o[2], o[3]); w.y = cvt_pk_fp8x4(o[4], o[5], o[6], o[7]);
                *(u32x2*)rowp = w; }
    }
};
struct EpiMoeDown {
    static constexpr bool PERM = false, F8 = false, I8 = false;
    const int* rowmap; const float* rowp; float* yslot; int ntn;
    __device__ __forceinline__ void operator()(const f32x4 (&acc)[2][2][4][2], const pg8::Unit& u, int wr, int wc, int fr, int fq) const {
        const int row0 = u.pm * 256 + wr * 64 + fr, col0 = (u.pn % ntn) * 256 + wc * 32 + 4 * fq;
#pragma unroll
        for (int ai = 0; ai < 2; ++ai)
#pragma unroll
            for (int m = 0; m < 4; ++m) { const int row = row0 + ai * 128 + m * 16; const int rm = rowmap[row]; if (rm < 0) continue; const float p = rowp[row];
                float* dst = yslot + ((size_t)(rm & 1) * ML + (size_t)(rm >> 1)) * D;
#pragma unroll
                for (int bj = 0; bj < 2; ++bj)
#pragma unroll
                    for (int n = 0; n < 2; ++n) { const int col = col0 + bj * 128 + n * 16; *(f32x4*)(dst + col) = acc[ai][bj][m][n] * p; } }
    }
};
__device__ __forceinline__ void moe_down_split(int npan, int& nfull, int& ks) { nfull = (npan / 32) * 32; const int lo = npan - nfull; ks = (lo == 0 || lo > 16 || KSF8 == 1) ? 1 : 2; if (ks == 1) nfull = npan; }
struct EpiMoeDownSplit {
    static constexpr bool PERM = false, F8 = true, I8 = false;
    const int* rowmap; const float* rowp; bf16_t* yslot; float* partm; int ntn, row_split, kq; float osc;
    __device__ __forceinline__ void operator()(const f32x4 (&acc)[2][2][4][2], const pg8::Unit& u, int wr, int wc, int fr, int fq) const {
        const int row0 = u.pm * 256 + wr * 64 + fr, col0 = (u.pn % ntn) * 256 + wc * 32 + 4 * fq;
        if (u.pm * 256 < row_split) {
#pragma unroll
            for (int ai = 0; ai < 2; ++ai)
#pragma unroll
                for (int m = 0; m < 4; ++m) { const int row = row0 + ai * 128 + m * 16; const int rm = rowmap[row]; if (rm < 0) continue; const float p = rowp[row] * osc;
                    bf16_t* dst = yslot + ((size_t)(rm & 1) * ML + (size_t)(rm >> 1)) * D;
#pragma unroll
                    for (int bj = 0; bj < 2; ++bj)
#pragma unroll
                        for (int n = 0; n < 2; ++n) { const int col = col0 + bj * 128 + n * 16; const f32x4 v = acc[ai][bj][m][n] * p; u32x2 w; w.x = cvt_pk_bf16(v[0], v[1]); w.y = cvt_pk_bf16(v[2], v[3]); *(u32x2*)(dst + col) = w; } }
        } else {
            float* pb = partm + (size_t)(u.k0 / kq) * PM_ROWS * D;
#pragma unroll
            for (int ai = 0; ai < 2; ++ai)
#pragma unroll
                for (int m = 0; m < 4; ++m) { float* dst = pb + (size_t)(row0 + ai * 128 + m * 16 - row_split) * D;
#pragma unroll
                    for (int bj = 0; bj < 2; ++bj)
#pragma unroll
                        for (int n = 0; n < 2; ++n) *(f32x4*)(dst + col0 + bj * 128 + n * 16) = acc[ai][bj][m][n] * osc; }
        }
    }
};
struct MoeOrder {
    static constexpr bool SPLITK = false;
    int npan, ntn, G, c; int p1, p2, p3, p4, p5, p6, p7;
    __device__ __forceinline__ void init(const Frame& F, int ntn_) {
        const unsigned* cnt = F.wsp<unsigned>(WS_CTL) + CW_CNT; int o = 0;
        o += (int)((cnt[0] + 255u) >> 8); p1 = o; o += (int)((cnt[64] + 255u) >> 8); p2 = o; o += (int)((cnt[128] + 255u) >> 8); p3 = o; o += (int)((cnt[192] + 255u) >> 8); p4 = o;
        o += (int)((cnt[256] + 255u) >> 8); p5 = o; o += (int)((cnt[320] + 255u) >> 8); p6 = o; o += (int)((cnt[384] + 255u) >> 8); p7 = o; o += (int)((cnt[448] + 255u) >> 8); npan = o;
        ntn = ntn_; G = F.G; c = F.bid; }
    __device__ __forceinline__ bool next(int i, pg8::Unit& u) const {
        long f; if ((G & 7) == 0) { const int per = G >> 3; f = ((long)i * 8 + (c & 7)) * per + (c >> 3); } else f = (long)i * G + c;
        if (f >= (long)npan * ntn) return false;
        const int fi = (int)f; const int q1 = p1 * ntn, q2 = p2 * ntn, q3 = p3 * ntn, q4 = p4 * ntn, q5 = p5 * ntn, q6 = p6 * ntn, q7 = p7 * ntn;
        const int e = (fi >= q1) + (fi >= q2) + (fi >= q3) + (fi >= q4) + (fi >= q5) + (fi >= q6) + (fi >= q7);
        const int pb = e == 0 ? 0 : e == 1 ? p1 : e == 2 ? p2 : e == 3 ? p3 : e == 4 ? p4 : e == 5 ? p5 : e == 6 ? p6 : p7;
        const int pe = e == 0 ? p1 : e == 1 ? p2 : e == 2 ? p3 : e == 3 ? p4 : e == 4 ? p5 : e == 5 ? p6 : e == 6 ? p7 : npan;
        const int gw = (ntn & 3) == 0 ? 4 : ((ntn & 1) == 0 ? 2 : 1);
        const int np = pe - pb, r = fi - pb * ntn, gsz = np * gw, tg = r / gsz, rr = r % gsz;
        u.pm = pb + rr / gw; u.pn = e * ntn + tg * gw + rr % gw; u.k0 = 0; u.nt = 0; return true;
    }
    __device__ __forceinline__ void a_ready(const pg8::Unit&) const {}
    __device__ __forceinline__ void done(const pg8::Unit&) const {}
};

struct MoeDownOrder {
    static constexpr bool SPLITK = true;
    MoeOrder mo; int nfull, KS, ntfull;
    __device__ __forceinline__ void init(const Frame& F, int ntn_, int K) { mo.init(F, ntn_); ntfull = K / 64; moe_down_split(mo.npan, nfull, KS); }
    __device__ __forceinline__ bool next(int i, pg8::Unit& u) const {
        const long L = (long)i * mo.G + mo.c; const long nnorm = (long)nfull * mo.ntn; if (L >= nnorm + (long)(mo.npan - nfull) * mo.ntn * KS) return false;
        int pm, pn, k0, ntu;
        if (L < nnorm) { pm = (int)(L / mo.ntn); pn = (int)(L % mo.ntn); k0 = 0; ntu = ntfull; }
        else { const int sub = (int)(L - nnorm), ks = sub % KS, t = sub / KS; pm = nfull + t / mo.ntn; pn = t % mo.ntn; ntu = ntfull / KS; k0 = ks * ntu * 64; }
        const int e = (pm >= mo.p1) + (pm >= mo.p2) + (pm >= mo.p3) + (pm >= mo.p4) + (pm >= mo.p5) + (pm >= mo.p6) + (pm >= mo.p7);
        u.pm = pm; u.pn = e * mo.ntn + pn; u.k0 = k0; u.nt = ntu; return true;
    }
    __device__ __forceinline__ void a_ready(const pg8::Unit&) const {}
    __device__ __forceinline__ void done(const pg8::Unit&) const {}
};

template <int MTN, int NTN, int KS>
__device__ __forceinline__ void wave_mma(f32x4 (&acc)[MTN][NTN], const LAS bf16_t* A, int rowA0, const LAS bf16_t* B, int rowB0, int lane) {
    const int r = lane & 15, q = lane >> 4;
#pragma unroll
    for (int ks = 0; ks < KS; ++ks) {
        bf16x8 a[MTN], b[NTN];
#pragma unroll
        for (int mt = 0; mt < MTN; ++mt) a[mt] = *(const LAS bf16x8*)(A + (rowA0 + 16 * mt + r) * TP + ks * 32 + q * 8);
#pragma unroll
        for (int nt = 0; nt < NTN; ++nt) b[nt] = *(const LAS bf16x8*)(B + (rowB0 + 16 * nt + r) * TP + ks * 32 + q * 8);
#pragma unroll
        for (int mt = 0; mt < MTN; ++mt)
#pragma unroll
            for (int nt = 0; nt < NTN; ++nt) acc[mt][nt] = MFMA16(a[mt], b[nt], acc[mt][nt]);
    }
}
template <int MTN, int NTN> __device__ __forceinline__ void zero_acc(f32x4 (&acc)[MTN][NTN]) {
#pragma unroll
    for (int a = 0; a < MTN; ++a)
#pragma unroll
        for (int b = 0; b < NTN; ++b) acc[a][b] = (f32x4){0.f, 0.f, 0.f, 0.f};
}

template <bool MAXOP> __device__ __forceinline__ void wave_scan128(const LAS float* a, LAS float* out, bool rev, int lane) {
    const int i0 = rev ? CH - 1 - 2 * lane : 2 * lane, i1 = rev ? i0 - 1 : i0 + 1;
    const float x0 = a[i0], x1 = a[i1]; float s = MAXOP ? fmaxf(x0, x1) : x0 + x1;
#pragma unroll
    for (int off = 1; off < 64; off <<= 1) { const float t = __shfl_up(s, off); if (lane >= off) s = MAXOP ? fmaxf(s, t) : s + t; }
    float prev = __shfl_up(s, 1); if (lane == 0) prev = MAXOP ? -INFINITY : 0.f;
    out[i0] = MAXOP ? fmaxf(prev, x0) : prev + x0; out[i1] = s;
}
__device__ __forceinline__ void conv3x8(const bf16_t* base, int ld, bool has_l, bool has_r, const float* w, int wld, const float* b, float (&o)[8]) {
    float xc[8], xl[8], xr[8];
    unpack8(*(const u32x4*)base, xc);
    if (has_l) unpack8(*(const u32x4*)(base - ld), xl); else {
#pragma unroll
        for (int j = 0; j < 8; ++j) xl[j] = 0.f; }
    if (has_r) unpack8(*(const u32x4*)(base + ld), xr); else {
#pragma unroll
        for (int j = 0; j < 8; ++j) xr[j] = 0.f; }
    const f32x4 w0a = *(const f32x4*)(w), w0b = *(const f32x4*)(w + 4), w1a = *(const f32x4*)(w + wld), w1b = *(const f32x4*)(w + wld + 4), w2a = *(const f32x4*)(w + 2 * wld), w2b = *(const f32x4*)(w + 2 * wld + 4);
    const f32x4 ba = *(const f32x4*)(b), bb = *(const f32x4*)(b + 4);
#pragma unroll
    for (int j = 0; j < 4; ++j) { o[j] = ba[j] + w0a[j] * xl[j] + w1a[j] * xc[j] + w2a[j] * xr[j]; o[4 + j] = bb[j] + w0b[j] * xl[4 + j] + w1b[j] * xc[4 + j] + w2b[j] * xr[4 + j]; }
}
__device__ __forceinline__ void conv_nbr(int cs, int s, bool& has_l, bool& has_r) {
    if (cs < NCC) { const int pos = cs * CH + s; has_l = pos > 0; has_r = pos < CTX - 1; }
    else { has_l = (s & (GW - 1)) != 0; has_r = (s & (GW - 1)) != GW - 1; }
}
__device__ __forceinline__ int chunk_row0(int b, int cs) { return cs < NCC ? ML + b * CTX + cs * CH : b * SEQ + (cs - NCC) * CH; }
__device__ __forceinline__ int scan_slot(int d, int q) { return d == 0 ? q : (q < NCC ? NCC - 1 - q : NCS - 1 - (q - NCC)); }

template <int MAP> __device__ __forceinline__ int conv_src_col(int nb, int half) {
    if (MAP == 0) return nb * 128;
    if (MAP == 1) return (nb & 1) * half + (nb >> 1) * 128;
    return nb * 128 < SSDD + XBC ? nb * 128 : nb * 128 + CD_SIDE;
}
template <int MAP> __device__ __forceinline__ void conv_job(const Frame& F, int& base, const float* src, int ld, bf16_t* dst, int K, int nblk, int half) {
    constexpr int PB = 264;
    const int ntile = nblk * (K / 128);
    const int n = F.tid & 127, kq = F.tid >> 7;
    int t = (F.bid - base % F.G + F.G) % F.G;
    base += ntile;
    f32x4 v[8];
    const unsigned ldb = (unsigned)ld * 4u, lane_off = (unsigned)n * 4u + (unsigned)(4 * kq) * ldb;
#define CONV_LOAD(tt) do { const int nb_ = (tt) % nblk, kb_ = (tt) / nblk; const char* sp_ = (const char*)(src + (size_t)(kb_ * 128) * ld + conv_src_col<MAP>(nb_, half)); \
        _Pragma("unroll") for (int i_ = 0; i_ < 8; ++i_) { const unsigned o_ = lane_off + (unsigned)(16 * i_) * ldb; \
            v[i_][0] = NTLD((const float*)(sp_ + o_)); v[i_][1] = NTLD((const float*)(sp_ + o_ + ldb)); v[i_][2] = NTLD((const float*)(sp_ + o_ + 2u * ldb)); v[i_][3] = NTLD((const float*)(sp_ + o_ + 3u * ldb)); } } while (0)
    if (t < ntile) CONV_LOAD(t);
    while (t < ntile) {
#pragma unroll
        for (int i = 0; i < 8; ++i) { u32x2 w; w.x = pk2(v[i][0], v[i][1]); w.y = pk2(v[i][2], v[i][3]); *(LAS u32x2*)(F.lds + n * PB + (kq + 4 * i) * 8) = w; }
        const int tn = t + F.G;
        if (tn < ntile) CONV_LOAD(tn);
        __syncthreads();
        const int nb = t % nblk, kb = t / nblk;
#pragma unroll
        for (int i = 0; i < 4; ++i) { const int ch = F.tid + 512 * i, nn = ch >> 4, kc = ch & 15;
            const u32x2 a = *(const LAS u32x2*)(F.lds + nn * PB + kc * 16), b = *(const LAS u32x2*)(F.lds + nn * PB + kc * 16 + 8);
            u32x4 w; w.x = a.x; w.y = a.y; w.z = b.x; w.w = b.y;
            *(u32x4*)(dst + (size_t)(nb * 128 + nn) * K + kb * 128 + kc * 8) = w; }
        __syncthreads();
        t = tn;
    }
#undef CONV_LOAD
}
constexpr int MQ_TGU = (2 * FF / 128) * (D / 128), MQ_TDN = (D / 128) * (FF / 128), MQ_NT = NE * (MQ_TGU + MQ_TDN);
struct MoeTile { const char* sp; unsigned char* dp; unsigned ldb; int K; };
__device__ __forceinline__ MoeTile moe_tile(const Frame& F, int t) {
    MoeTile m;
    if (t < NE * MQ_TGU) { const int e = t / MQ_TGU, r = t % MQ_TGU, nb = r % (2 * FF / 128), kb = r / (2 * FF / 128);
        m.sp = (const char*)(F.in[I_MOEGU] + (size_t)e * D * 2 * FF + (size_t)(kb * 128) * (2 * FF) + (nb & 1) * FF + (nb >> 1) * 128); m.ldb = 2u * FF * 4u;
        m.dp = F.wsp<unsigned char>(WS_W_MGU) + (size_t)e * 2 * FF * D + (size_t)(nb * 128) * D + kb * 128; m.K = D; }
    else { const int tt = t - NE * MQ_TGU, e = tt / MQ_TDN, r = tt % MQ_TDN, nb = r % (D / 128), kb = r / (D / 128);
        m.sp = (const char*)(F.in[I_MOEDN] + (size_t)e * FF * D + (size_t)(kb * 128) * D + nb * 128); m.ldb = (unsigned)D * 4u;
        m.dp = F.wsp<unsigned char>(WS_W_MDN) + (size_t)e * D * FF + (size_t)(nb * 128) * FF + kb * 128; m.K = FF; }
    return m;
}
#define MQ_LOAD(m, v) do { const unsigned lo_ = (unsigned)(F.tid & 127) * 4u + (unsigned)(4 * (F.tid >> 7)) * (m).ldb; \
        _Pragma("unroll") for (int i_ = 0; i_ < 8; ++i_) { const unsigned o_ = lo_ + (unsigned)(16 * i_) * (m).ldb; \
            v[i_][0] = NTLD((const float*)((m).sp + o_)); v[i_][1] = NTLD((const float*)((m).sp + o_ + (m).ldb)); v[i_][2] = NTLD((const float*)((m).sp + o_ + 2u * (m).ldb)); v[i_][3] = NTLD((const float*)((m).sp + o_ + 3u * (m).ldb)); } } while (0)
#define MQ_TOLDS(v) do { _Pragma("unroll") for (int i_ = 0; i_ < 8; ++i_) *(LAS unsigned*)(F.lds + (F.tid & 127) * 132 + ((F.tid >> 7) + 4 * i_) * 4) = \
        cvt_pk_fp8x4(v[i_][0] * W8SCALE, v[i_][1] * W8SCALE, v[i_][2] * W8SCALE, v[i_][3] * W8SCALE); } while (0)
#define MQ_STORE(m) do { _Pragma("unroll") for (int i_ = 0; i_ < 2; ++i_) { const int ch_ = F.tid + 512 * i_, nn_ = ch_ >> 3, kc_ = ch_ & 7; const LAS unsigned* lp_ = (const LAS unsigned*)(F.lds + nn_ * 132 + kc_ * 16); \
        u32x4 w_; w_.x = lp_[0]; w_.y = lp_[1]; w_.z = lp_[2]; w_.w = lp_[3]; NTST(w_, (u32x4*)((m).dp + (size_t)nn_ * (m).K + kc_ * 16)); } } while (0)
__device__ __forceinline__ void conv_job_f8(const Frame& F, int& base, const float* src, int ld, unsigned char* dst, int K, int nblk) {
    const int ntile = nblk * (K / 128);
    int t = (F.bid - base % F.G + F.G) % F.G; base += ntile;
    f32x4 v[8]; MoeTile m, mn;
    __syncthreads();
#define CF8_TILE(mm, tt) do { const int nb_ = (tt) % nblk, kb_ = (tt) / nblk; (mm).sp = (const char*)(src + (size_t)(kb_ * 128) * ld + nb_ * 128); (mm).ldb = (unsigned)ld * 4u; (mm).dp = dst + (size_t)(nb_ * 128) * K + kb_ * 128; (mm).K = K; } while (0)
    if (t < ntile) { CF8_TILE(m, t); MQ_LOAD(m, v); }
    while (t < ntile) {
        MQ_TOLDS(v);
        const int tn = t + F.G; mn = m;
        if (tn < ntile) { CF8_TILE(mn, tn); MQ_LOAD(mn, v); }
        __syncthreads();
        MQ_STORE(m);
        __syncthreads();
        m = mn; t = tn;
    }
#undef CF8_TILE
}
__device__ __forceinline__ void moe_convert_strided(const Frame& F, int t0, int t1, int st) {
    __syncthreads();
    if (t0 >= t1) return;
    f32x4 v[8]; MoeTile m = moe_tile(F, t0), mn = m; MQ_LOAD(m, v);
#pragma unroll 1
    for (int t = t0; t < t1; t += st) {
        MQ_TOLDS(v);
        const int tn = t + st; mn = m;
        if (tn < t1) { mn = moe_tile(F, tn); MQ_LOAD(mn, v); }
        __syncthreads();
        MQ_STORE(m);
        __syncthreads();
        m = mn;
    }
}
struct MqSlot { int nu, q; };
__device__ __forceinline__ int mq_nu(int slot) {
    constexpr int NU_ML = NB * MLH * NCS, NU7 = (ML / 256) * (D / 256) + (MC / 256) * (D / 256) * KS7, NU9 = (MT / 256) * (2 * FF / 256), NU10 = (ML / 256) * (D / 256) + (MC / 256) * (D / 256) * KS10,
                  NU12 = (MT / 256) * (CD_MAIN / 256), NU13 = NB * NCS * SSDG * 2 * (HPG / 4), NU16 = (ML / 256) * (2 * S5W / 256);
    return slot == 0 ? NU_ML : slot == 1 ? NU_ML : slot == 2 ? NU7 : slot == 3 ? NU9 : slot == 4 ? NU10 : slot == 5 ? NU12 : slot == 6 ? NU13 : NU16;
}
__device__ __forceinline__ int mq_q(int slot) { return slot == 0 ? 6 : slot == 1 ? 16 : slot == 2 ? 2 : slot == 3 ? 8 : slot == 4 ? 12 : slot == 5 ? 16 : slot == 6 ? 8 : 2; }
constexpr int MQ_NSLOT = 8;
__device__ __forceinline__ int mq_base(int G, int slot) { int b = 0;
#pragma unroll
    for (int k = 0; k < MQ_NSLOT; ++k) { const int r = mq_nu(k) % G; if (k < slot && r != 0) b += (G - r) * mq_q(k); }
    return b < MQ_NT ? b : MQ_NT; }
__device__ __forceinline__ void help_slot(const Frame& F, int slot) {
    const int r = mq_nu(slot) % F.G; if (r == 0 || F.bid < r) return;
    const int nh = F.G - r, b0 = mq_base(F.G, slot); int b1 = b0 + nh * mq_q(slot); if (b1 > MQ_NT) b1 = MQ_NT;
    moe_convert_strided(F, b0 + (F.bid - r), b1, nh);
}
constexpr int MQ_Q20 = 8;
__device__ __forceinline__ int mq_tail_lo(const Frame& F, int& r) {
    const unsigned* cnt = F.wsp<unsigned>(WS_CTL) + CW_CNT; int npan = 0;
#pragma unroll
    for (int k = 0; k < NE; ++k) npan += (int)((cnt[64 * k] + 255u) >> 8);
    const int U = npan * (2 * FF / 256); r = U % F.G; const int nidle = r ? F.G - r : 0; const int b = mq_base(F.G, MQ_NSLOT);
    int tl = nidle * MQ_Q20; if (tl > MQ_NT - b) tl = MQ_NT - b; if (tl < 0) tl = 0;
    return MQ_NT - tl;
}
__device__ __forceinline__ void help_drain(const Frame& F) {
    int r; const int hi = mq_tail_lo(F, r);
    const int b = mq_base(F.G, MQ_NSLOT); if (hi - b <= 0) return;
    moe_convert_strided(F, b + F.bid, hi, F.G);
}
__device__ __forceinline__ void help_moe_tail(const Frame& F) {
    int r; const int lo = mq_tail_lo(F, r); if (r == 0) return;
    const int pos = (F.G & 7) == 0 ? (F.bid & 7) * (F.G >> 3) + (F.bid >> 3) : F.bid;
    if (pos < r) return;
    moe_convert_strided(F, lo + (pos - r), MQ_NT, F.G - r);
}
template <int MAP> __device__ __forceinline__ void conv_job_i8(const Frame& F, int& base, const float* src, int ld, signed char* dst, float* scale, int K, int nblk, int half) {
    LAS float* cmx = (LAS float*)(F.lds + 128 * 132);
    const int n = F.tid & 127, kq = F.tid >> 7; const unsigned ldb = (unsigned)ld * 4u, lane_off = (unsigned)n * 4u + (unsigned)(4 * kq) * ldb;
    for (int nb = (F.bid - base % F.G + F.G) % F.G; nb < nblk; nb += F.G) {
        const char* sp0 = (const char*)(src + conv_src_col<MAP>(nb, half)); float mx = 0.f;
        for (int kb = 0; kb < K / 128; ++kb) { const char* sp = sp0 + (size_t)(kb * 128) * ldb;
#pragma unroll
            for (int i = 0; i < 8; ++i) { const unsigned o = lane_off + (unsigned)(16 * i) * ldb;
                mx = fmaxf(mx, fmaxf(fmaxf(fabsf(*(const float*)(sp + o)), fabsf(*(const float*)(sp + o + ldb))), fmaxf(fabsf(*(const float*)(sp + o + 2u * ldb)), fabsf(*(const float*)(sp + o + 3u * ldb))))); } }
        __syncthreads();
        cmx[kq * 128 + n] = mx;
        __syncthreads();
        if (F.tid < 128) { const float m4 = fmaxf(fmaxf(cmx[n], cmx[128 + n]), fmaxf(cmx[256 + n], cmx[384 + n])); const float sc = m4 > 0.f ? m4 * (1.0f / 127.0f) : 1.0f; scale[nb * 128 + n] = sc; cmx[512 + n] = 1.0f / sc; }
        __syncthreads();
        const float inv = cmx[512 + n];
        for (int kb = 0; kb < K / 128; ++kb) { const char* sp = sp0 + (size_t)(kb * 128) * ldb;
#pragma unroll
            for (int i = 0; i < 8; ++i) { const unsigned o = lane_off + (unsigned)(16 * i) * ldb;
                *(LAS unsigned*)(F.lds + n * 132 + (kq + 4 * i) * 4) = pk_i8x4(*(const float*)(sp + o) * inv, *(const float*)(sp + o + ldb) * inv, *(const float*)(sp + o + 2u * ldb) * inv, *(const float*)(sp + o + 3u * ldb) * inv); }
            __syncthreads();
#pragma unroll
            for (int i = 0; i < 2; ++i) { const int ch = F.tid + 512 * i, nn = ch >> 3, kc = ch & 7; const LAS unsigned* lp = (const LAS unsigned*)(F.lds + nn * 132 + kc * 16);
                u32x4 w; w.x = lp[0]; w.y = lp[1]; w.z = lp[2]; w.w = lp[3]; *(u32x4*)(dst + (size_t)(nb * 128 + nn) * K + kb * 128 + kc * 16) = w; }
            __syncthreads(); }
    }
    base += nblk;
}
__device__ __forceinline__ void conv_side(const Frame& F, const float* src, int ld, int col0, int nside, bf16_t* dst, int K) {
    for (int idx = F.bid * NTHREADS + F.tid; idx < 32 * K; idx += F.G * NTHREADS) { const int n = idx / K, k = idx % K;
        dst[idx] = (bf16_t)(n < nside ? f2bf(src[(size_t)k * ld + col0 + n]) : 0u); }
}

__device__ __forceinline__ void adaln_units(const Frame& F) {
    LAS float* cond = (LAS float*)F.lds;
    const float* adaw = F.in[I_ADAW]; float* part = F.wsp<float>(WS_MODP);
    constexpr int NCHUNK = 6 * D / 512, NU = 2 * NCHUNK * KSL;
    for (int u = F.bid; u < NU; u += F.G) {
        const int l = u / (NCHUNK * KSL), rem = u % (NCHUNK * KSL), ks = rem / NCHUNK, nc = rem % NCHUNK;
        __syncthreads();
        for (int i = F.tid; i < NR * 256; i += NTHREADS) { const int r = i / 256, k = ks * 256 + (i & 255); const float c = r < NB ? F.in[I_C][r * D + k] : F.in[I_CCTX][k]; cond[i] = siluf(c); }
        __syncthreads();
        const int n = nc * 512 + F.tid; const float* wp = adaw + ((size_t)l * D + ks * 256) * (6 * D) + n;
        float acc[NR];
#pragma unroll
        for (int r = 0; r < NR; ++r) acc[r] = 0.f;
#pragma unroll 1
        for (int k0 = 0; k0 < 256; k0 += 32) { float w[32];
#pragma unroll
            for (int j = 0; j < 32; ++j) w[j] = NTLD(wp + (size_t)(k0 + j) * (6 * D));
#pragma unroll
            for (int j = 0; j < 32; ++j)
#pragma unroll
                for (int r = 0; r < NR; ++r) acc[r] += cond[r * 256 + k0 + j] * w[j]; }
#pragma unroll
        for (int r = 0; r < NR; ++r) part[(((size_t)l * KSL + ks) * NR + r) * (6 * D) + n] = acc[r];
    }
    __syncthreads();
}

__device__ __forceinline__ void hyena_filter_units(const Frame& F, int wg_off) {
    constexpr int H2P = 36, OBP = 33, FC = HYD >= NTHREADS ? HYD / NTHREADS : 1;
    LAS float* feats = (LAS float*)F.lds;
    LAS float* h1 = feats + 32 * 36;
    LAS float* h2 = h1 + 32 * 64;
    LAS float* ob = h2 + 64 * H2P;
    static_assert((32 * 36 + 32 * 64 + 64 * H2P + NTHREADS * OBP) * 4 <= LDS_MISC, "filter LDS");
    static_assert(SEQ % 32 == 0 && CTX % 32 == 0 && (HYD % NTHREADS == 0 || HYD < NTHREADS), "filter shapes");
    const float* w1 = F.in[I_HYW1]; const float* b1 = F.in[I_HYB1]; const float* w2 = F.in[I_HYW2]; const float* b2 = F.in[I_HYB2]; const float* w3 = F.in[I_HYW3]; const float* fq = F.in[I_HYFREQ];
    constexpr int NU0 = 2 * (SEQ / 32), NU = NU0 + 2 * (CTX / 32);
    for (int u = (F.bid - wg_off % F.G + F.G) % F.G; u < NU; u += F.G) {
        const int set = u < NU0 ? 0 : 1, L = set ? CTX : SEQ, ul = set ? u - NU0 : u, dir = ul & 1, p0 = (ul >> 1) * 32, pb = (set ? SEQ / 32 : 0) + (ul >> 1);
        float* filt = F.wsp<float>(set ? WS_FILT1 : WS_FILT0);
        int tid = F.tid; LAUNDER(tid);
        __syncthreads();
        for (int e = tid; e < 32 * HYEMB; e += NTHREADS) { const int p = e / HYEMB, i = e % HYEMB; const float pos = (float)(p0 + dir + p); float v;
            if (i == 0) v = pos / (float)(L - 1);
            else { const int bi = (i - 1) & 15; const float band = 1e-4f + (float)bi * ((15.0f - 1e-4f) / 15.0f); const float ang = (float)(2.0 * M_PI / (double)L) * pos * band; v = i <= 16 ? cosf(ang) : -sinf(ang); }
            feats[p * 36 + i] = v; }
        __syncthreads();
        { const int pq = tid >> 6, j = tid & 63; float wv[HYEMB]; float sa[4];
#pragma unroll
            for (int i = 0; i < HYEMB; ++i) wv[i] = w1[i * HYHID + j];
#pragma unroll
            for (int x = 0; x < 4; ++x) sa[x] = b1[j];
#pragma unroll
            for (int i = 0; i < HYEMB; ++i)
#pragma unroll
                for (int x = 0; x < 4; ++x) sa[x] += feats[(4 * pq + x) * 36 + i] * wv[i];
#pragma unroll
            for (int x = 0; x < 4; ++x) h1[(4 * pq + x) * 64 + j] = fq[j] * sa[x];
#pragma unroll 1
            for (int x = 0; x < 4; ++x) { LAS float* hp = h1 + (4 * pq + x) * 64 + j; *hp = sinf(*hp); } }
        __syncthreads();
        { const int pq = tid >> 6, j = tid & 63; float wv[HYHID]; float sa[4];
#pragma unroll
            for (int i = 0; i < HYHID; ++i) wv[i] = w2[i * HYHID + j];
#pragma unroll
            for (int x = 0; x < 4; ++x) sa[x] = b2[j];
#pragma unroll
            for (int i = 0; i < HYHID; ++i)
#pragma unroll
                for (int x = 0; x < 4; ++x) sa[x] += h1[(4 * pq + x) * 64 + i] * wv[i];
#pragma unroll
            for (int x = 0; x < 4; ++x) h2[j * H2P + 4 * pq + x] = fq[HYHID + j] * sa[x];
#pragma unroll 1
            for (int x = 0; x < 4; ++x) { LAS float* hp = h2 + j * H2P + 4 * pq + x; *hp = sinf(*hp); } }
        __syncthreads();
        float acc[FC][32];
#pragma unroll
        for (int cc = 0; cc < FC; ++cc)
#pragma unroll
            for (int p = 0; p < 32; ++p) acc[cc][p] = 0.f;
        const int cl = tid < HYD ? tid : 0;
#pragma unroll 1
        for (int k0 = 0; k0 < HYHID; k0 += 16) { float w[16][FC];
#pragma unroll
            for (int j = 0; j < 16; ++j)
#pragma unroll
                for (int cc = 0; cc < FC; ++cc) w[j][cc] = w3[(size_t)(k0 + j) * (2 * HYD) + dir * HYD + cl + NTHREADS * cc];
#pragma unroll
            for (int j = 0; j < 16; ++j) {
#pragma unroll
                for (int i = 0; i < 8; ++i) { const f32x4 hv = *(const LAS f32x4*)(h2 + (k0 + j) * H2P + 4 * i);
#pragma unroll
                    for (int cc = 0; cc < FC; ++cc) { acc[cc][4 * i] += hv[0] * w[j][cc]; acc[cc][4 * i + 1] += hv[1] * w[j][cc]; acc[cc][4 * i + 2] += hv[2] * w[j][cc]; acc[cc][4 * i + 3] += hv[3] * w[j][cc]; } } } }
        const int a0 = dir ? L - p0 - 32 : L + p0;
#pragma unroll
        for (int cc = 0; cc < FC; ++cc) { const int c = cl + NTHREADS * cc;
            const float delta = (float)(-log(1e-2) / 1.5) + (float)c * (float)((-log(1e-2) / 0.3 + log(1e-2) / 1.5) / (double)(HYD - 1));
            float l1 = 0.f;
#pragma unroll
            for (int p = 0; p < 32; ++p) { const int pos = p0 + dir + p; const float t = (float)pos / (float)(L - 1); float v = acc[cc][p] * expf(-t * delta);
                if (pos >= L) v = 0.f;
                l1 += fabsf(v); ob[tid * OBP + (dir ? 31 - p : p)] = v; }
            if (tid < HYD) F.wsp<float>(WS_L1P)[(size_t)pb * (2 * HYD) + dir * HYD + c] = l1;
            __syncthreads();
            for (int e = tid; e < (HYD < NTHREADS ? HYD : NTHREADS) * 8; e += NTHREADS) { const int ch = e >> 3, qd = e & 7; const LAS float* op = ob + ch * OBP + 4 * qd;
                const f32x4 v4 = {op[0], op[1], op[2], op[3]};
                *(f32x4*)(filt + (size_t)(ch + NTHREADS * cc) * (2 * L) + a0 + 4 * qd) = v4; }
            __syncthreads();
        }
    }
    __syncthreads();
}

__device__ __forceinline__ void s5_param_units(const Frame& F) {
    float* par = F.wsp<float>(WS_S5PAR);
    for (int i = F.bid + F.G * F.tid; i < 2 * S5G * S5P; i += F.G * NTHREADS) {
        const int d = i / (S5G * S5P), g = (i / S5P) % S5G, p = i % S5P;
        const float dt = expf(F.in[I_S5LDT][d * S5G + g]), lr = F.in[I_S5LRE][i], li = F.in[I_S5LIM][i];
        const float mag = expf(lr * dt), lbr = mag * cosf(li * dt), lbi = mag * sinf(li * dt), den = lr * lr + li * li;
        const float fr = ((lbr - 1.f) * lr + lbi * li) / den, fi = (lbi * lr - (lbr - 1.f) * li) / den;
        float* o = par + (size_t)i * 36; o[0] = lbr; o[1] = lbi;
        const float* bre = F.in[I_S5BRE] + ((size_t)g * S5P + p) * S5GS; const float* bim = F.in[I_S5BIM] + ((size_t)g * S5P + p) * S5GS;
        float br[S5GS], bi[S5GS];
#pragma unroll
        for (int k = 0; k < S5GS; ++k) { br[k] = bre[k]; bi[k] = bim[k]; }
#pragma unroll
        for (int k = 0; k < S5GS; ++k) { o[2 + k] = fr * br[k] - fi * bi[k]; o[18 + k] = fr * bi[k] + fi * br[k]; }
        const float magc = expf(lr * dt * (float)CH); o[34] = magc * cosf(li * dt * (float)CH); o[35] = magc * sinf(li * dt * (float)CH);
    }
}

__device__ __forceinline__ void phase_prologue(const Frame& F, int pm = 0) {
    int base = 0;
    if (pm == 0 || pm == 1) {
    conv_job<0>(F, base, F.in[I_ABWIN], AB_IN, F.wsp<bf16_t>(WS_W_ABIN), D, AB_MAIN / 128, 0);
    conv_job<0>(F, base, F.in[I_ABWOUT], D, F.wsp<bf16_t>(WS_W_ABOUT), YC1, D / 128, 0); }
    const int i8_hi = base + 2 * FF / 128;
    if (pm == 0 || pm == 2)
    conv_job_i8<1>(F, base, F.in[I_FFNGU], 2 * FF, F.wsp<signed char>(WS_W_GU), F.wsp<float>(WS_SB_GU), D, 2 * FF / 128, FF);
    if (pm == 0 || pm == 1) {
    conv_job_f8(F, base, F.in[I_FFNDN], D, F.wsp<unsigned char>(WS_W_DN), FF, D / 128);
    conv_job<2>(F, base, F.in[I_CDWIN], CD_IN, F.wsp<bf16_t>(WS_W_CDIN), D, CD_MAIN / 128, 0);
    conv_job<1>(F, base, F.in[I_S5GLU], 2 * S5W, F.wsp<bf16_t>(WS_W_GLU), S5W, 2 * S5W / 128, S5W);
    conv_job<0>(F, base, F.in[I_CDWOUT], D, F.wsp<bf16_t>(WS_W_CDOUT), YC2, D / 128, 0);
    conv_side(F, F.in[I_ABWIN], AB_IN, AB_MAIN, AB_SIDE, F.wsp<bf16_t>(WS_W_ABSIDE), D);
    conv_side(F, F.in[I_CDWIN], CD_IN, SSDD + XBC, CD_SIDE, F.wsp<bf16_t>(WS_W_CDSIDE), D); }
    if (pm == 0 || pm == 3) adaln_units(F);
    if (pm == 0 || pm == 4) { hyena_filter_units(F, i8_hi);
    s5_param_units(F); }
}

__device__ __forceinline__ void phase_finalize(const Frame& F) {
    const float* part = F.wsp<float>(WS_MODP); float* mod = F.wsp<float>(WS_MOD); const float* adab = F.in[I_ADAB];
    for (int i = F.bid * NTHREADS + F.tid; i < 2 * NR * 6 * D; i += F.G * NTHREADS) {
        const int l = i / (NR * 6 * D), r = (i / (6 * D)) % NR, n = i % (6 * D);
        float s = adab[l * 6 * D + n];
        for (int ks = 0; ks < KSL; ++ks) s += part[(((size_t)l * KSL + ks) * NR + r) * (6 * D) + n];
        mod[i] = s; }
    const float* l1p = F.wsp<float>(WS_L1P); float* l1 = F.wsp<float>(WS_L1);
    for (int i = F.bid * NTHREADS + F.tid; i < 2 * HYD; i += F.G * NTHREADS) {
        const int set = i / HYD, c = i % HYD; const int u0 = set ? SEQ / 32 : 0, nu = set ? CTX / 32 : SEQ / 32; float s = 0.f;
        for (int u = 0; u < nu; ++u) s += l1p[(size_t)(u0 + u) * (2 * HYD) + c] + l1p[(size_t)(u0 + u) * (2 * HYD) + HYD + c];
        l1[i] = 1.0f / s; }
}

template <bool ROUTE, bool OUTI8 = false> __device__ __forceinline__ void modulate_rows(const Frame& F, const float* xlat, const float* xctx, int layer, int si, bf16_t* dst, int m_hi, const float* part = nullptr, const float* pgate = nullptr, int nks = 0, float* xw = nullptr) {
    const float* mod = F.wsp<float>(WS_MOD) + (size_t)layer * NR * 6 * D;
    LAS float* rwl = (LAS float*)F.lds;
    LAS float* mdl = (LAS float*)F.lds + (ROUTE ? NE * D : 0); constexpr int NRL = ROUTE ? NB : NR;
    static_assert(((ROUTE ? NE * D : 0) + NRL * 2 * D) * 4 <= LDS_MISC, "modulate LDS");
    __syncthreads();
    if (ROUTE) { for (int i = F.tid; i < D * NE; i += NTHREADS) rwl[(i % NE) * D + i / NE] = F.in[I_ROUTER][i]; }
    for (int i = F.tid; i < NRL * 2 * D; i += NTHREADS) { const int r = i / (2 * D), w = i % (2 * D); mdl[i] = mod[(size_t)r * 6 * D + (size_t)si * D + w]; }
    __syncthreads();
    constexpr int NV = D / 256;
    for (int m = F.gw(); m < m_hi; m += F.ngw()) {
        const float* xr = m < ML ? xlat + (size_t)m * D : xctx + (size_t)(m - ML) * D; const int r = mod_row(m);
        const LAS float* sh = mdl + r * 2 * D; const LAS float* sc = sh + D;
        f32x4 v[NV]; float ss = 0.f;
#pragma unroll
        for (int i = 0; i < NV; ++i) { const int k = 4 * (F.lane + 64 * i); v[i] = *(const f32x4*)(xr + k);
            if (!ROUTE && part != nullptr && m >= ML) { f32x4 ps = *(const f32x4*)(part + (size_t)(m - ML) * D + k);
                for (int ks = 1; ks < nks; ++ks) ps += *(const f32x4*)(part + ((size_t)ks * MC + (m - ML)) * D + k);
                v[i] += *(const f32x4*)(pgate + k) * ps; *(f32x4*)(xw + (size_t)m * D + k) = v[i]; }
            ss += v[i][0] * v[i][0] + v[i][1] * v[i][1] + v[i][2] * v[i][2] + v[i][3] * v[i][3]; }
        ss = wave_sum(ss); const float rinv = 1.0f / sqrtf(ss * (1.0f / (float)D) + EPS);
        float lg[NE];
        if (ROUTE) {
#pragma unroll
            for (int e = 0; e < NE; ++e) lg[e] = 0.f; }
        if (OUTI8) {
            float mx = 0.f;
#pragma unroll
            for (int i = 0; i < NV; ++i) { const int k = 4 * (F.lane + 64 * i); const f32x4 s4 = *(const LAS f32x4*)(sh + k), c4 = *(const LAS f32x4*)(sc + k); v[i] = v[i] * rinv * (c4 + 1.0f) + s4;
                mx = fmaxf(mx, fmaxf(fmaxf(fabsf(v[i][0]), fabsf(v[i][1])), fmaxf(fabsf(v[i][2]), fabsf(v[i][3])))); }
            mx = wave_max(mx); const float scl = mx > 0.f ? mx * (1.0f / 127.0f) : 1.0f, inv = 1.0f / scl;
            signed char* d8 = F.wsp<signed char>(WS_A8) + (size_t)m * D;
#pragma unroll
            for (int i = 0; i < NV; ++i) *(unsigned*)(d8 + 4 * (F.lane + 64 * i)) = pk_i8x4(v[i][0] * inv, v[i][1] * inv, v[i][2] * inv, v[i][3] * inv);
            if (F.lane == 0) F.wsp<float>(WS_SA8)[m] = scl;
            continue; }
#pragma unroll
        for (int i = 0; i < NV; ++i) { const int k = 4 * (F.lane + 64 * i); const f32x4 s4 = *(const LAS f32x4*)(sh + k), c4 = *(const LAS f32x4*)(sc + k);
            f32x4 y = v[i] * rinv * (c4 + 1.0f) + s4;
            if (ROUTE) *(unsigned*)((unsigned char*)dst + (size_t)m * D + k) = cvt_pk_fp8x4(y[0], y[1], y[2], y[3]);
            else { u32x2 w; w.x = pk2(y[0], y[1]); w.y = pk2(y[2], y[3]); *(u32x2*)(dst + (size_t)m * D + k) = w; }
            if (ROUTE) {
#pragma unroll
                for (int e = 0; e < NE; ++e) { const f32x4 rv = *(const LAS f32x4*)(rwl + e * D + k); lg[e] += y[0] * rv[0] + y[1] * rv[1] + y[2] * rv[2] + y[3] * rv[3]; } SCHED_BARRIER(); } }
        if (ROUTE) {
#pragma unroll
            for (int e = 0; e < NE; ++e) lg[e] = wave_sum(lg[e]);
            if (F.lane == 0) { int e0 = 0; float v0 = lg[0];
#pragma unroll
                for (int e = 1; e < NE; ++e) if (lg[e] > v0) { v0 = lg[e]; e0 = e; }
                int e1 = -1; float v1 = -INFINITY;
#pragma unroll
                for (int e = 0; e < NE; ++e) if (e != e0 && lg[e] > v1) { v1 = lg[e]; e1 = e; }
                const float p1 = 1.0f / (1.0f + expf(v0 - v1)), p0 = 1.0f - p1;
                unsigned* cnt = F.wsp<unsigned>(WS_CTL) + CW_CNT;
                const unsigned pos0 = ATOM_ADD(cnt + 64 * e0, 1u), pos1 = ATOM_ADD(cnt + 64 * e1, 1u);
                int* rt = F.wsp<int>(WS_ROUTE) + (size_t)m * 4; rt[0] = e0; rt[1] = e1; rt[2] = (int)pos0; rt[3] = (int)pos1;
                float* rp = F.wsp<float>(WS_RPROB) + (size_t)m * 2; rp[0] = p0; rp[1] = p1; } }
    }
}

__device__ __forceinline__ void side_gemm(const Frame& F, const bf16_t* A, const bf16_t* Ws, float* out, int M) {
    const int r = F.lane & 15, q = F.lane >> 4; constexpr int KW = D / NWAVES; static_assert(KW % 32 == 0 && NTHREADS == 16 * 32, "side gemm split");
    LAS float* red = (LAS float*)F.lds;
    for (int blk = F.bid; blk < M / 16; blk += F.G) {
        f32x4 acc0 = (f32x4){0.f, 0.f, 0.f, 0.f}, acc1 = acc0; const int k0 = F.wave * KW;
        const bf16_t* ap = A + (size_t)(blk * 16 + r) * D + k0 + q * 8; const bf16_t* b0 = Ws + (size_t)r * D + k0 + q * 8; const bf16_t* b1 = Ws + (size_t)(16 + r) * D + k0 + q * 8;
#pragma unroll
        for (int k = 0; k < KW; k += 32) { const bf16x8 a = *(const bf16x8*)(ap + k), x0 = *(const bf16x8*)(b0 + k), x1 = *(const bf16x8*)(b1 + k);
            acc0 = MFMA16(a, x0, acc0); acc1 = MFMA16(a, x1, acc1); }
        __syncthreads();
#pragma unroll
        for (int j = 0; j < 4; ++j) { red[(F.wave * 16 + 4 * q + j) * 32 + r] = acc0[j]; red[(F.wave * 16 + 4 * q + j) * 32 + 16 + r] = acc1[j]; }
        __syncthreads();
        { const int row = F.tid >> 5, col = F.tid & 31; float sm = 0.f;
#pragma unroll
            for (int w = 0; w < NWAVES; ++w) sm += red[(w * 16 + row) * 32 + col];
            out[(size_t)(blk * 16 + row) * 32 + col] = sm; }
    }
    __syncthreads();
}

__device__ __forceinline__ void conv3x4(const bf16_t* rec, bool has_l, bool has_r, const float* w, int wld, const float* b, float (&o)[4]) {
    const u32x2 c = *(const u32x2*)rec; u32x2 l = (u32x2){0u, 0u}, r = (u32x2){0u, 0u};
    if (has_l) l = *(const u32x2*)(rec - 4);
    if (has_r) r = *(const u32x2*)(rec + 4);
    const f32x4 w0 = *(const f32x4*)w, w1 = *(const f32x4*)(w + wld), w2 = *(const f32x4*)(w + 2 * wld), bb = *(const f32x4*)b;
    const float xc[4] = {bf2f(c.x & 0xffffu), bf2f(c.x >> 16), bf2f(c.y & 0xffffu), bf2f(c.y >> 16)};
    const float xl[4] = {bf2f(l.x & 0xffffu), bf2f(l.x >> 16), bf2f(l.y & 0xffffu), bf2f(l.y >> 16)};
    const float xr[4] = {bf2f(r.x & 0xffffu), bf2f(r.x >> 16), bf2f(r.y & 0xffffu), bf2f(r.y >> 16)};
#pragma unroll
    for (int j = 0; j < 4; ++j) o[j] = bb[j] + w0[j] * xl[j] + w1[j] * xc[j] + w2[j] * xr[j];
}
template <int L, bool LAT> __device__ __forceinline__ void hyena_unit(const Frame& F0, int cg, int hymode = 0) {
    Frame F = F0; LAUNDER(F.tid); F.lane = F.tid & 63;
    constexpr int NT1 = L / 128, ZP = 136, ZCH = NB * NT1 * ZP, KRP = 2 * L + 8;
    static_assert(4 * ZCH * 2 + 8 * KRP * 2 + ZP * 2 <= LDS_MISC && 4 * NB * L * 4 <= LDS_MISC && NB <= 4 && NT1 <= 16, "hyena LDS");
    LAS bf16_t* zl = (LAS bf16_t*)F.lds;
    LAS bf16_t* kr = zl + 4 * ZCH;
    LAS bf16_t* zz = kr + 8 * KRP;
    LAS float* res = (LAS float*)F.lds;
    const bf16_t* PH = F.wsp<bf16_t>(WS_PH); const float* cw = F.in[I_HYCW]; const float* cb = F.in[I_HYCB];
    const float* filt = F.wsp<float>(LAT ? WS_FILT0 : WS_FILT1);
    const int c0 = cg * 4;
    __syncthreads();
    constexpr int ZB = 8;
    for (int idx0 = F.tid; idx0 < ((hymode & 2) ? 0 : NB * L); idx0 += ZB * NTHREADS) { float a[ZB][4], v[ZB][4];
#pragma unroll
        for (int j = 0; j < ZB; ++j) { const int idx = idx0 + j * NTHREADS < NB * L ? idx0 + j * NTHREADS : idx0; const int b = idx / L, t = idx % L; const int m = LAT ? b * SEQ + t : ML + b * CTX + t;
            bool hl, hr; if (LAT) { hl = (t & (GW - 1)) != 0; hr = (t & (GW - 1)) != GW - 1; } else { hl = t > 0; hr = t < L - 1; }
            conv3x4(PH + ((size_t)(HYD / 4 + cg) * MT + m) * 4, hl, hr, cw + HYD + c0, 3 * HYD, cb + HYD + c0, a[j]);
            conv3x4(PH + ((size_t)(2 * HYD / 4 + cg) * MT + m) * 4, hl, hr, cw + 2 * HYD + c0, 3 * HYD, cb + 2 * HYD + c0, v[j]); }
#pragma unroll
        for (int j = 0; j < ZB; ++j) { const int idx = idx0 + j * NTHREADS; if (idx < NB * L) { const int b = idx / L, t = idx % L;
#pragma unroll
            for (int c = 0; c < 4; ++c) zl[c * ZCH + (b * NT1 + (t >> 7)) * ZP + (t & 127)] = (bf16_t)f2bf(a[j][c] * v[j][c]); } } }
    constexpr int KB = 8;
    for (int idx0 = F.tid; idx0 < 4 * KRP; idx0 += KB * NTHREADS) { float tv[KB];
#pragma unroll
        for (int j = 0; j < KB; ++j) { const int idx = idx0 + j * NTHREADS; const int c = idx / KRP, i = idx % KRP;
            tv[j] = (idx < 4 * KRP && i >= 1 && i <= 2 * L - 1) ? filt[(size_t)(c0 + c) * (2 * L) + 2 * L - i] : 0.f; }
#pragma unroll
        for (int j = 0; j < KB; ++j) { const int idx = idx0 + j * NTHREADS; if (idx < 4 * KRP) { const int c = idx / KRP, i = idx % KRP;
            const bf16_t v = (bf16_t)((i >= 1 && i <= 2 * L - 1) ? f2bf(tv[j]) : 0u);
            kr[(c * 2) * KRP + i] = v; if (i >= 1) kr[(c * 2 + 1) * KRP + i - 1] = v; else kr[(c * 2 + 1) * KRP + KRP - 1] = 0; } } }
    if (F.tid < ZP) zz[F.tid] = 0;
    __syncthreads();
    const int ch = F.wave >> 1, h = F.wave & 1, i = F.lane & 31, q = F.lane >> 5;
    const int cb_ = i >> 3, t1 = 8 * h + (i & 7); const bool colok = cb_ < NB && t1 < NT1;
    f32x16 acc[4];
#pragma unroll
    for (int mt = 0; mt < 4; ++mt)
#pragma unroll
        for (int r = 0; r < 16; ++r) acc[mt][r] = 0.f;
    if (8 * h < NT1) {
        const int d_lo = 8 * h - (NT1 - 1), d_hi = (hymode & 1) ? d_lo - 1 : ((8 * h + 7 < NT1 - 1) ? 8 * h + 7 : NT1 - 1);
        const LAS unsigned* kbase = (const LAS unsigned*)(kr + (ch * 2 + (i & 1)) * KRP) + (L / 2 + 4 * q - ((i + 1) >> 1));
        const LAS bf16_t* zc = zl + ch * ZCH + (colok ? cb_ : 0) * NT1 * ZP + 8 * q;
        bf16x8 fa[14], fb[14];
#define HY_LOADF(dst, dd) do { const LAS unsigned* kb_ = kbase - 8 * (8 * (dd) - 7); _Pragma("unroll") for (int fi_ = 0; fi_ < 14; ++fi_) { const LAS unsigned* p_ = kb_ - 8 * fi_; \
            u32x4 fw_; fw_.x = p_[0]; fw_.y = p_[1]; fw_.z = p_[2]; fw_.w = p_[3]; dst[fi_] = __builtin_bit_cast(bf16x8, fw_); } } while (0)
#define HY_STEP(cur, nxt, dd) do { const int s1_ = t1 - (dd); const bool ok_ = colok && s1_ >= 0 && s1_ < NT1; const LAS bf16_t* zp_ = ok_ ? zc + s1_ * ZP : zz + 8 * q; const int zs_ = ok_ ? 16 : 0; \
            bf16x8 zf_[8]; _Pragma("unroll") for (int ks_ = 0; ks_ < 8; ++ks_) zf_[ks_] = *(const LAS bf16x8*)(zp_ + zs_ * ks_); \
            if ((dd) + 1 <= d_hi) HY_LOADF(nxt, (dd) + 1); \
            _Pragma("unroll") for (int ks_ = 0; ks_ < 8; ++ks_) _Pragma("unroll") for (int mt_ = 0; mt_ < 4; ++mt_) acc[mt_] = MFMA32(cur[2 * mt_ - ks_ + 7], zf_[ks_], acc[mt_]); } while (0)
        if (d_lo <= d_hi) HY_LOADF(fa, d_lo);
#pragma unroll 1
        for (int d = d_lo; d <= d_hi; d += 2) {
            HY_STEP(fa, fb, d);
            if (d + 1 <= d_hi) HY_STEP(fb, fa, d + 1);
        }
#undef HY_LOADF
#undef HY_STEP
        if (colok) { const float il1 = F.wsp<float>(WS_L1)[(LAT ? 0 : HYD) + c0 + ch], bias = F.in[I_HYBIAS][c0 + ch]; const LAS bf16_t* zr = zl + ch * ZCH + (cb_ * NT1 + t1) * ZP;
#pragma unroll
            for (int mt = 0; mt < 4; ++mt)
#pragma unroll
                for (int r = 0; r < 16; ++r) { const int t0 = 32 * mt + 8 * (r >> 2) + 4 * q + (r & 3); acc[mt][r] = acc[mt][r] * il1 + bias * bf2f(zr[t0]); } }
    }
    __syncthreads();
    if (8 * h < NT1 && colok) {
#pragma unroll
        for (int mt = 0; mt < 4; ++mt)
#pragma unroll
            for (int r = 0; r < 16; ++r) res[(ch * NB + cb_) * L + t1 * 128 + 32 * mt + 8 * (r >> 2) + 4 * q + (r & 3)] = acc[mt][r]; }
    __syncthreads();
    bf16_t* Y = F.wsp<bf16_t>(WS_YCAT);
    for (int idx0 = F.tid; idx0 < ((hymode & 2) ? 0 : NB * L); idx0 += ZB * NTHREADS) { float x0[ZB][4];
#pragma unroll
        for (int j = 0; j < ZB; ++j) { const int idx = idx0 + j * NTHREADS < NB * L ? idx0 + j * NTHREADS : idx0; const int b = idx / L, t = idx % L; const int m = LAT ? b * SEQ + t : ML + b * CTX + t;
            bool hl, hr; if (LAT) { hl = (t & (GW - 1)) != 0; hr = (t & (GW - 1)) != GW - 1; } else { hl = t > 0; hr = t < L - 1; }
            conv3x4(PH + ((size_t)cg * MT + m) * 4, hl, hr, cw + c0, 3 * HYD, cb + c0, x0[j]); }
#pragma unroll
        for (int j = 0; j < ZB; ++j) { const int idx = idx0 + j * NTHREADS; if (idx < NB * L) { const int b = idx / L, t = idx % L; const int m = LAT ? b * SEQ + t : ML + b * CTX + t;
            u32x2 wv; wv.x = pk2(x0[j][0] * res[(0 * NB + b) * L + t], x0[j][1] * res[(1 * NB + b) * L + t]); wv.y = pk2(x0[j][2] * res[(2 * NB + b) * L + t], x0[j][3] * res[(3 * NB + b) * L + t]);
            *(u32x2*)(Y + (size_t)m * YC1 + c0) = wv; } } }
    __syncthreads();
}
__device__ __forceinline__ void hyena_units(const Frame& F, int hymode = 0) {
    for (int u = F.bid; u < HYD / 4; u += F.G) hyena_unit<SEQ, true>(F, u, hymode);
    for (int u = F.bid; u < HYD / 4; u += F.G) hyena_unit<CTX, false>(F, u, hymode);
}

__device__ __forceinline__ float* mlst_slot(const Frame& F, int d, int b, int h, int cs) { return F.wsp<float>(WS_MLST) + ((((size_t)d * NB + b) * MLH + h) * NCS + cs) * MLST_STRIDE; }

__device__ __forceinline__ void mlstm_gates(const Frame& F, LAS float* ga, int m0, int h) {
    if (F.tid < CH) { const float* sd = F.wsp<float>(WS_SIDE) + (size_t)(m0 + F.tid) * 32; const float* gb = F.in[I_MLGB];
        ga[0 * CH + F.tid] = logsigmoidf_(sd[MLH + h] + gb[MLH + h]); ga[1 * CH + F.tid] = sd[h] + gb[h];
        ga[2 * CH + F.tid] = logsigmoidf_(sd[3 * MLH + h] + gb[3 * MLH + h]); ga[3 * CH + F.tid] = sd[2 * MLH + h] + gb[2 * MLH + h]; }
    __syncthreads();
    if (F.wave == 0) wave_scan128<false>(ga + 0 * CH, ga + 4 * CH, false, F.lane);
    else if (F.wave == 1) wave_scan128<false>(ga + 2 * CH, ga + 5 * CH, true, F.lane);
    __syncthreads();
}

__device__ __forceinline__ void mlstm_local_unit(const Frame& F0, int b, int h, int cs) {
    Frame F = F0; LAUNDER(F.tid); F.lane = F.tid & 63;
    LAS bf16_t* KwF = (LAS bf16_t*)F.lds; LAS bf16_t* KwB = (LAS bf16_t*)(F.lds + TILE_B); LAS bf16_t* VT = (LAS bf16_t*)(F.lds + 2 * TILE_B);
    LAS float* ga = (LAS float*)(F.lds + 3 * TILE_B);
    const int m0 = chunk_row0(b, cs);
    __syncthreads();
    mlstm_gates(F, ga, m0, h);
    if (F.tid < 2 * CH) { const int d = F.tid >> 7, i = F.tid & 127; const LAS float* bc = ga + (4 + d) * CH; const LAS float* ig = ga + (1 + 2 * d) * CH; const float g = d ? bc[0] : bc[CH - 1];
        const float a = g - bc[i] + ig[i]; float mx = a;
        mx = fmaxf(mx, __shfl_xor(mx, 1)); mx = fmaxf(mx, __shfl_xor(mx, 2)); mx = fmaxf(mx, __shfl_xor(mx, 4)); mx = fmaxf(mx, __shfl_xor(mx, 8)); mx = fmaxf(mx, __shfl_xor(mx, 16)); mx = fmaxf(mx, __shfl_xor(mx, 32));
        ga[(6 + d) * CH + i] = a; if ((i & 63) == 0) ga[8 * CH + 8 + 2 * d + (i >> 6)] = mx; }
    __syncthreads();
    if (F.tid < 2 * CH) { const int d = F.tid >> 7, i = F.tid & 127; const float mx = fmaxf(ga[8 * CH + 8 + 2 * d], ga[8 * CH + 8 + 2 * d + 1]);
        const LAS float* bc = ga + (4 + d) * CH; ga[(6 + d) * CH + i] = expf(ga[(6 + d) * CH + i] - mx);
        if (i == 0) { ga[8 * CH + 2 * d] = mx; ga[8 * CH + 2 * d + 1] = d ? bc[0] : bc[CH - 1]; } }
    __syncthreads();
    const bf16_t* P = F.wsp<bf16_t>(WS_P); const float* cw = F.in[I_MLCW]; const float* cb = F.in[I_MLCB];
    { const int s = F.tid & 127, fgq = F.tid >> 7; bool hl, hr; conv_nbr(cs, s, hl, hr); const float wf = ga[6 * CH + s], wb = ga[7 * CH + s];
#pragma unroll 2
        for (int i = 0; i < 4; ++i) { const int f0 = (fgq + 4 * i) * 8;
            float kv[8]; conv3x8(P + (size_t)(m0 + s) * AB_MAIN + 3 * HYD + MLD + h * DH + f0, AB_MAIN, hl, hr, cw + MLD + h * DH + f0, 2 * MLD, cb + MLD + h * DH + f0, kv);
            float vv[8]; unpack8(*(const u32x4*)(P + (size_t)(m0 + s) * AB_MAIN + 3 * HYD + 2 * MLD + h * DH + f0), vv);
#pragma unroll
            for (int j = 0; j < 8; ++j) { const float kk = siluf(kv[j]); KwF[(f0 + j) * TP + s] = (bf16_t)f2bf(kk * wf); KwB[(f0 + j) * TP + s] = (bf16_t)f2bf(kk * wb); VT[(f0 + j) * TP + s] = (bf16_t)f2bf(vv[j]); } } }
    __syncthreads();
    const int wm = F.wave >> 1, wn = F.wave & 1, r = F.lane & 15, q = F.lane >> 4;
#pragma unroll
    for (int d = 0; d < 2; ++d) {
        f32x4 acc[2][4]; zero_acc(acc);
        wave_mma<2, 4, 4>(acc, d ? KwB : KwF, 32 * wm, VT, 64 * wn, F.lane);
        bf16_t* ct = (bf16_t*)mlst_slot(F, d, b, h, cs);
#pragma unroll
        for (int mt = 0; mt < 2; ++mt)
#pragma unroll
            for (int nt = 0; nt < 4; ++nt) { u32x2 w; w.x = pk2(acc[mt][nt][0], acc[mt][nt][1]); w.y = pk2(acc[mt][nt][2], acc[mt][nt][3]);
                *(u32x2*)(ct + (64 * wn + 16 * nt + r) * DH + 32 * wm + 16 * mt + 4 * q) = w; }
    }
    if (F.tid < 2 * CH) { const int d = F.tid >> 7, kk = F.tid & 127; const LAS bf16_t* row = (d ? KwB : KwF) + kk * TP; float s = 0.f;
        for (int i = 0; i < CH; i += 8) { float f[8]; unpack8(*(const LAS u32x4*)(row + i), f);
#pragma unroll
            for (int j = 0; j < 8; ++j) s += f[j]; }
        float* sl = mlst_slot(F, d, b, h, cs); sl[MLST_CT + kk] = s;
        if (kk == 0) { sl[MLST_CT + DH] = ga[8 * CH + 2 * d]; sl[MLST_CT + DH + 1] = ga[8 * CH + 2 * d + 1]; } }
    __syncthreads();
}

__device__ __forceinline__ void mlstm_carry(const Frame& F) {
    constexpr int NCI = DH * DH / 8, NVI = NCI + DH / 4, NITEM = 2 * NB * MLH * NVI;
    for (int it = F.bid * NTHREADS + F.tid; it < NITEM; it += F.G * NTHREADS) {
        const int grp = it / NVI, e = it % NVI, d = grp / (NB * MLH), b = (grp / MLH) % NB, h = grp % MLH;
        float st[8];
#pragma unroll
        for (int j = 0; j < 8; ++j) st[j] = 0.f;
        float mp = 0.f;
        u32x4 lc[NCS]; float mls[NCS], gs[NCS];
#pragma unroll
        for (int qi = 0; qi < NCS; ++qi) { const float* sl = mlst_slot(F, d, b, h, scan_slot(d, qi)); mls[qi] = sl[MLST_CT + DH]; gs[qi] = sl[MLST_CT + DH + 1];
            lc[qi] = e < NCI ? *((const u32x4*)sl + e) : __builtin_bit_cast(u32x4, *((const f32x4*)(sl + MLST_CT) + (e - NCI))); }
#pragma unroll
        for (int qi = 0; qi < NCS; ++qi) { float* sl = mlst_slot(F, d, b, h, scan_slot(d, qi));
            const float ml = mls[qi], g = gs[qi];
            const float mn = fmaxf(g + mp, ml), sp = expf(g + mp - mn), slc = expf(ml - mn);
            if (e < NCI) { u32x4* pp = (u32x4*)sl + e; float loc[8]; unpack8(lc[qi], loc);
                u32x4 w; w.x = pk2(st[0], st[1]); w.y = pk2(st[2], st[3]); w.z = pk2(st[4], st[5]); w.w = pk2(st[6], st[7]); *pp = w;
#pragma unroll
                for (int j = 0; j < 8; ++j) st[j] = st[j] * sp + loc[j] * slc; }
            else { f32x4* pp = (f32x4*)(sl + MLST_CT) + (e - NCI); const f32x4 loc = __builtin_bit_cast(f32x4, lc[qi]); *pp = (f32x4){st[0], st[1], st[2], st[3]};
                st[0] = st[0] * sp + loc[0] * slc; st[1] = st[1] * sp + loc[1] * slc; st[2] = st[2] * sp + loc[2] * slc; st[3] = st[3] * sp + loc[3] * slc;
                if (e == NCI) sl[MLST_CT + DH + 2] = mp; }
            mp = mn; }
    }
}

__device__ __forceinline__ void mlstm_out_unit(const Frame& F0, int b, int h, int cs) {
    Frame F = F0; LAUNDER(F.tid); F.lane = F.tid & 63;
    LAS bf16_t* Qs = (LAS bf16_t*)F.lds; LAS bf16_t* Ks = (LAS bf16_t*)(F.lds + TILE_B); LAS bf16_t* VT = (LAS bf16_t*)(F.lds + 2 * TILE_B); LAS bf16_t* Cs = (LAS bf16_t*)(F.lds + 3 * TILE_B);
    LAS bf16_t* Ss = Ks;
    LAS float* Hs = (LAS float*)F.lds;
    LAS float* ga = (LAS float*)(F.lds + 4 * TILE_B);
    LAS float* den2 = ga;
    LAS float* qn = ga + 2 * CH;
    LAS float* nin = ga + 3 * CH;
    static_assert(4 * TILE_B + 14 * CH * 4 <= LDS_MISC, "mLSTM out LDS");
    const int m0 = chunk_row0(b, cs);
    const bf16_t* P = F.wsp<bf16_t>(WS_P); const float* cw = F.in[I_MLCW]; const float* cb = F.in[I_MLCB];
    u32x4 cpre[4], opre[4]; float npre = 0.f;
    { const u32x4* s0 = (const u32x4*)mlst_slot(F, 0, b, h, cs);
#pragma unroll
        for (int i = 0; i < 4; ++i) cpre[i] = s0[F.tid + NTHREADS * i];
        if (F.tid < DH) npre = mlst_slot(F, 0, b, h, cs)[MLST_CT + F.tid];
        const bf16_t* op = P + (size_t)(m0 + (F.tid >> 2)) * AB_MAIN + 3 * HYD + 3 * MLD + h * DH + (F.tid & 3) * 32;
#pragma unroll
        for (int i = 0; i < 4; ++i) opre[i] = *(const u32x4*)(op + 8 * i); }
    __syncthreads();
    mlstm_gates(F, ga, m0, h);
    if (F.wave < 2) { const int d = F.wave; const LAS float* bc = ga + (4 + d) * CH; const LAS float* ig = ga + (1 + 2 * d) * CH;
        const int i0 = d ? CH - 1 - 2 * F.lane : 2 * F.lane, i1 = d ? i0 - 1 : i0 + 1; ga[(6 + d) * CH + i0] = ig[i0] - bc[i0]; ga[(6 + d) * CH + i1] = ig[i1] - bc[i1];
        wave_scan128<true>(ga + (6 + d) * CH, ga + (8 + d) * CH, d != 0, F.lane); }
    { const int fg = F.tid & 15, sr = F.tid >> 4, f0 = fg * 8; const float qs = 0.08838834764831845f;
        const float* wq = cw + h * DH + f0; const float* wk = cw + MLD + h * DH + f0;
        f32x4 wqa[3], wqb[3], wka[3], wkb[3];
#pragma unroll
        for (int tp = 0; tp < 3; ++tp) { wqa[tp] = *(const f32x4*)(wq + tp * 2 * MLD); wqb[tp] = *(const f32x4*)(wq + tp * 2 * MLD + 4); wka[tp] = *(const f32x4*)(wk + tp * 2 * MLD); wkb[tp] = *(const f32x4*)(wk + tp * 2 * MLD + 4); }
        const f32x4 bqa = *(const f32x4*)(cb + h * DH + f0), bqb = *(const f32x4*)(cb + h * DH + f0 + 4), bka = *(const f32x4*)(cb + MLD + h * DH + f0), bkb = *(const f32x4*)(cb + MLD + h * DH + f0 + 4);
#pragma unroll 2
        for (int ps = 0; ps < CH / 32; ++ps) { const int s = 32 * ps + sr; bool hl, hr; conv_nbr(cs, s, hl, hr);
            const bf16_t* qp = P + (size_t)(m0 + s) * AB_MAIN + 3 * HYD + h * DH + f0; const bf16_t* kp = qp + MLD;
            const u32x4 z4 = {0u, 0u, 0u, 0u};
            const u32x4 qc = *(const u32x4*)qp, kc = *(const u32x4*)kp;
            u32x4 ql = z4, qr = z4, kl = z4, kr_ = z4;
            if (hl) { ql = *(const u32x4*)(qp - AB_MAIN); kl = *(const u32x4*)(kp - AB_MAIN); }
            if (hr) { qr = *(const u32x4*)(qp + AB_MAIN); kr_ = *(const u32x4*)(kp + AB_MAIN); }
            float xl[8], xc[8], xr[8], qv[8], kv[8];
            unpack8(ql, xl); unpack8(qc, xc); unpack8(qr, xr);
#pragma unroll
            for (int j = 0; j < 4; ++j) { qv[j] = bqa[j] + wqa[0][j] * xl[j] + wqa[1][j] * xc[j] + wqa[2][j] * xr[j]; qv[4 + j] = bqb[j] + wqb[0][j] * xl[4 + j] + wqb[1][j] * xc[4 + j] + wqb[2][j] * xr[4 + j]; }
            unpack8(kl, xl); unpack8(kc, xc); unpack8(kr_, xr);
#pragma unroll
            for (int j = 0; j < 4; ++j) { kv[j] = bka[j] + wka[0][j] * xl[j] + wka[1][j] * xc[j] + wka[2][j] * xr[j]; kv[4 + j] = bkb[j] + wkb[0][j] * xl[4 + j] + wkb[1][j] * xc[4 + j] + wkb[2][j] * xr[4 + j]; }
            u32x4 qw, kw; qw.x = pk2(siluf(qv[0]) * qs, siluf(qv[1]) * qs); qw.y = pk2(siluf(qv[2]) * qs, siluf(qv[3]) * qs); qw.z = pk2(siluf(qv[4]) * qs, siluf(qv[5]) * qs); qw.w = pk2(siluf(qv[6]) * qs, siluf(qv[7]) * qs);
            kw.x = pk2(siluf(kv[0]), siluf(kv[1])); kw.y = pk2(siluf(kv[2]), siluf(kv[3])); kw.z = pk2(siluf(kv[4]), siluf(kv[5])); kw.w = pk2(siluf(kv[6]), siluf(kv[7]));
            *(LAS u32x4*)(Qs + s * TP + f0) = qw; *(LAS u32x4*)(Ks + s * TP + f0) = kw; } }
    { const int s = F.tid & 127, fgq = F.tid >> 7;
#pragma unroll
        for (int i = 0; i < 4; ++i) { const int f0 = (fgq + 4 * i) * 8;
            float vv[8]; unpack8(*(const u32x4*)(P + (size_t)(m0 + s) * AB_MAIN + 3 * HYD + 2 * MLD + h * DH + f0), vv);
#pragma unroll
            for (int j = 0; j < 8; ++j) VT[(f0 + j) * TP + s] = (bf16_t)f2bf(vv[j]); } }
    __syncthreads();
    if (F.tid < 2 * CH) { const int d = F.tid >> 7, i = F.tid & 127; const float m_in = mlst_slot(F, d, b, h, cs)[MLST_CT + DH + 2]; const float M = fmaxf(ga[(8 + d) * CH + i], m_in);
        const float bci = ga[(4 + d) * CH + i]; ga[(8 + d) * CH + i] = M; ga[(10 + d) * CH + i] = expf(m_in - M); ga[(12 + d) * CH + i] = expf(-(bci + M)); }
    const int wm = F.wave >> 1, wn = F.wave & 1, r = F.lane & 15, q = F.lane >> 4;
    f32x4 sraw[2][4]; zero_acc(sraw);
    wave_mma<2, 4, 4>(sraw, Qs, 32 * wm, Ks, 64 * wn, F.lane);
    f32x4 hsum[2][4]; zero_acc(hsum);
    __syncthreads();
#pragma unroll 1
    for (int d = 0; d < 2; ++d) {
#pragma unroll
        for (int i = 0; i < 4; ++i) { const int it = F.tid + NTHREADS * i, vv = (8 * it) / DH, kk = (8 * it) % DH; *(LAS u32x4*)(Cs + vv * TP + kk) = cpre[i]; }
        if (F.tid < DH) nin[F.tid] = npre;
        if (d == 0) { const u32x4* s1 = (const u32x4*)mlst_slot(F, 1, b, h, cs);
#pragma unroll
            for (int i = 0; i < 4; ++i) cpre[i] = s1[F.tid + NTHREADS * i];
            if (F.tid < DH) npre = mlst_slot(F, 1, b, h, cs)[MLST_CT + F.tid]; }
        const LAS float* ea = ga + (6 + d) * CH; const LAS float* Ma = ga + (8 + d) * CH;
#pragma unroll
        for (int mt = 0; mt < 2; ++mt)
#pragma unroll
            for (int j = 0; j < 4; ++j) { const int t = 32 * wm + 16 * mt + 4 * q + j; const float Mt = Ma[t]; float rs = 0.f;
#pragma unroll
                for (int nt = 0; nt < 4; ++nt) { const int s = 64 * wn + 16 * nt + r; const bool ok = d ? (s >= t) : (s <= t);
                    const float v = ok ? sraw[mt][nt][j] * FEXP(ea[s] - Mt) : 0.f; rs += v; Ss[t * TP + s] = (bf16_t)f2bf(v); }
                rs += __shfl_xor(rs, 1); rs += __shfl_xor(rs, 2); rs += __shfl_xor(rs, 4); rs += __shfl_xor(rs, 8);
                if (r == 0) den2[wn * CH + t] = rs; }
        __syncthreads();
        if (F.tid < CH) { const LAS bf16_t* row = Qs + F.tid * TP; float s = 0.f;
            for (int i = 0; i < DH; i += 8) { float f[8]; unpack8(*(const LAS u32x4*)(row + i), f);
#pragma unroll
                for (int j = 0; j < 8; ++j) s += f[j] * nin[i + j]; }
            qn[F.tid] = s; }
        f32x4 asv[2][4], aqc[2][4]; zero_acc(asv); zero_acc(aqc);
        wave_mma<2, 4, 4>(asv, Ss, 32 * wm, VT, 64 * wn, F.lane);
        wave_mma<2, 4, 4>(aqc, Qs, 32 * wm, Cs, 64 * wn, F.lane);
        __syncthreads();
        const LAS float* wi = ga + (10 + d) * CH; const LAS float* emt = ga + (12 + d) * CH;
#pragma unroll
        for (int mt = 0; mt < 2; ++mt)
#pragma unroll
            for (int j = 0; j < 4; ++j) { const int t = 32 * wm + 16 * mt + 4 * q + j; const float w = wi[t];
                const float den = den2[t] + den2[CH + t] + w * qn[t]; const float inv = 1.0f / fmaxf(fabsf(den), emt[t]);
#pragma unroll
                for (int nt = 0; nt < 4; ++nt) hsum[mt][nt][j] += (asv[mt][nt][j] + w * aqc[mt][nt][j]) * inv; }
        __syncthreads();
    }
#pragma unroll
    for (int mt = 0; mt < 2; ++mt)
#pragma unroll
        for (int nt = 0; nt < 4; ++nt)
#pragma unroll
            for (int j = 0; j < 4; ++j) Hs[(32 * wm + 16 * mt + 4 * q + j) * 132 + 64 * wn + 16 * nt + r] = hsum[mt][nt][j];
    __syncthreads();
    { const int t = F.tid >> 2, part = F.tid & 3; const LAS float* hr_ = Hs + t * 132 + part * 32; float v[32]; float s = 0.f;
#pragma unroll
        for (int i = 0; i < 32; ++i) { v[i] = hr_[i]; s += v[i]; }
        s += __shfl_xor(s, 1); s += __shfl_xor(s, 2); const float mu = s * (1.0f / DH); float qv = 0.f;
#pragma unroll
        for (int i = 0; i < 32; ++i) { v[i] -= mu; qv += v[i] * v[i]; }
        qv += __shfl_xor(qv, 1); qv += __shfl_xor(qv, 2); const float inv = 1.0f / sqrtf(qv * (1.0f / DH) + EPS);
        const float* nw = F.in[I_MLNW] + h * DH + part * 32;
        f32x4 nwv[8];
#pragma unroll
        for (int i = 0; i < 8; ++i) nwv[i] = *(const f32x4*)(nw + 4 * i);
        bf16_t* yp = F.wsp<bf16_t>(WS_YCAT) + (size_t)(m0 + t) * YC1 + HYD + h * DH + part * 32;
#pragma unroll
        for (int i = 0; i < 32; i += 8) { float o[8]; unpack8(opre[i >> 3], o); float y[8];
#pragma unroll
            for (int j = 0; j < 8; ++j) y[j] = v[i + j] * inv * nwv[(i + j) >> 2][(i + j) & 3] * sigmoidf_(o[j]);
            u32x4 w; w.x = pk2(y[0], y[1]); w.y = pk2(y[2], y[3]); w.z = pk2(y[4], y[5]); w.w = pk2(y[6], y[7]); *(u32x4*)(yp + i) = w; } }
    __syncthreads();
}

__device__ __forceinline__ float* ssd_slot(const Frame& F, int d, int b, int hd, int cs) { return F.wsp<float>(WS_SSDST) + ((((size_t)d * NB + b) * SSDH + hd) * NCS + cs) * SSDST_STRIDE; }
constexpr int XB_B = SSDD + SSDD, XB_C = SSDD + SSDD + SSDG * SSDN;

__device__ __forceinline__ void ssd_act_pass(const Frame& F) {
    const bf16_t* P = F.wsp<bf16_t>(WS_P); bf16_t* XA = F.wsp<bf16_t>(WS_XACT); const float* cw = F.in[I_SSDCW]; const float* cb = F.in[I_SSDCB];
    constexpr int NFG = XBC / 8;
    const int stride = F.G * NTHREADS; constexpr int AB_ = 4;
    for (int idx0 = F.bid * NTHREADS + F.tid; idx0 < MT * NFG; idx0 += AB_ * stride) {
        float v[AB_][8];
#pragma unroll
        for (int j = 0; j < AB_; ++j) { const int ij = idx0 + j * stride; const int idx = ij < MT * NFG ? ij : idx0; const int m = idx / NFG, c = (idx % NFG) * 8; bool hl, hr;
            if (m < ML) { hl = (m & (GW - 1)) != 0; hr = (m & (GW - 1)) != GW - 1; } else { const int pos = (m - ML) % CTX; hl = pos > 0; hr = pos < CTX - 1; }
            conv3x8(P + (size_t)m * CD_MAIN + SSDD + c, CD_MAIN, hl, hr, cw + c, XBC, cb + c, v[j]); }
#pragma unroll
        for (int j = 0; j < AB_; ++j) { const int idx = idx0 + j * stride; if (idx < MT * NFG) { const int m = idx / NFG, c = (idx % NFG) * 8;
            u32x4 w; w.x = pk2(siluf(v[j][0]), siluf(v[j][1])); w.y = pk2(siluf(v[j][2]), siluf(v[j][3])); w.z = pk2(siluf(v[j][4]), siluf(v[j][5])); w.w = pk2(siluf(v[j][6]), siluf(v[j][7]));
            *(u32x4*)(XA + (size_t)m * XBC + c) = w; } }
    }
}
__device__ __forceinline__ void ssd_local_unit(const Frame& F0, int b, int cs, int g, int d, int hh) {
    Frame F = F0; LAUNDER(F.tid); F.lane = F.tid & 63;
    LAS bf16_t* BT = (LAS bf16_t*)F.lds; LAS bf16_t* XwT = (LAS bf16_t*)(F.lds + TILE_B);
    LAS float* ar = (LAS float*)(F.lds + 3 * TILE_B);
    const int m0 = chunk_row0(b, cs); const bf16_t* P = F.wsp<bf16_t>(WS_P); const float* sd = F.wsp<float>(WS_SIDE);
    const float* cw = F.in[I_SSDCW]; const float* cb = F.in[I_SSDCB];
    __syncthreads();
    { const int s = F.tid & 127, j = F.tid >> 7, hd = g * HPG + hh * 4 + j;
        const float dtv = softplusf_(sd[(size_t)(m0 + s) * 32 + d * SSDH + hd] + F.in[I_SSDDTB][d * SSDH + hd]);
        ar[j * CH + s] = dtv; ar[(4 + j) * CH + s] = -dtv * expf(F.in[I_SSDALOG][d * SSDH + hd]); }
    __syncthreads();
    if (F.wave < 4) { const int j = F.wave; LAS float* la = ar + (4 + j) * CH; wave_scan128<false>(la, la, d != 0, F.lane);
        if (F.lane == 0) ssd_slot(F, d, b, g * HPG + hh * 4 + j, cs)[SSD_HF] = expf(d ? la[0] : la[CH - 1]); }
    __syncthreads();
    { const int i = F.tid & 127, j = F.tid >> 7; const LAS float* la = ar + (4 + j) * CH; const float aend = d ? la[0] : la[CH - 1]; ar[(8 + j) * CH + i] = expf(aend - la[i]) * ar[j * CH + i]; }
    __syncthreads();
    { const int s = F.tid & 127, fgq = F.tid >> 7; const bf16_t* xrow = F.wsp<bf16_t>(WS_XACT) + (size_t)(m0 + s) * XBC;
#pragma unroll
        for (int i = 0; i < 4; ++i) { const int f0 = (fgq + 4 * i) * 8; const u32x4 w = *(const u32x4*)(xrow + SSDD + g * SSDN + f0);
            BT[(f0 + 0) * TP + s] = (bf16_t)(w.x & 0xffffu); BT[(f0 + 1) * TP + s] = (bf16_t)(w.x >> 16); BT[(f0 + 2) * TP + s] = (bf16_t)(w.y & 0xffffu); BT[(f0 + 3) * TP + s] = (bf16_t)(w.y >> 16);
            BT[(f0 + 4) * TP + s] = (bf16_t)(w.z & 0xffffu); BT[(f0 + 5) * TP + s] = (bf16_t)(w.z >> 16); BT[(f0 + 6) * TP + s] = (bf16_t)(w.w & 0xffffu); BT[(f0 + 7) * TP + s] = (bf16_t)(w.w >> 16); }
#pragma unroll
        for (int i = 0; i < 8; ++i) { const int fg = fgq + 4 * i, j = fg >> 3, p0 = (fg & 7) * 8; float v[8]; unpack8(*(const u32x4*)(xrow + (g * HPG + hh * 4 + j) * SSDP + p0), v); const float we = ar[(8 + j) * CH + s];
#pragma unroll
            for (int jj = 0; jj < 8; ++jj) XwT[(j * 64 + p0 + jj) * TP + s] = (bf16_t)f2bf(v[jj] * we); } }
    __syncthreads();
    f32x4 acc[8][2]; zero_acc(acc);
    wave_mma<8, 2, 4>(acc, BT, 0, XwT, 32 * F.wave, F.lane);
    const int r = F.lane & 15, q = F.lane >> 4;
#pragma unroll
    for (int nt = 0; nt < 2; ++nt) { const int jp = 32 * F.wave + 16 * nt + r, j = jp >> 6, p = jp & 63; bf16_t* sl = (bf16_t*)ssd_slot(F, d, b, g * HPG + hh * 4 + j, cs) + p * SSDN;
#pragma unroll
        for (int mt = 0; mt < 8; ++mt) { u32x2 w; w.x = pk2(acc[mt][nt][0], acc[mt][nt][1]); w.y = pk2(acc[mt][nt][2], acc[mt][nt][3]); *(u32x2*)(sl + 16 * mt + 4 * q) = w; } }
    __syncthreads();
}

__device__ __forceinline__ void ssd_carry(const Frame& F) {
    constexpr int NVI = SSDP * SSDN / 8, NITEM = 2 * NB * SSDH * NVI;
    for (int it = F.bid * NTHREADS + F.tid; it < NITEM; it += F.G * NTHREADS) {
        const int grp = it / NVI, e = it % NVI, d = grp / (NB * SSDH), b = (grp / SSDH) % NB, hd = grp % SSDH;
        float st[8];
#pragma unroll
        for (int j = 0; j < 8; ++j) st[j] = 0.f;
        u32x4 lc[NCS]; float decs[NCS];
#pragma unroll
        for (int qi = 0; qi < NCS; ++qi) { const float* sl = ssd_slot(F, d, b, hd, scan_slot(d, qi)); lc[qi] = *((const u32x4*)sl + e); decs[qi] = sl[SSD_HF]; }
#pragma unroll
        for (int qi = 0; qi < NCS; ++qi) { float* sl = ssd_slot(F, d, b, hd, scan_slot(d, qi)); u32x4* pp = (u32x4*)sl + e; float loc[8]; unpack8(lc[qi], loc); const float dec = decs[qi];
            u32x4 w; w.x = pk2(st[0], st[1]); w.y = pk2(st[2], st[3]); w.z = pk2(st[4], st[5]); w.w = pk2(st[6], st[7]); *pp = w;
#pragma unroll
            for (int j = 0; j < 8; ++j) st[j] = st[j] * dec + loc[j]; }
    }
}

__device__ __forceinline__ void ssd_out_unit(const Frame& F0, int b, int lc, int g, int hh) {
    Frame F = F0; LAUNDER(F.tid); F.lane = F.tid & 63;
    LAS bf16_t* Cs = (LAS bf16_t*)F.lds; LAS bf16_t* Bs = (LAS bf16_t*)(F.lds + TILE_B); LAS bf16_t* Ls = Bs;
    LAS bf16_t* XT = (LAS bf16_t*)(F.lds + 2 * TILE_B); LAS bf16_t* Hs = (LAS bf16_t*)(F.lds + 2 * TILE_B + 64 * TP * 2);
    LAS float* ar = (LAS float*)(F.lds + 3 * TILE_B);
    const int cs = NCC + lc, m0 = b * SEQ + lc * CH; const bf16_t* P = F.wsp<bf16_t>(WS_P); const float* sd = F.wsp<float>(WS_SIDE);
    const float* cw = F.in[I_SSDCW]; const float* cb = F.in[I_SSDCB];
    __syncthreads();
    { const int s = F.tid & 127, j = F.tid >> 7, hd = g * HPG + hh * 4 + j;
#pragma unroll
        for (int d = 0; d < 2; ++d) { const float dtv = softplusf_(sd[(size_t)(m0 + s) * 32 + d * SSDH + hd] + F.in[I_SSDDTB][d * SSDH + hd]);
            ar[(d * 4 + j) * CH + s] = dtv; ar[(8 + d * 4 + j) * CH + s] = -dtv * expf(F.in[I_SSDALOG][d * SSDH + hd]); } }
    __syncthreads();
    { const int k = F.wave, d = k >> 2; LAS float* la = ar + (8 + k) * CH; wave_scan128<false>(la, la, d != 0, F.lane); }
    { const int s = F.tid & 127, fgq = F.tid >> 7; const bf16_t* xrow = F.wsp<bf16_t>(WS_XACT) + (size_t)(m0 + s) * XBC;
#pragma unroll
        for (int i = 0; i < 4; ++i) { const int f0 = (fgq + 4 * i) * 8;
            *(LAS u32x4*)(Bs + s * TP + f0) = *(const u32x4*)(xrow + SSDD + g * SSDN + f0);
            *(LAS u32x4*)(Cs + s * TP + f0) = *(const u32x4*)(xrow + SSDD + SSDG * SSDN + g * SSDN + f0); } }
    __syncthreads();
    const int wm = F.wave >> 1, wn = F.wave & 1, r = F.lane & 15, q = F.lane >> 4;
    f32x4 cbm[2][4]; zero_acc(cbm);
    wave_mma<2, 4, 4>(cbm, Cs, 32 * wm, Bs, 64 * wn, F.lane);
    float ssq[2][4];
#pragma unroll
    for (int mt = 0; mt < 2; ++mt)
#pragma unroll
        for (int jj = 0; jj < 4; ++jj) ssq[mt][jj] = 0.f;
    LAS bf16_t* Hs2 = (LAS bf16_t*)(F.lds + 3 * TILE_B + 18 * CH * 4);
    static_assert(3 * TILE_B + 18 * CH * 4 + 64 * TP * 2 <= LDS_MISC, "ssd out LDS");
    u32x4 hpre[4], xpre[2];
    const int xs_ = F.tid & 127, xfq = F.tid >> 7; const bf16_t* xrow = F.wsp<bf16_t>(WS_XACT) + (size_t)(m0 + xs_) * XBC;
#define SSD_LOADH(jn) do { const u32x4* sf_ = (const u32x4*)ssd_slot(F, 0, b, g * HPG + hh * 4 + (jn), cs); const u32x4* sb_ = (const u32x4*)ssd_slot(F, 1, b, g * HPG + hh * 4 + (jn), cs); \
        hpre[0] = sf_[F.tid]; hpre[1] = sf_[F.tid + NTHREADS]; hpre[2] = sb_[F.tid]; hpre[3] = sb_[F.tid + NTHREADS]; } while (0)
#define SSD_LOADX(jn) do { xpre[0] = *(const u32x4*)(xrow + (g * HPG + hh * 4 + (jn)) * SSDP + xfq * 8); xpre[1] = *(const u32x4*)(xrow + (g * HPG + hh * 4 + (jn)) * SSDP + (xfq + 4) * 8); } while (0)
    SSD_LOADH(0); SSD_LOADX(0);
#pragma unroll 1
    for (int j = 0; j < 4; ++j) {
        const int hd = g * HPG + hh * 4 + j;
        __syncthreads();
#pragma unroll
        for (int i = 0; i < 2; ++i) { const int f0 = (xfq + 4 * i) * 8; const u32x4 w = xpre[i];
            XT[(f0 + 0) * TP + xs_] = (bf16_t)(w.x & 0xffffu); XT[(f0 + 1) * TP + xs_] = (bf16_t)(w.x >> 16); XT[(f0 + 2) * TP + xs_] = (bf16_t)(w.y & 0xffffu); XT[(f0 + 3) * TP + xs_] = (bf16_t)(w.y >> 16);
            XT[(f0 + 4) * TP + xs_] = (bf16_t)(w.z & 0xffffu); XT[(f0 + 5) * TP + xs_] = (bf16_t)(w.z >> 16); XT[(f0 + 6) * TP + xs_] = (bf16_t)(w.w & 0xffffu); XT[(f0 + 7) * TP + xs_] = (bf16_t)(w.w >> 16); }
#pragma unroll
        for (int i = 0; i < 2; ++i) { const int it = F.tid + NTHREADS * i, p = (8 * it) / SSDN, n = (8 * it) % SSDN; *(LAS u32x4*)(Hs + p * TP + n) = hpre[i]; *(LAS u32x4*)(Hs2 + p * TP + n) = hpre[2 + i]; }
        if (j < 3) { SSD_LOADX(j + 1); SSD_LOADH(j + 1); }
        bf16_t zpre[2][4][2];
#pragma unroll
        for (int mt = 0; mt < 2; ++mt)
#pragma unroll
            for (int jj = 0; jj < 4; ++jj)
#pragma unroll
                for (int nt = 0; nt < 2; ++nt) zpre[mt][jj][nt] = P[(size_t)(m0 + 32 * wm + 16 * mt + 4 * q + jj) * CD_MAIN + hd * SSDP + 32 * wn + 16 * nt + r];
        const LAS float* dtf = ar + j * CH; const LAS float* dtb = ar + (4 + j) * CH; const LAS float* acf = ar + (8 + j) * CH; const LAS float* acb = ar + (12 + j) * CH;
#pragma unroll
        for (int mt = 0; mt < 2; ++mt)
#pragma unroll
            for (int jj = 0; jj < 4; ++jj) { const int t = 32 * wm + 16 * mt + 4 * q + jj; const float atf = acf[t], atb = acb[t];
#pragma unroll
                for (int nt = 0; nt < 4; ++nt) { const int s_ = 64 * wn + 16 * nt + r;
                    const float vf = s_ <= t ? FEXP(atf - acf[s_]) * dtf[s_] : 0.f, vb = s_ >= t ? FEXP(atb - acb[s_]) * dtb[s_] : 0.f;
                    Ls[t * TP + s_] = (bf16_t)f2bf(cbm[mt][nt][jj] * (vf + vb)); } }
        __syncthreads();
        f32x4 ysum[2][2], yof[2][2], yob[2][2]; zero_acc(ysum); zero_acc(yof); zero_acc(yob);
        wave_mma<2, 2, 4>(ysum, Ls, 32 * wm, XT, 32 * wn, F.lane);
        wave_mma<2, 2, 4>(yof, Cs, 32 * wm, Hs, 32 * wn, F.lane);
        wave_mma<2, 2, 4>(yob, Cs, 32 * wm, Hs2, 32 * wn, F.lane);
#pragma unroll
        for (int mt = 0; mt < 2; ++mt)
#pragma unroll
            for (int jj = 0; jj < 4; ++jj) { const int t = 32 * wm + 16 * mt + 4 * q + jj; const float eaf = FEXP(acf[t]), eab = FEXP(acb[t]);
#pragma unroll
                for (int nt = 0; nt < 2; ++nt) ysum[mt][nt][jj] += eaf * yof[mt][nt][jj] + eab * yob[mt][nt][jj]; }
        const float dsk = F.in[I_SSDD][hd];
#pragma unroll
        for (int mt = 0; mt < 2; ++mt)
#pragma unroll
            for (int jj = 0; jj < 4; ++jj) { const int t = 32 * wm + 16 * mt + 4 * q + jj;
#pragma unroll
                for (int nt = 0; nt < 2; ++nt) { const int p = 32 * wn + 16 * nt + r; const float xs = bf2f(XT[p * TP + t]);
                    const float z = bf2f(zpre[mt][jj][nt]); const float y = (ysum[mt][nt][jj] + dsk * xs) * siluf(z);
                    F.wsp<float>(WS_YPRE)[(size_t)(m0 + t) * SSDD + hd * SSDP + p] = y; ssq[mt][jj] += y * y; } }
    }
#undef SSD_LOADH
#undef SSD_LOADX
    LAS float* ssq2 = ar + 16 * CH;
#pragma unroll
    for (int mt = 0; mt < 2; ++mt)
#pragma unroll
        for (int jj = 0; jj < 4; ++jj) { float s = ssq[mt][jj]; s += __shfl_xor(s, 1); s += __shfl_xor(s, 2); s += __shfl_xor(s, 4); s += __shfl_xor(s, 8);
            if (r == 0) ssq2[wn * CH + 32 * wm + 16 * mt + 4 * q + jj] = s; }
    __syncthreads();
    if (F.tid < CH) F.wsp<float>(WS_SSQ)[(size_t)(m0 + F.tid) * 4 + g * 2 + hh] = ssq2[F.tid] + ssq2[CH + F.tid];
    __syncthreads();
}

__device__ __forceinline__ void ssd_norm_rows(const Frame& F, int wg_lo, int wg_cnt) {
    const float* yp = F.wsp<float>(WS_YPRE); const float* sq = F.wsp<float>(WS_SSQ); const float* nw = F.in[I_SSDNW]; bf16_t* Y = F.wsp<bf16_t>(WS_YCAT);
    if (F.bid < wg_lo || F.bid >= wg_lo + wg_cnt) return;
    constexpr int NI = SSDD / 256; static_assert(SSDD % 256 == 0, "ssd norm row pieces");
    f32x4 w4[NI];
#pragma unroll
    for (int i = 0; i < NI; ++i) w4[i] = *(const f32x4*)(nw + 4 * F.lane + 256 * i);
    for (int m = (F.bid - wg_lo) * NWAVES + F.wave; m < ML; m += wg_cnt * NWAVES) { const f32x4 s4 = *(const f32x4*)(sq + (size_t)m * 4); f32x4 y[NI];
#pragma unroll
        for (int i = 0; i < NI; ++i) y[i] = *(const f32x4*)(yp + (size_t)m * SSDD + 4 * F.lane + 256 * i);
        const float rinv = 1.0f / sqrtf((s4[0] + s4[1] + s4[2] + s4[3]) * (1.0f / SSDD) + EPS);
#pragma unroll
        for (int i = 0; i < NI; ++i) { u32x2 w; w.x = pk2(y[i][0] * rinv * w4[i][0], y[i][1] * rinv * w4[i][1]); w.y = pk2(y[i][2] * rinv * w4[i][2], y[i][3] * rinv * w4[i][3]);
            *(u32x2*)(Y + (size_t)m * YC2 + 4 * F.lane + 256 * i) = w; } }
}

__device__ __forceinline__ float* s5_slot(const Frame& F, int d, int b, int cs, int g) { return F.wsp<float>(WS_S5ST) + ((((size_t)d * NB + b) * NCS + cs) * S5G + g) * (S5P * 2); }
__device__ __forceinline__ void s5_load_u(const Frame& F, LAS float* ub, int m0, int g) {
    const bf16_t* P = F.wsp<bf16_t>(WS_P);
#pragma unroll
    for (int k = 0; k < 2; ++k) { const int s = F.lane + 64 * k; const bf16_t* up = P + (size_t)(m0 + s) * CD_MAIN + SSDD + XBC + g * S5GS; float f[8];
        unpack8(*(const u32x4*)up, f);
#pragma unroll
        for (int j = 0; j < 8; ++j) ub[s * 16 + j] = f[j];
        unpack8(*(const u32x4*)(up + 8), f);
#pragma unroll
        for (int j = 0; j < 8; ++j) ub[s * 16 + 8 + j] = f[j]; }
    WAVE_SYNC();
}
#define S5_STEP(s) do { const f32x4 u0 = *(const LAS f32x4*)(ub + (s) * 16), u1 = *(const LAS f32x4*)(ub + (s) * 16 + 4), u2 = *(const LAS f32x4*)(ub + (s) * 16 + 8), u3 = *(const LAS f32x4*)(ub + (s) * 16 + 12); \
    f32x2 b0 = {0.f, 0.f}, b1 = {0.f, 0.f}, b2 = {0.f, 0.f}, b3 = {0.f, 0.f}; _Pragma("unroll") for (int k = 0; k < 4; ++k) { b0 += bb2[k] * (f32x2){u0[k], u0[k]}; b1 += bb2[4 + k] * (f32x2){u1[k], u1[k]}; b2 += bb2[8 + k] * (f32x2){u2[k], u2[k]}; b3 += bb2[12 + k] * (f32x2){u3[k], u3[k]}; } \
    const f32x2 bs = (b0 + b1) + (b2 + b3); \
    const float nr = lbr * xr - lbi * xi + bs[0], ni = lbr * xi + lbi * xr + bs[1]; xr = nr; xi = ni; } while (0)
#define S5_LOAD_PAR(d, g) const float* par = F.wsp<float>(WS_S5PAR) + ((size_t)((d) * S5G + (g)) * S5P + F.lane) * 36; const float lbr = par[0], lbi = par[1]; f32x2 bb2[16]; \
    _Pragma("unroll") for (int k = 0; k < 16; ++k) { bb2[k][0] = par[2 + k]; bb2[k][1] = par[18 + k]; }

__device__ __forceinline__ void s5_local_units(const Frame& F) {
    LAS float* ub = (LAS float*)(F.lds + F.wave * 8192);
    constexpr int NU = 2 * NB * NCS * S5G;
    for (int u = F.gw(); u < NU; u += F.ngw()) { const int g = u % S5G, cs = (u / S5G) % NCS, b = (u / (S5G * NCS)) % NB, d = u / (S5G * NCS * NB);
        WAVE_SYNC();
        s5_load_u(F, ub, chunk_row0(b, cs), g);
        S5_LOAD_PAR(d, g)
        float xr = 0.f, xi = 0.f;
        _Pragma("unroll 4") for (int ii = 0; ii < CH; ++ii) { const int s = d ? CH - 1 - ii : ii; S5_STEP(s); }
        float* sl = s5_slot(F, d, b, cs, g); sl[F.lane * 2] = xr; sl[F.lane * 2 + 1] = xi; }
}
__device__ __forceinline__ void s5_carry(const Frame& F) {
    for (int it = F.bid * NTHREADS + F.tid; it < 2 * NB * S5G * S5P; it += F.G * NTHREADS) { const int p = it % S5P, g = (it / S5P) % S5G, b = (it / (S5P * S5G)) % NB, d = it / (S5P * S5G * NB);
        const float* par = F.wsp<float>(WS_S5PAR) + ((size_t)(d * S5G + g) * S5P + p) * 36; const float pr = par[34], pi = par[35]; float xr = 0.f, xi = 0.f;
        float lrs[NCS], lis[NCS];
#pragma unroll
        for (int qi = 0; qi < NCS; ++qi) { const float* sl = s5_slot(F, d, b, scan_slot(d, qi), g) + p * 2; lrs[qi] = sl[0]; lis[qi] = sl[1]; }
#pragma unroll
        for (int qi = 0; qi < NCS; ++qi) { float* sl = s5_slot(F, d, b, scan_slot(d, qi), g) + p * 2; const float lr = lrs[qi], li = lis[qi]; sl[0] = xr; sl[1] = xi;
            const float nr = pr * xr - pi * xi + lr, ni = pr * xi + pi * xr + li; xr = nr; xi = ni; } }
}
__device__ __forceinline__ void s5_out_units(const Frame& F) {
    LAS float* ub = (LAS float*)(F.lds + F.wave * 16896); LAS bf16_t* xb = (LAS bf16_t*)(F.lds + F.wave * 16896 + 8192);
    const int r = F.lane & 15, q = F.lane >> 4;
    constexpr int NU = NB * NCL * S5G;
    for (int u = F.gw(); u < NU; u += F.ngw()) { const int g = u % S5G, lc = (u / S5G) % NCL, b = u / (S5G * NCL); const int cs = NCC + lc, m0 = b * SEQ + lc * CH;
        WAVE_SYNC();
        s5_load_u(F, ub, m0, g);
        bf16x8 cf[4];
#pragma unroll
        for (int ks = 0; ks < 4; ++ks) { const int k0 = 32 * ks + 8 * q; const bool im = k0 >= 64; const float* cp = (im ? F.in[I_S5CIM] : F.in[I_S5CRE]) + ((size_t)g * S5GS + r) * S5P + (k0 & 63);
#pragma unroll
            for (int j = 0; j < 8; ++j) cf[ks][j] = (short)f2bf(im ? -cp[j] : cp[j]); }
        f32x4 acc[8];
#pragma unroll
        for (int i = 0; i < 8; ++i) acc[i] = (f32x4){0.f, 0.f, 0.f, 0.f};
#pragma unroll
        for (int d = 0; d < 2; ++d) {
            S5_LOAD_PAR(d, g)
            const float* sl = s5_slot(F, d, b, cs, g); float xr = sl[F.lane * 2], xi = sl[F.lane * 2 + 1];
#pragma unroll
            for (int sbi = 0; sbi < 4; ++sbi) { const int sb = d ? 3 - sbi : sbi;
                for (int ii = 0; ii < 32; ++ii) { const int sl_ = d ? 31 - ii : ii; const int s = 32 * sb + sl_; S5_STEP(s);
                    xb[sl_ * TP + F.lane] = (bf16_t)f2bf(xr); xb[sl_ * TP + 64 + F.lane] = (bf16_t)f2bf(xi); }
                WAVE_SYNC();
#pragma unroll
                for (int mt = 0; mt < 2; ++mt)
#pragma unroll
                    for (int ks = 0; ks < 4; ++ks) { const bf16x8 a = *(const LAS bf16x8*)(xb + (16 * mt + r) * TP + 32 * ks + 8 * q); acc[2 * sb + mt] = MFMA16(a, cf[ks], acc[2 * sb + mt]); }
                WAVE_SYNC(); }
        }
        const float dsk = F.in[I_S5D][g * S5GS + r]; bf16_t* out = F.wsp<bf16_t>(WS_S5G);
#pragma unroll
        for (int mtile = 0; mtile < 8; ++mtile)
#pragma unroll
            for (int j = 0; j < 4; ++j) { const int t = 16 * mtile + 4 * q + j; const float v = acc[mtile][j] + dsk * ub[t * 16 + r];
                out[(size_t)(m0 + t) * S5W + g * S5GS + r] = (bf16_t)f2bf(0.5f * v * (1.0f + erff(v * 0.70710678118654752f))); }
    }
}

__device__ __forceinline__ int moe_off(const Frame& F, int e) {
    const unsigned* cnt = F.wsp<unsigned>(WS_CTL) + CW_CNT; int o = 0;
#pragma unroll
    for (int k = 0; k < NE; ++k) o += (k < e) ? (int)((cnt[64 * k] + 255u) & ~255u) : 0;
    return o;
}
__device__ __forceinline__ void phase_moe_scatter(const Frame& F) {
    const unsigned char* A = F.wsp<unsigned char>(WS_A); unsigned char* As = F.wsp<unsigned char>(WS_AS); const int* rt = F.wsp<int>(WS_ROUTE); const float* rp = F.wsp<float>(WS_RPROB);
    int* rowmap = F.wsp<int>(WS_ROWMAP); float* rowp = F.wsp<float>(WS_ROWP);
    constexpr int SBN = 4, SNJ = (D + 1023) / 1024; static_assert(SNJ <= 2 && D % 16 == 0, "scatter row chunks");
    for (int it = F.gw(); it < 2 * ML; it += SBN * F.ngw()) {
        int mm[SBN], ee[SBN], pp[SBN]; u32x4 va[SBN][2];
#pragma unroll
        for (int k = 0; k < SBN; ++k) { const int itk = it + k * F.ngw(); const bool ok = itk < 2 * ML; const int m = ok ? itk >> 1 : 0, slot = itk & 1; mm[k] = ok ? m * 2 + slot : -1;
            ee[k] = rt[m * 4 + slot]; pp[k] = rt[m * 4 + 2 + slot];
#pragma unroll
            for (int j = 0; j < SNJ; ++j) if (16 * F.lane + 1024 * j < D) va[k][j] = *(const u32x4*)(A + (size_t)m * D + 16 * F.lane + 1024 * j); }
#pragma unroll
        for (int k = 0; k < SBN; ++k) { if (mm[k] < 0) continue; const int dst = moe_off(F, ee[k]) + pp[k];
#pragma unroll
            for (int j = 0; j < SNJ; ++j) if (16 * F.lane + 1024 * j < D) *(u32x4*)(As + (size_t)dst * D + 16 * F.lane + 1024 * j) = va[k][j];
            if (F.lane == 0) { rowmap[dst] = mm[k]; rowp[dst] = rp[mm[k]]; } } }
    const unsigned* cnt = F.wsp<unsigned>(WS_CTL) + CW_CNT;
    for (int i = F.bid * NTHREADS + F.tid; i < NE * 256; i += F.G * NTHREADS) { const int e = i >> 8, k = i & 255; const int row = moe_off(F, e) + (int)cnt[64 * e] + k; if (row < moe_off(F, e + 1)) { rowmap[row] = -1; rowp[row] = 0.f; } }
}

__device__ __forceinline__ void phase_final(const Frame& F) {
    const float* XL = F.wsp<float>(WS_XL); const bf16_t* ys = F.wsp<bf16_t>(WS_YSLOT); const float* mod = F.wsp<float>(WS_MOD) + (size_t)1 * NR * 6 * D; const float* fw = F.in[I_FNW];
    const float* pmb = F.wsp<float>(WS_PARTM); const int* rt = F.wsp<int>(WS_ROUTE); const float* rp = F.wsp<float>(WS_RPROB);
    int nfull, KS; moe_down_split(moe_off(F, NE) / 256, nfull, KS); const int row_split = nfull * 256;
    constexpr int NV = D / 256;
    LAS float* gl = (LAS float*)F.lds;
    __syncthreads();
    for (int i = F.tid; i < (NB + 1) * D; i += NTHREADS) gl[i] = i < NB * D ? mod[(size_t)(i / D) * 6 * D + 5 * D + i % D] : fw[i - NB * D];
    __syncthreads();
    i32x4 rtn = {0, 0, 0, 0}; float p0n = 0.f, p1n = 0.f;
    if (F.gw() < ML) { rtn = *(const i32x4*)(rt + F.gw() * 4); p0n = rp[F.gw() * 2]; p1n = rp[F.gw() * 2 + 1]; }
    for (int m = F.gw(); m < ML; m += F.ngw()) { const LAS float* gp = gl + mod_row(m) * D; f32x4 v[NV]; float ss = 0.f;
        const i32x4 rtv = rtn; const float p0 = p0n, p1 = p1n;
        { const int mn = m + F.ngw(); if (mn < ML) { rtn = *(const i32x4*)(rt + mn * 4); p0n = rp[mn * 2]; p1n = rp[mn * 2 + 1]; } }
        const int r0 = moe_off(F, rtv[0]) + rtv[2], r1 = moe_off(F, rtv[1]) + rtv[3]; const bool s0 = r0 >= row_split, s1 = r1 >= row_split;
#pragma unroll
        for (int i = 0; i < NV; ++i) { const int k = 4 * (F.lane + 64 * i); const f32x4 x = *(const f32x4*)(XL + (size_t)m * D + k), g = *(const LAS f32x4*)(gp + k); f32x4 a, b;
            if (s0) { a = *(const f32x4*)(pmb + (size_t)(r0 - row_split) * D + k); for (int ks = 1; ks < KS; ++ks) a += *(const f32x4*)(pmb + ((size_t)ks * PM_ROWS + (r0 - row_split)) * D + k); a *= p0; }
            else { const u32x2 w = *(const u32x2*)(ys + (size_t)m * D + k); a = (f32x4){bf2f(w.x & 0xffffu), bf2f(w.x >> 16), bf2f(w.y & 0xffffu), bf2f(w.y >> 16)}; }
            if (s1) { b = *(const f32x4*)(pmb + (size_t)(r1 - row_split) * D + k); for (int ks = 1; ks < KS; ++ks) b += *(const f32x4*)(pmb + ((size_t)ks * PM_ROWS + (r1 - row_split)) * D + k); b *= p1; }
            else { const u32x2 w = *(const u32x2*)(ys + ((size_t)ML + m) * D + k); b = (f32x4){bf2f(w.x & 0xffffu), bf2f(w.x >> 16), bf2f(w.y & 0xffffu), bf2f(w.y >> 16)}; }
            v[i] = x + g * (a + b); ss += v[i][0] * v[i][0] + v[i][1] * v[i][1] + v[i][2] * v[i][2] + v[i][3] * v[i][3]; }
        ss = wave_sum(ss); const float rinv = 1.0f / sqrtf(ss * (1.0f / (float)D) + EPS);
#pragma unroll
        for (int i = 0; i < NV; ++i) { const int k = 4 * (F.lane + 64 * i); const f32x4 w4 = *(const LAS f32x4*)(gl + NB * D + k); NTST(v[i] * rinv * w4, (f32x4*)(F.out + (size_t)m * D + k)); } }
}

constexpr int NPHASE = 23;
__global__ void __launch_bounds__(NTHREADS, 2) fwd_kernel(Args args) {
#ifdef EMU
    unsigned char* lds_raw = emu::tl_blk->lds;
#else
    extern __shared__ __attribute__((aligned(16))) unsigned char lds_raw[];
#endif
    const int tid0 = threadIdx.x;
    volatile LAS unsigned* misc = (volatile LAS unsigned*)((LAS unsigned char*)lds_raw + LDS_MISC);
    if (tid0 < 16) misc[tid0] = 0u;
    __syncthreads();
    const int lo = args.ph_lo, hi = args.ph_hi;
    XcdBarrier bar = xcd_barrier_post((unsigned*)(args.ws + WS_CTL) + CW_BAR, misc);
#ifndef ONLY_PHASE
#define ONLY_PHASE -1
#endif
#define IN(k) ((ONLY_PHASE < 0 || ONLY_PHASE == (k)) && lo <= (k) && (k) < hi)
#define SEAM(k) do { if (IN(k) && IN((k) + 1)) xcd_barrier(bar); } while (0)
#define MKF() Frame F; { int t_ = tid0; LAUNDER(t_); F.lds = (LAS unsigned char*)lds_raw; F.tid = t_; F.lane = t_ & 63; F.wave = RFL(t_ >> 6); F.G = gridDim.x; F.bid = blockIdx.x; F.in = args.in; F.out = args.out; F.ws = args.ws; } \
    float* XL = F.wsp<float>(WS_XL); bf16_t* A = F.wsp<bf16_t>(WS_A); bf16_t* P = F.wsp<bf16_t>(WS_P); bf16_t* Y = F.wsp<bf16_t>(WS_YCAT); bf16_t* H = F.wsp<bf16_t>(WS_H); \
    const float* mod0 = F.wsp<float>(WS_MOD); const float* mod1 = mod0 + (size_t)NR * 6 * D; (void)XL; (void)A; (void)P; (void)Y; (void)H; (void)mod0; (void)mod1;

    if (IN(0)) { MKF() phase_prologue(F); }
    SEAM(0);
    if (IN(1)) { MKF() phase_finalize(F); }
    SEAM(1);
    if (IN(2)) { MKF() modulate_rows<false>(F, F.in[I_X], F.in[I_CTX], 0, 0, A, MT); }
    SEAM(2);
    if (IN(3)) {
        MKF()
        pg8::Gemm g{A, F.wsp<bf16_t>(WS_W_ABIN), MT, AB_MAIN, D}; pg8::StaticOrder S; S.init(MT, AB_MAIN, F.G, F.bid);
        EpiInProj0 E{P, AB_MAIN, F.wsp<bf16_t>(WS_PH)};
        pg8::gemm_phase(F.lds, g, S, E);
        side_gemm(F, A, F.wsp<bf16_t>(WS_W_ABSIDE), F.wsp<float>(WS_SIDE), MT);
    }
    SEAM(3);
    if (IN(4)) {
        MKF()
        hyena_units(F);
        for (int u = F.bid; u < NB * MLH * NCS; u += F.G) mlstm_local_unit(F, u / (MLH * NCS), (u / NCS) % MLH, u % NCS);
    }
    if (IN(4)) { MKF() help_slot(F, 0); }
    SEAM(4);
    if (IN(5)) { MKF() mlstm_carry(F); }
    SEAM(5);
    if (IN(6)) { MKF() for (int u = F.bid; u < NB * MLH * NCS; u += F.G) mlstm_out_unit(F, u / (MLH * NCS), (u / NCS) % MLH, u % NCS); }
    if (IN(6)) { MKF() help_slot(F, 1); }
    SEAM(6);
    if (IN(7)) {
        MKF()
        pg8::Gemm g{Y, F.wsp<bf16_t>(WS_W_ABOUT), MT, D, YC1}; CtxSplitOrder S; S.init(D, YC1, KS7, F.G, F.bid);
        EpiResidSplit E{F.in[I_X], XL, mod0 + 2 * D, F.wsp<float>(WS_PART), YC1 / KS7};
        pg8::gemm_phase(F.lds, g, S, E);
    }
    if (IN(7)) { MKF() help_slot(F, 2); }
    SEAM(7);
    if (IN(8)) { MKF() modulate_rows<false, true>(F, XL, F.in[I_CTX], 0, 3, A, MT, F.wsp<float>(WS_PART), mod0 + (size_t)NB * 6 * D + 2 * D, KS7, XL); }
    SEAM(8);
    if (IN(9)) {
        MKF()
        pg8::Gemm g{F.wsp<bf16_t>(WS_A8), F.wsp<bf16_t>(WS_W_GU), MT, 2 * FF, D / 2}; pg8::StaticOrder S; S.init(MT, 2 * FF, F.G, F.bid);
        EpiGatedI8F8 E{F.wsp<unsigned char>(WS_H), FF, F.wsp<float>(WS_SA8), F.wsp<float>(WS_SB_GU)};
        pg8::gemm_phase(F.lds, g, S, E);
    }
    if (IN(9)) { MKF() help_slot(F, 3); }
    SEAM(9);
    if (IN(10)) {
        MKF()
        pg8::Gemm g{H, F.wsp<bf16_t>(WS_W_DN), MT, D, FF / 2}; CtxSplitOrder S; S.init(D, FF / 2, KS10, F.G, F.bid);
        EpiResidSplitF8 E{XL, XL, mod0 + 5 * D, F.wsp<float>(WS_PART), FF / 2 / KS10};
        pg8::gemm_phase(F.lds, g, S, E);
    }
    if (IN(10)) { MKF() help_slot(F, 4); }
    SEAM(10);
    if (IN(11)) { MKF() modulate_rows<false>(F, XL, XL + (size_t)ML * D, 1, 0, A, MT, F.wsp<float>(WS_PART), mod0 + (size_t)NB * 6 * D + 5 * D, KS10, XL); }
    SEAM(11);
    if (IN(12)) {
        MKF()
        pg8::Gemm g{A, F.wsp<bf16_t>(WS_W_CDIN), MT, CD_MAIN, D}; pg8::StaticOrder S; S.init(MT, CD_MAIN, F.G, F.bid);
        EpiStoreBf16 E{P, CD_MAIN};
        pg8::gemm_phase(F.lds, g, S, E);
        side_gemm(F, A, F.wsp<bf16_t>(WS_W_CDSIDE), F.wsp<float>(WS_SIDE), MT);
    }
    if (IN(12)) { MKF() help_slot(F, 5); }
    SEAM(12);
    if (IN(13)) {
        MKF()
        ssd_act_pass(F);
        xcd_barrier(bar);
        for (int u = F.bid; u < NB * NCS * SSDG * 2 * (HPG / 4); u += F.G) { int r = u; const int hh = r % (HPG / 4); r /= (HPG / 4); const int d = r % 2; r /= 2; const int g = r % SSDG; r /= SSDG; const int cs = r % NCS; r /= NCS;
            ssd_local_unit(F, r, cs, g, d, hh); }
        s5_local_units(F);
    }
    if (IN(13)) { MKF() help_slot(F, 6); }
    SEAM(13);
    if (IN(14)) { MKF() ssd_carry(F); s5_carry(F); }
    SEAM(14);
    if (IN(15)) {
        MKF()
        for (int u = F.bid; u < NB * NCL * SSDG * (HPG / 4); u += F.G) { int r = u; const int hh = r % (HPG / 4); r /= (HPG / 4); const int g = r % SSDG; r /= SSDG; const int lc = r % NCL; r /= NCL;
            ssd_out_unit(F, r, lc, g, hh); }
        __syncthreads();
        s5_out_units(F);
    }
    SEAM(15);
    if (IN(16)) {
        MKF()
        pg8::Gemm g{F.wsp<bf16_t>(WS_S5G), F.wsp<bf16_t>(WS_W_GLU), ML, 2 * S5W, S5W}; pg8::StaticOrder S; S.init(ML, 2 * S5W, F.G, F.bid);
        EpiGated<1> E{Y, YC2, SSDD, 2 * S5W / 256};
        constexpr int NU16 = (ML / 256) * (2 * S5W / 256); const int r16 = NU16 < F.G ? NU16 : 0;
        if (r16 != 0 && F.bid >= r16) ssd_norm_rows(F, r16, F.G - r16);
        pg8::gemm_phase(F.lds, g, S, E);
        if (r16 == 0) ssd_norm_rows(F, 0, F.G);
    }
    if (IN(16)) { MKF() help_slot(F, 7); }
    SEAM(16);
    if (IN(17)) {
        MKF()
        pg8::Gemm g{Y, F.wsp<bf16_t>(WS_W_CDOUT), ML, D, YC2}; pg8::StaticOrder S; S.init(ML, D, F.G, F.bid);
        EpiResid E{XL, XL + (size_t)ML * D, XL, mod1 + 2 * D};
        pg8::gemm_phase(F.lds, g, S, E);
    }
    SEAM(17);
    if (IN(18)) { MKF() modulate_rows<true>(F, XL, XL + (size_t)ML * D, 1, 3, A, ML); }
    SEAM(18);
    if (IN(19)) { MKF() phase_moe_scatter(F); }
    if (IN(19)) { MKF() help_drain(F); }
    SEAM(19);
    if (IN(20)) {
        MKF()
        MoeOrder S; S.init(F, 2 * FF / 256);
        pg8::Gemm g{F.wsp<bf16_t>(WS_AS), F.wsp<bf16_t>(WS_W_MGU), 0, 0, D / 2};
        EpiGatedF8 E{F.wsp<unsigned char>(WS_H), FF, 2 * FF / 256};
        pg8::gemm_phase(F.lds, g, S, E);
    }
    if (IN(20)) { MKF() help_moe_tail(F); }
    SEAM(20);
    if (IN(21)) {
        MKF()
        MoeDownOrder S; S.init(F, D / 256, FF / 2);
        pg8::Gemm g{H, F.wsp<bf16_t>(WS_W_MDN), 0, 0, FF / 2};
        EpiMoeDownSplit E{F.wsp<int>(WS_ROWMAP), F.wsp<float>(WS_ROWP), F.wsp<bf16_t>(WS_YSLOT), F.wsp<float>(WS_PARTM), D / 256, S.nfull * 256, FF / 2 / S.KS, W8INV};
        pg8::gemm_phase(F.lds, g, S, E);
    }
    SEAM(21);
    if (IN(22)) { MKF() phase_final(F); }
#undef IN
#undef SEAM
}

#ifndef N_LAUNCH_MODE
#define N_LAUNCH_MODE 0
#endif
extern "C" void kernel_launch(void* const* d_in, const int* in_sizes, int n_in, void* d_out, int out_size, void* d_ws, size_t ws_size, hipStream_t stream) {
    (void)in_sizes; (void)out_size;
    static int grid = 0;
    if (grid == 0) {
        if (n_in != 44 || ws_size < WS_END) { fprintf(stderr, "kernel_launch: expected 44 inputs and >= %zu bytes of workspace (got %d, %zu)\n", (size_t)WS_END, n_in, ws_size); grid = -1; return; }
#ifdef EMU
        grid = emu_grid_override();
#else
        int dev = 0, cus = 0, per_cu = 0;
        if (hipGetDevice(&dev) != hipSuccess || hipDeviceGetAttribute(&cus, hipDeviceAttributeMultiprocessorCount, dev) != hipSuccess) { grid = -1; return; }
        if (hipFuncSetAttribute((const void*)fwd_kernel, hipFuncAttributeMaxDynamicSharedMemorySize, LDS_BYTES) != hipSuccess) { fprintf(stderr, "kernel_launch: hipFuncSetAttribute failed\n"); grid = -1; return; }
        if (hipOccupancyMaxActiveBlocksPerMultiprocessor(&per_cu, (const void*)fwd_kernel, NTHREADS, LDS_BYTES) != hipSuccess || per_cu < 1) { fprintf(stderr, "kernel_launch: occupancy query says %d\n", per_cu); (void)hipGetLastError(); }
        grid = cus;
#endif
    }
    if (grid < 0) return;
    (void)hipMemsetAsync((char*)d_ws + WS_CTL, 0, CTL_BYTES, stream);
    Args a; memset(&a, 0, sizeof(a));
    for (int i = 0; i < 44; ++i) a.in[i] = (const float*)d_in[i];
    a.out = (float*)d_out; a.ws = (unsigned char*)d_ws;
#if N_LAUNCH_MODE == 0
    a.ph_lo = 0; a.ph_hi = NPHASE;
#ifdef EMU
    emu::launch([](void* p) { fwd_kernel(*(Args*)p); }, &a, dim3(grid), dim3(NTHREADS), LDS_BYTES);
#else
    hipLaunchKernelGGL(fwd_kernel, dim3(grid), dim3(NTHREADS), LDS_BYTES, stream, a);
#endif
#else
    for (int ph = 0; ph < NPHASE; ++ph) { a.ph_lo = ph; a.ph_hi = ph + 1;
#ifdef EMU
        emu::launch([](void* p) { fwd_kernel(*(Args*)p); }, &a, dim3(grid), dim3(NTHREADS), LDS_BYTES);
#else
        hipLaunchKernelGGL(fwd_kernel, dim3(grid), dim3(NTHREADS), LDS_BYTES, stream, a);
#endif
    }
#endif
}
#ifdef EMU
#include <string.h>
extern "C" size_t emu_ws_dump_offset(const char* name, size_t* bytes) {
    struct E { const char* n; size_t off, b; };
    const E tab[] = { {"MOD", WS_MOD, (size_t)2 * NR * 6 * D * 4}, {"A", WS_A, (size_t)MT * D * 2}, {"P", WS_P, (size_t)MT * AB_MAIN * 2}, {"SIDE", WS_SIDE, (size_t)MT * 32 * 4},
        {"YCAT", WS_YCAT, (size_t)MT * YC1 * 2}, {"XL", WS_XL, (size_t)MT * D * 4}, {"FILT0", WS_FILT0, (size_t)HYD * 2 * SEQ * 4}, {"L1", WS_L1, (size_t)2 * HYD * 4}, {"H", WS_H, (size_t)MT * FF * 2},
        {"YPRE", WS_YPRE, (size_t)ML * SSDD * 4}, {"S5G", WS_S5G, (size_t)ML * S5W * 2}, {"SSQ", WS_SSQ, (size_t)ML * 4 * 4}, {"MLST", WS_MLST, (size_t)2 * NB * MLH * NCS * MLST_STRIDE * 4} };
    for (const E& e : tab) if (!strcmp(e.n, name)) { *bytes = e.b; return e.off; }
    *bytes = 0; return 0;
}
#endif
```

```cpp
#ifndef EMU
#include <hip/hip_runtime.h>
#endif
#include <stdint.h>
#include <stddef.h>
#include <math.h>
#include <stdio.h>
#include <string.h>

#ifdef CFG_SMALL
#ifndef CFG_SEQ
#define CFG_SEQ 256
#endif
constexpr int D = 256, NB = 2, SEQ = CFG_SEQ, CTX = 128, HYD = 256, MLH = 2, SSDH = 8, S5W = 256, FF = 256;
#else
constexpr int D = 2048, NB = 4, SEQ = 2048, CTX = 256, HYD = 1024, MLH = 8, SSDH = 16, S5W = 512, FF = 5632;
#endif
constexpr int GW = 64, DH = 128, MLD = MLH * DH, CH = 128;
constexpr int ML = NB * SEQ, MC = NB * CTX, MT = ML + MC, NR = NB + 1;
constexpr int NCL = SEQ / CH, NCC = CTX / CH, NCS = NCL + NCC;
constexpr int AB_MAIN = 3 * HYD + 4 * MLD, AB_SIDE = 4 * MLH, AB_IN = AB_MAIN + AB_SIDE;
constexpr int SSDP = 64, SSDD = SSDH * SSDP, SSDG = 2, SSDN = 128, XBC = SSDD + 2 * SSDG * SSDN, HPG = SSDH / SSDG;
constexpr int CD_MAIN = SSDD + XBC + S5W, CD_SIDE = 2 * SSDH, CD_IN = CD_MAIN + CD_SIDE;
constexpr int S5GS = 16, S5G = S5W / S5GS, S5P = 64;
constexpr int NE = 8, HYEMB = 33, HYHID = 64;
constexpr int YC1 = HYD + MLD, YC2 = SSDD + S5W;
constexpr int MOE_ROWS = 2 * ML + NE * 256;
constexpr float EPS = 1e-6f;
constexpr int NTHREADS = 512, NWAVES = 8;
constexpr int KSL = D / 256;
static_assert(D % 256 == 0 && ML % 256 == 0 && MT % 256 == 0 && AB_MAIN % 256 == 0 && CD_MAIN % 256 == 0 && FF % 128 == 0 && S5W % 128 == 0, "tile shapes");
static_assert(AB_SIDE <= 32 && CD_SIDE <= 32 && HPG % 4 == 0, "side widths");

typedef unsigned short bf16_t;
typedef short bf16x8 __attribute__((ext_vector_type(8)));
typedef float f32x4 __attribute__((ext_vector_type(4)));
typedef float f32x2 __attribute__((ext_vector_type(2)));
typedef float f32x16 __attribute__((ext_vector_type(16)));
typedef int i32x8 __attribute__((ext_vector_type(8)));
typedef int i32x4 __attribute__((ext_vector_type(4)));
typedef unsigned u32x4 __attribute__((ext_vector_type(4)));
typedef unsigned u32x2 __attribute__((ext_vector_type(2)));
#ifdef EMU
#define MFMA16(a, b, c) emu_mfma16(a, b, c)
#define MFMA32(a, b, c) emu_mfma32(a, b, c)
#define MFMA_F8(a, b, c) emu_mfma_f8(a, b, c)
#define MFMA_I8(a, b, c) emu_mfma_i8(a, b, c)
#define ALIGNBIT(hi, lo, sh) ((unsigned)(((((unsigned long long)(hi)) << 32) | (unsigned long long)(lo)) >> ((sh) & 31u)))
#define GLDS16(g, l) emu_glds16((const void*)(g), (void*)(l))
#define S_BARRIER() emu::syncthreads()
#define WAIT_VM(n) ((void)0)
#define WAIT_LGKM(n) ((void)0)
#define WAIT_ALL() ((void)0)
#define SCHED_BARRIER() ((void)0)
#define SETPRIO(x) ((void)0)
#define RFL(x) (x)
#define WAVE_SYNC() emu::wave_sync()
#define CFENCE() ((void)0)
#define S_SLEEP(n) emu_spin_pause()
#define FEXP(x) expf(x)
#define NTLD(p) (*(p))
#define NTST(v, p) (*(p) = (v))
#define MFMA_SETTLE() ((void)0)
#define FRCP(x) (1.0f / (x))
#define LAUNDER(x) ((void)0)
#define ATOM_LD(p) emu_atomic_ld((const unsigned*)(p))
#define ATOM_ST(p, v) emu_atomic_st((unsigned*)(p), (v))
#define ATOM_ADD(p, v) emu_atomic_add((unsigned*)(p), (v))
#define FENCE_ACQ() __atomic_thread_fence(__ATOMIC_SEQ_CST)
#define FENCE_REL() __atomic_thread_fence(__ATOMIC_SEQ_CST)
static inline unsigned cvt_pk_bf16(float lo, float hi);
#else
#define LAS __attribute__((address_space(3)))
#define MFMA16(a, b, c) __builtin_amdgcn_mfma_f32_16x16x32_bf16(a, b, c, 0, 0, 0)
#define MFMA32(a, b, c) __builtin_amdgcn_mfma_f32_32x32x16_bf16(a, b, c, 0, 0, 0)
#define MFMA_I8(a, b, c) __builtin_amdgcn_mfma_i32_16x16x64_i8(a, b, c, 0, 0, 0)
#define MFMA_F8(a, b, c) mfma_f8_inplace(a, b, c)
#define ALIGNBIT(hi, lo, sh) __builtin_amdgcn_alignbit(hi, lo, sh)
#define GLDS16(g, l) __builtin_amdgcn_global_load_lds((const unsigned*)(g), (LAS unsigned*)(l), 16, 0, 0)
#define S_BARRIER() __builtin_amdgcn_s_barrier()
#define WAIT_VM(n) asm volatile("s_waitcnt vmcnt(" #n ")" ::: "memory")
#define WAIT_LGKM(n) asm volatile("s_waitcnt lgkmcnt(" #n ")" ::: "memory")
#define WAIT_ALL() asm volatile("s_waitcnt vmcnt(0) lgkmcnt(0)" ::: "memory")
#define SCHED_BARRIER() __builtin_amdgcn_sched_barrier(0)
#define SETPRIO(x) __builtin_amdgcn_s_setprio(x)
#define RFL(x) __builtin_amdgcn_readfirstlane(x)
#define WAVE_SYNC() do { asm volatile("s_waitcnt lgkmcnt(0)" ::: "memory"); __builtin_amdgcn_wave_barrier(); } while (0)
#define CFENCE() asm volatile("" ::: "memory")
#define S_SLEEP(n) __builtin_amdgcn_s_sleep(n)
#define FEXP(x) __expf(x)
#define NTST(v, p) __builtin_nontemporal_store((v), (p))
#define NTLD(p) __builtin_nontemporal_load(p)
#define MFMA_SETTLE() asm volatile("s_nop 15\n\ts_nop 15" ::: "memory")
#define FRCP(x) __builtin_amdgcn_rcpf(x)
#define LAUNDER(x) asm volatile("" : "+v"(x))
#define ATOM_LD(p) __hip_atomic_load((p), __ATOMIC_RELAXED, __HIP_MEMORY_SCOPE_AGENT)
#define ATOM_ST(p, v) __hip_atomic_store((p), (v), __ATOMIC_RELAXED, __HIP_MEMORY_SCOPE_AGENT)
#define ATOM_ADD(p, v) __hip_atomic_fetch_add((p), (v), __ATOMIC_RELAXED, __HIP_MEMORY_SCOPE_AGENT)
#define FENCE_ACQ() __builtin_amdgcn_fence(__ATOMIC_ACQUIRE, "agent")
#define FENCE_REL() __builtin_amdgcn_fence(__ATOMIC_RELEASE, "agent")
#endif

__device__ __forceinline__ unsigned f2bf(float f) { unsigned u = __float_as_uint(f); return (u + 0x7fffu + ((u >> 16) & 1u)) >> 16; }
__device__ __forceinline__ float bf2f(unsigned h) { return __uint_as_float(h << 16); }
__device__ __forceinline__ unsigned pk2(float lo, float hi) { return f2bf(lo) | (f2bf(hi) << 16); }
#ifdef EMU
static inline unsigned cvt_pk_bf16(float lo, float hi) { return pk2(lo, hi); }
#else
__device__ __forceinline__ unsigned cvt_pk_bf16(float lo, float hi) { unsigned r; asm volatile("v_cvt_pk_bf16_f32 %0, %1, %2" : "=v"(r) : "v"(lo), "v"(hi)); return r; }
#endif
#ifdef EMU
static inline unsigned emu_f2e4m3(float f) { const unsigned s = f < 0.f ? 0x80u : 0u; float a = fabsf(f); if (!(a == a)) return 0x7fu; if (a > 448.f) a = 448.f;
    if (a < 0.015625f) { const unsigned man = (unsigned)rintf(a * 512.0f); return s | man; }
    int e; (void)frexpf(a, &e); e -= 1; unsigned man = (unsigned)rintf((a / ldexpf(1.0f, e) - 1.0f) * 8.0f); if (man == 8u) { man = 0u; e += 1; }
    unsigned E = (unsigned)(e + 7); if (E > 15u || (E == 15u && man == 7u)) { E = 15u; man = 6u; } return s | (E << 3) | man; }
static inline float emu_e4m32f(unsigned b) { const float s = (b & 0x80u) ? -1.f : 1.f; const unsigned E = (b >> 3) & 15u, man = b & 7u; if (E == 0) return s * ldexpf((float)man, -9); return s * ldexpf(1.0f + (float)man * 0.125f, (int)E - 7); }
static inline unsigned cvt_pk_fp8x4(float a, float b, float c, float d) { return emu_f2e4m3(a) | (emu_f2e4m3(b) << 8) | (emu_f2e4m3(c) << 16) | (emu_f2e4m3(d) << 24); }
static inline i32x4 emu_mfma_i8(i32x4 a, i32x4 b, i32x4 c) {
    emu::Block* blk = emu::tl_blk; emu::Wave* w = &blk->waves[blk->cur >> 6]; int lane = blk->cur & 63;
    memcpy(w->buf[lane], &a, 16); memcpy(w->buf[lane] + 16, &b, 16); emu::wave_sync();
    const int j = lane & 15; i32x4 d = c;
    for (int r = 0; r < 4; ++r) { const int i = 4 * (lane >> 4) + r; int s = 0;
        for (int kb = 0; kb < 4; ++kb) for (int t = 0; t < 16; ++t) s += (int)(signed char)w->buf[i + 16 * kb][t] * (int)(signed char)w->buf[j + 16 * kb][16 + t];
        d[r] += s; }
    emu::wave_sync(); return d;
}
static inline f32x4 emu_mfma_f8(i32x8 a, i32x8 b, f32x4 c) {
    emu::Block* blk = emu::tl_blk; emu::Wave* w = &blk->waves[blk->cur >> 6]; int lane = blk->cur & 63;
    memcpy(w->buf[lane], &a, 32); memcpy(w->buf[lane] + 32, &b, 32); emu::wave_sync();
    const int j = lane & 15; f32x4 d = c;
    for (int r = 0; r < 4; ++r) { const int i = 4 * (lane >> 4) + r; float s = 0.f;
        for (int kb = 0; kb < 4; ++kb) for (int t = 0; t < 32; ++t) s += emu_e4m32f(w->buf[i + 16 * kb][t]) * emu_e4m32f(w->buf[j + 16 * kb][32 + t]);
        d[r] += s; }
    emu::wave_sync(); return d;
}
#else
__device__ __forceinline__ unsigned cvt_pk_fp8x4(float a, float b, float c, float d) {
    a = fminf(fmaxf(a, -448.f), 448.f); b = fminf(fmaxf(b, -448.f), 448.f); c = fminf(fmaxf(c, -448.f), 448.f); d = fminf(fmaxf(d, -448.f), 448.f);
    int p = __builtin_amdgcn_cvt_pk_fp8_f32(a, b, 0, false); p = __builtin_amdgcn_cvt_pk_fp8_f32(c, d, p, true); return (unsigned)p; }
#endif
#ifndef EMU
__device__ __forceinline__ f32x4 mfma_f8_inplace(i32x8 a, i32x8 b, f32x4 c) {
    asm volatile("v_mfma_scale_f32_16x16x128_f8f6f4 %0, %1, %2, %0, %3, %3 op_sel_hi:[0,0,0]" : "+v"(c) : "v"(a), "v"(b), "v"(0x7F7F7F7F));
    return c; }
#endif
constexpr float W8SCALE = 64.0f, W8INV = 1.0f / 64.0f;
constexpr int KSF8 = ((FF / 128) % 4 == 0) ? 2 : 1;
__device__ __forceinline__ float wave_max(float v) { v = fmaxf(v, __shfl_xor(v, 1)); v = fmaxf(v, __shfl_xor(v, 2)); v = fmaxf(v, __shfl_xor(v, 4)); v = fmaxf(v, __shfl_xor(v, 8)); v = fmaxf(v, __shfl_xor(v, 16)); v = fmaxf(v, __shfl_xor(v, 32)); return v; }
__device__ __forceinline__ unsigned pk_i8x4(float a, float b, float c, float d) { return ((unsigned)(int)rintf(a) & 0xffu) | (((unsigned)(int)rintf(b) & 0xffu) << 8) | (((unsigned)(int)rintf(c) & 0xffu) << 16) | (((unsigned)(int)rintf(d) & 0xffu) << 24); }
__device__ __forceinline__ float wave_sum(float v) { v += __shfl_xor(v, 1); v += __shfl_xor(v, 2); v += __shfl_xor(v, 4); v += __shfl_xor(v, 8); v += __shfl_xor(v, 16); v += __shfl_xor(v, 32); return v; }
__device__ __forceinline__ float siluf(float x) { return x * FRCP(1.0f + FEXP(-x)); }
__device__ __forceinline__ float sigmoidf_(float x) { return FRCP(1.0f + FEXP(-x)); }
__device__ __forceinline__ float logsigmoidf_(float x) { return x < 0.f ? x - log1pf(expf(x)) : -log1pf(expf(-x)); }
__device__ __forceinline__ float softplusf_(float x) { return x > 0.f ? x + log1pf(expf(-x)) : log1pf(expf(x)); }
__device__ __forceinline__ void unpack8(const u32x4 w, float (&f)[8]) {
    f[0] = bf2f(w.x & 0xffffu); f[1] = bf2f(w.x >> 16); f[2] = bf2f(w.y & 0xffffu); f[3] = bf2f(w.y >> 16);
    f[4] = bf2f(w.z & 0xffffu); f[5] = bf2f(w.z >> 16); f[6] = bf2f(w.w & 0xffffu); f[7] = bf2f(w.w >> 16);
}

constexpr size_t al(size_t x) { return (x + 4095) & ~(size_t)4095; }
constexpr size_t WS_CTL = 0, CTL_BYTES = 1u << 20;
constexpr size_t WS_W_ABIN = WS_CTL + CTL_BYTES;
constexpr size_t WS_W_ABSIDE = WS_W_ABIN + al((size_t)AB_MAIN * D * 2);
constexpr size_t WS_W_ABOUT = WS_W_ABSIDE + al((size_t)32 * D * 2);
constexpr size_t WS_W_GU = WS_W_ABOUT + al((size_t)D * YC1 * 2);
constexpr size_t WS_W_DN = WS_W_GU + al((size_t)2 * FF * D * 2);
constexpr size_t WS_W_CDIN = WS_W_DN + al((size_t)D * FF * 2);
constexpr size_t WS_W_CDSIDE = WS_W_CDIN + al((size_t)CD_MAIN * D * 2);
constexpr size_t WS_W_GLU = WS_W_CDSIDE + al((size_t)32 * D * 2);
constexpr size_t WS_W_CDOUT = WS_W_GLU + al((size_t)2 * S5W * S5W * 2);
constexpr size_t WS_W_MGU = WS_W_CDOUT + al((size_t)D * YC2 * 2);
constexpr size_t WS_W_MDN = WS_W_MGU + al((size_t)NE * 2 * FF * D * 2);
constexpr size_t WS_MODP = WS_W_MDN + al((size_t)NE * D * FF * 2);
constexpr size_t WS_MOD = WS_MODP + al((size_t)2 * KSL * NR * 6 * D * 4);
constexpr size_t WS_FILT0 = WS_MOD + al((size_t)2 * NR * 6 * D * 4);
constexpr size_t WS_FILT1 = WS_FILT0 + al((size_t)HYD * 2 * SEQ * 4);
constexpr size_t WS_L1P = WS_FILT1 + al((size_t)HYD * 2 * CTX * 4);
constexpr size_t WS_L1 = WS_L1P + al((size_t)((SEQ + CTX) / 8) * 2 * HYD * 4);
constexpr size_t WS_S5PAR = WS_L1 + al((size_t)2 * HYD * 4);
constexpr size_t WS_XL = WS_S5PAR + al((size_t)2 * S5G * S5P * 36 * 4);
constexpr size_t WS_A = WS_XL + al((size_t)MT * D * 4);
constexpr size_t WS_P = WS_A + al((size_t)MT * D * 2);
constexpr size_t WS_SIDE = WS_P + al((size_t)MT * (AB_MAIN > CD_MAIN ? AB_MAIN : CD_MAIN) * 2);
constexpr size_t WS_YCAT = WS_SIDE + al((size_t)MT * 32 * 4);
constexpr size_t WS_H = WS_YCAT + al((size_t)MT * YC1 * 2);
constexpr size_t WS_AS = WS_H + al((size_t)MOE_ROWS * FF * 2);
constexpr size_t WS_YSLOT = WS_AS + al((size_t)MOE_ROWS * D * 2);
constexpr int MLST_CT = DH * DH / 2;
constexpr int MLST_STRIDE = MLST_CT + DH + 64;
constexpr size_t WS_MLST = WS_YSLOT + al((size_t)2 * ML * D * 4);
constexpr int SSD_HF = SSDP * SSDN / 2;
constexpr int SSDST_STRIDE = SSD_HF + 64;
constexpr size_t WS_SSDST = WS_MLST + al((size_t)2 * NB * MLH * NCS * MLST_STRIDE * 4);
constexpr size_t WS_S5ST = WS_SSDST + al((size_t)2 * NB * SSDH * NCS * SSDST_STRIDE * 4);
constexpr size_t WS_YPRE = WS_S5ST + al((size_t)2 * NB * NCS * S5G * S5P * 2 * 4);
constexpr size_t WS_SSQ = WS_YPRE + al((size_t)ML * SSDD * 4);
constexpr size_t WS_S5G = WS_SSQ + al((size_t)ML * 4 * 4);
constexpr size_t WS_ROUTE = WS_S5G + al((size_t)ML * S5W * 2);
constexpr size_t WS_RPROB = WS_ROUTE + al((size_t)ML * 4 * 4);
constexpr size_t WS_ROWMAP = WS_RPROB + al((size_t)ML * 2 * 4);
constexpr size_t WS_ROWP = WS_ROWMAP + al((size_t)MOE_ROWS * 4);
constexpr size_t WS_PH = WS_ROWP + al((size_t)MOE_ROWS * 4);
constexpr int KSPLIT = 4;
constexpr int KS7 = ((HYD + MLD) / 64) % (2 * KSPLIT) == 0 ? KSPLIT : 2, KS10 = (FF / 128) % (2 * KSPLIT) == 0 ? KSPLIT : ((FF / 128) % 4 == 0 ? 2 : 1);
constexpr size_t WS_PART = WS_PH + al((size_t)3 * HYD * MT * 2);
constexpr int PM_ROWS = 16 * 256;
constexpr size_t WS_PARTM = WS_PART + al((size_t)KSPLIT * MC * D * 4);
constexpr size_t WS_XACT = WS_PARTM + al((size_t)4 * PM_ROWS * D * 4);
constexpr size_t WS_SB_GU = WS_XACT + al((size_t)MT * XBC * 2);
constexpr size_t WS_A8 = WS_SB_GU + al((size_t)2 * FF * 4);
constexpr size_t WS_SA8 = WS_A8 + al((size_t)MT * D);
constexpr size_t WS_END = WS_SA8 + al((size_t)MT * 4);
constexpr int CW_BAR = 4096;
constexpr int CW_CNT = 16384;
constexpr int CW_QNEXT = 20480;
constexpr int CW_ARRIVE = 24576;

#ifdef EMU
struct XcdBarrier { unsigned* bar; unsigned gen; };
static inline XcdBarrier xcd_barrier_post(unsigned* bar, volatile unsigned*) { XcdBarrier b; b.bar = bar; b.gen = 0; return b; }
static inline void xcd_barrier(XcdBarrier& b) {
    __syncthreads();
    if (threadIdx.x == 0) { const unsigned G = gridDim.x; const unsigned old = emu_atomic_add(&b.bar[0], 1u); const unsigned target = (old / G + 1u) * G;
        while (emu_atomic_ld(&b.bar[0]) < target) sched_yield(); }
    __syncthreads();
}
#define XCD_BAR_WORDS 3456
#else
#define XB_TMO      128
#define XB_XCNT(j)  (256  + 64 * (j))
#define XB_XSUB(j)  (1280 + 64 * (j))
#define XB_XGEN(j)  (2304 + 64 * (j))
#define XB_TOP      3328
#define XB_TOPGEN   3392
#define XCD_BAR_WORDS 3456
#define XB_SPIN_CAP (1u << 18)

__device__ __forceinline__ unsigned xb_ld(unsigned* p)              { return __hip_atomic_load(p, __ATOMIC_RELAXED, __HIP_MEMORY_SCOPE_AGENT); }
__device__ __forceinline__ unsigned xb_add(unsigned* p, unsigned v) { return __hip_atomic_fetch_add(p, v, __ATOMIC_RELAXED, __HIP_MEMORY_SCOPE_AGENT); }
__device__ __forceinline__ unsigned xb_xcc_id() { return (unsigned)__builtin_amdgcn_s_getreg((3 << 11) | 20) & 0xFu; }
#define XB_SPIN(cond, bar) do { unsigned _sp = 0; while (cond) { __builtin_amdgcn_s_sleep(1); \
    if ((++_sp & 255u) == 0u) { if (xb_ld(&(bar)[XB_TMO])) break; if (_sp > XB_SPIN_CAP) { atomicAdd(&(bar)[XB_TMO], 1u); break; } } } } while (0)

struct XcdBarrier {
    unsigned* bar; unsigned x;
    volatile LAS unsigned* st;
};

__device__ __forceinline__ XcdBarrier xcd_barrier_post(unsigned* bar, volatile LAS unsigned* st) {
    XcdBarrier b; b.bar = bar; b.x = xb_xcc_id(); b.st = st;
    if (threadIdx.x == 0) (void)xb_add(&bar[XB_XCNT(b.x)], 1u);
    return b;
}
__device__ __forceinline__ void xcd_barrier_complete(unsigned* bar, unsigned x, unsigned& nloc, unsigned& nx) {
    const unsigned G = gridDim.x * gridDim.y * gridDim.z;
    unsigned sum, cnt, mine, sp = 0u;
    for (;;) {
        sum = 0u; cnt = 0u; mine = 0u;
#pragma unroll
        for (unsigned j = 0; j < 16; ++j) { const unsigned c = xb_ld(&bar[XB_XCNT(j)]); sum += c; cnt += (c > 0u) ? 1u : 0u; mine = (j == x) ? c : mine; }
        if (sum == G) break;
        __builtin_amdgcn_s_sleep(1);
        if ((++sp & 255u) == 0u) { if (xb_ld(&bar[XB_TMO])) break; if (sp > XB_SPIN_CAP) { atomicAdd(&bar[XB_TMO], 1u); break; } }
    }
    nloc = mine > 0u ? mine : 1u; nx = cnt > 0u ? cnt : 1u;
}

__device__ __forceinline__ void xcd_barrier(const XcdBarrier& b) {
    asm volatile("s_waitcnt vmcnt(0)" ::: "memory");
    __syncthreads();
    if (threadIdx.x == 0) {
        unsigned* bar = b.bar;
        __builtin_amdgcn_s_waitcnt(0);
        unsigned nloc = b.st[0], nx = b.st[1];
        if (nloc == 0u) { xcd_barrier_complete(bar, b.x, nloc, nx); b.st[0] = nloc; b.st[1] = nx; }
        const unsigned old = xb_add(&bar[XB_XSUB(b.x)], 1u);
        const unsigned gen = old / nloc;
        if (old + 1u == (gen + 1u) * nloc) {
            __builtin_amdgcn_fence(__ATOMIC_RELEASE, "agent");
            asm volatile("s_waitcnt vmcnt(0)" ::: "memory");
            const unsigned og = xb_add(&bar[XB_TOP], 1u);
            const unsigned tg = og / nx;
            if (og + 1u == (tg + 1u) * nx) xb_add(&bar[XB_TOPGEN], 1u);
            else XB_SPIN(xb_ld(&bar[XB_TOPGEN]) == tg, bar);
            __builtin_amdgcn_fence(__ATOMIC_ACQUIRE, "agent");
            xb_add(&bar[XB_XGEN(b.x)], 1u);
            asm volatile("s_waitcnt vmcnt(0)" ::: "memory");
        } else {
            XB_SPIN(xb_ld(&bar[XB_XGEN(b.x)]) == gen, bar);
            __builtin_amdgcn_fence(__ATOMIC_ACQUIRE, "agent");
            asm volatile("s_waitcnt vmcnt(0)" ::: "memory");
        }
    }
    __syncthreads();
}
#endif

namespace pg8 {
constexpr int BM = 256, BK = 64, HALF = 128, HTB = HALF * BK * 2  , STAGE_BYTES = 8 * HTB, NXCD = 8, WGM = 8;

__host__ __device__ __forceinline__ int lds_byte(int r, int c) { const int st = (r >> 4) * 2 + (c >> 5), rr = r & 15, cc = c & 31, ob = rr * 64 + cc * 2; return st * 1024 + (ob ^ (((ob >> 9) & 1) << 5)); }
__host__ __device__ __forceinline__ void stage_rc(int b, int& R, int& C) { const int st = b / 1024, sb = b % 1024, swz = sb ^ (((sb >> 9) & 1) << 5); R = (st >> 1) * 16 + swz / 64; C = (st & 1) * 32 + (swz % 64) / 2; }
__host__ __device__ __forceinline__ int perm32(int rho) { const int n = rho >> 4, i = rho & 15; return 8 * (i >> 2) + 4 * n + (i & 3); }

struct Unit { int pm, pn, k0, nt; };
struct Gemm { const bf16_t* A; const bf16_t* Bt; int M, N, K; };

struct StaticOrder {
    int nM, nN, nwg, G, c;
    __host__ __device__ __forceinline__ void init(int M, int N, int G_, int c_) { nM = M / BM; nN = N / BM; nwg = nM * nN; G = G_; c = c_; }
    __host__ __device__ __forceinline__ bool next(int i, Unit& u) const {
        const long L = (long)i * G + c; if (L >= nwg) return false;
        int wgid = (int)L; { const int q = nwg / NXCD, r = nwg % NXCD, xcd = wgid % NXCD, off = wgid / NXCD; wgid = (xcd < r ? xcd * (q + 1) : r * (q + 1) + (xcd - r) * q) + off; }
        const int nig = WGM * nN, gid = wgid / nig, fm = gid * WGM, gsz = (nM - fm) < WGM ? (nM - fm) : WGM;
        u.pm = fm + ((wgid % nig) % gsz); u.pn = (wgid % nig) / gsz; return true;
    }
    static constexpr bool SPLITK = false;
    __device__ __forceinline__ void a_ready(const Unit&) const {}
    __device__ __forceinline__ void done(const Unit&) const {}
};

template <class Epi, class Sched>
__device__ __forceinline__ void gemm_phase(LAS unsigned char* lds, const Gemm g, const Sched& S, const Epi& E) {
    const int tid = threadIdx.x, wid = RFL(tid >> 6), lane = tid & 63, wr = wid >> 2, wc = wid & 3, fr = lane & 15, fq = lane >> 4;
    const int K = g.K, nt = K / BK;
    unsigned voffA[2], voffB[2];
#pragma unroll
    for (int i = 0; i < 2; ++i) { int R, C; stage_rc(tid * 16 + i * 8192, R, C); const int Rb = Epi::PERM ? ((R & ~31) + perm32(R & 31)) : R;
        voffA[i] = (unsigned)(R * K + C) * 2u; voffB[i] = (unsigned)(Rb * K + C) * 2u; }
    const size_t kstep = (size_t)(BK * 2);
    const size_t hstep = (size_t)HALF * K * 2;
    const size_t tstep = 2 * hstep;
    const unsigned ldsw = (unsigned)wid * 1024u;
    const int aoff = Epi::F8 ? lds_byte(wr * 64 + fr, fq * 16) : lds_byte(wr * 64 + fr, fq * 8), boff = Epi::F8 ? lds_byte(wc * 32 + fr, fq * 16) : lds_byte(wc * 32 + fr, fq * 8);
#define PG8_SA(b, h) (((b) * 2 + (h)) * HTB)
#define PG8_SB(b, h) ((4 + (b) * 2 + (h)) * HTB)
#define PG8_STAGE(bufoff, gbase, voff) do { _Pragma("unroll") for (int _i = 0; _i < 2; ++_i) \
        GLDS16((const char*)(gbase) + (voff)[_i], lds + (bufoff) + ldsw + _i * 8192); } while (0)
#define PG8_LD16(off) (*(const LAS i32x4*)(lds + (off)))
#define PG8_CAT(lo, hi) __builtin_shufflevector((lo), (hi), 0, 1, 2, 3, 4, 5, 6, 7)
#define PG8_LDA(dst, b, h) do { if (Epi::F8) { _Pragma("unroll") for (int m = 0; m < 4; ++m) dst##8[m] = PG8_CAT(PG8_LD16(PG8_SA(b, h) + aoff + m * 2048), PG8_LD16(PG8_SA(b, h) + aoff + m * 2048 + 16)); } \
        else { _Pragma("unroll") for (int m = 0; m < 4; ++m) _Pragma("unroll") for (int k = 0; k < 2; ++k) dst[m][k] = *(const LAS bf16x8*)(lds + PG8_SA(b, h) + aoff + m * 2048 + k * 1024); } } while (0)
#define PG8_LDB(dst, b, h) do { if (Epi::F8) { _Pragma("unroll") for (int n = 0; n < 2; ++n) dst##8[n] = PG8_CAT(PG8_LD16(PG8_SB(b, h) + boff + n * 2048), PG8_LD16(PG8_SB(b, h) + boff + n * 2048 + 16)); } \
        else { _Pragma("unroll") for (int n = 0; n < 2; ++n) _Pragma("unroll") for (int k = 0; k < 2; ++k) dst[n][k] = *(const LAS bf16x8*)(lds + PG8_SB(b, h) + boff + n * 2048 + k * 1024); } } while (0)
#define PG8_MMA(ai, bj, At, Bt) do { SETPRIO(1); if (Epi::F8) { _Pragma("unroll") for (int m = 0; m < 4; ++m) _Pragma("unroll") for (int n = 0; n < 2; ++n) \
            acc[ai][bj][m][n] = MFMA_F8(Bt##8[n], At##8[m], acc[ai][bj][m][n]); } \
        else if (Epi::I8) { _Pragma("unroll") for (int m = 0; m < 4; ++m) _Pragma("unroll") for (int n = 0; n < 2; ++n) _Pragma("unroll") for (int k = 0; k < 2; ++k) \
            acc[ai][bj][m][n] = __builtin_bit_cast(f32x4, MFMA_I8(__builtin_bit_cast(i32x4, Bt[n][k]), __builtin_bit_cast(i32x4, At[m][k]), __builtin_bit_cast(i32x4, acc[ai][bj][m][n]))); } \
        else { _Pragma("unroll") for (int m = 0; m < 4; ++m) _Pragma("unroll") for (int n = 0; n < 2; ++n) _Pragma("unroll") for (int k = 0; k < 2; ++k) \
            acc[ai][bj][m][n] = MFMA16(Bt[n][k], At[m][k], acc[ai][bj][m][n]); } SETPRIO(0); } while (0)
#define PG8_BAR S_BARRIER()
#define PG8_SCHED SCHED_BARRIER()
    Unit cur, nxt; int ui = 0;
    if (!S.next(0, cur)) return;
    f32x4 acc[2][2][4][2];
#pragma unroll
    for (int a = 0; a < 2; ++a)
#pragma unroll
        for (int b = 0; b < 2; ++b)
#pragma unroll
            for (int m = 0; m < 4; ++m)
#pragma unroll
                for (int n = 0; n < 2; ++n) acc[a][b][m][n] = (f32x4){0.f, 0.f, 0.f, 0.f};
    bf16x8 At[4][2], B0[2][2], B1[2][2];
    i32x8 At8[4], B08[2], B18[2];
    const char* cA = (const char*)g.A + (size_t)cur.pm * tstep; const char* cB = (const char*)g.Bt + (size_t)cur.pn * tstep;
    if (Sched::SPLITK) { cA += (size_t)cur.k0 * 2; cB += (size_t)cur.k0 * 2; }
    S.a_ready(cur);
    PG8_STAGE(PG8_SB(0, 0), cB, voffB); PG8_STAGE(PG8_SA(0, 0), cA, voffA); PG8_STAGE(PG8_SB(0, 1), cB + hstep, voffB); PG8_STAGE(PG8_SA(0, 1), cA + hstep, voffA);
    if (wr == 1) PG8_BAR;
    WAIT_VM(4); PG8_BAR;
    PG8_STAGE(PG8_SB(1, 0), cB + kstep, voffB); PG8_STAGE(PG8_SA(1, 0), cA + kstep, voffA); PG8_STAGE(PG8_SB(1, 1), cB + hstep + kstep, voffB);
    WAIT_VM(6); PG8_BAR;
    for (;;) {
        const bool has_next = S.next(ui + 1, nxt);
        const char* nA = has_next ? (const char*)g.A + (size_t)nxt.pm * tstep : cA; const char* nB = has_next ? (const char*)g.Bt + (size_t)nxt.pn * tstep : cB;
        if (Sched::SPLITK && has_next) { nA += (size_t)nxt.k0 * 2; nB += (size_t)nxt.k0 * 2; }
        const int ntu = Sched::SPLITK ? cur.nt : nt;
        for (int t = 0; t < ntu; t += 2) {
            const bool last = (t == ntu - 2);
            const char* a1 = cA + (size_t)(t + 1) * kstep;
            const char* a2 = last ? nA : cA + (size_t)(t + 2) * kstep; const char* b2 = last ? nB : cB + (size_t)(t + 2) * kstep;
            const char* a3 = a2 + kstep; const char* b3 = b2 + kstep;
            if (last && has_next) S.a_ready(nxt);
            PG8_LDB(B0, 0, 0); PG8_SCHED; PG8_LDA(At, 0, 0); PG8_STAGE(PG8_SA(1, 1), a1 + hstep, voffA);
            WAIT_LGKM(8); PG8_BAR; WAIT_LGKM(0); PG8_MMA(0, 0, At, B0); PG8_BAR; PG8_SCHED;
            PG8_LDB(B1, 0, 1); PG8_STAGE(PG8_SB(0, 0), b2, voffB);
            PG8_BAR; WAIT_LGKM(0); PG8_MMA(0, 1, At, B1); PG8_BAR;
            PG8_LDA(At, 0, 1); PG8_STAGE(PG8_SA(0, 0), a2, voffA);
            PG8_BAR; WAIT_LGKM(0); PG8_MMA(1, 0, At, B0); PG8_BAR; PG8_SCHED;
            PG8_STAGE(PG8_SB(0, 1), b2 + hstep, voffB);
            WAIT_VM(6); PG8_BAR; PG8_MMA(1, 1, At, B1); PG8_BAR;
            PG8_LDB(B0, 1, 0); PG8_SCHED; PG8_LDA(At, 1, 0); PG8_STAGE(PG8_SA(0, 1), a2 + hstep, voffA);
            WAIT_LGKM(8); PG8_BAR; WAIT_LGKM(0); PG8_MMA(0, 0, At, B0); PG8_BAR; PG8_SCHED;
            PG8_LDB(B1, 1, 1); PG8_STAGE(PG8_SB(1, 0), b3, voffB);
            PG8_BAR; WAIT_LGKM(0); PG8_MMA(0, 1, At, B1); PG8_BAR;
            PG8_LDA(At, 1, 1); PG8_STAGE(PG8_SA(1, 0), a3, voffA);
            PG8_BAR; WAIT_LGKM(0); PG8_MMA(1, 0, At, B0); PG8_BAR; PG8_SCHED;
            PG8_STAGE(PG8_SB(1, 1), b3 + hstep, voffB);
            WAIT_VM(6); PG8_BAR; PG8_MMA(1, 1, At, B1); PG8_BAR;
        }
        if (Epi::F8) MFMA_SETTLE();
        E(acc, cur, wr, wc, fr, fq); S.done(cur);
        if (!has_next) break;
#pragma unroll
        for (int a = 0; a < 2; ++a)
#pragma unroll
            for (int b = 0; b < 2; ++b)
#pragma unroll
                for (int m = 0; m < 4; ++m)
#pragma unroll
                    for (int n = 0; n < 2; ++n) acc[a][b][m][n] = (f32x4){0.f, 0.f, 0.f, 0.f};
        cur = nxt; cA = nA; cB = nB; ++ui;
    }
    WAIT_VM(0);
    if (wr == 0) PG8_BAR;
    PG8_BAR;
#undef PG8_SA
#undef PG8_SB
#undef PG8_STAGE
#undef PG8_LDA
#undef PG8_LDB
#undef PG8_MMA
#undef PG8_CAT
#undef PG8_LD16
#undef PG8_BAR
#undef PG8_SCHED
}
}

constexpr int LDS_BYTES = 147456;
constexpr int LDS_MISC = LDS_BYTES - 64;
constexpr int TP = 136;
constexpr int TILE_B = 128 * TP * 2;

struct Args { const float* in[44]; float* out; unsigned char* ws; int ph_lo, ph_hi; };

enum InIdx { I_X = 0, I_C, I_CTX, I_CCTX, I_ADAW, I_ADAB, I_ABWIN, I_HYCW, I_HYCB, I_HYW1, I_HYB1, I_HYW2, I_HYB2, I_HYW3, I_HYFREQ, I_HYBIAS,
             I_MLCW, I_MLCB, I_MLGB, I_MLNW, I_ABWOUT, I_FFNGU, I_FFNDN, I_CDWIN, I_SSDCW, I_SSDCB, I_SSDALOG, I_SSDDTB, I_SSDD, I_SSDNW,
             I_S5LRE, I_S5LIM, I_S5LDT, I_S5BRE, I_S5BIM, I_S5CRE, I_S5CIM, I_S5D, I_S5GLU, I_CDWOUT, I_ROUTER, I_MOEGU, I_MOEDN, I_FNW };

struct Frame {
    LAS unsigned char* lds; int tid, lane, wave, G, bid;
    const float* const* in; float* out; unsigned char* ws;
    __device__ __forceinline__ int gw() const { return bid * NWAVES + wave; }
    __device__ __forceinline__ int ngw() const { return G * NWAVES; }
    template <class T> __device__ __forceinline__ T* wsp(size_t off) const { return (T*)(ws + off); }
};

__device__ __forceinline__ int mod_row(int m) { return m < ML ? m / SEQ : NB; }

struct EpiStoreBf16 {
    static constexpr bool PERM = true, F8 = false, I8 = false;
    bf16_t* O; int ldc;
    __device__ __forceinline__ void operator()(const f32x4 (&acc)[2][2][4][2], const pg8::Unit& u, int wr, int wc, int fr, int fq) const {
        const int row0 = u.pm * 256 + wr * 64 + fr, col0 = u.pn * 256 + wc * 32 + 8 * fq;
#pragma unroll
        for (int ai = 0; ai < 2; ++ai)
#pragma unroll
            for (int m = 0; m < 4; ++m) { bf16_t* rowp = O + (size_t)(row0 + ai * 128 + m * 16) * ldc + col0;
#pragma unroll
                for (int bj = 0; bj < 2; ++bj) { const f32x4 v0 = acc[ai][bj][m][0], v1 = acc[ai][bj][m][1];
                    u32x4 w; w.x = cvt_pk_bf16(v0[0], v0[1]); w.y = cvt_pk_bf16(v0[2], v0[3]); w.z = cvt_pk_bf16(v1[0], v1[1]); w.w = cvt_pk_bf16(v1[2], v1[3]);
                    *(u32x4*)(rowp + bj * 128) = w; } }
    }
};
struct EpiInProj0 {
    static constexpr bool PERM = true, F8 = false, I8 = false;
    bf16_t* O; int ldc; bf16_t* PH;
    __device__ __forceinline__ void operator()(const f32x4 (&acc)[2][2][4][2], const pg8::Unit& u, int wr, int wc, int fr, int fq) const {
        const int row0 = u.pm * 256 + wr * 64 + fr, col0 = u.pn * 256 + wc * 32 + 8 * fq;
        if (u.pn * 256 < 3 * HYD) {
#pragma unroll
            for (int ai = 0; ai < 2; ++ai)
#pragma unroll
                for (int m = 0; m < 4; ++m) { const int row = row0 + ai * 128 + m * 16;
#pragma unroll
                    for (int bj = 0; bj < 2; ++bj) { const f32x4 v0 = acc[ai][bj][m][0], v1 = acc[ai][bj][m][1]; const int c = col0 + bj * 128;
                        u32x2 a, b; a.x = cvt_pk_bf16(v0[0], v0[1]); a.y = cvt_pk_bf16(v0[2], v0[3]); b.x = cvt_pk_bf16(v1[0], v1[1]); b.y = cvt_pk_bf16(v1[2], v1[3]);
                        *(u32x2*)(PH + ((size_t)(c >> 2) * MT + row) * 4) = a; *(u32x2*)(PH + ((size_t)((c >> 2) + 1) * MT + row) * 4) = b; } }
        } else {
#pragma unroll
            for (int ai = 0; ai < 2; ++ai)
#pragma unroll
                for (int m = 0; m < 4; ++m) { bf16_t* rowp = O + (size_t)(row0 + ai * 128 + m * 16) * ldc + col0;
#pragma unroll
                    for (int bj = 0; bj < 2; ++bj) { const f32x4 v0 = acc[ai][bj][m][0], v1 = acc[ai][bj][m][1];
                        u32x4 w; w.x = cvt_pk_bf16(v0[0], v0[1]); w.y = cvt_pk_bf16(v0[2], v0[3]); w.z = cvt_pk_bf16(v1[0], v1[1]); w.w = cvt_pk_bf16(v1[2], v1[3]);
                        *(u32x4*)(rowp + bj * 128) = w; } }
        }
    }
};
struct EpiResid {
    static constexpr bool PERM = false, F8 = false, I8 = false;
    const float* xlat; const float* xctx; float* XL; const float* gate;
    __device__ __forceinline__ void operator()(const f32x4 (&acc)[2][2][4][2], const pg8::Unit& u, int wr, int wc, int fr, int fq) const {
        const int row0 = u.pm * 256 + wr * 64 + fr, col0 = u.pn * 256 + wc * 32 + 4 * fq;
#pragma unroll
        for (int ai = 0; ai < 2; ++ai)
#pragma unroll
            for (int m = 0; m < 4; ++m) { const int row = row0 + ai * 128 + m * 16; const int r = mod_row(row);
                const float* src = row < ML ? xlat + (size_t)row * D : xctx + (size_t)(row - ML) * D; float* dst = XL + (size_t)row * D; const float* gp = gate + (size_t)r * 6 * D;
#pragma unroll
                for (int bj = 0; bj < 2; ++bj)
#pragma unroll
                    for (int n = 0; n < 2; ++n) { const int col = col0 + bj * 128 + n * 16; const f32x4 gv = *(const f32x4*)(gp + col); const f32x4 xv = *(const f32x4*)(src + col);
                        *(f32x4*)(dst + col) = xv + gv * acc[ai][bj][m][n]; } }
    }
};
struct EpiResidSplit {
    static constexpr bool PERM = false, F8 = false, I8 = false;
    const float* xlat; float* XL; const float* gate; float* part; int kq;
    __device__ __forceinline__ void operator()(const f32x4 (&acc)[2][2][4][2], const pg8::Unit& u, int wr, int wc, int fr, int fq) const {
        const int row0 = u.pm * 256 + wr * 64 + fr, col0 = u.pn * 256 + wc * 32 + 4 * fq;
        if (u.pm * 256 < ML) {
#pragma unroll
            for (int ai = 0; ai < 2; ++ai)
#pragma unroll
                for (int m = 0; m < 4; ++m) { const int row = row0 + ai * 128 + m * 16; const float* src = xlat + (size_t)row * D; float* dst = XL + (size_t)row * D; const float* gp = gate + (size_t)(row / SEQ) * 6 * D;
#pragma unroll
                    for (int bj = 0; bj < 2; ++bj)
#pragma unroll
                        for (int n = 0; n < 2; ++n) { const int col = col0 + bj * 128 + n * 16; const f32x4 gv = *(const f32x4*)(gp + col); const f32x4 xv = *(const f32x4*)(src + col);
                            *(f32x4*)(dst + col) = xv + gv * acc[ai][bj][m][n]; } }
        } else {
            float* pb = part + (size_t)(u.k0 / kq) * MC * D;
#pragma unroll
            for (int ai = 0; ai < 2; ++ai)
#pragma unroll
                for (int m = 0; m < 4; ++m) { float* dst = pb + (size_t)(row0 + ai * 128 + m * 16 - ML) * D;
#pragma unroll
                    for (int bj = 0; bj < 2; ++bj)
#pragma unroll
                        for (int n = 0; n < 2; ++n) *(f32x4*)(dst + col0 + bj * 128 + n * 16) = acc[ai][bj][m][n]; }
        }
    }
};
struct EpiResidSplitF8 {
    static constexpr bool PERM = false, F8 = true, I8 = false;
    const float* xlat; float* XL; const float* gate; float* part; int kq;
    __device__ __forceinline__ void operator()(const f32x4 (&acc)[2][2][4][2], const pg8::Unit& u, int wr, int wc, int fr, int fq) const {
        const int row0 = u.pm * 256 + wr * 64 + fr, col0 = u.pn * 256 + wc * 32 + 4 * fq;
        if (u.pm * 256 < ML) {
#pragma unroll
            for (int ai = 0; ai < 2; ++ai)
#pragma unroll
                for (int m = 0; m < 4; ++m) { const int row = row0 + ai * 128 + m * 16; const float* src = xlat + (size_t)row * D; float* dst = XL + (size_t)row * D; const float* gp = gate + (size_t)(row / SEQ) * 6 * D;
#pragma unroll
                    for (int bj = 0; bj < 2; ++bj)
#pragma unroll
                        for (int n = 0; n < 2; ++n) { const int col = col0 + bj * 128 + n * 16; const f32x4 gv = *(const f32x4*)(gp + col); const f32x4 xv = *(const f32x4*)(src + col);
                            *(f32x4*)(dst + col) = xv + gv * (acc[ai][bj][m][n] * W8INV); } }
        } else {
            float* pb = part + (size_t)(u.k0 / kq) * MC * D;
#pragma unroll
            for (int ai = 0; ai < 2; ++ai)
#pragma unroll
                for (int m = 0; m < 4; ++m) { float* dst = pb + (size_t)(row0 + ai * 128 + m * 16 - ML) * D;
#pragma unroll
                    for (int bj = 0; bj < 2; ++bj)
#pragma unroll
                        for (int n = 0; n < 2; ++n) *(f32x4*)(dst + col0 + bj * 128 + n * 16) = acc[ai][bj][m][n] * W8INV; }
        }
    }
};
struct CtxSplitOrder {
    static constexpr bool SPLITK = true;
    pg8::StaticOrder so; int nN, KS, ntfull, NCU, G, c;
    __device__ __forceinline__ void init(int N, int K, int KS_, int G_, int c_) { so.init(ML, N, G_, c_); nN = N / 256; KS = KS_; ntfull = K / 64; NCU = (MC / 256) * nN * KS_; G = G_; c = c_; }
    __device__ __forceinline__ bool next(int i, pg8::Unit& u) const {
        const long L = (long)i * G + c; const int nwg = so.nwg; if (L >= (long)nwg + NCU) return false;
        int pm, pn, k0, ntu;
        if (L < nwg) { int wgid = (int)L; { const int q = nwg / pg8::NXCD, r = nwg % pg8::NXCD, xcd = wgid % pg8::NXCD, off = wgid / pg8::NXCD; wgid = (xcd < r ? xcd * (q + 1) : r * (q + 1) + (xcd - r) * q) + off; }
            const int nig = pg8::WGM * so.nN, gid = wgid / nig, fm = gid * pg8::WGM, gsz = (so.nM - fm) < pg8::WGM ? (so.nM - fm) : pg8::WGM;
            pm = fm + ((wgid % nig) % gsz); pn = (wgid % nig) / gsz; k0 = 0; ntu = ntfull; }
        else { const int sub = (int)(L - nwg), ks = sub % KS, t = sub / KS; pm = ML / 256 + t / nN; pn = t % nN; ntu = ntfull / KS; k0 = ks * ntu * 64; }
        u.pm = pm; u.pn = pn; u.k0 = k0; u.nt = ntu; return true;
    }
    __device__ __forceinline__ void a_ready(const pg8::Unit&) const {}
    __device__ __forceinline__ void done(const pg8::Unit&) const {}
};
template <int MODE> struct EpiGated {
    static constexpr bool PERM = true, F8 = false, I8 = false;
    bf16_t* O; int ldc; int col_base; int ntn;
    __device__ __forceinline__ void operator()(const f32x4 (&acc)[2][2][4][2], const pg8::Unit& u, int wr, int wc, int fr, int fq) const {
        const int row0 = u.pm * 256 + wr * 64 + fr, col0 = col_base + (u.pn % ntn) * 128 + wc * 32 + 8 * fq;
#pragma unroll
        for (int ai = 0; ai < 2; ++ai)
#pragma unroll
            for (int m = 0; m < 4; ++m) { bf16_t* rowp = O + (size_t)(row0 + ai * 128 + m * 16) * ldc + col0;
                float o[8];
#pragma unroll
                for (int n = 0; n < 2; ++n)
#pragma unroll
                    for (int j = 0; j < 4; ++j) { const float a = acc[ai][0][m][n][j], b = acc[ai][1][m][n][j];
                        o[n * 4 + j] = MODE == 0 ? (a / (1.0f + FEXP(-a))) * b : a / (1.0f + FEXP(-b)); }
                u32x4 w; w.x = cvt_pk_bf16(o[0], o[1]); w.y = cvt_pk_bf16(o[2], o[3]); w.z = cvt_pk_bf16(o[4], o[5]); w.w = cvt_pk_bf16(o[6], o[7]);
                if (O != nullptr) *(u32x4*)rowp = w; }
    }
};
struct EpiGatedI8 {
    static constexpr bool PERM = true, F8 = false, I8 = true;
    bf16_t* O; int ldc; const float* sa; const float* sb;
    __device__ __forceinline__ void operator()(const f32x4 (&acc)[2][2][4][2], const pg8::Unit& u, int wr, int wc, int fr, int fq) const {
        const int row0 = u.pm * 256 + wr * 64 + fr, c0 = wc * 32 + 8 * fq;
        const f32x4 sga = *(const f32x4*)(sb + u.pn * 256 + c0), sgb = *(const f32x4*)(sb + u.pn * 256 + c0 + 4), sua = *(const f32x4*)(sb + u.pn * 256 + 128 + c0), sub = *(const f32x4*)(sb + u.pn * 256 + 128 + c0 + 4);
#pragma unroll
        for (int ai = 0; ai < 2; ++ai)
#pragma unroll
            for (int m = 0; m < 4; ++m) { const int row = row0 + ai * 128 + m * 16; const float sr = sa[row]; bf16_t* rowp = O + (size_t)row * ldc + u.pn * 128 + c0;
                float o[8];
#pragma unroll
                for (int n = 0; n < 2; ++n)
#pragma unroll
                    for (int j = 0; j < 4; ++j) { const i32x4 ig = __builtin_bit_cast(i32x4, acc[ai][0][m][n]), iu = __builtin_bit_cast(i32x4, acc[ai][1][m][n]);
                        const float a = (float)ig[j] * sr * (n ? sgb[j] : sga[j]), b = (float)iu[j] * sr * (n ? sub[j] : sua[j]); o[n * 4 + j] = a * FRCP(1.0f + FEXP(-a)) * b; }
                u32x4 w; w.x = cvt_pk_bf16(o[0], o[1]); w.y = cvt_pk_bf16(o[2], o[3]); w.z = cvt_pk_bf16(o[4], o[5]); w.w = cvt_pk_bf16(o[6], o[7]);
                *(u32x4*)rowp = w; }
    }
};
struct EpiGatedI8F8 {
    static constexpr bool PERM = true, F8 = false, I8 = true;
    unsigned char* O; int ldc; const float* sa; const float* sb;
    __device__ __forceinline__ void operator()(const f32x4 (&acc)[2][2][4][2], const pg8::Unit& u, int wr, int wc, int fr, int fq) const {
        const int row0 = u.pm * 256 + wr * 64 + fr, c0 = wc * 32 + 8 * fq;
        const f32x4 sga = *(const f32x4*)(sb + u.pn * 256 + c0), sgb = *(const f32x4*)(sb + u.pn * 256 + c0 + 4), sua = *(const f32x4*)(sb + u.pn * 256 + 128 + c0), sub = *(const f32x4*)(sb + u.pn * 256 + 128 + c0 + 4);
#pragma unroll
        for (int ai = 0; ai < 2; ++ai)
#pragma unroll
            for (int m = 0; m < 4; ++m) { const int row = row0 + ai * 128 + m * 16; const float sr = sa[row]; unsigned char* rowp = O + (size_t)row * ldc + u.pn * 128 + c0;
                float o[8];
#pragma unroll
                for (int n = 0; n < 2; ++n)
#pragma unroll
                    for (int j = 0; j < 4; ++j) { const i32x4 ig = __builtin_bit_cast(i32x4, acc[ai][0][m][n]), iu = __builtin_bit_cast(i32x4, acc[ai][1][m][n]);
                        const float a = (float)ig[j] * sr * (n ? sgb[j] : sga[j]), b = (float)iu[j] * sr * (n ? sub[j] : sua[j]); o[n * 4 + j] = a * FRCP(1.0f + FEXP(-a)) * b; }
                u32x2 w; w.x = cvt_pk_fp8x4(o[0], o[1], o[2], o[3]); w.y = cvt_pk_fp8x4(o[4], o[5], o[6], o[7]);
                *(u32x2*)rowp = w; }
    }
};
struct EpiGatedF8 {
    static constexpr bool PERM = true, F8 = true, I8 = false;
    unsigned char* O; int ldc; int ntn;
    __device__ __forceinline__ void operator()(const f32x4 (&acc)[2][2][4][2], const pg8::Unit& u, int wr, int wc, int fr, int fq) const {
        const int row0 = u.pm * 256 + wr * 64 + fr, col0 = (u.pn % ntn) * 128 + wc * 32 + 8 * fq;
#pragma unroll
        for (int ai = 0; ai < 2; ++ai)
#pragma unroll
            for (int m = 0; m < 4; ++m) { unsigned char* rowp = O + (size_t)(row0 + ai * 128 + m * 16) * ldc + col0;
                float o[8];
#pragma unroll
                for (int n = 0; n < 2; ++n)
#pragma unroll
                    for (int j = 0; j < 4; ++j) { const float a = acc[ai][0][m][n][j] * W8INV, b = acc[ai][1][m][n][j] * W8INV; o[n * 4 + j] = a * FRCP(1.0f + FEXP(-a)) * b; }
                u32x2 w; w.x = cvt_pk_fp8x4(o[0], o[1], o[2], o[3]); w.y = cvt_pk_fp8x4(o[4], o[5], o[6], o[7]);
                *(u32x2*)rowp = w; }
    }
};
struct EpiMoeDown {
    static constexpr bool PERM = false, F8 = false, I8 = false;
    const int* rowmap; const float* rowp; float* yslot; int ntn;
    __device__ __forceinline__ void operator()(const f32x4 (&acc)[2][2][4][2], const pg8::Unit& u, int wr, int wc, int fr, int fq) const {
        const int row0 = u.pm * 256 + wr * 64 + fr, col0 = (u.pn % ntn) * 256 + wc * 32 + 4 * fq;
#pragma unroll
        for (int ai = 0; ai < 2; ++ai)
#pragma unroll
            for (int m = 0; m < 4; ++m) { const int row = row0 + ai * 128 + m * 16; const int rm = rowmap[row]; if (rm < 0) continue; const float p = rowp[row];
                float* dst = yslot + ((size_t)(rm & 1) * ML + (size_t)(rm >> 1)) * D;
#pragma unroll
                for (int bj = 0; bj < 2; ++bj)
#pragma unroll
                    for (int n = 0; n < 2; ++n) { const int col = col0 + bj * 128 + n * 16; *(f32x4*)(dst + col) = acc[ai][bj][m][n] * p; } }
    }
};
__device__ __forceinline__ void moe_down_split(int npan, int& nfull, int& ks) { nfull = (npan / 32) * 32; const int lo = npan - nfull; ks = (lo == 0 || lo > 16 || KSF8 == 1) ? 1 : 2; if (ks == 1) nfull = npan; }
struct EpiMoeDownSplit {
    static constexpr bool PERM = false, F8 = true, I8 = false;
    const int* rowmap; const float* rowp; bf16_t* yslot; float* partm; int ntn, row_split, kq; float osc;
    __device__ __forceinline__ void operator()(const f32x4 (&acc)[2][2][4][2], const pg8::Unit& u, int wr, int wc, int fr, int fq) const {
        const int row0 = u.pm * 256 + wr * 64 + fr, col0 = (u.pn % ntn) * 256 + wc * 32 + 4 * fq;
        if (u.pm * 256 < row_split) {
#pragma unroll
            for (int ai = 0; ai < 2; ++ai)
#pragma unroll
                for (int m = 0; m < 4; ++m) { const int row = row0 + ai * 128 + m * 16; const int rm = rowmap[row]; if (rm < 0) continue; const float p = rowp[row] * osc;
                    bf16_t* dst = yslot + ((size_t)(rm & 1) * ML + (size_t)(rm >> 1)) * D;
#pragma unroll
                    for (int bj = 0; bj < 2; ++bj)
#pragma unroll
                        for (int n = 0; n < 2; ++n) { const int col = col0 + bj * 128 + n * 16; const f32x4 v = acc[ai][bj][m][n] * p; u32x2 w; w.x = cvt_pk_bf16(v[0], v[1]); w.y = cvt_pk_bf16(v[2], v[3]); *(u32x2*)(dst + col) = w; } }
        } else {
            float* pb = partm + (size_t)(u.k0 / kq) * PM_ROWS * D;
#pragma unroll
            for (int ai = 0; ai < 2; ++ai)
#pragma unroll
                for (int m = 0; m < 4; ++m) { float* dst = pb + (size_t)(row0 + ai * 128 + m * 16 - row_split) * D;
#pragma unroll
                    for (int bj = 0; bj < 2; ++bj)
#pragma unroll
                        for (int n = 0; n < 2; ++n) *(f32x4*)(dst + col0 + bj * 128 + n * 16) = acc[ai][bj][m][n] * osc; }
        }
    }
};
struct MoeOrder {
    static constexpr bool SPLITK = false;
    int npan, ntn, G, c; int p1, p2, p3, p4, p5, p6, p7;
    __device__ __forceinline__ void init(const Frame& F, int ntn_) {
        const unsigned* cnt = F.wsp<unsigned>(WS_CTL) + CW_CNT; int o = 0;
        o += (int)((cnt[0] + 255u) >> 8); p1 = o; o += (int)((cnt[64] + 255u) >> 8); p2 = o; o += (int)((cnt[128] + 255u) >> 8); p3 = o; o += (int)((cnt[192] + 255u) >> 8); p4 = o;
        o += (int)((cnt[256] + 255u) >> 8); p5 = o; o += (int)((cnt[320] + 255u) >> 8); p6 = o; o += (int)((cnt[384] + 255u) >> 8); p7 = o; o += (int)((cnt[448] + 255u) >> 8); npan = o;
        ntn = ntn_; G = F.G; c = F.bid; }
    __device__ __forceinline__ bool next(int i, pg8::Unit& u) const {
        long f; if ((G & 7) == 0) { const int per = G >> 3; f = ((long)i * 8 + (c & 7)) * per + (c >> 3); } else f = (long)i * G + c;
        if (f >= (long)npan * ntn) return false;
        const int fi = (int)f; const int q1 = p1 * ntn, q2 = p2 * ntn, q3 = p3 * ntn, q4 = p4 * ntn, q5 = p5 * ntn, q6 = p6 * ntn, q7 = p7 * ntn;
        const int e = (fi >= q1) + (fi >= q2) + (fi >= q3) + (fi >= q4) + (fi >= q5) + (fi >= q6) + (fi >= q7);
        const int pb = e == 0 ? 0 : e == 1 ? p1 : e == 2 ? p2 : e == 3 ? p3 : e == 4 ? p4 : e == 5 ? p5 : e == 6 ? p6 : p7;
        const int pe = e == 0 ? p1 : e == 1 ? p2 : e == 2 ? p3 : e == 3 ? p4 : e == 4 ? p5 : e == 5 ? p6 : e == 6 ? p7 : npan;
        const int gw = (ntn & 3) == 0 ? 4 : ((ntn & 1) == 0 ? 2 : 1);
        const int np = pe - pb, r = fi - pb * ntn, gsz = np * gw, tg = r / gsz, rr = r % gsz;
        u.pm = pb + rr / gw; u.pn = e * ntn + tg * gw + rr % gw; u.k0 = 0; u.nt = 0; return true;
    }
    __device__ __forceinline__ void a_ready(const pg8::Unit&) const {}
    __device__ __forceinline__ void done(const pg8::Unit&) const {}
};

struct MoeDownOrder {
    static constexpr bool SPLITK = true;
    MoeOrder mo; int nfull, KS, ntfull;
    __device__ __forceinline__ void init(const Frame& F, int ntn_, int K) { mo.init(F, ntn_); ntfull = K / 64; moe_down_split(mo.npan, nfull, KS); }
    __device__ __forceinline__ bool next(int i, pg8::Unit& u) const {
        const long L = (long)i * mo.G + mo.c; const long nnorm = (long)nfull * mo.ntn; if (L >= nnorm + (long)(mo.npan - nfull) * mo.ntn * KS) return false;
        int pm, pn, k0, ntu;
        if (L < nnorm) { pm = (int)(L / mo.ntn); pn = (int)(L % mo.ntn); k0 = 0; ntu = ntfull; }
        else { const int sub = (int)(L - nnorm), ks = sub % KS, t = sub / KS; pm = nfull + t / mo.ntn; pn = t % mo.ntn; ntu = ntfull / KS; k0 = ks * ntu * 64; }
        const int e = (pm >= mo.p1) + (pm >= mo.p2) + (pm >= mo.p3) + (pm >= mo.p4) + (pm >= mo.p5) + (pm >= mo.p6) + (pm >= mo.p7);
        u.pm = pm; u.pn = e * mo.ntn + pn; u.k0 = k0; u.nt = ntu; return true;
    }
    __device__ __forceinline__ void a_ready(const pg8::Unit&) const {}
    __device__ __forceinline__ void done(const pg8::Unit&) const {}
};

template <int MTN, int NTN, int KS>
__device__ __forceinline__ void wave_mma(f32x4 (&acc)[MTN][NTN], const LAS bf16_t* A, int rowA0, const LAS bf16_t* B, int rowB0, int lane) {
    const int r = lane & 15, q = lane >> 4;
#pragma unroll
    for (int ks = 0; ks < KS; ++ks) {
        bf16x8 a[MTN], b[NTN];
#pragma unroll
        for (int mt = 0; mt < MTN; ++mt) a[mt] = *(const LAS bf16x8*)(A + (rowA0 + 16 * mt + r) * TP + ks * 32 + q * 8);
#pragma unroll
        for (int nt = 0; nt < NTN; ++nt) b[nt] = *(const LAS bf16x8*)(B + (rowB0 + 16 * nt + r) * TP + ks * 32 + q * 8);
#pragma unroll
        for (int mt = 0; mt < MTN; ++mt)
#pragma unroll
            for (int nt = 0; nt < NTN; ++nt) acc[mt][nt] = MFMA16(a[mt], b[nt], acc[mt][nt]);
    }
}
template <int MTN, int NTN> __device__ __forceinline__ void zero_acc(f32x4 (&acc)[MTN][NTN]) {
#pragma unroll
    for (int a = 0; a < MTN; ++a)
#pragma unroll
        for (int b = 0; b < NTN; ++b) acc[a][b] = (f32x4){0.f, 0.f, 0.f, 0.f};
}

template <bool MAXOP> __device__ __forceinline__ void wave_scan128(const LAS float* a, LAS float* out, bool rev, int lane) {
    const int i0 = rev ? CH - 1 - 2 * lane : 2 * lane, i1 = rev ? i0 - 1 : i0 + 1;
    const float x0 = a[i0], x1 = a[i1]; float s = MAXOP ? fmaxf(x0, x1) : x0 + x1;
#pragma unroll
    for (int off = 1; off < 64; off <<= 1) { const float t = __shfl_up(s, off); if (lane >= off) s = MAXOP ? fmaxf(s, t) : s + t; }
    float prev = __shfl_up(s, 1); if (lane == 0) prev = MAXOP ? -INFINITY : 0.f;
    out[i0] = MAXOP ? fmaxf(prev, x0) : prev + x0; out[i1] = s;
}
__device__ __forceinline__ void conv3x8(const bf16_t* base, int ld, bool has_l, bool has_r, const float* w, int wld, const float* b, float (&o)[8]) {
    float xc[8], xl[8], xr[8];
    unpack8(*(const u32x4*)base, xc);
    if (has_l) unpack8(*(const u32x4*)(base - ld), xl); else {
#pragma unroll
        for (int j = 0; j < 8; ++j) xl[j] = 0.f; }
    if (has_r) unpack8(*(const u32x4*)(base + ld), xr); else {
#pragma unroll
        for (int j = 0; j < 8; ++j) xr[j] = 0.f; }
    const f32x4 w0a = *(const f32x4*)(w), w0b = *(const f32x4*)(w + 4), w1a = *(const f32x4*)(w + wld), w1b = *(const f32x4*)(w + wld + 4), w2a = *(const f32x4*)(w + 2 * wld), w2b = *(const f32x4*)(w + 2 * wld + 4);
    const f32x4 ba = *(const f32x4*)(b), bb = *(const f32x4*)(b + 4);
#pragma unroll
    for (int j = 0; j < 4; ++j) { o[j] = ba[j] + w0a[j] * xl[j] + w1a[j] * xc[j] + w2a[j] * xr[j]; o[4 + j] = bb[j] + w0b[j] * xl[4 + j] + w1b[j] * xc[4 + j] + w2b[j] * xr[4 + j]; }
}
__device__ __forceinline__ void conv_nbr(int cs, int s, bool& has_l, bool& has_r) {
    if (cs < NCC) { const int pos = cs * CH + s; has_l = pos > 0; has_r = pos < CTX - 1; }
    else { has_l = (s & (GW - 1)) != 0; has_r = (s & (GW - 1)) != GW - 1; }
}
__device__ __forceinline__ int chunk_row0(int b, int cs) { return cs < NCC ? ML + b * CTX + cs * CH : b * SEQ + (cs - NCC) * CH; }
__device__ __forceinline__ int scan_slot(int d, int q) { return d == 0 ? q : (q < NCC ? NCC - 1 - q : NCS - 1 - (q - NCC)); }

template <int MAP> __device__ __forceinline__ int conv_src_col(int nb, int half) {
    if (MAP == 0) return nb * 128;
    if (MAP == 1) return (nb & 1) * half + (nb >> 1) * 128;
    return nb * 128 < SSDD + XBC ? nb * 128 : nb * 128 + CD_SIDE;
}
template <int MAP> __device__ __forceinline__ void conv_job(const Frame& F, int& base, const float* src, int ld, bf16_t* dst, int K, int nblk, int half) {
    constexpr int PB = 264;
    const int ntile = nblk * (K / 128);
    const int n = F.tid & 127, kq = F.tid >> 7;
    int t = (F.bid - base % F.G + F.G) % F.G;
    base += ntile;
    f32x4 v[8];
    const unsigned ldb = (unsigned)ld * 4u, lane_off = (unsigned)n * 4u + (unsigned)(4 * kq) * ldb;
#define CONV_LOAD(tt) do { const int nb_ = (tt) % nblk, kb_ = (tt) / nblk; const char* sp_ = (const char*)(src + (size_t)(kb_ * 128) * ld + conv_src_col<MAP>(nb_, half)); \
        _Pragma("unroll") for (int i_ = 0; i_ < 8; ++i_) { const unsigned o_ = lane_off + (unsigned)(16 * i_) * ldb; \
            v[i_][0] = NTLD((const float*)(sp_ + o_)); v[i_][1] = NTLD((const float*)(sp_ + o_ + ldb)); v[i_][2] = NTLD((const float*)(sp_ + o_ + 2u * ldb)); v[i_][3] = NTLD((const float*)(sp_ + o_ + 3u * ldb)); } } while (0)
    if (t < ntile) CONV_LOAD(t);
    while (t < ntile) {
#pragma unroll
        for (int i = 0; i < 8; ++i) { u32x2 w; w.x = pk2(v[i][0], v[i][1]); w.y = pk2(v[i][2], v[i][3]); *(LAS u32x2*)(F.lds + n * PB + (kq + 4 * i) * 8) = w; }
        const int tn = t + F.G;
        if (tn < ntile) CONV_LOAD(tn);
        __syncthreads();
        const int nb = t % nblk, kb = t / nblk;
#pragma unroll
        for (int i = 0; i < 4; ++i) { const int ch = F.tid + 512 * i, nn = ch >> 4, kc = ch & 15;
            const u32x2 a = *(const LAS u32x2*)(F.lds + nn * PB + kc * 16), b = *(const LAS u32x2*)(F.lds + nn * PB + kc * 16 + 8);
            u32x4 w; w.x = a.x; w.y = a.y; w.z = b.x; w.w = b.y;
            *(u32x4*)(dst + (size_t)(nb * 128 + nn) * K + kb * 128 + kc * 8) = w; }
        __syncthreads();
        t = tn;
    }
#undef CONV_LOAD
}
constexpr int MQ_TGU = (2 * FF / 128) * (D / 128), MQ_TDN = (D / 128) * (FF / 128), MQ_NT = NE * (MQ_TGU + MQ_TDN);
struct MoeTile { const char* sp; unsigned char* dp; unsigned ldb; int K; };
__device__ __forceinline__ MoeTile moe_tile(const Frame& F, int t) {
    MoeTile m;
    if (t < NE * MQ_TGU) { const int e = t / MQ_TGU, r = t % MQ_TGU, nb = r % (2 * FF / 128), kb = r / (2 * FF / 128);
        m.sp = (const char*)(F.in[I_MOEGU] + (size_t)e * D * 2 * FF + (size_t)(kb * 128) * (2 * FF) + (nb & 1) * FF + (nb >> 1) * 128); m.ldb = 2u * FF * 4u;
        m.dp = F.wsp<unsigned char>(WS_W_MGU) + (size_t)e * 2 * FF * D + (size_t)(nb * 128) * D + kb * 128; m.K = D; }
    else { const int tt = t - NE * MQ_TGU, e = tt / MQ_TDN, r = tt % MQ_TDN, nb = r % (D / 128), kb = r / (D / 128);
        m.sp = (const char*)(F.in[I_MOEDN] + (size_t)e * FF * D + (size_t)(kb * 128) * D + nb * 128); m.ldb = (unsigned)D * 4u;
        m.dp = F.wsp<unsigned char>(WS_W_MDN) + (size_t)e * D * FF + (size_t)(nb * 128) * FF + kb * 128; m.K = FF; }
    return m;
}
#define MQ_LOAD(m, v) do { const unsigned lo_ = (unsigned)(F.tid & 127) * 4u + (unsigned)(4 * (F.tid >> 7)) * (m).ldb; \
        _Pragma("unroll") for (int i_ = 0; i_ < 8; ++i_) { const unsigned o_ = lo_ + (unsigned)(16 * i_) * (m).ldb; \
            v[i_][0] = NTLD((const float*)((m).sp + o_)); v[i_][1] = NTLD((const float*)((m).sp + o_ + (m).ldb)); v[i_][2] = NTLD((const float*)((m).sp + o_ + 2u * (m).ldb)); v[i_][3] = NTLD((const float*)((m).sp + o_ + 3u * (m).ldb)); } } while (0)
#define MQ_TOLDS(v) do { _Pragma("unroll") for (int i_ = 0; i_ < 8; ++i_) *(LAS unsigned*)(F.lds + (F.tid & 127) * 132 + ((F.tid >> 7) + 4 * i_) * 4) = \
        cvt_pk_fp8x4(v[i_][0] * W8SCALE, v[i_][1] * W8SCALE, v[i_][2] * W8SCALE, v[i_][3] * W8SCALE); } while (0)
#define MQ_STORE(m) do { _Pragma("unroll") for (int i_ = 0; i_ < 2; ++i_) { const int ch_ = F.tid + 512 * i_, nn_ = ch_ >> 3, kc_ = ch_ & 7; const LAS unsigned* lp_ = (const LAS unsigned*)(F.lds + nn_ * 132 + kc_ * 16); \
        u32x4 w_; w_.x = lp_[0]; w_.y = lp_[1]; w_.z = lp_[2]; w_.w = lp_[3]; NTST(w_, (u32x4*)((m).dp + (size_t)nn_ * (m).K + kc_ * 16)); } } while (0)
__device__ __forceinline__ void conv_job_f8(const Frame& F, int& base, const float* src, int ld, unsigned char* dst, int K, int nblk) {
    const int ntile = nblk * (K / 128);
    int t = (F.bid - base % F.G + F.G) % F.G; base += ntile;
    f32x4 v[8]; MoeTile m, mn;
    __syncthreads();
#define CF8_TILE(mm, tt) do { const int nb_ = (tt) % nblk, kb_ = (tt) / nblk; (mm).sp = (const char*)(src + (size_t)(kb_ * 128) * ld + nb_ * 128); (mm).ldb = (unsigned)ld * 4u; (mm).dp = dst + (size_t)(nb_ * 128) * K + kb_ * 128; (mm).K = K; } while (0)
    if (t < ntile) { CF8_TILE(m, t); MQ_LOAD(m, v); }
    while (t < ntile) {
        MQ_TOLDS(v);
        const int tn = t + F.G; mn = m;
        if (tn < ntile) { CF8_TILE(mn, tn); MQ_LOAD(mn, v); }
        __syncthreads();
        MQ_STORE(m);
        __syncthreads();
        m = mn; t = tn;
    }
#undef CF8_TILE
}
__device__ __forceinline__ void moe_convert_strided(const Frame& F, int t0, int t1, int st) {
    __syncthreads();
    if (t0 >= t1) return;
    f32x4 v[8]; MoeTile m = moe_tile(F, t0), mn = m; MQ_LOAD(m, v);
#pragma unroll 1
    for (int t = t0; t < t1; t += st) {
        MQ_TOLDS(v);
        const int tn = t + st; mn = m;
        if (tn < t1) { mn = moe_tile(F, tn); MQ_LOAD(mn, v); }
        __syncthreads();
        MQ_STORE(m);
        __syncthreads();
        m = mn;
    }
}
struct MqSlot { int nu, q; };
__device__ __forceinline__ int mq_nu(int slot) {
    constexpr int NU_ML = NB * MLH * NCS, NU7 = (ML / 256) * (D / 256) + (MC / 256) * (D / 256) * KS7, NU9 = (MT / 256) * (2 * FF / 256), NU10 = (ML / 256) * (D / 256) + (MC / 256) * (D / 256) * KS10,
                  NU12 = (MT / 256) * (CD_MAIN / 256), NU13 = NB * NCS * SSDG * 2 * (HPG / 4), NU16 = (ML / 256) * (2 * S5W / 256);
    return slot == 0 ? NU_ML : slot == 1 ? NU_ML : slot == 2 ? NU7 : slot == 3 ? NU9 : slot == 4 ? NU10 : slot == 5 ? NU12 : slot == 6 ? NU13 : NU16;
}
__device__ __forceinline__ int mq_q(int slot) { return slot == 0 ? 6 : slot == 1 ? 16 : slot == 2 ? 2 : slot == 3 ? 8 : slot == 4 ? 12 : slot == 5 ? 16 : slot == 6 ? 8 : 2; }
constexpr int MQ_NSLOT = 8;
__device__ __forceinline__ int mq_base(int G, int slot) { int b = 0;
#pragma unroll
    for (int k = 0; k < MQ_NSLOT; ++k) { const int r = mq_nu(k) % G; if (k < slot && r != 0) b += (G - r) * mq_q(k); }
    return b < MQ_NT ? b : MQ_NT; }
__device__ __forceinline__ void help_slot(const Frame& F, int slot) {
    const int r = mq_nu(slot) % F.G; if (r == 0 || F.bid < r) return;
    const int nh = F.G - r, b0 = mq_base(F.G, slot); int b1 = b0 + nh * mq_q(slot); if (b1 > MQ_NT) b1 = MQ_NT;
    moe_convert_strided(F, b0 + (F.bid - r), b1, nh);
}
constexpr int MQ_Q20 = 8;
__device__ __forceinline__ int mq_tail_lo(const Frame& F, int& r) {
    const unsigned* cnt = F.wsp<unsigned>(WS_CTL) + CW_CNT; int npan = 0;
#pragma unroll
    for (int k = 0; k < NE; ++k) npan += (int)((cnt[64 * k] + 255u) >> 8);
    const int U = npan * (2 * FF / 256); r = U % F.G; const int nidle = r ? F.G - r : 0; const int b = mq_base(F.G, MQ_NSLOT);
    int tl = nidle * MQ_Q20; if (tl > MQ_NT - b) tl = MQ_NT - b; if (tl < 0) tl = 0;
    return MQ_NT - tl;
}
__device__ __forceinline__ void help_drain(const Frame& F) {
    int r; const int hi = mq_tail_lo(F, r);
    const int b = mq_base(F.G, MQ_NSLOT); if (hi - b <= 0) return;
    moe_convert_strided(F, b + F.bid, hi, F.G);
}
__device__ __forceinline__ void help_moe_tail(const Frame& F) {
    int r; const int lo = mq_tail_lo(F, r); if (r == 0) return;
    const int pos = (F.G & 7) == 0 ? (F.bid & 7) * (F.G >> 3) + (F.bid >> 3) : F.bid;
    if (pos < r) return;
    moe_convert_strided(F, lo + (pos - r), MQ_NT, F.G - r);
}
template <int MAP> __device__ __forceinline__ void conv_job_i8(const Frame& F, int& base, const float* src, int ld, signed char* dst, float* scale, int K, int nblk, int half) {
    LAS float* cmx = (LAS float*)(F.lds + 128 * 132);
    const int n = F.tid & 127, kq = F.tid >> 7; const unsigned ldb = (unsigned)ld * 4u, lane_off = (unsigned)n * 4u + (unsigned)(4 * kq) * ldb;
    for (int nb = (F.bid - base % F.G + F.G) % F.G; nb < nblk; nb += F.G) {
        const char* sp0 = (const char*)(src + conv_src_col<MAP>(nb, half)); float mx = 0.f;
        for (int kb = 0; kb < K / 128; ++kb) { const char* sp = sp0 + (size_t)(kb * 128) * ldb;
#pragma unroll
            for (int i = 0; i < 8; ++i) { const unsigned o = lane_off + (unsigned)(16 * i) * ldb;
                mx = fmaxf(mx, fmaxf(fmaxf(fabsf(*(const float*)(sp + o)), fabsf(*(const float*)(sp + o + ldb))), fmaxf(fabsf(*(const float*)(sp + o + 2u * ldb)), fabsf(*(const float*)(sp + o + 3u * ldb))))); } }
        __syncthreads();
        cmx[kq * 128 + n] = mx;
        __syncthreads();
        if (F.tid < 128) { const float m4 = fmaxf(fmaxf(cmx[n], cmx[128 + n]), fmaxf(cmx[256 + n], cmx[384 + n])); const float sc = m4 > 0.f ? m4 * (1.0f / 127.0f) : 1.0f; scale[nb * 128 + n] = sc; cmx[512 + n] = 1.0f / sc; }
        __syncthreads();
        const float inv = cmx[512 + n];
        for (int kb = 0; kb < K / 128; ++kb) { const char* sp = sp0 + (size_t)(kb * 128) * ldb;
#pragma unroll
            for (int i = 0; i < 8; ++i) { const unsigned o = lane_off + (unsigned)(16 * i) * ldb;
                *(LAS unsigned*)(F.lds + n * 132 + (kq + 4 * i) * 4) = pk_i8x4(*(const float*)(sp + o) * inv, *(const float*)(sp + o + ldb) * inv, *(const float*)(sp + o + 2u * ldb) * inv, *(const float*)(sp + o + 3u * ldb) * inv); }
            __syncthreads();
#pragma unroll
            for (int i = 0; i < 2; ++i) { const int ch = F.tid + 512 * i, nn = ch >> 3, kc = ch & 7; const LAS unsigned* lp = (const LAS unsigned*)(F.lds + nn * 132 + kc * 16);
                u32x4 w; w.x = lp[0]; w.y = lp[1]; w.z = lp[2]; w.w = lp[3]; *(u32x4*)(dst + (size_t)(nb * 128 + nn) * K + kb * 128 + kc * 16) = w; }
            __syncthreads(); }
    }
    base += nblk;
}
__device__ __forceinline__ void conv_side(const Frame& F, const float* src, int ld, int col0, int nside, bf16_t* dst, int K) {
    for (int idx = F.bid * NTHREADS + F.tid; idx < 32 * K; idx += F.G * NTHREADS) { const int n = idx / K, k = idx % K;
        dst[idx] = (bf16_t)(n < nside ? f2bf(src[(size_t)k * ld + col0 + n]) : 0u); }
}

__device__ __forceinline__ void adaln_units(const Frame& F) {
    LAS float* cond = (LAS float*)F.lds;
    const float* adaw = F.in[I_ADAW]; float* part = F.wsp<float>(WS_MODP);
    constexpr int NCHUNK = 6 * D / 512, NU = 2 * NCHUNK * KSL;
    for (int u = F.bid; u < NU; u += F.G) {
        const int l = u / (NCHUNK * KSL), rem = u % (NCHUNK * KSL), ks = rem / NCHUNK, nc = rem % NCHUNK;
        __syncthreads();
        for (int i = F.tid; i < NR * 256; i += NTHREADS) { const int r = i / 256, k = ks * 256 + (i & 255); const float c = r < NB ? F.in[I_C][r * D + k] : F.in[I_CCTX][k]; cond[i] = siluf(c); }
        __syncthreads();
        const int n = nc * 512 + F.tid; const float* wp = adaw + ((size_t)l * D + ks * 256) * (6 * D) + n;
        float acc[NR];
#pragma unroll
        for (int r = 0; r < NR; ++r) acc[r] = 0.f;
#pragma unroll 1
        for (int k0 = 0; k0 < 256; k0 += 32) { float w[32];
#pragma unroll
            for (int j = 0; j < 32; ++j) w[j] = NTLD(wp + (size_t)(k0 + j) * (6 * D));
#pragma unroll
            for (int j = 0; j < 32; ++j)
#pragma unroll
                for (int r = 0; r < NR; ++r) acc[r] += cond[r * 256 + k0 + j] * w[j]; }
#pragma unroll
        for (int r = 0; r < NR; ++r) part[(((size_t)l * KSL + ks) * NR + r) * (6 * D) + n] = acc[r];
    }
    __syncthreads();
}

__device__ __forceinline__ void hyena_filter_units(const Frame& F, int wg_off) {
    constexpr int H2P = 36, OBP = 33, FC = HYD >= NTHREADS ? HYD / NTHREADS : 1;
    LAS float* feats = (LAS float*)F.lds;
    LAS float* h1 = feats + 32 * 36;
    LAS float* h2 = h1 + 32 * 64;
    LAS float* ob = h2 + 64 * H2P;
    static_assert((32 * 36 + 32 * 64 + 64 * H2P + NTHREADS * OBP) * 4 <= LDS_MISC, "filter LDS");
    static_assert(SEQ % 32 == 0 && CTX % 32 == 0 && (HYD % NTHREADS == 0 || HYD < NTHREADS), "filter shapes");
    const float* w1 = F.in[I_HYW1]; const float* b1 = F.in[I_HYB1]; const float* w2 = F.in[I_HYW2]; const float* b2 = F.in[I_HYB2]; const float* w3 = F.in[I_HYW3]; const float* fq = F.in[I_HYFREQ];
    constexpr int NU0 = 2 * (SEQ / 32), NU = NU0 + 2 * (CTX / 32);
    for (int u = (F.bid - wg_off % F.G + F.G) % F.G; u < NU; u += F.G) {
        const int set = u < NU0 ? 0 : 1, L = set ? CTX : SEQ, ul = set ? u - NU0 : u, dir = ul & 1, p0 = (ul >> 1) * 32, pb = (set ? SEQ / 32 : 0) + (ul >> 1);
        float* filt = F.wsp<float>(set ? WS_FILT1 : WS_FILT0);
        int tid = F.tid; LAUNDER(tid);
        __syncthreads();
        for (int e = tid; e < 32 * HYEMB; e += NTHREADS) { const int p = e / HYEMB, i = e % HYEMB; const float pos = (float)(p0 + dir + p); float v;
            if (i == 0) v = pos / (float)(L - 1);
            else { const int bi = (i - 1) & 15; const float band = 1e-4f + (float)bi * ((15.0f - 1e-4f) / 15.0f); const float ang = (float)(2.0 * M_PI / (double)L) * pos * band; v = i <= 16 ? cosf(ang) : -sinf(ang); }
            feats[p * 36 + i] = v; }
        __syncthreads();
        { const int pq = tid >> 6, j = tid & 63; float wv[HYEMB]; float sa[4];
#pragma unroll
            for (int i = 0; i < HYEMB; ++i) wv[i] = w1[i * HYHID + j];
#pragma unroll
            for (int x = 0; x < 4; ++x) sa[x] = b1[j];
#pragma unroll
            for (int i = 0; i < HYEMB; ++i)
#pragma unroll
                for (int x = 0; x < 4; ++x) sa[x] += feats[(4 * pq + x) * 36 + i] * wv[i];
#pragma unroll
            for (int x = 0; x < 4; ++x) h1[(4 * pq + x) * 64 + j] = fq[j] * sa[x];
#pragma unroll 1
            for (int x = 0; x < 4; ++x) { LAS float* hp = h1 + (4 * pq + x) * 64 + j; *hp = sinf(*hp); } }
        __syncthreads();
        { const int pq = tid >> 6, j = tid & 63; float wv[HYHID]; float sa[4];
#pragma unroll
            for (int i = 0; i < HYHID; ++i) wv[i] = w2[i * HYHID + j];
#pragma unroll
            for (int x = 0; x < 4; ++x) sa[x] = b2[j];
#pragma unroll
            for (int i = 0; i < HYHID; ++i)
#pragma unroll
                for (int x = 0; x < 4; ++x) sa[x] += h1[(4 * pq + x) * 64 + i] * wv[i];
#pragma unroll
            for (int x = 0; x < 4; ++x) h2[j * H2P + 4 * pq + x] = fq[HYHID + j] * sa[x];
#pragma unroll 1
            for (int x = 0; x < 4; ++x) { LAS float* hp = h2 + j * H2P + 4 * pq + x; *hp = sinf(*hp); } }
        __syncthreads();
        float acc[FC][32];
#pragma unroll
        for (int cc = 0; cc < FC; ++cc)
#pragma unroll
            for (int p = 0; p < 32; ++p) acc[cc][p] = 0.f;
        const int cl = tid < HYD ? tid : 0;
#pragma unroll 1
        for (int k0 = 0; k0 < HYHID; k0 += 16) { float w[16][FC];
#pragma unroll
            for (int j = 0; j < 16; ++j)
#pragma unroll
                for (int cc = 0; cc < FC; ++cc) w[j][cc] = w3[(size_t)(k0 + j) * (2 * HYD) + dir * HYD + cl + NTHREADS * cc];
#pragma unroll
            for (int j = 0; j < 16; ++j) {
#pragma unroll
                for (int i = 0; i < 8; ++i) { const f32x4 hv = *(const LAS f32x4*)(h2 + (k0 + j) * H2P + 4 * i);
#pragma unroll
                    for (int cc = 0; cc < FC; ++cc) { acc[cc][4 * i] += hv[0] * w[j][cc]; acc[cc][4 * i + 1] += hv[1] * w[j][cc]; acc[cc][4 * i + 2] += hv[2] * w[j][cc]; acc[cc][4 * i + 3] += hv[3] * w[j][cc]; } } } }
        const int a0 = dir ? L - p0 - 32 : L + p0;
#pragma unroll
        for (int cc = 0; cc < FC; ++cc) { const int c = cl + NTHREADS * cc;
            const float delta = (float)(-log(1e-2) / 1.5) + (float)c * (float)((-log(1e-2) / 0.3 + log(1e-2) / 1.5) / (double)(HYD - 1));
            float l1 = 0.f;
#pragma unroll
            for (int p = 0; p < 32; ++p) { const int pos = p0 + dir + p; const float t = (float)pos / (float)(L - 1); float v = acc[cc][p] * expf(-t * delta);
                if (pos >= L) v = 0.f;
                l1 += fabsf(v); ob[tid * OBP + (dir ? 31 - p : p)] = v; }
            if (tid < HYD) F.wsp<float>(WS_L1P)[(size_t)pb * (2 * HYD) + dir * HYD + c] = l1;
            __syncthreads();
            for (int e = tid; e < (HYD < NTHREADS ? HYD : NTHREADS) * 8; e += NTHREADS) { const int ch = e >> 3, qd = e & 7; const LAS float* op = ob + ch * OBP + 4 * qd;
                const f32x4 v4 = {op[0], op[1], op[2], op[3]};
                *(f32x4*)(filt + (size_t)(ch + NTHREADS * cc) * (2 * L) + a0 + 4 * qd) = v4; }
            __syncthreads();
        }
    }
    __syncthreads();
}

__device__ __forceinline__ void s5_param_units(const Frame& F) {
    float* par = F.wsp<float>(WS_S5PAR);
    for (int i = F.bid + F.G * F.tid; i < 2 * S5G * S5P; i += F.G * NTHREADS) {
        const int d = i / (S5G * S5P), g = (i / S5P) % S5G, p = i % S5P;
        const float dt = expf(F.in[I_S5LDT][d * S5G + g]), lr = F.in[I_S5LRE][i], li = F.in[I_S5LIM][i];
        const float mag = expf(lr * dt), lbr = mag * cosf(li * dt), lbi = mag * sinf(li * dt), den = lr * lr + li * li;
        const float fr = ((lbr - 1.f) * lr + lbi * li) / den, fi = (lbi * lr - (lbr - 1.f) * li) / den;
        float* o = par + (size_t)i * 36; o[0] = lbr; o[1] = lbi;
        const float* bre = F.in[I_S5BRE] + ((size_t)g * S5P + p) * S5GS; const float* bim = F.in[I_S5BIM] + ((size_t)g * S5P + p) * S5GS;
        float br[S5GS], bi[S5GS];
#pragma unroll
        for (int k = 0; k < S5GS; ++k) { br[k] = bre[k]; bi[k] = bim[k]; }
#pragma unroll
        for (int k = 0; k < S5GS; ++k) { o[2 + k] = fr * br[k] - fi * bi[k]; o[18 + k] = fr * bi[k] + fi * br[k]; }
        const float magc = expf(lr * dt * (float)CH); o[34] = magc * cosf(li * dt * (float)CH); o[35] = magc * sinf(li * dt * (float)CH);
    }
}

__device__ __forceinline__ void phase_prologue(const Frame& F, int pm = 0) {
    int base = 0;
    if (pm == 0 || pm == 1) {
    conv_job<0>(F, base, F.in[I_ABWIN], AB_IN, F.wsp<bf16_t>(WS_W_ABIN), D, AB_MAIN / 128, 0);
    conv_job<0>(F, base, F.in[I_ABWOUT], D, F.wsp<bf16_t>(WS_W_ABOUT), YC1, D / 128, 0); }
    const int i8_hi = base + 2 * FF / 128;
    if (pm == 0 || pm == 2)
    conv_job_i8<1>(F, base, F.in[I_FFNGU], 2 * FF, F.wsp<signed char>(WS_W_GU), F.wsp<float>(WS_SB_GU), D, 2 * FF / 128, FF);
    if (pm == 0 || pm == 1) {
    conv_job_f8(F, base, F.in[I_FFNDN], D, F.wsp<unsigned char>(WS_W_DN), FF, D / 128);
    conv_job<2>(F, base, F.in[I_CDWIN], CD_IN, F.wsp<bf16_t>(WS_W_CDIN), D, CD_MAIN / 128, 0);
    conv_job<1>(F, base, F.in[I_S5GLU], 2 * S5W, F.wsp<bf16_t>(WS_W_GLU), S5W, 2 * S5W / 128, S5W);
    conv_job<0>(F, base, F.in[I_CDWOUT], D, F.wsp<bf16_t>(WS_W_CDOUT), YC2, D / 128, 0);
    conv_side(F, F.in[I_ABWIN], AB_IN, AB_MAIN, AB_SIDE, F.wsp<bf16_t>(WS_W_ABSIDE), D);
    conv_side(F, F.in[I_CDWIN], CD_IN, SSDD + XBC, CD_SIDE, F.wsp<bf16_t>(WS_W_CDSIDE), D); }
    if (pm == 0 || pm == 3) adaln_units(F);
    if (pm == 0 || pm == 4) { hyena_filter_units(F, i8_hi);
    s5_param_units(F); }
}

__device__ __forceinline__ void phase_finalize(const Frame& F) {
    const float* part = F.wsp<float>(WS_MODP); float* mod = F.wsp<float>(WS_MOD); const float* adab = F.in[I_ADAB];
    for (int i = F.bid * NTHREADS + F.tid; i < 2 * NR * 6 * D; i += F.G * NTHREADS) {
        const int l = i / (NR * 6 * D), r = (i / (6 * D)) % NR, n = i % (6 * D);
        float s = adab[l * 6 * D + n];
        for (int ks = 0; ks < KSL; ++ks) s += part[(((size_t)l * KSL + ks) * NR + r) * (6 * D) + n];
        mod[i] = s; }
    const float* l1p = F.wsp<float>(WS_L1P); float* l1 = F.wsp<float>(WS_L1);
    for (int i = F.bid * NTHREADS + F.tid; i < 2 * HYD; i += F.G * NTHREADS) {
        const int set = i / HYD, c = i % HYD; const int u0 = set ? SEQ / 32 : 0, nu = set ? CTX / 32 : SEQ / 32; float s = 0.f;
        for (int u = 0; u < nu; ++u) s += l1p[(size_t)(u0 + u) * (2 * HYD) + c] + l1p[(size_t)(u0 + u) * (2 * HYD) + HYD + c];
        l1[i] = 1.0f / s; }
}

template <bool ROUTE, bool OUTI8 = false> __device__ __forceinline__ void modulate_rows(const Frame& F, const float* xlat, const float* xctx, int layer, int si, bf16_t* dst, int m_hi, const float* part = nullptr, const float* pgate = nullptr, int nks = 0, float* xw = nullptr) {
    const float* mod = F.wsp<float>(WS_MOD) + (size_t)layer * NR * 6 * D;
    LAS float* rwl = (LAS float*)F.lds;
    LAS float* mdl = (LAS float*)F.lds + (ROUTE ? NE * D : 0); constexpr int NRL = ROUTE ? NB : NR;
    static_assert(((ROUTE ? NE * D : 0) + NRL * 2 * D) * 4 <= LDS_MISC, "modulate LDS");
    __syncthreads();
    if (ROUTE) { for (int i = F.tid; i < D * NE; i += NTHREADS) rwl[(i % NE) * D + i / NE] = F.in[I_ROUTER][i]; }
    for (int i = F.tid; i < NRL * 2 * D; i += NTHREADS) { const int r = i / (2 * D), w = i % (2 * D); mdl[i] = mod[(size_t)r * 6 * D + (size_t)si * D + w]; }
    __syncthreads();
    constexpr int NV = D / 256;
    for (int m = F.gw(); m < m_hi; m += F.ngw()) {
        const float* xr = m < ML ? xlat + (size_t)m * D : xctx + (size_t)(m - ML) * D; const int r = mod_row(m);
        const LAS float* sh = mdl + r * 2 * D; const LAS float* sc = sh + D;
        f32x4 v[NV]; float ss = 0.f;
#pragma unroll
        for (int i = 0; i < NV; ++i) { const int k = 4 * (F.lane + 64 * i); v[i] = *(const f32x4*)(xr + k);
            if (!ROUTE && part != nullptr && m >= ML) { f32x4 ps = *(const f32x4*)(part + (size_t)(m - ML) * D + k);
                for (int ks = 1; ks < nks; ++ks) ps += *(const f32x4*)(part + ((size_t)ks * MC + (m - ML)) * D + k);
                v[i] += *(const f32x4*)(pgate + k) * ps; *(f32x4*)(xw + (size_t)m * D + k) = v[i]; }
            ss += v[i][0] * v[i][0] + v[i][1] * v[i][1] + v[i][2] * v[i][2] + v[i][3] * v[i][3]; }
        ss = wave_sum(ss); const float rinv = 1.0f / sqrtf(ss * (1.0f / (float)D) + EPS);
        float lg[NE];
        if (ROUTE) {
#pragma unroll
            for (int e = 0; e < NE; ++e) lg[e] = 0.f; }
        if (OUTI8) {
            float mx = 0.f;
#pragma unroll
            for (int i = 0; i < NV; ++i) { const int k = 4 * (F.lane + 64 * i); const f32x4 s4 = *(const LAS f32x4*)(sh + k), c4 = *(const LAS f32x4*)(sc + k); v[i] = v[i] * rinv * (c4 + 1.0f) + s4;
                mx = fmaxf(mx, fmaxf(fmaxf(fabsf(v[i][0]), fabsf(v[i][1])), fmaxf(fabsf(v[i][2]), fabsf(v[i][3])))); }
            mx = wave_max(mx); const float scl = mx > 0.f ? mx * (1.0f / 127.0f) : 1.0f, inv = 1.0f / scl;
            signed char* d8 = F.wsp<signed char>(WS_A8) + (size_t)m * D;
#pragma unroll
            for (int i = 0; i < NV; ++i) *(unsigned*)(d8 + 4 * (F.lane + 64 * i)) = pk_i8x4(v[i][0] * inv, v[i][1] * inv, v[i][2] * inv, v[i][3] * inv);
            if (F.lane == 0) F.wsp<float>(WS_SA8)[m] = scl;
            continue; }
#pragma unroll
        for (int i = 0; i < NV; ++i) { const int k = 4 * (F.lane + 64 * i); const f32x4 s4 = *(const LAS f32x4*)(sh + k), c4 = *(const LAS f32x4*)(sc + k);
            f32x4 y = v[i] * rinv * (c4 + 1.0f) + s4;
            if (ROUTE) *(unsigned*)((unsigned char*)dst + (size_t)m * D + k) = cvt_pk_fp8x4(y[0], y[1], y[2], y[3]);
            else { u32x2 w; w.x = pk2(y[0], y[1]); w.y = pk2(y[2], y[3]); *(u32x2*)(dst + (size_t)m * D + k) = w; }
            if (ROUTE) {
#pragma unroll
                for (int e = 0; e < NE; ++e) { const f32x4 rv = *(const LAS f32x4*)(rwl + e * D + k); lg[e] += y[0] * rv[0] + y[1] * rv[1] + y[2] * rv[2] + y[3] * rv[3]; } SCHED_BARRIER(); } }
        if (ROUTE) {
#pragma unroll
            for (int e = 0; e < NE; ++e) lg[e] = wave_sum(lg[e]);
            if (F.lane == 0) { int e0 = 0; float v0 = lg[0];
#pragma unroll
                for (int e = 1; e < NE; ++e) if (lg[e] > v0) { v0 = lg[e]; e0 = e; }
                int e1 = -1; float v1 = -INFINITY;
#pragma unroll
                for (int e = 0; e < NE; ++e) if (e != e0 && lg[e] > v1) { v1 = lg[e]; e1 = e; }
                const float p1 = 1.0f / (1.0f + expf(v0 - v1)), p0 = 1.0f - p1;
                unsigned* cnt = F.wsp<unsigned>(WS_CTL) + CW_CNT;
                const unsigned pos0 = ATOM_ADD(cnt + 64 * e0, 1u), pos1 = ATOM_ADD(cnt + 64 * e1, 1u);
                int* rt = F.wsp<int>(WS_ROUTE) + (size_t)m * 4; rt[0] = e0; rt[1] = e1; rt[2] = (int)pos0; rt[3] = (int)pos1;
                float* rp = F.wsp<float>(WS_RPROB) + (size_t)m * 2; rp[0] = p0; rp[1] = p1; } }
    }
}

__device__ __forceinline__ void side_gemm(const Frame& F, const bf16_t* A, const bf16_t* Ws, float* out, int M) {
    const int r = F.lane & 15, q = F.lane >> 4; constexpr int KW = D / NWAVES; static_assert(KW % 32 == 0 && NTHREADS == 16 * 32, "side gemm split");
    LAS float* red = (LAS float*)F.lds;
    for (int blk = F.bid; blk < M / 16; blk += F.G) {
        f32x4 acc0 = (f32x4){0.f, 0.f, 0.f, 0.f}, acc1 = acc0; const int k0 = F.wave * KW;
        const bf16_t* ap = A + (size_t)(blk * 16 + r) * D + k0 + q * 8; const bf16_t* b0 = Ws + (size_t)r * D + k0 + q * 8; const bf16_t* b1 = Ws + (size_t)(16 + r) * D + k0 + q * 8;
#pragma unroll
        for (int k = 0; k < KW; k += 32) { const bf16x8 a = *(const bf16x8*)(ap + k), x0 = *(const bf16x8*)(b0 + k), x1 = *(const bf16x8*)(b1 + k);
            acc0 = MFMA16(a, x0, acc0); acc1 = MFMA16(a, x1, acc1); }
        __syncthreads();
#pragma unroll
        for (int j = 0; j < 4; ++j) { red[(F.wave * 16 + 4 * q + j) * 32 + r] = acc0[j]; red[(F.wave * 16 + 4 * q + j) * 32 + 16 + r] = acc1[j]; }
        __syncthreads();
        { const int row = F.tid >> 5, col = F.tid & 31; float sm = 0.f;
#pragma unroll
            for (int w = 0; w < NWAVES; ++w) sm += red[(w * 16 + row) * 32 + col];
            out[(size_t)(blk * 16 + row) * 32 + col] = sm; }
    }
    __syncthreads();
}

__device__ __forceinline__ void conv3x4(const bf16_t* rec, bool has_l, bool has_r, const float* w, int wld, const float* b, float (&o)[4]) {
    const u32x2 c = *(const u32x2*)rec; u32x2 l = (u32x2){0u, 0u}, r = (u32x2){0u, 0u};
    if (has_l) l = *(const u32x2*)(rec - 4);
    if (has_r) r = *(const u32x2*)(rec + 4);
    const f32x4 w0 = *(const f32x4*)w, w1 = *(const f32x4*)(w + wld), w2 = *(const f32x4*)(w + 2 * wld), bb = *(const f32x4*)b;
    const float xc[4] = {bf2f(c.x & 0xffffu), bf2f(c.x >> 16), bf2f(c.y & 0xffffu), bf2f(c.y >> 16)};
    const float xl[4] = {bf2f(l.x & 0xffffu), bf2f(l.x >> 16), bf2f(l.y & 0xffffu), bf2f(l.y >> 16)};
    const float xr[4] = {bf2f(r.x & 0xffffu), bf2f(r.x >> 16), bf2f(r.y & 0xffffu), bf2f(r.y >> 16)};
#pragma unroll
    for (int j = 0; j < 4; ++j) o[j] = bb[j] + w0[j] * xl[j] + w1[j] * xc[j] + w2[j] * xr[j];
}
template <int L, bool LAT> __device__ __forceinline__ void hyena_unit(const Frame& F0, int cg, int hymode = 0) {
    Frame F = F0; LAUNDER(F.tid); F.lane = F.tid & 63;
    constexpr int NT1 = L / 128, ZP = 136, ZCH = NB * NT1 * ZP, KRP = 2 * L + 8;
    static_assert(4 * ZCH * 2 + 8 * KRP * 2 + ZP * 2 <= LDS_MISC && 4 * NB * L * 4 <= LDS_MISC && NB <= 4 && NT1 <= 16, "hyena LDS");
    LAS bf16_t* zl = (LAS bf16_t*)F.lds;
    LAS bf16_t* kr = zl + 4 * ZCH;
    LAS bf16_t* zz = kr + 8 * KRP;
    LAS float* res = (LAS float*)F.lds;
    const bf16_t* PH = F.wsp<bf16_t>(WS_PH); const float* cw = F.in[I_HYCW]; const float* cb = F.in[I_HYCB];
    const float* filt = F.wsp<float>(LAT ? WS_FILT0 : WS_FILT1);
    const int c0 = cg * 4;
    __syncthreads();
    constexpr int ZB = 8;
    for (int idx0 = F.tid; idx0 < ((hymode & 2) ? 0 : NB * L); idx0 += ZB * NTHREADS) { float a[ZB][4], v[ZB][4];
#pragma unroll
        for (int j = 0; j < ZB; ++j) { const int idx = idx0 + j * NTHREADS < NB * L ? idx0 + j * NTHREADS : idx0; const int b = idx / L, t = idx % L; const int m = LAT ? b * SEQ + t : ML + b * CTX + t;
            bool hl, hr; if (LAT) { hl = (t & (GW - 1)) != 0; hr = (t & (GW - 1)) != GW - 1; } else { hl = t > 0; hr = t < L - 1; }
            conv3x4(PH + ((size_t)(HYD / 4 + cg) * MT + m) * 4, hl, hr, cw + HYD + c0, 3 * HYD, cb + HYD + c0, a[j]);
            conv3x4(PH + ((size_t)(2 * HYD / 4 + cg) * MT + m) * 4, hl, hr, cw + 2 * HYD + c0, 3 * HYD, cb + 2 * HYD + c0, v[j]); }
#pragma unroll
        for (int j = 0; j < ZB; ++j) { const int idx = idx0 + j * NTHREADS; if (idx < NB * L) { const int b = idx / L, t = idx % L;
#pragma unroll
            for (int c = 0; c < 4; ++c) zl[c * ZCH + (b * NT1 + (t >> 7)) * ZP + (t & 127)] = (bf16_t)f2bf(a[j][c] * v[j][c]); } } }
    constexpr int KB = 8;
    for (int idx0 = F.tid; idx0 < 4 * KRP; idx0 += KB * NTHREADS) { float tv[KB];
#pragma unroll
        for (int j = 0; j < KB; ++j) { const int idx = idx0 + j * NTHREADS; const int c = idx / KRP, i = idx % KRP;
            tv[j] = (idx < 4 * KRP && i >= 1 && i <= 2 * L - 1) ? filt[(size_t)(c0 + c) * (2 * L) + 2 * L - i] : 0.f; }
#pragma unroll
        for (int j = 0; j < KB; ++j) { const int idx = idx0 + j * NTHREADS; if (idx < 4 * KRP) { const int c = idx / KRP, i = idx % KRP;
            const bf16_t v = (bf16_t)((i >= 1 && i <= 2 * L - 1) ? f2bf(tv[j]) : 0u);
            kr[(c * 2) * KRP + i] = v; if (i >= 1) kr[(c * 2 + 1) * KRP + i - 1] = v; else kr[(c * 2 + 1) * KRP + KRP - 1] = 0; } } }
    if (F.tid < ZP) zz[F.tid] = 0;
    __syncthreads();
    const int ch = F.wave >> 1, h = F.wave & 1, i = F.lane & 31, q = F.lane >> 5;
    const int cb_ = i >> 3, t1 = 8 * h + (i & 7); const bool colok = cb_ < NB && t1 < NT1;
    f32x16 acc[4];
#pragma unroll
    for (int mt = 0; mt < 4; ++mt)
#pragma unroll
        for (int r = 0; r < 16; ++r) acc[mt][r] = 0.f;
    if (8 * h < NT1) {
        const int d_lo = 8 * h - (NT1 - 1), d_hi = (hymode & 1) ? d_lo - 1 : ((8 * h + 7 < NT1 - 1) ? 8 * h + 7 : NT1 - 1);
        const LAS unsigned* kbase = (const LAS unsigned*)(kr + (ch * 2 + (i & 1)) * KRP) + (L / 2 + 4 * q - ((i + 1) >> 1));
        const LAS bf16_t* zc = zl + ch * ZCH + (colok ? cb_ : 0) * NT1 * ZP + 8 * q;
        bf16x8 fa[14], fb[14];
#define HY_LOADF(dst, dd) do { const LAS unsigned* kb_ = kbase - 8 * (8 * (dd) - 7); _Pragma("unroll") for (int fi_ = 0; fi_ < 14; ++fi_) { const LAS unsigned* p_ = kb_ - 8 * fi_; \
            u32x4 fw_; fw_.x = p_[0]; fw_.y = p_[1]; fw_.z = p_[2]; fw_.w = p_[3]; dst[fi_] = __builtin_bit_cast(bf16x8, fw_); } } while (0)
#define HY_STEP(cur, nxt, dd) do { const int s1_ = t1 - (dd); const bool ok_ = colok && s1_ >= 0 && s1_ < NT1; const LAS bf16_t* zp_ = ok_ ? zc + s1_ * ZP : zz + 8 * q; const int zs_ = ok_ ? 16 : 0; \
            bf16x8 zf_[8]; _Pragma("unroll") for (int ks_ = 0; ks_ < 8; ++ks_) zf_[ks_] = *(const LAS bf16x8*)(zp_ + zs_ * ks_); \
            if ((dd) + 1 <= d_hi) HY_LOADF(nxt, (dd) + 1); \
            _Pragma("unroll") for (int ks_ = 0; ks_ < 8; ++ks_) _Pragma("unroll") for (int mt_ = 0; mt_ < 4; ++mt_) acc[mt_] = MFMA32(cur[2 * mt_ - ks_ + 7], zf_[ks_], acc[mt_]); } while (0)
        if (d_lo <= d_hi) HY_LOADF(fa, d_lo);
#pragma unroll 1
        for (int d = d_lo; d <= d_hi; d += 2) {
            HY_STEP(fa, fb, d);
            if (d + 1 <= d_hi) HY_STEP(fb, fa, d + 1);
        }
#undef HY_LOADF
#undef HY_STEP
        if (colok) { const float il1 = F.wsp<float>(WS_L1)[(LAT ? 0 : HYD) + c0 + ch], bias = F.in[I_HYBIAS][c0 + ch]; const LAS bf16_t* zr = zl + ch * ZCH + (cb_ * NT1 + t1) * ZP;
#pragma unroll
            for (int mt = 0; mt < 4; ++mt)
#pragma unroll
                for (int r = 0; r < 16; ++r) { const int t0 = 32 * mt + 8 * (r >> 2) + 4 * q + (r & 3); acc[mt][r] = acc[mt][r] * il1 + bias * bf2f(zr[t0]); } }
    }
    __syncthreads();
    if (8 * h < NT1 && colok) {
#pragma unroll
        for (int mt = 0; mt < 4; ++mt)
#pragma unroll
            for (int r = 0; r < 16; ++r) res[(ch * NB + cb_) * L + t1 * 128 + 32 * mt + 8 * (r >> 2) + 4 * q + (r & 3)] = acc[mt][r]; }
    __syncthreads();
    bf16_t* Y = F.wsp<bf16_t>(WS_YCAT);
    for (int idx0 = F.tid; idx0 < ((hymode & 2) ? 0 : NB * L); idx0 += ZB * NTHREADS) { float x0[ZB][4];
#pragma unroll
        for (int j = 0; j < ZB; ++j) { const int idx = idx0 + j * NTHREADS < NB * L ? idx0 + j * NTHREADS : idx0; const int b = idx / L, t = idx % L; const int m = LAT ? b * SEQ + t : ML + b * CTX + t;
            bool hl, hr; if (LAT) { hl = (t & (GW - 1)) != 0; hr = (t & (GW - 1)) != GW - 1; } else { hl = t > 0; hr = t < L - 1; }
            conv3x4(PH + ((size_t)cg * MT + m) * 4, hl, hr, cw + c0, 3 * HYD, cb + c0, x0[j]); }
#pragma unroll
        for (int j = 0; j < ZB; ++j) { const int idx = idx0 + j * NTHREADS; if (idx < NB * L) { const int b = idx / L, t = idx % L; const int m = LAT ? b * SEQ + t : ML + b * CTX + t;
            u32x2 wv; wv.x = pk2(x0[j][0] * res[(0 * NB + b) * L + t], x0[j][1] * res[(1 * NB + b) * L + t]); wv.y = pk2(x0[j][2] * res[(2 * NB + b) * L + t], x0[j][3] * res[(3 * NB + b) * L + t]);
            *(u32x2*)(Y + (size_t)m * YC1 + c0) = wv; } } }
    __syncthreads();
}
__device__ __forceinline__ void hyena_units(const Frame& F, int hymode = 0) {
    for (int u = F.bid; u < HYD / 4; u += F.G) hyena_unit<SEQ, true>(F, u, hymode);
    for (int u = F.bid; u < HYD / 4; u += F.G) hyena_unit<CTX, false>(F, u, hymode);
}

__device__ __forceinline__ float* mlst_slot(const Frame& F, int d, int b, int h, int cs) { return F.wsp<float>(WS_MLST) + ((((size_t)d * NB + b) * MLH + h) * NCS + cs) * MLST_STRIDE; }

__device__ __forceinline__ void mlstm_gates(const Frame& F, LAS float* ga, int m0, int h) {
    if (F.tid < CH) { const float* sd = F.wsp<float>(WS_SIDE) + (size_t)(m0 + F.tid) * 32; const float* gb = F.in[I_MLGB];
        ga[0 * CH + F.tid] = logsigmoidf_(sd[MLH + h] + gb[MLH + h]); ga[1 * CH + F.tid] = sd[h] + gb[h];
        ga[2 * CH + F.tid] = logsigmoidf_(sd[3 * MLH + h] + gb[3 * MLH + h]); ga[3 * CH + F.tid] = sd[2 * MLH + h] + gb[2 * MLH + h]; }
    __syncthreads();
    if (F.wave == 0) wave_scan128<false>(ga + 0 * CH, ga + 4 * CH, false, F.lane);
    else if (F.wave == 1) wave_scan128<false>(ga + 2 * CH, ga + 5 * CH, true, F.lane);
    __syncthreads();
}

__device__ __forceinline__ void mlstm_local_unit(const Frame& F0, int b, int h, int cs) {
    Frame F = F0; LAUNDER(F.tid); F.lane = F.tid & 63;
    LAS bf16_t* KwF = (LAS bf16_t*)F.lds; LAS bf16_t* KwB = (LAS bf16_t*)(F.lds + TILE_B); LAS bf16_t* VT = (LAS bf16_t*)(F.lds + 2 * TILE_B);
    LAS float* ga = (LAS float*)(F.lds + 3 * TILE_B);
    const int m0 = chunk_row0(b, cs);
    __syncthreads();
    mlstm_gates(F, ga, m0, h);
    if (F.tid < 2 * CH) { const int d = F.tid >> 7, i = F.tid & 127; const LAS float* bc = ga + (4 + d) * CH; const LAS float* ig = ga + (1 + 2 * d) * CH; const float g = d ? bc[0] : bc[CH - 1];
        const float a = g - bc[i] + ig[i]; float mx = a;
        mx = fmaxf(mx, __shfl_xor(mx, 1)); mx = fmaxf(mx, __shfl_xor(mx, 2)); mx = fmaxf(mx, __shfl_xor(mx, 4)); mx = fmaxf(mx, __shfl_xor(mx, 8)); mx = fmaxf(mx, __shfl_xor(mx, 16)); mx = fmaxf(mx, __shfl_xor(mx, 32));
        ga[(6 + d) * CH + i] = a; if ((i & 63) == 0) ga[8 * CH + 8 + 2 * d + (i >> 6)] = mx; }
    __syncthreads();
    if (F.tid < 2 * CH) { const int d = F.tid >> 7, i = F.tid & 127; const float mx = fmaxf(ga[8 * CH + 8 + 2 * d], ga[8 * CH + 8 + 2 * d + 1]);
        const LAS float* bc = ga + (4 + d) * CH; ga[(6 + d) * CH + i] = expf(ga[(6 + d) * CH + i] - mx);
        if (i == 0) { ga[8 * CH + 2 * d] = mx; ga[8 * CH + 2 * d + 1] = d ? bc[0] : bc[CH - 1]; } }
    __syncthreads();
    const bf16_t* P = F.wsp<bf16_t>(WS_P); const float* cw = F.in[I_MLCW]; const float* cb = F.in[I_MLCB];
    { const int s = F.tid & 127, fgq = F.tid >> 7; bool hl, hr; conv_nbr(cs, s, hl, hr); const float wf = ga[6 * CH + s], wb = ga[7 * CH + s];
#pragma unroll
        for (int i = 0; i < 4; ++i) { const int f0 = (fgq + 4 * i) * 8;
            float kv[8]; conv3x8(P + (size_t)(m0 + s) * AB_MAIN + 3 * HYD + MLD + h * DH + f0, AB_MAIN, hl, hr, cw + MLD + h * DH + f0, 2 * MLD, cb + MLD + h * DH + f0, kv);
            float vv[8]; unpack8(*(const u32x4*)(P + (size_t)(m0 + s) * AB_MAIN + 3 * HYD + 2 * MLD + h * DH + f0), vv);
#pragma unroll
            for (int j = 0; j < 8; ++j) { const float kk = siluf(kv[j]); KwF[(f0 + j) * TP + s] = (bf16_t)f2bf(kk * wf); KwB[(f0 + j) * TP + s] = (bf16_t)f2bf(kk * wb); VT[(f0 + j) * TP + s] = (bf16_t)f2bf(vv[j]); } } }
    __syncthreads();
    const int wm = F.wave >> 1, wn = F.wave & 1, r = F.lane & 15, q = F.lane >> 4;
#pragma unroll
    for (int d = 0; d < 2; ++d) {
        f32x4 acc[2][4]; zero_acc(acc);
        wave_mma<2, 4, 4>(acc, d ? KwB : KwF, 32 * wm, VT, 64 * wn, F.lane);
        bf16_t* ct = (bf16_t*)mlst_slot(F, d, b, h, cs);
#pragma unroll
        for (int mt = 0; mt < 2; ++mt)
#pragma unroll
            for (int nt = 0; nt < 4; ++nt) { u32x2 w; w.x = pk2(acc[mt][nt][0], acc[mt][nt][1]); w.y = pk2(acc[mt][nt][2], acc[mt][nt][3]);
                *(u32x2*)(ct + (64 * wn + 16 * nt + r) * DH + 32 * wm + 16 * mt + 4 * q) = w; }
    }
    if (F.tid < 2 * CH) { const int d = F.tid >> 7, kk = F.tid & 127; const LAS bf16_t* row = (d ? KwB : KwF) + kk * TP; float s = 0.f;
        for (int i = 0; i < CH; i += 8) { float f[8]; unpack8(*(const LAS u32x4*)(row + i), f);
#pragma unroll
            for (int j = 0; j < 8; ++j) s += f[j]; }
        float* sl = mlst_slot(F, d, b, h, cs); sl[MLST_CT + kk] = s;
        if (kk == 0) { sl[MLST_CT + DH] = ga[8 * CH + 2 * d]; sl[MLST_CT + DH + 1] = ga[8 * CH + 2 * d + 1]; } }
    __syncthreads();
}

__device__ __forceinline__ void mlstm_carry(const Frame& F) {
    constexpr int NCI = DH * DH / 8, NVI = NCI + DH / 4, NITEM = 2 * NB * MLH * NVI;
    for (int it = F.bid * NTHREADS + F.tid; it < NITEM; it += F.G * NTHREADS) {
        const int grp = it / NVI, e = it % NVI, d = grp / (NB * MLH), b = (grp / MLH) % NB, h = grp % MLH;
        float st[8];
#pragma unroll
        for (int j = 0; j < 8; ++j) st[j] = 0.f;
        float mp = 0.f;
        u32x4 lc[NCS]; float mls[NCS], gs[NCS];
#pragma unroll
        for (int qi = 0; qi < NCS; ++qi) { const float* sl = mlst_slot(F, d, b, h, scan_slot(d, qi)); mls[qi] = sl[MLST_CT + DH]; gs[qi] = sl[MLST_CT + DH + 1];
            lc[qi] = e < NCI ? *((const u32x4*)sl + e) : __builtin_bit_cast(u32x4, *((const f32x4*)(sl + MLST_CT) + (e - NCI))); }
#pragma unroll
        for (int qi = 0; qi < NCS; ++qi) { float* sl = mlst_slot(F, d, b, h, scan_slot(d, qi));
            const float ml = mls[qi], g = gs[qi];
            const float mn = fmaxf(g + mp, ml), sp = expf(g + mp - mn), slc = expf(ml - mn);
            if (e < NCI) { u32x4* pp = (u32x4*)sl + e; float loc[8]; unpack8(lc[qi], loc);
                u32x4 w; w.x = pk2(st[0], st[1]); w.y = pk2(st[2], st[3]); w.z = pk2(st[4], st[5]); w.w = pk2(st[6], st[7]); *pp = w;
#pragma unroll
                for (int j = 0; j < 8; ++j) st[j] = st[j] * sp + loc[j] * slc; }
            else { f32x4* pp = (f32x4*)(sl + MLST_CT) + (e - NCI); const f32x4 loc = __builtin_bit_cast(f32x4, lc[qi]); *pp = (f32x4){st[0], st[1], st[2], st[3]};
                st[0] = st[0] * sp + loc[0] * slc; st[1] = st[1] * sp + loc[1] * slc; st[2] = st[2] * sp + loc[2] * slc; st[3] = st[3] * sp + loc[3] * slc;
                if (e == NCI) sl[MLST_CT + DH + 2] = mp; }
            mp = mn; }
    }
}

__device__ __forceinline__ void mlstm_out_unit(const Frame& F0, int b, int h, int cs) {
    Frame F = F0; LAUNDER(F.tid); F.lane = F.tid & 63;
    LAS bf16_t* Qs = (LAS bf16_t*)F.lds; LAS bf16_t* Ks = (LAS bf16_t*)(F.lds + TILE_B); LAS bf16_t* VT = (LAS bf16_t*)(F.lds + 2 * TILE_B); LAS bf16_t* Cs = (LAS bf16_t*)(F.lds + 3 * TILE_B);
    LAS bf16_t* Ss = Ks;
    LAS float* Hs = (LAS float*)F.lds;
    LAS float* ga = (LAS float*)(F.lds + 4 * TILE_B);
    LAS float* den2 = ga;
    LAS float* qn = ga + 2 * CH;
    LAS float* nin = ga + 3 * CH;
    static_assert(4 * TILE_B + 14 * CH * 4 <= LDS_MISC, "mLSTM out LDS");
    const int m0 = chunk_row0(b, cs);
    const bf16_t* P = F.wsp<bf16_t>(WS_P); const float* cw = F.in[I_MLCW]; const float* cb = F.in[I_MLCB];
    u32x4 cpre[4], opre[4]; float npre = 0.f;
    { const u32x4* s0 = (const u32x4*)mlst_slot(F, 0, b, h, cs);
#pragma unroll
        for (int i = 0; i < 4; ++i) cpre[i] = s0[F.tid + NTHREADS * i];
        if (F.tid < DH) npre = mlst_slot(F, 0, b, h, cs)[MLST_CT + F.tid];
        const bf16_t* op = P + (size_t)(m0 + (F.tid >> 2)) * AB_MAIN + 3 * HYD + 3 * MLD + h * DH + (F.tid & 3) * 32;
#pragma unroll
        for (int i = 0; i < 4; ++i) opre[i] = *(const u32x4*)(op + 8 * i); }
    __syncthreads();
    mlstm_gates(F, ga, m0, h);
    if (F.wave < 2) { const int d = F.wave; const LAS float* bc = ga + (4 + d) * CH; const LAS float* ig = ga + (1 + 2 * d) * CH;
        const int i0 = d ? CH - 1 - 2 * F.lane : 2 * F.lane, i1 = d ? i0 - 1 : i0 + 1; ga[(6 + d) * CH + i0] = ig[i0] - bc[i0]; ga[(6 + d) * CH + i1] = ig[i1] - bc[i1];
        wave_scan128<true>(ga + (6 + d) * CH, ga + (8 + d) * CH, d != 0, F.lane); }
    { const int fg = F.tid & 15, sr = F.tid >> 4, f0 = fg * 8; const float qs = 0.08838834764831845f;
        const float* wq = cw + h * DH + f0; const float* wk = cw + MLD + h * DH + f0;
        f32x4 wqa[3], wqb[3], wka[3], wkb[3];
#pragma unroll
        for (int tp = 0; tp < 3; ++tp) { wqa[tp] = *(const f32x4*)(wq + tp * 2 * MLD); wqb[tp] = *(const f32x4*)(wq + tp * 2 * MLD + 4); wka[tp] = *(const f32x4*)(wk + tp * 2 * MLD); wkb[tp] = *(const f32x4*)(wk + tp * 2 * MLD + 4); }
        const f32x4 bqa = *(const f32x4*)(cb + h * DH + f0), bqb = *(const f32x4*)(cb + h * DH + f0 + 4), bka = *(const f32x4*)(cb + MLD + h * DH + f0), bkb = *(const f32x4*)(cb + MLD + h * DH + f0 + 4);
#pragma unroll 2
        for (int ps = 0; ps < CH / 32; ++ps) { const int s = 32 * ps + sr; bool hl, hr; conv_nbr(cs, s, hl, hr);
            const bf16_t* qp = P + (size_t)(m0 + s) * AB_MAIN + 3 * HYD + h * DH + f0; const bf16_t* kp = qp + MLD;
            const u32x4 z4 = {0u, 0u, 0u, 0u};
            const u32x4 qc = *(const u32x4*)qp, kc = *(const u32x4*)kp;
            u32x4 ql = z4, qr = z4, kl = z4, kr_ = z4;
            if (hl) { ql = *(const u32x4*)(qp - AB_MAIN); kl = *(const u32x4*)(kp - AB_MAIN); }
            if (hr) { qr = *(const u32x4*)(qp + AB_MAIN); kr_ = *(const u32x4*)(kp + AB_MAIN); }
            float xl[8], xc[8], xr[8], qv[8], kv[8];
            unpack8(ql, xl); unpack8(qc, xc); unpack8(qr, xr);
#pragma unroll
            for (int j = 0; j < 4; ++j) { qv[j] = bqa[j] + wqa[0][j] * xl[j] + wqa[1][j] * xc[j] + wqa[2][j] * xr[j]; qv[4 + j] = bqb[j] + wqb[0][j] * xl[4 + j] + wqb[1][j] * xc[4 + j] + wqb[2][j] * xr[4 + j]; }
            unpack8(kl, xl); unpack8(kc, xc); unpack8(kr_, xr);
#pragma unroll
            for (int j = 0; j < 4; ++j) { kv[j] = bka[j] + wka[0][j] * xl[j] + wka[1][j] * xc[j] + wka[2][j] * xr[j]; kv[4 + j] = bkb[j] + wkb[0][j] * xl[4 + j] + wkb[1][j] * xc[4 + j] + wkb[2][j] * xr[4 + j]; }
            u32x4 qw, kw; qw.x = pk2(siluf(qv[0]) * qs, siluf(qv[1]) * qs); qw.y = pk2(siluf(qv[2]) * qs, siluf(qv[3]) * qs); qw.z = pk2(siluf(qv[4]) * qs, siluf(qv[5]) * qs); qw.w = pk2(siluf(qv[6]) * qs, siluf(qv[7]) * qs);
            kw.x = pk2(siluf(kv[0]), siluf(kv[1])); kw.y = pk2(siluf(kv[2]), siluf(kv[3])); kw.z = pk2(siluf(kv[4]), siluf(kv[5])); kw.w = pk2(siluf(kv[6]), siluf(kv[7]));
            *(LAS u32x4*)(Qs + s * TP + f0) = qw; *(LAS u32x4*)(Ks + s * TP + f0) = kw; } }
    { const int s = F.tid & 127, fgq = F.tid >> 7;
#pragma unroll
        for (int i = 0; i < 4; ++i) { const int f0 = (fgq + 4 * i) * 8;
            float vv[8]; unpack8(*(const u32x4*)(P + (size_t)(m0 + s) * AB_MAIN + 3 * HYD + 2 * MLD + h * DH + f0), vv);
#pragma unroll
            for (int j = 0; j < 8; ++j) VT[(f0 + j) * TP + s] = (bf16_t)f2bf(vv[j]); } }
    __syncthreads();
    if (F.tid < 2 * CH) { const int d = F.tid >> 7, i = F.tid & 127; const float m_in = mlst_slot(F, d, b, h, cs)[MLST_CT + DH + 2]; const float M = fmaxf(ga[(8 + d) * CH + i], m_in);
        const float bci = ga[(4 + d) * CH + i]; ga[(8 + d) * CH + i] = M; ga[(10 + d) * CH + i] = expf(m_in - M); ga[(12 + d) * CH + i] = expf(-(bci + M)); }
    const int wm = F.wave >> 1, wn = F.wave & 1, r = F.lane & 15, q = F.lane >> 4;
    f32x4 sraw[2][4]; zero_acc(sraw);
    wave_mma<2, 4, 4>(sraw, Qs, 32 * wm, Ks, 64 * wn, F.lane);
    f32x4 hsum[2][4]; zero_acc(hsum);
    __syncthreads();
#pragma unroll 1
    for (int d = 0; d < 2; ++d) {
#pragma unroll
        for (int i = 0; i < 4; ++i) { const int it = F.tid + NTHREADS * i, vv = (8 * it) / DH, kk = (8 * it) % DH; *(LAS u32x4*)(Cs + vv * TP + kk) = cpre[i]; }
        if (F.tid < DH) nin[F.tid] = npre;
        if (d == 0) { const u32x4* s1 = (const u32x4*)mlst_slot(F, 1, b, h, cs);
#pragma unroll
            for (int i = 0; i < 4; ++i) cpre[i] = s1[F.tid + NTHREADS * i];
            if (F.tid < DH) npre = mlst_slot(F, 1, b, h, cs)[MLST_CT + F.tid]; }
        const LAS float* ea = ga + (6 + d) * CH; const LAS float* Ma = ga + (8 + d) * CH;
#pragma unroll
        for (int mt = 0; mt < 2; ++mt)
#pragma unroll
            for (int j = 0; j < 4; ++j) { const int t = 32 * wm + 16 * mt + 4 * q + j; const float Mt = Ma[t]; float rs = 0.f;
#pragma unroll
                for (int nt = 0; nt < 4; ++nt) { const int s = 64 * wn + 16 * nt + r; const bool ok = d ? (s >= t) : (s <= t);
                    const float v = ok ? sraw[mt][nt][j] * FEXP(ea[s] - Mt) : 0.f; rs += v; Ss[t * TP + s] = (bf16_t)f2bf(v); }
                rs += __shfl_xor(rs, 1); rs += __shfl_xor(rs, 2); rs += __shfl_xor(rs, 4); rs += __shfl_xor(rs, 8);
                if (r == 0) den2[wn * CH + t] = rs; }
        __syncthreads();
        if (F.tid < CH) { const LAS bf16_t* row = Qs + F.tid * TP; float s = 0.f;
            for (int i = 0; i < DH; i += 8) { float f[8]; unpack8(*(const LAS u32x4*)(row + i), f);
#pragma unroll
                for (int j = 0; j < 8; ++j) s += f[j] * nin[i + j]; }
            qn[F.tid] = s; }
        f32x4 asv[2][4], aqc[2][4]; zero_acc(asv); zero_acc(aqc);
        wave_mma<2, 4, 4>(asv, Ss, 32 * wm, VT, 64 * wn, F.lane);
        wave_mma<2, 4, 4>(aqc, Qs, 32 * wm, Cs, 64 * wn, F.lane);
        __syncthreads();
        const LAS float* wi = ga + (10 + d) * CH; const LAS float* emt = ga + (12 + d) * CH;
#pragma unroll
        for (int mt = 0; mt < 2; ++mt)
#pragma unroll
            for (int j = 0; j < 4; ++j) { const int t = 32 * wm + 16 * mt + 4 * q + j; const float w = wi[t];
                const float den = den2[t] + den2[CH + t] + w * qn[t]; const float inv = 1.0f / fmaxf(fabsf(den), emt[t]);
#pragma unroll
                for (int nt = 0; nt < 4; ++nt) hsum[mt][nt][j] += (asv[mt][nt][j] + w * aqc[mt][nt][j]) * inv; }
        __syncthreads();
    }
#pragma unroll
    for (int mt = 0; mt < 2; ++mt)
#pragma unroll
        for (int nt = 0; nt < 4; ++nt)
#pragma unroll
            for (int j = 0; j < 4; ++j) Hs[(32 * wm + 16 * mt + 4 * q + j) * 132 + 64 * wn + 16 * nt + r] = hsum[mt][nt][j];
    __syncthreads();
    { const int t = F.tid >> 2, part = F.tid & 3; const LAS float* hr_ = Hs + t * 132 + part * 32; float v[32]; float s = 0.f;
#pragma unroll
        for (int i = 0; i < 32; ++i) { v[i] = hr_[i]; s += v[i]; }
        s += __shfl_xor(s, 1); s += __shfl_xor(s, 2); const float mu = s * (1.0f / DH); float qv = 0.f;
#pragma unroll
        for (int i = 0; i < 32; ++i) { v[i] -= mu; qv += v[i] * v[i]; }
        qv += __shfl_xor(qv, 1); qv += __shfl_xor(qv, 2); const float inv = 1.0f / sqrtf(qv * (1.0f / DH) + EPS);
        const float* nw = F.in[I_MLNW] + h * DH + part * 32;
        f32x4 nwv[8];
#pragma unroll
        for (int i = 0; i < 8; ++i) nwv[i] = *(const f32x4*)(nw + 4 * i);
        bf16_t* yp = F.wsp<bf16_t>(WS_YCAT) + (size_t)(m0 + t) * YC1 + HYD + h * DH + part * 32;
#pragma unroll
        for (int i = 0; i < 32; i += 8) { float o[8]; unpack8(opre[i >> 3], o); float y[8];
#pragma unroll
            for (int j = 0; j < 8; ++j) y[j] = v[i + j] * inv * nwv[(i + j) >> 2][(i + j) & 3] * sigmoidf_(o[j]);
            u32x4 w; w.x = pk2(y[0], y[1]); w.y = pk2(y[2], y[3]); w.z = pk2(y[4], y[5]); w.w = pk2(y[6], y[7]); *(u32x4*)(yp + i) = w; } }
    __syncthreads();
}

__device__ __forceinline__ float* ssd_slot(const Frame& F, int d, int b, int hd, int cs) { return F.wsp<float>(WS_SSDST) + ((((size_t)d * NB + b) * SSDH + hd) * NCS + cs) * SSDST_STRIDE; }
constexpr int XB_B = SSDD + SSDD, XB_C = SSDD + SSDD + SSDG * SSDN;

__device__ __forceinline__ void ssd_act_pass(const Frame& F) {
    const bf16_t* P = F.wsp<bf16_t>(WS_P); bf16_t* XA = F.wsp<bf16_t>(WS_XACT); const float* cw = F.in[I_SSDCW]; const float* cb = F.in[I_SSDCB];
    constexpr int NFG = XBC / 8;
    const int stride = F.G * NTHREADS; constexpr int AB_ = 4;
    for (int idx0 = F.bid * NTHREADS + F.tid; idx0 < MT * NFG; idx0 += AB_ * stride) {
        float v[AB_][8];
#pragma unroll
        for (int j = 0; j < AB_; ++j) { const int ij = idx0 + j * stride; const int idx = ij < MT * NFG ? ij : idx0; const int m = idx / NFG, c = (idx % NFG) * 8; bool hl, hr;
            if (m < ML) { hl = (m & (GW - 1)) != 0; hr = (m & (GW - 1)) != GW - 1; } else { const int pos = (m - ML) % CTX; hl = pos > 0; hr = pos < CTX - 1; }
            conv3x8(P + (size_t)m * CD_MAIN + SSDD + c, CD_MAIN, hl, hr, cw + c, XBC, cb + c, v[j]); }
#pragma unroll
        for (int j = 0; j < AB_; ++j) { const int idx = idx0 + j * stride; if (idx < MT * NFG) { const int m = idx / NFG, c = (idx % NFG) * 8;
            u32x4 w; w.x = pk2(siluf(v[j][0]), siluf(v[j][1])); w.y = pk2(siluf(v[j][2]), siluf(v[j][3])); w.z = pk2(siluf(v[j][4]), siluf(v[j][5])); w.w = pk2(siluf(v[j][6]), siluf(v[j][7]));
            *(u32x4*)(XA + (size_t)m * XBC + c) = w; } }
    }
}
__device__ __forceinline__ void ssd_local_unit(const Frame& F0, int b, int cs, int g, int d, int hh) {
    Frame F = F0; LAUNDER(F.tid); F.lane = F.tid & 63;
    LAS bf16_t* BT = (LAS bf16_t*)F.lds; LAS bf16_t* XwT = (LAS bf16_t*)(F.lds + TILE_B);
    LAS float* ar = (LAS float*)(F.lds + 3 * TILE_B);
    const int m0 = chunk_row0(b, cs); const bf16_t* P = F.wsp<bf16_t>(WS_P); const float* sd = F.wsp<float>(WS_SIDE);
    const float* cw = F.in[I_SSDCW]; const float* cb = F.in[I_SSDCB];
    __syncthreads();
    { const int s = F.tid & 127, j = F.tid >> 7, hd = g * HPG + hh * 4 + j;
        const float dtv = softplusf_(sd[(size_t)(m0 + s) * 32 + d * SSDH + hd] + F.in[I_SSDDTB][d * SSDH + hd]);
        ar[j * CH + s] = dtv; ar[(4 + j) * CH + s] = -dtv * expf(F.in[I_SSDALOG][d * SSDH + hd]); }
    __syncthreads();
    if (F.wave < 4) { const int j = F.wave; LAS float* la = ar + (4 + j) * CH; wave_scan128<false>(la, la, d != 0, F.lane);
        if (F.lane == 0) ssd_slot(F, d, b, g * HPG + hh * 4 + j, cs)[SSD_HF] = expf(d ? la[0] : la[CH - 1]); }
    __syncthreads();
    { const int i = F.tid & 127, j = F.tid >> 7; const LAS float* la = ar + (4 + j) * CH; const float aend = d ? la[0] : la[CH - 1]; ar[(8 + j) * CH + i] = expf(aend - la[i]) * ar[j * CH + i]; }
    __syncthreads();
    { const int s = F.tid & 127, fgq = F.tid >> 7; const bf16_t* xrow = F.wsp<bf16_t>(WS_XACT) + (size_t)(m0 + s) * XBC;
#pragma unroll
        for (int i = 0; i < 4; ++i) { const int f0 = (fgq + 4 * i) * 8; const u32x4 w = *(const u32x4*)(xrow + SSDD + g * SSDN + f0);
            BT[(f0 + 0) * TP + s] = (bf16_t)(w.x & 0xffffu); BT[(f0 + 1) * TP + s] = (bf16_t)(w.x >> 16); BT[(f0 + 2) * TP + s] = (bf16_t)(w.y & 0xffffu); BT[(f0 + 3) * TP + s] = (bf16_t)(w.y >> 16);
            BT[(f0 + 4) * TP + s] = (bf16_t)(w.z & 0xffffu); BT[(f0 + 5) * TP + s] = (bf16_t)(w.z >> 16); BT[(f0 + 6) * TP + s] = (bf16_t)(w.w & 0xffffu); BT[(f0 + 7) * TP + s] = (bf16_t)(w.w >> 16); }
#pragma unroll
        for (int i = 0; i < 8; ++i) { const int fg = fgq + 4 * i, j = fg >> 3, p0 = (fg & 7) * 8; float v[8]; unpack8(*(const u32x4*)(xrow + (g * HPG + hh * 4 + j) * SSDP + p0), v); const float we = ar[(8 + j) * CH + s];
#pragma unroll
            for (int jj = 0; jj < 8; ++jj) XwT[(j * 64 + p0 + jj) * TP + s] = (bf16_t)f2bf(v[jj] * we); } }
    __syncthreads();
    f32x4 acc[8][2]; zero_acc(acc);
    wave_mma<8, 2, 4>(acc, BT, 0, XwT, 32 * F.wave, F.lane);
    const int r = F.lane & 15, q = F.lane >> 4;
#pragma unroll
    for (int nt = 0; nt < 2; ++nt) { const int jp = 32 * F.wave + 16 * nt + r, j = jp >> 6, p = jp & 63; bf16_t* sl = (bf16_t*)ssd_slot(F, d, b, g * HPG + hh * 4 + j, cs) + p * SSDN;
#pragma unroll
        for (int mt = 0; mt < 8; ++mt) { u32x2 w; w.x = pk2(acc[mt][nt][0], acc[mt][nt][1]); w.y = pk2(acc[mt][nt][2], acc[mt][nt][3]); *(u32x2*)(sl + 16 * mt + 4 * q) = w; } }
    __syncthreads();
}

__device__ __forceinline__ void ssd_carry(const Frame& F) {
    constexpr int NVI = SSDP * SSDN / 8, NITEM = 2 * NB * SSDH * NVI;
    for (int it = F.bid * NTHREADS + F.tid; it < NITEM; it += F.G * NTHREADS) {
        const int grp = it / NVI, e = it % NVI, d = grp / (NB * SSDH), b = (grp / SSDH) % NB, hd = grp % SSDH;
        float st[8];
#pragma unroll
        for (int j = 0; j < 8; ++j) st[j] = 0.f;
        u32x4 lc[NCS]; float decs[NCS];
#pragma unroll
        for (int qi = 0; qi < NCS; ++qi) { const float* sl = ssd_slot(F, d, b, hd, scan_slot(d, qi)); lc[qi] = *((const u32x4*)sl + e); decs[qi] = sl[SSD_HF]; }
#pragma unroll
        for (int qi = 0; qi < NCS; ++qi) { float* sl = ssd_slot(F, d, b, hd, scan_slot(d, qi)); u32x4* pp = (u32x4*)sl + e; float loc[8]; unpack8(lc[qi], loc); const float dec = decs[qi];
            u32x4 w; w.x = pk2(st[0], st[1]); w.y = pk2(st[2], st[3]); w.z = pk2(st[4], st[5]); w.w = pk2(st[6], st[7]); *pp = w;
#pragma unroll
            for (int j = 0; j < 8; ++j) st[j] = st[j] * dec + loc[j]; }
    }
}

__device__ __forceinline__ void ssd_out_unit(const Frame& F0, int b, int lc, int g, int hh) {
    Frame F = F0; LAUNDER(F.tid); F.lane = F.tid & 63;
    LAS bf16_t* Cs = (LAS bf16_t*)F.lds; LAS bf16_t* Bs = (LAS bf16_t*)(F.lds + TILE_B); LAS bf16_t* Ls = Bs;
    LAS bf16_t* XT = (LAS bf16_t*)(F.lds + 2 * TILE_B); LAS bf16_t* Hs = (LAS bf16_t*)(F.lds + 2 * TILE_B + 64 * TP * 2);
    LAS float* ar = (LAS float*)(F.lds + 3 * TILE_B);
    const int cs = NCC + lc, m0 = b * SEQ + lc * CH; const bf16_t* P = F.wsp<bf16_t>(WS_P); const float* sd = F.wsp<float>(WS_SIDE);
    const float* cw = F.in[I_SSDCW]; const float* cb = F.in[I_SSDCB];
    __syncthreads();
    { const int s = F.tid & 127, j = F.tid >> 7, hd = g * HPG + hh * 4 + j;
#pragma unroll
        for (int d = 0; d < 2; ++d) { const float dtv = softplusf_(sd[(size_t)(m0 + s) * 32 + d * SSDH + hd] + F.in[I_SSDDTB][d * SSDH + hd]);
            ar[(d * 4 + j) * CH + s] = dtv; ar[(8 + d * 4 + j) * CH + s] = -dtv * expf(F.in[I_SSDALOG][d * SSDH + hd]); } }
    __syncthreads();
    { const int k = F.wave, d = k >> 2; LAS float* la = ar + (8 + k) * CH; wave_scan128<false>(la, la, d != 0, F.lane); }
    { const int s = F.tid & 127, fgq = F.tid >> 7; const bf16_t* xrow = F.wsp<bf16_t>(WS_XACT) + (size_t)(m0 + s) * XBC;
#pragma unroll
        for (int i = 0; i < 4; ++i) { const int f0 = (fgq + 4 * i) * 8;
            *(LAS u32x4*)(Bs + s * TP + f0) = *(const u32x4*)(xrow + SSDD + g * SSDN + f0);
            *(LAS u32x4*)(Cs + s * TP + f0) = *(const u32x4*)(xrow + SSDD + SSDG * SSDN + g * SSDN + f0); } }
    __syncthreads();
    const int wm = F.wave >> 1, wn = F.wave & 1, r = F.lane & 15, q = F.lane >> 4;
    f32x4 cbm[2][4]; zero_acc(cbm);
    wave_mma<2, 4, 4>(cbm, Cs, 32 * wm, Bs, 64 * wn, F.lane);
    float ssq[2][4];
#pragma unroll
    for (int mt = 0; mt < 2; ++mt)
#pragma unroll
        for (int jj = 0; jj < 4; ++jj) ssq[mt][jj] = 0.f;
    LAS bf16_t* Hs2 = (LAS bf16_t*)(F.lds + 3 * TILE_B + 18 * CH * 4);
    static_assert(3 * TILE_B + 18 * CH * 4 + 64 * TP * 2 <= LDS_MISC, "ssd out LDS");
    u32x4 hpre[4], xpre[2];
    const int xs_ = F.tid & 127, xfq = F.tid >> 7; const bf16_t* xrow = F.wsp<bf16_t>(WS_XACT) + (size_t)(m0 + xs_) * XBC;
#define SSD_LOADH(jn) do { const u32x4* sf_ = (const u32x4*)ssd_slot(F, 0, b, g * HPG + hh * 4 + (jn), cs); const u32x4* sb_ = (const u32x4*)ssd_slot(F, 1, b, g * HPG + hh * 4 + (jn), cs); \
        hpre[0] = sf_[F.tid]; hpre[1] = sf_[F.tid + NTHREADS]; hpre[2] = sb_[F.tid]; hpre[3] = sb_[F.tid + NTHREADS]; } while (0)
#define SSD_LOADX(jn) do { xpre[0] = *(const u32x4*)(xrow + (g * HPG + hh * 4 + (jn)) * SSDP + xfq * 8); xpre[1] = *(const u32x4*)(xrow + (g * HPG + hh * 4 + (jn)) * SSDP + (xfq + 4) * 8); } while (0)
    SSD_LOADH(0); SSD_LOADX(0);
#pragma unroll 1
    for (int j = 0; j < 4; ++j) {
        const int hd = g * HPG + hh * 4 + j;
        __syncthreads();
#pragma unroll
        for (int i = 0; i < 2; ++i) { const int f0 = (xfq + 4 * i) * 8; const u32x4 w = xpre[i];
            XT[(f0 + 0) * TP + xs_] = (bf16_t)(w.x & 0xffffu); XT[(f0 + 1) * TP + xs_] = (bf16_t)(w.x >> 16); XT[(f0 + 2) * TP + xs_] = (bf16_t)(w.y & 0xffffu); XT[(f0 + 3) * TP + xs_] = (bf16_t)(w.y >> 16);
            XT[(f0 + 4) * TP + xs_] = (bf16_t)(w.z & 0xffffu); XT[(f0 + 5) * TP + xs_] = (bf16_t)(w.z >> 16); XT[(f0 + 6) * TP + xs_] = (bf16_t)(w.w & 0xffffu); XT[(f0 + 7) * TP + xs_] = (bf16_t)(w.w >> 16); }
#pragma unroll
        for (int i = 0; i < 2; ++i) { const int it = F.tid + NTHREADS * i, p = (8 * it) / SSDN, n = (8 * it) % SSDN; *(LAS u32x4*)(Hs + p * TP + n) = hpre[i]; *(LAS u32x4*)(Hs2 + p * TP + n) = hpre[2 + i]; }
        if (j < 3) { SSD_LOADX(j + 1); SSD_LOADH(j + 1); }
        bf16_t zpre[2][4][2];
#pragma unroll
        for (int mt = 0; mt < 2; ++mt)
#pragma unroll
            for (int jj = 0; jj < 4; ++jj)
#pragma unroll
                for (int nt = 0; nt < 2; ++nt) zpre[mt][jj][nt] = P[(size_t)(m0 + 32 * wm + 16 * mt + 4 * q + jj) * CD_MAIN + hd * SSDP + 32 * wn + 16 * nt + r];
        const LAS float* dtf = ar + j * CH; const LAS float* dtb = ar + (4 + j) * CH; const LAS float* acf = ar + (8 + j) * CH; const LAS float* acb = ar + (12 + j) * CH;
#pragma unroll
        for (int mt = 0; mt < 2; ++mt)
#pragma unroll
            for (int jj = 0; jj < 4; ++jj) { const int t = 32 * wm + 16 * mt + 4 * q + jj; const float atf = acf[t], atb = acb[t];
#pragma unroll
                for (int nt = 0; nt < 4; ++nt) { const int s_ = 64 * wn + 16 * nt + r;
                    const float vf = s_ <= t ? FEXP(atf - acf[s_]) * dtf[s_] : 0.f, vb = s_ >= t ? FEXP(atb - acb[s_]) * dtb[s_] : 0.f;
                    Ls[t * TP + s_] = (bf16_t)f2bf(cbm[mt][nt][jj] * (vf + vb)); } }
        __syncthreads();
        f32x4 ysum[2][2], yof[2][2], yob[2][2]; zero_acc(ysum); zero_acc(yof); zero_acc(yob);
        wave_mma<2, 2, 4>(ysum, Ls, 32 * wm, XT, 32 * wn, F.lane);
        wave_mma<2, 2, 4>(yof, Cs, 32 * wm, Hs, 32 * wn, F.lane);
        wave_mma<2, 2, 4>(yob, Cs, 32 * wm, Hs2, 32 * wn, F.lane);
#pragma unroll
        for (int mt = 0; mt < 2; ++mt)
#pragma unroll
            for (int jj = 0; jj < 4; ++jj) { const int t = 32 * wm + 16 * mt + 4 * q + jj; const float eaf = FEXP(acf[t]), eab = FEXP(acb[t]);
#pragma unroll
                for (int nt = 0; nt < 2; ++nt) ysum[mt][nt][jj] += eaf * yof[mt][nt][jj] + eab * yob[mt][nt][jj]; }
        const float dsk = F.in[I_SSDD][hd];
#pragma unroll
        for (int mt = 0; mt < 2; ++mt)
#pragma unroll
            for (int jj = 0; jj < 4; ++jj) { const int t = 32 * wm + 16 * mt + 4 * q + jj;
#pragma unroll
                for (int nt = 0; nt < 2; ++nt) { const int p = 32 * wn + 16 * nt + r; const float xs = bf2f(XT[p * TP + t]);
                    const float z = bf2f(zpre[mt][jj][nt]); const float y = (ysum[mt][nt][jj] + dsk * xs) * siluf(z);
                    F.wsp<float>(WS_YPRE)[(size_t)(m0 + t) * SSDD + hd * SSDP + p] = y; ssq[mt][jj] += y * y; } }
    }
#undef SSD_LOADH
#undef SSD_LOADX
    LAS float* ssq2 = ar + 16 * CH;
#pragma unroll
    for (int mt = 0; mt < 2; ++mt)
#pragma unroll
        for (int jj = 0; jj < 4; ++jj) { float s = ssq[mt][jj]; s += __shfl_xor(s, 1); s += __shfl_xor(s, 2); s += __shfl_xor(s, 4); s += __shfl_xor(s, 8);
            if (r == 0) ssq2[wn * CH + 32 * wm + 16 * mt + 4 * q + jj] = s; }
    __syncthreads();
    if (F.tid < CH) F.wsp<float>(WS_SSQ)[(size_t)(m0 + F.tid) * 4 + g * 2 + hh] = ssq2[F.tid] + ssq2[CH + F.tid];
    __syncthreads();
}

__device__ __forceinline__ void ssd_norm_rows(const Frame& F, int wg_lo, int wg_cnt) {
    const float* yp = F.wsp<float>(WS_YPRE); const float* sq = F.wsp<float>(WS_SSQ); const float* nw = F.in[I_SSDNW]; bf16_t* Y = F.wsp<bf16_t>(WS_YCAT);
    if (F.bid < wg_lo || F.bid >= wg_lo + wg_cnt) return;
    constexpr int NI = SSDD / 256; static_assert(SSDD % 256 == 0, "ssd norm row pieces");
    f32x4 w4[NI];
#pragma unroll
    for (int i = 0; i < NI; ++i) w4[i] = *(const f32x4*)(nw + 4 * F.lane + 256 * i);
    for (int m = (F.bid - wg_lo) * NWAVES + F.wave; m < ML; m += wg_cnt * NWAVES) { const f32x4 s4 = *(const f32x4*)(sq + (size_t)m * 4); f32x4 y[NI];
#pragma unroll
        for (int i = 0; i < NI; ++i) y[i] = *(const f32x4*)(yp + (size_t)m * SSDD + 4 * F.lane + 256 * i);
        const float rinv = 1.0f / sqrtf((s4[0] + s4[1] + s4[2] + s4[3]) * (1.0f / SSDD) + EPS);
#pragma unroll
        for (int i = 0; i < NI; ++i) { u32x2 w; w.x = pk2(y[i][0] * rinv * w4[i][0], y[i][1] * rinv * w4[i][1]); w.y = pk2(y[i][2] * rinv * w4[i][2], y[i][3] * rinv * w4[i][3]);
            *(u32x2*)(Y + (size_t)m * YC2 + 4 * F.lane + 256 * i) = w; } }
}

__device__ __forceinline__ float* s5_slot(const Frame& F, int d, int b, int cs, int g) { return F.wsp<float>(WS_S5ST) + ((((size_t)d * NB + b) * NCS + cs) * S5G + g) * (S5P * 2); }
__device__ __forceinline__ void s5_load_u(const Frame& F, LAS float* ub, int m0, int g) {
    const bf16_t* P = F.wsp<bf16_t>(WS_P);
#pragma unroll
    for (int k = 0; k < 2; ++k) { const int s = F.lane + 64 * k; const bf16_t* up = P + (size_t)(m0 + s) * CD_MAIN + SSDD + XBC + g * S5GS; float f[8];
        unpack8(*(const u32x4*)up, f);
#pragma unroll
        for (int j = 0; j < 8; ++j) ub[s * 16 + j] = f[j];
        unpack8(*(const u32x4*)(up + 8), f);
#pragma unroll
        for (int j = 0; j < 8; ++j) ub[s * 16 + 8 + j] = f[j]; }
    WAVE_SYNC();
}
#define S5_STEP(s) do { const f32x4 u0 = *(const LAS f32x4*)(ub + (s) * 16), u1 = *(const LAS f32x4*)(ub + (s) * 16 + 4), u2 = *(const LAS f32x4*)(ub + (s) * 16 + 8), u3 = *(const LAS f32x4*)(ub + (s) * 16 + 12); \
    f32x2 b0 = {0.f, 0.f}, b1 = {0.f, 0.f}, b2 = {0.f, 0.f}, b3 = {0.f, 0.f}; _Pragma("unroll") for (int k = 0; k < 4; ++k) { b0 += bb2[k] * (f32x2){u0[k], u0[k]}; b1 += bb2[4 + k] * (f32x2){u1[k], u1[k]}; b2 += bb2[8 + k] * (f32x2){u2[k], u2[k]}; b3 += bb2[12 + k] * (f32x2){u3[k], u3[k]}; } \
    const f32x2 bs = (b0 + b1) + (b2 + b3); \
    const float nr = lbr * xr - lbi * xi + bs[0], ni = lbr * xi + lbi * xr + bs[1]; xr = nr; xi = ni; } while (0)
#define S5_LOAD_PAR(d, g) const float* par = F.wsp<float>(WS_S5PAR) + ((size_t)((d) * S5G + (g)) * S5P + F.lane) * 36; const float lbr = par[0], lbi = par[1]; f32x2 bb2[16]; \
    _Pragma("unroll") for (int k = 0; k < 16; ++k) { bb2[k][0] = par[2 + k]; bb2[k][1] = par[18 + k]; }

__device__ __forceinline__ void s5_local_units(const Frame& F) {
    LAS float* ub = (LAS float*)(F.lds + F.wave * 8192);
    constexpr int NU = 2 * NB * NCS * S5G;
    for (int u = F.gw(); u < NU; u += F.ngw()) { const int g = u % S5G, cs = (u / S5G) % NCS, b = (u / (S5G * NCS)) % NB, d = u / (S5G * NCS * NB);
        WAVE_SYNC();
        s5_load_u(F, ub, chunk_row0(b, cs), g);
        S5_LOAD_PAR(d, g)
        float xr = 0.f, xi = 0.f;
        _Pragma("unroll 4") for (int ii = 0; ii < CH; ++ii) { const int s = d ? CH - 1 - ii : ii; S5_STEP(s); }
        float* sl = s5_slot(F, d, b, cs, g); sl[F.lane * 2] = xr; sl[F.lane * 2 + 1] = xi; }
}
__device__ __forceinline__ void s5_carry(const Frame& F) {
    for (int it = F.bid * NTHREADS + F.tid; it < 2 * NB * S5G * S5P; it += F.G * NTHREADS) { const int p = it % S5P, g = (it / S5P) % S5G, b = (it / (S5P * S5G)) % NB, d = it / (S5P * S5G * NB);
        const float* par = F.wsp<float>(WS_S5PAR) + ((size_t)(d * S5G + g) * S5P + p) * 36; const float pr = par[34], pi = par[35]; float xr = 0.f, xi = 0.f;
        float lrs[NCS], lis[NCS];
#pragma unroll
        for (int qi = 0; qi < NCS; ++qi) { const float* sl = s5_slot(F, d, b, scan_slot(d, qi), g) + p * 2; lrs[qi] = sl[0]; lis[qi] = sl[1]; }
#pragma unroll
        for (int qi = 0; qi < NCS; ++qi) { float* sl = s5_slot(F, d, b, scan_slot(d, qi), g) + p * 2; const float lr = lrs[qi], li = lis[qi]; sl[0] = xr; sl[1] = xi;
            const float nr = pr * xr - pi * xi + lr, ni = pr * xi + pi * xr + li; xr = nr; xi = ni; } }
}
__device__ __forceinline__ void s5_out_units(const Frame& F) {
    LAS float* ub = (LAS float*)(F.lds + F.wave * 16896); LAS bf16_t* xb = (LAS bf16_t*)(F.lds + F.wave * 16896 + 8192);
    const int r = F.lane & 15, q = F.lane >> 4;
    constexpr int NU = NB * NCL * S5G;
    for (int u = F.gw(); u < NU; u += F.ngw()) { const int g = u % S5G, lc = (u / S5G) % NCL, b = u / (S5G * NCL); const int cs = NCC + lc, m0 = b * SEQ + lc * CH;
        WAVE_SYNC();
        s5_load_u(F, ub, m0, g);
        bf16x8 cf[4];
#pragma unroll
        for (int ks = 0; ks < 4; ++ks) { const int k0 = 32 * ks + 8 * q; const bool im = k0 >= 64; const float* cp = (im ? F.in[I_S5CIM] : F.in[I_S5CRE]) + ((size_t)g * S5GS + r) * S5P + (k0 & 63);
#pragma unroll
            for (int j = 0; j < 8; ++j) cf[ks][j] = (short)f2bf(im ? -cp[j] : cp[j]); }
        f32x4 acc[8];
#pragma unroll
        for (int i = 0; i < 8; ++i) acc[i] = (f32x4){0.f, 0.f, 0.f, 0.f};
#pragma unroll
        for (int d = 0; d < 2; ++d) {
            S5_LOAD_PAR(d, g)
            const float* sl = s5_slot(F, d, b, cs, g); float xr = sl[F.lane * 2], xi = sl[F.lane * 2 + 1];
#pragma unroll
            for (int sbi = 0; sbi < 4; ++sbi) { const int sb = d ? 3 - sbi : sbi;
                for (int ii = 0; ii < 32; ++ii) { const int sl_ = d ? 31 - ii : ii; const int s = 32 * sb + sl_; S5_STEP(s);
                    xb[sl_ * TP + F.lane] = (bf16_t)f2bf(xr); xb[sl_ * TP + 64 + F.lane] = (bf16_t)f2bf(xi); }
                WAVE_SYNC();
#pragma unroll
                for (int mt = 0; mt < 2; ++mt)
#pragma unroll
                    for (int ks = 0; ks < 4; ++ks) { const bf16x8 a = *(const LAS bf16x8*)(xb + (16 * mt + r) * TP + 32 * ks + 8 * q); acc[2 * sb + mt] = MFMA16(a, cf[ks], acc[2 * sb + mt]); }
                WAVE_SYNC(); }
        }
        const float dsk = F.in[I_S5D][g * S5GS + r]; bf16_t* out = F.wsp<bf16_t>(WS_S5G);
#pragma unroll
        for (int mtile = 0; mtile < 8; ++mtile)
#pragma unroll
            for (int j = 0; j < 4; ++j) { const int t = 16 * mtile + 4 * q + j; const float v = acc[mtile][j] + dsk * ub[t * 16 + r];
                out[(size_t)(m0 + t) * S5W + g * S5GS + r] = (bf16_t)f2bf(0.5f * v * (1.0f + erff(v * 0.70710678118654752f))); }
    }
}

__device__ __forceinline__ int moe_off(const Frame& F, int e) {
    const unsigned* cnt = F.wsp<unsigned>(WS_CTL) + CW_CNT; int o = 0;
#pragma unroll
    for (int k = 0; k < NE; ++k) o += (k < e) ? (int)((cnt[64 * k] + 255u) & ~255u) : 0;
    return o;
}
__device__ __forceinline__ void phase_moe_scatter(const Frame& F) {
    const unsigned char* A = F.wsp<unsigned char>(WS_A); unsigned char* As = F.wsp<unsigned char>(WS_AS); const int* rt = F.wsp<int>(WS_ROUTE); const float* rp = F.wsp<float>(WS_RPROB);
    int* rowmap = F.wsp<int>(WS_ROWMAP); float* rowp = F.wsp<float>(WS_ROWP);
    constexpr int SBN = 4, SNJ = (D + 1023) / 1024; static_assert(SNJ <= 2 && D % 16 == 0, "scatter row chunks");
    for (int it = F.gw(); it < 2 * ML; it += SBN * F.ngw()) {
        int mm[SBN], ee[SBN], pp[SBN]; u32x4 va[SBN][2];
#pragma unroll
        for (int k = 0; k < SBN; ++k) { const int itk = it + k * F.ngw(); const bool ok = itk < 2 * ML; const int m = ok ? itk >> 1 : 0, slot = itk & 1; mm[k] = ok ? m * 2 + slot : -1;
            ee[k] = rt[m * 4 + slot]; pp[k] = rt[m * 4 + 2 + slot];
#pragma unroll
            for (int j = 0; j < SNJ; ++j) if (16 * F.lane + 1024 * j < D) va[k][j] = *(const u32x4*)(A + (size_t)m * D + 16 * F.lane + 1024 * j); }
#pragma unroll
        for (int k = 0; k < SBN; ++k) { if (mm[k] < 0) continue; const int dst = moe_off(F, ee[k]) + pp[k];
#pragma unroll
            for (int j = 0; j < SNJ; ++j) if (16 * F.lane + 1024 * j < D) *(u32x4*)(As + (size_t)dst * D + 16 * F.lane + 1024 * j) = va[k][j];
            if (F.lane == 0) { rowmap[dst] = mm[k]; rowp[dst] = rp[mm[k]]; } } }
    const unsigned* cnt = F.wsp<unsigned>(WS_CTL) + CW_CNT;
    for (int i = F.bid * NTHREADS + F.tid; i < NE * 256; i += F.G * NTHREADS) { const int e = i >> 8, k = i & 255; const int row = moe_off(F, e) + (int)cnt[64 * e] + k; if (row < moe_off(F, e + 1)) { rowmap[row] = -1; rowp[row] = 0.f; } }
}

__device__ __forceinline__ void phase_final(const Frame& F) {
    const float* XL = F.wsp<float>(WS_XL); const bf16_t* ys = F.wsp<bf16_t>(WS_YSLOT); const float* mod = F.wsp<float>(WS_MOD) + (size_t)1 * NR * 6 * D; const float* fw = F.in[I_FNW];
    const float* pmb = F.wsp<float>(WS_PARTM); const int* rt = F.wsp<int>(WS_ROUTE); const float* rp = F.wsp<float>(WS_RPROB);
    int nfull, KS; moe_down_split(moe_off(F, NE) / 256, nfull, KS); const int row_split = nfull * 256;
    constexpr int NV = D / 256;
    LAS float* gl = (LAS float*)F.lds;
    __syncthreads();
    for (int i = F.tid; i < (NB + 1) * D; i += NTHREADS) gl[i] = i < NB * D ? mod[(size_t)(i / D) * 6 * D + 5 * D + i % D] : fw[i - NB * D];
    __syncthreads();
    i32x4 rtn = {0, 0, 0, 0}; float p0n = 0.f, p1n = 0.f;
    if (F.gw() < ML) { rtn = *(const i32x4*)(rt + F.gw() * 4); p0n = rp[F.gw() * 2]; p1n = rp[F.gw() * 2 + 1]; }
    for (int m = F.gw(); m < ML; m += F.ngw()) { const LAS float* gp = gl + mod_row(m) * D; f32x4 v[NV]; float ss = 0.f;
        const i32x4 rtv = rtn; const float p0 = p0n, p1 = p1n;
        { const int mn = m + F.ngw(); if (mn < ML) { rtn = *(const i32x4*)(rt + mn * 4); p0n = rp[mn * 2]; p1n = rp[mn * 2 + 1]; } }
        const int r0 = moe_off(F, rtv[0]) + rtv[2], r1 = moe_off(F, rtv[1]) + rtv[3]; const bool s0 = r0 >= row_split, s1 = r1 >= row_split;
#pragma unroll
        for (int i = 0; i < NV; ++i) { const int k = 4 * (F.lane + 64 * i); const f32x4 x = *(const f32x4*)(XL + (size_t)m * D + k), g = *(const LAS f32x4*)(gp + k); f32x4 a, b;
            if (s0) { a = *(const f32x4*)(pmb + (size_t)(r0 - row_split) * D + k); for (int ks = 1; ks < KS; ++ks) a += *(const f32x4*)(pmb + ((size_t)ks * PM_ROWS + (r0 - row_split)) * D + k); a *= p0; }
            else { const u32x2 w = *(const u32x2*)(ys + (size_t)m * D + k); a = (f32x4){bf2f(w.x & 0xffffu), bf2f(w.x >> 16), bf2f(w.y & 0xffffu), bf2f(w.y >> 16)}; }
            if (s1) { b = *(const f32x4*)(pmb + (size_t)(r1 - row_split) * D + k); for (int ks = 1; ks < KS; ++ks) b += *(const f32x4*)(pmb + ((size_t)ks * PM_ROWS + (r1 - row_split)) * D + k); b *= p1; }
            else { const u32x2 w = *(const u32x2*)(ys + ((size_t)ML + m) * D + k); b = (f32x4){bf2f(w.x & 0xffffu), bf2f(w.x >> 16), bf2f(w.y & 0xffffu), bf2f(w.y >> 16)}; }
            v[i] = x + g * (a + b); ss += v[i][0] * v[i][0] + v[i][1] * v[i][1] + v[i][2] * v[i][2] + v[i][3] * v[i][3]; }
        ss = wave_sum(ss); const float rinv = 1.0f / sqrtf(ss * (1.0f / (float)D) + EPS);
#pragma unroll
        for (int i = 0; i < NV; ++i) { const int k = 4 * (F.lane + 64 * i); const f32x4 w4 = *(const LAS f32x4*)(gl + NB * D + k); NTST(v[i] * rinv * w4, (f32x4*)(F.out + (size_t)m * D + k)); } }
}

constexpr int NPHASE = 23;
__global__ void __launch_bounds__(NTHREADS, 2) fwd_kernel(Args args) {
#ifdef EMU
    unsigned char* lds_raw = emu::tl_blk->lds;
#else
    extern __shared__ __attribute__((aligned(16))) unsigned char lds_raw[];
#endif
    const int tid0 = threadIdx.x;
    volatile LAS unsigned* misc = (volatile LAS unsigned*)((LAS unsigned char*)lds_raw + LDS_MISC);
    if (tid0 < 16) misc[tid0] = 0u;
    __syncthreads();
    const int lo = args.ph_lo, hi = args.ph_hi;
    XcdBarrier bar = xcd_barrier_post((unsigned*)(args.ws + WS_CTL) + CW_BAR, misc);
#ifndef ONLY_PHASE
#define ONLY_PHASE -1
#endif
#define IN(k) ((ONLY_PHASE < 0 || ONLY_PHASE == (k)) && lo <= (k) && (k) < hi)
#define SEAM(k) do { if (IN(k) && IN((k) + 1)) xcd_barrier(bar); } while (0)
#define MKF() Frame F; { int t_ = tid0; LAUNDER(t_); F.lds = (LAS unsigned char*)lds_raw; F.tid = t_; F.lane = t_ & 63; F.wave = RFL(t_ >> 6); F.G = gridDim.x; F.bid = blockIdx.x; F.in = args.in; F.out = args.out; F.ws = args.ws; } \
    float* XL = F.wsp<float>(WS_XL); bf16_t* A = F.wsp<bf16_t>(WS_A); bf16_t* P = F.wsp<bf16_t>(WS_P); bf16_t* Y = F.wsp<bf16_t>(WS_YCAT); bf16_t* H = F.wsp<bf16_t>(WS_H); \
    const float* mod0 = F.wsp<float>(WS_MOD); const float* mod1 = mod0 + (size_t)NR * 6 * D; (void)XL; (void)A; (void)P; (void)Y; (void)H; (void)mod0; (void)mod1;

    if (IN(0)) { MKF() phase_prologue(F); }
    SEAM(0);
    if (IN(1)) { MKF() phase_finalize(F); }
    SEAM(1);
    if (IN(2)) { MKF() modulate_rows<false>(F, F.in[I_X], F.in[I_CTX], 0, 0, A, MT); }
    SEAM(2);
    if (IN(3)) {
        MKF()
        pg8::Gemm g{A, F.wsp<bf16_t>(WS_W_ABIN), MT, AB_MAIN, D}; pg8::StaticOrder S; S.init(MT, AB_MAIN, F.G, F.bid);
        EpiInProj0 E{P, AB_MAIN, F.wsp<bf16_t>(WS_PH)};
        pg8::gemm_phase(F.lds, g, S, E);
        side_gemm(F, A, F.wsp<bf16_t>(WS_W_ABSIDE), F.wsp<float>(WS_SIDE), MT);
    }
    SEAM(3);
    if (IN(4)) {
        MKF()
        hyena_units(F);
        for (int u = F.bid; u < NB * MLH * NCS; u += F.G) mlstm_local_unit(F, u / (MLH * NCS), (u / NCS) % MLH, u % NCS);
    }
    if (IN(4)) { MKF() help_slot(F, 0); }
    SEAM(4);
    if (IN(5)) { MKF() mlstm_carry(F); }
    SEAM(5);
    if (IN(6)) { MKF() for (int u = F.bid; u < NB * MLH * NCS; u += F.G) mlstm_out_unit(F, u / (MLH * NCS), (u / NCS) % MLH, u % NCS); }
    if (IN(6)) { MKF() help_slot(F, 1); }
    SEAM(6);
    if (IN(7)) {
        MKF()
        pg8::Gemm g{Y, F.wsp<bf16_t>(WS_W_ABOUT), MT, D, YC1}; CtxSplitOrder S; S.init(D, YC1, KS7, F.G, F.bid);
        EpiResidSplit E{F.in[I_X], XL, mod0 + 2 * D, F.wsp<float>(WS_PART), YC1 / KS7};
        pg8::gemm_phase(F.lds, g, S, E);
    }
    if (IN(7)) { MKF() help_slot(F, 2); }
    SEAM(7);
    if (IN(8)) { MKF() modulate_rows<false, true>(F, XL, F.in[I_CTX], 0, 3, A, MT, F.wsp<float>(WS_PART), mod0 + (size_t)NB * 6 * D + 2 * D, KS7, XL); }
    SEAM(8);
    if (IN(9)) {
        MKF()
        pg8::Gemm g{F.wsp<bf16_t>(WS_A8), F.wsp<bf16_t>(WS_W_GU), MT, 2 * FF, D / 2}; pg8::StaticOrder S; S.init(MT, 2 * FF, F.G, F.bid);
        EpiGatedI8F8 E{F.wsp<unsigned char>(WS_H), FF, F.wsp<float>(WS_SA8), F.wsp<float>(WS_SB_GU)};
        pg8::gemm_phase(F.lds, g, S, E);
    }
    if (IN(9)) { MKF() help_slot(F, 3); }
    SEAM(9);
    if (IN(10)) {
        MKF()
        pg8::Gemm g{H, F.wsp<bf16_t>(WS_W_DN), MT, D, FF / 2}; CtxSplitOrder S; S.init(D, FF / 2, KS10, F.G, F.bid);
        EpiResidSplitF8 E{XL, XL, mod0 + 5 * D, F.wsp<float>(WS_PART), FF / 2 / KS10};
        pg8::gemm_phase(F.lds, g, S, E);
    }
    if (IN(10)) { MKF() help_slot(F, 4); }
    SEAM(10);
    if (IN(11)) { MKF() modulate_rows<false>(F, XL, XL + (size_t)ML * D, 1, 0, A, MT, F.wsp<float>(WS_PART), mod0 + (size_t)NB * 6 * D + 5 * D, KS10, XL); }
    SEAM(11);
    if (IN(12)) {
        MKF()
        pg8::Gemm g{A, F.wsp<bf16_t>(WS_W_CDIN), MT, CD_MAIN, D}; pg8::StaticOrder S; S.init(MT, CD_MAIN, F.G, F.bid);
        EpiStoreBf16 E{P, CD_MAIN};
        pg8::gemm_phase(F.lds, g, S, E);
        side_gemm(F, A, F.wsp<bf16_t>(WS_W_CDSIDE), F.wsp<float>(WS_SIDE), MT);
    }
    if (IN(12)) { MKF() help_slot(F, 5); }
    SEAM(12);
    if (IN(13)) {
        MKF()
        ssd_act_pass(F);
        xcd_barrier(bar);
        for (int u = F.bid; u < NB * NCS * SSDG * 2 * (HPG / 4); u += F.G) { int r = u; const int hh = r % (HPG / 4); r /= (HPG / 4); const int d = r % 2; r /= 2; const int g = r % SSDG; r /= SSDG; const int cs = r % NCS; r /= NCS;
            ssd_local_unit(F, r, cs, g, d, hh); }
        s5_local_units(F);
    }
    if (IN(13)) { MKF() help_slot(F, 6); }
    SEAM(13);
    if (IN(14)) { MKF() ssd_carry(F); s5_carry(F); }
    SEAM(14);
    if (IN(15)) {
        MKF()
        for (int u = F.bid; u < NB * NCL * SSDG * (HPG / 4); u += F.G) { int r = u; const int hh = r % (HPG / 4); r /= (HPG / 4); const int g = r % SSDG; r /= SSDG; const int lc = r % NCL; r /= NCL;
            ssd_out_unit(F, r, lc, g, hh); }
        __syncthreads();
        s5_out_units(F);
    }
    SEAM(15);
    if (IN(16)) {
        MKF()
        pg8::Gemm g{F.wsp<bf16_t>(WS_S5G), F.wsp<bf16_t>(WS_W_GLU), ML, 2 * S5W, S5W}; pg8::StaticOrder S; S.init(ML, 2 * S5W, F.G, F.bid);
        EpiGated<1> E{Y, YC2, SSDD, 2 * S5W / 256};
        constexpr int NU16 = (ML / 256) * (2 * S5W / 256); const int r16 = NU16 < F.G ? NU16 : 0;
        if (r16 != 0 && F.bid >= r16) ssd_norm_rows(F, r16, F.G - r16);
        pg8::gemm_phase(F.lds, g, S, E);
        if (r16 == 0) ssd_norm_rows(F, 0, F.G);
    }
    if (IN(16)) { MKF() help_slot(F, 7); }
    SEAM(16);
    if (IN(17)) {
        MKF()
        pg8::Gemm g{Y, F.wsp<bf16_t>(WS_W_CDOUT), ML, D, YC2}; pg8::StaticOrder S; S.init(ML, D, F.G, F.bid);
        EpiResid E{XL, XL + (size_t)ML * D, XL, mod1 + 2 * D};
        pg8::gemm_phase(F.lds, g, S, E);
    }
    SEAM(17);
    if (IN(18)) { MKF() modulate_rows<true>(F, XL, XL + (size_t)ML * D, 1, 3, A, ML); }
    SEAM(18);
    if (IN(19)) { MKF() phase_moe_scatter(F); }
    if (IN(19)) { MKF() help_drain(F); }
    SEAM(19);
    if (IN(20)) {
        MKF()
        MoeOrder S; S.init(F, 2 * FF / 256);
        pg8::Gemm g{F.wsp<bf16_t>(WS_AS), F.wsp<bf16_t>(WS_W_MGU), 0, 0, D / 2};
        EpiGatedF8 E{F.wsp<unsigned char>(WS_H), FF, 2 * FF / 256};
        pg8::gemm_phase(F.lds, g, S, E);
    }
    if (IN(20)) { MKF() help_moe_tail(F); }
    SEAM(20);
    if (IN(21)) {
        MKF()
        MoeDownOrder S; S.init(F, D / 256, FF / 2);
        pg8::Gemm g{H, F.wsp<bf16_t>(WS_W_MDN), 0, 0, FF / 2};
        EpiMoeDownSplit E{F.wsp<int>(WS_ROWMAP), F.wsp<float>(WS_ROWP), F.wsp<bf16_t>(WS_YSLOT), F.wsp<float>(WS_PARTM), D / 256, S.nfull * 256, FF / 2 / S.KS, W8INV};
        pg8::gemm_phase(F.lds, g, S, E);
    }
    SEAM(21);
    if (IN(22)) { MKF() phase_final(F); }
#undef IN
#undef SEAM
}

#ifndef N_LAUNCH_MODE
#define N_LAUNCH_MODE 0
#endif
extern "C" void kernel_launch(void* const* d_in, const int* in_sizes, int n_in, void* d_out, int out_size, void* d_ws, size_t ws_size, hipStream_t stream) {
    (void)in_sizes; (void)out_size;
    static int grid = 0;
    if (grid == 0) {
        if (n_in != 44 || ws_size < WS_END) { fprintf(stderr, "kernel_launch: expected 44 inputs and >= %zu bytes of workspace (got %d, %zu)\n", (size_t)WS_END, n_in, ws_size); grid = -1; return; }
#ifdef EMU
        grid = emu_grid_override();
#else
        int dev = 0, cus = 0, per_cu = 0;
        if (hipGetDevice(&dev) != hipSuccess || hipDeviceGetAttribute(&cus, hipDeviceAttributeMultiprocessorCount, dev) != hipSuccess) { grid = -1; return; }
        if (hipFuncSetAttribute((const void*)fwd_kernel, hipFuncAttributeMaxDynamicSharedMemorySize, LDS_BYTES) != hipSuccess) { fprintf(stderr, "kernel_launch: hipFuncSetAttribute failed\n"); grid = -1; return; }
        if (hipOccupancyMaxActiveBlocksPerMultiprocessor(&per_cu, (const void*)fwd_kernel, NTHREADS, LDS_BYTES) != hipSuccess || per_cu < 1) { fprintf(stderr, "kernel_launch: occupancy query says %d\n", per_cu); (void)hipGetLastError(); }
        grid = cus;
#endif
    }
    if (grid < 0) return;
    (void)hipMemsetAsync((char*)d_ws + WS_CTL, 0, CTL_BYTES, stream);
    Args a; memset(&a, 0, sizeof(a));
    for (int i = 0; i < 44; ++i) a.in[i] = (const float*)d_in[i];
    a.out = (float*)d_out; a.ws = (unsigned char*)d_ws;
#if N_LAUNCH_MODE == 0
    a.ph_lo = 0; a.ph_hi = NPHASE;
#ifdef EMU
    emu::launch([](void* p) { fwd_kernel(*(Args*)p); }, &a, dim3(grid), dim3(NTHREADS), LDS_BYTES);
#else
    hipLaunchKernelGGL(fwd_kernel, dim3(grid), dim3(NTHREADS), LDS_BYTES, stream, a);
#endif
#else
    for (int ph = 0; ph < NPHASE; ++ph) { a.ph_lo = ph; a.ph_hi = ph + 1;
#ifdef EMU
        emu::launch([](void* p) { fwd_kernel(*(Args*)p); }, &a, dim3(grid), dim3(NTHREADS), LDS_BYTES);
#else
        hipLaunchKernelGGL(fwd_kernel, dim3(grid), dim3(NTHREADS), LDS_BYTES, stream, a);
#endif
    }
#endif
}
#ifdef EMU
#include <string.h>
extern "C" size_t emu_ws_dump_offset(const char* name, size_t* bytes) {
    struct E { const char* n; size_t off, b; };
    const E tab[] = { {"MOD", WS_MOD, (size_t)2 * NR * 6 * D * 4}, {"A", WS_A, (size_t)MT * D * 2}, {"P", WS_P, (size_t)MT * AB_MAIN * 2}, {"SIDE", WS_SIDE, (size_t)MT * 32 * 4},
        {"YCAT", WS_YCAT, (size_t)MT * YC1 * 2}, {"XL", WS_XL, (size_t)MT * D * 4}, {"FILT0", WS_FILT0, (size_t)HYD * 2 * SEQ * 4}, {"L1", WS_L1, (size_t)2 * HYD * 4}, {"H", WS_H, (size_t)MT * FF * 2},
        {"YPRE", WS_YPRE, (size_t)ML * SSDD * 4}, {"S5G", WS_S5G, (size_t)ML * S5W * 2}, {"SSQ", WS_SSQ, (size_t)ML * 4 * 4}, {"MLST", WS_MLST, (size_t)2 * NB * MLH * NCS * MLST_STRIDE * 4} };
    for (const E& e : tab) if (!strcmp(e.n, name)) { *bytes = e.b; return e.off; }
    *bytes = 0; return 0;
}
#endif
```
